# Optimizing an MI355X kernel written in HIP

```python
import jax, jax.numpy as jnp
from jax import lax
import numpy as np

D_MODEL = 1024
BATCH = 16
SEQ = 2048
DEPTH = 4

GRID_W = 64
CTX_LEN = 256
N_MIXERS = 3
N_HEADS = 16
N_KV_HEADS = 4
HEAD_DIM = D_MODEL // N_HEADS
Q_PER_KV = N_HEADS // N_KV_HEADS
QKV_DIM = (N_HEADS + 2 * N_KV_HEADS) * HEAD_DIM
ATTN_SCALE = HEAD_DIM ** -0.5
ROPE_THETA = 10000.0
BLOCK_Q = 128
WINDOW = 128
NA_WIN_H = 8
NA_WIN_W = 16
N_GROUPS = 4
EXPERTS_PER_GROUP = 8
N_EXPERTS = N_GROUPS * EXPERTS_PER_GROUP
TOP_K_IN_GROUP = 2
EXPERT_HIDDEN = D_MODEL // 2
MOE_BLOCK = 128
NORM_EPS = 1e-6
NEG_INF = -1e30
N_A_LAYERS = (DEPTH + N_MIXERS - 1) // N_MIXERS
N_B_LAYERS = (DEPTH + N_MIXERS - 2) // N_MIXERS
N_C_LAYERS = DEPTH // N_MIXERS

kernel_name = 'hybrid_dit_window_dense_natten_hmoe'


def _rmsnorm(x, g):
    x32 = x.astype(jnp.float32)
    y = x32 * lax.rsqrt(jnp.mean(x32 * x32, axis=-1, keepdims=True) + NORM_EPS)
    return (y * g.astype(jnp.float32)).astype(x.dtype)


def _modulate(h, shift, scale):
    return h * (1 + scale) + shift


def _axial_rope_tables(n, dtype):
    t = jnp.arange(n)
    row = (t // GRID_W).astype(jnp.float32)
    col = (t % GRID_W).astype(jnp.float32)
    quarter = HEAD_DIM // 4
    inv = ROPE_THETA ** (-jnp.arange(quarter, dtype=jnp.float32) / quarter)
    ar = row[:, None] * inv
    ac = col[:, None] * inv
    ang = jnp.concatenate([ar, ar, ac, ac], axis=-1)
    return jnp.cos(ang).astype(dtype), jnp.sin(ang).astype(dtype)


def _rot_axial(x):
    r1, r2, c1, c2 = jnp.split(x, 4, axis=-1)
    return jnp.concatenate([-r2, r1, -c2, c1], axis=-1)


def _apply_rope(x, cos, sin):
    shp = (1, x.shape[1]) + (1,) * (x.ndim - 3) + (HEAD_DIM,)
    return x * cos.reshape(shp) + _rot_axial(x) * sin.reshape(shp)


def _split_qkv(h, w_qkv):
    b, n, _ = h.shape
    qkv = h @ w_qkv
    q, k, v = jnp.split(qkv, [N_HEADS * HEAD_DIM, (N_HEADS + N_KV_HEADS) * HEAD_DIM], axis=-1)
    return (q.reshape(b, n, N_KV_HEADS, Q_PER_KV, HEAD_DIM),
            k.reshape(b, n, N_KV_HEADS, HEAD_DIM),
            v.reshape(b, n, N_KV_HEADS, HEAD_DIM))


def _sink_column(sink, lead_shape):
    return jnp.broadcast_to(sink.astype(jnp.float32).reshape(1, N_KV_HEADS, Q_PER_KV, 1, 1), lead_shape + (1,))


def _joint_softmax(s_lat, s_ctx, sink):
    parts = [s_lat, s_ctx]
    if sink is not None:
        parts.append(_sink_column(sink, s_lat.shape[:-1]))
    p = jax.nn.softmax(jnp.concatenate(parts, axis=-1), axis=-1)
    k1 = s_lat.shape[-1]
    c = s_ctx.shape[-1]
    return p[..., :k1], p[..., k1:k1 + c]


def _ctx_self_attention(qc, kc, vc, sink):
    b, n = qc.shape[:2]
    s = jnp.einsum('bqhgd,bkhd->bhgqk', qc, kc).astype(jnp.float32)
    if sink is not None:
        s = jnp.concatenate([s, _sink_column(sink, s.shape[:-1])], axis=-1)
    p = jax.nn.softmax(s, axis=-1)[..., :kc.shape[1]]
    o = jnp.einsum('bhgqk,bkhd->bqhgd', p.astype(vc.dtype), vc)
    return o.reshape(b, n, N_HEADS * HEAD_DIM)


def _mixer_window(q, k, v, kc, vc, sink, cos, sin):
    b, n = q.shape[:2]
    nb = n // BLOCK_Q
    span = BLOCK_Q + 2 * WINDOW
    q_rot = _apply_rope(q, cos, sin)
    pad = ((0, 0), (WINDOW, WINDOW), (0, 0), (0, 0))
    k_pad = jnp.pad(_apply_rope(k, cos, sin), pad)
    v_pad = jnp.pad(v, pad)

    def block(i):
        start = i * BLOCK_Q
        qb = lax.dynamic_slice_in_dim(q_rot, start, BLOCK_Q, 1)
        qpb = lax.dynamic_slice_in_dim(q, start, BLOCK_Q, 1)
        kb = lax.dynamic_slice_in_dim(k_pad, start, span, 1)
        vb = lax.dynamic_slice_in_dim(v_pad, start, span, 1)
        qpos = start + jnp.arange(BLOCK_Q)
        kpos = start - WINDOW + jnp.arange(span)
        mask = ((jnp.abs(kpos[None, :] - qpos[:, None]) <= WINDOW)
                & (kpos >= 0)[None, :] & (kpos < n)[None, :])
        s_lat = jnp.einsum('bqhgd,bkhd->bhgqk', qb, kb).astype(jnp.float32)
        s_lat = jnp.where(mask, s_lat, NEG_INF)
        s_ctx = jnp.einsum('bqhgd,bkhd->bhgqk', qpb, kc).astype(jnp.float32)
        p_lat, p_ctx = _joint_softmax(s_lat, s_ctx, sink)
        return (jnp.einsum('bhgqk,bkhd->bqhgd', p_lat.astype(v.dtype), vb)
                + jnp.einsum('bhgqk,bkhd->bqhgd', p_ctx.astype(vc.dtype), vc))

    o = lax.map(block, jnp.arange(nb))
    return jnp.moveaxis(o, 0, 1).reshape(b, n, N_HEADS * HEAD_DIM)


def _mixer_global(q, k, v, kc, vc, cos, sin):
    b, n = q.shape[:2]
    nb = n // BLOCK_Q
    q_rot = _apply_rope(q, cos, sin)
    k_rot = _apply_rope(k, cos, sin)

    def block(i):
        start = i * BLOCK_Q
        qb = lax.dynamic_slice_in_dim(q_rot, start, BLOCK_Q, 1)
        qpb = lax.dynamic_slice_in_dim(q, start, BLOCK_Q, 1)
        s_lat = jnp.einsum('bqhgd,bkhd->bhgqk', qb, k_rot).astype(jnp.float32)
        s_ctx = jnp.einsum('bqhgd,bkhd->bhgqk', qpb, kc).astype(jnp.float32)
        p_lat, p_ctx = _joint_softmax(s_lat, s_ctx, None)
        return (jnp.einsum('bhgqk,bkhd->bqhgd', p_lat.astype(v.dtype), v)
                + jnp.einsum('bhgqk,bkhd->bqhgd', p_ctx.astype(vc.dtype), vc))

    o = lax.map(block, jnp.arange(nb))
    return jnp.moveaxis(o, 0, 1).reshape(b, n, N_HEADS * HEAD_DIM)


def _na_tables(n):
    rows = n // GRID_W
    wh = min(NA_WIN_H, rows)
    ww = min(NA_WIN_W, GRID_W)
    t = np.arange(n)
    r = t // GRID_W
    cl = t % GRID_W
    rs = np.clip(r - wh // 2, 0, rows - wh)
    cs = np.clip(cl - ww // 2, 0, GRID_W - ww)
    kr = rs[:, None, None] + np.arange(wh)[None, :, None]
    kcol = cs[:, None, None] + np.arange(ww)[None, None, :]
    idx = (kr * GRID_W + kcol).reshape(n, wh * ww)
    rel = ((kr - r[:, None, None] + NA_WIN_H - 1) * (2 * NA_WIN_W - 1)
           + (kcol - cl[:, None, None] + NA_WIN_W - 1)).reshape(n, wh * ww)
    return idx.astype(np.int32), rel.astype(np.int32)


def _mixer_neighbourhood(q, k, v, kc, vc, rpb):
    b, n = q.shape[:2]
    nb = n // BLOCK_Q
    idx, rel = _na_tables(n)
    n_keys = idx.shape[1]
    idx_blocks = jnp.asarray(idx).reshape(nb, BLOCK_Q, n_keys)
    rel_blocks = jnp.asarray(rel).reshape(nb, BLOCK_Q, n_keys)
    rpb_flat = rpb.reshape(N_HEADS, -1)

    def block(args):
        i, idx_b, rel_b = args
        qb = lax.dynamic_slice_in_dim(q, i * BLOCK_Q, BLOCK_Q, 1)
        kg = k[:, idx_b]
        vg = v[:, idx_b]
        bias = rpb_flat[:, rel_b].reshape(N_KV_HEADS, Q_PER_KV, BLOCK_Q, n_keys).astype(jnp.float32)
        s_lat = jnp.einsum('bqhgd,bqkhd->bhgqk', qb, kg).astype(jnp.float32) + bias
        s_ctx = jnp.einsum('bqhgd,bkhd->bhgqk', qb, kc).astype(jnp.float32)
        p_lat, p_ctx = _joint_softmax(s_lat, s_ctx, None)
        return (jnp.einsum('bhgqk,bqkhd->bqhgd', p_lat.astype(v.dtype), vg)
                + jnp.einsum('bhgqk,bkhd->bqhgd', p_ctx.astype(vc.dtype), vc))

    o = lax.map(block, (jnp.arange(nb), idx_blocks, rel_blocks))
    return jnp.moveaxis(o, 0, 1).reshape(b, n, N_HEADS * HEAD_DIM)


def _hier_moe(h, w_group, b_group, w_router, b_router, w_gate, w_up, w_down):
    t, d = h.shape
    p_grp = jax.nn.softmax((h @ w_group + b_group).astype(jnp.float32), axis=-1)
    grp = jnp.argmax(p_grp, axis=-1)
    p_top = jnp.take_along_axis(p_grp, grp[:, None], axis=-1)
    lg = (h @ w_router + b_router).astype(jnp.float32).reshape(t, N_GROUPS, EXPERTS_PER_GROUP)
    lg = jnp.take_along_axis(lg, grp[:, None, None], axis=1)[:, 0]
    p_in, e_in = lax.top_k(jax.nn.softmax(lg, axis=-1), TOP_K_IN_GROUP)
    wts = (p_top * p_in / jnp.sum(p_in, axis=-1, keepdims=True)).reshape(-1)
    eid = (grp[:, None] * EXPERTS_PER_GROUP + e_in).reshape(-1).astype(jnp.int32)
    tok = jnp.repeat(jnp.arange(t, dtype=jnp.int32), TOP_K_IN_GROUP)
    n_asg = t * TOP_K_IN_GROUP
    cap = -(-n_asg // MOE_BLOCK) * MOE_BLOCK + N_EXPERTS * MOE_BLOCK
    n_blocks = cap // MOE_BLOCK
    order = jnp.argsort(eid)
    eid_s = eid[order]
    tok_s = tok[order]
    wts_s = wts[order]
    counts = jnp.bincount(eid, length=N_EXPERTS).astype(jnp.int32)
    padded = (counts + MOE_BLOCK - 1) // MOE_BLOCK * MOE_BLOCK
    pad_end = jnp.cumsum(padded)
    pad_start = pad_end - padded
    start = jnp.cumsum(counts) - counts
    dest = pad_start[eid_s] + jnp.arange(n_asg, dtype=jnp.int32) - start[eid_s]
    tok_buf = jnp.full((cap,), t, jnp.int32).at[dest].set(tok_s)
    w_buf = jnp.zeros((cap,), jnp.float32).at[dest].set(wts_s)
    blk_e = jnp.minimum(jnp.searchsorted(pad_end, jnp.arange(n_blocks, dtype=jnp.int32) * MOE_BLOCK, side='right'),
                        N_EXPERTS - 1)
    h_pad = jnp.concatenate([h, jnp.zeros((1, d), h.dtype)], axis=0)
    xb = h_pad[tok_buf].reshape(n_blocks, MOE_BLOCK, d)

    def expert_block(args):
        xe, e = args
        return (jax.nn.silu(xe @ w_gate[e]) * (xe @ w_up[e])) @ w_down[e]

    y = lax.map(expert_block, (xb, blk_e)).reshape(cap, d)
    out = jax.ops.segment_sum(y.astype(jnp.float32) * w_buf[:, None], tok_buf, num_segments=t + 1)
    return out[:t]


def setup_inputs(seed: int = 0) -> dict:
    key = jax.random.key(seed)
    ks = jax.random.split(key, 24)

    def nrm(k, shape, s):
        return jax.random.normal(k, shape, jnp.float32) * s

    d, f, hd = D_MODEL, EXPERT_HIDDEN, N_HEADS * HEAD_DIM
    return {
        'x': nrm(ks[0], (BATCH, SEQ, d), 1.0),
        'c': nrm(ks[1], (BATCH, d), 1.0),
        'ctx': nrm(ks[2], (BATCH, CTX_LEN, d), 1.0),
        'c_ctx': nrm(ks[3], (d,), 1.0),
        'w_ada': nrm(ks[4], (DEPTH, d, 6 * d), 0.5 * d ** -0.5),
        'b_ada': nrm(ks[5], (DEPTH, 6 * d), 0.02),
        'g_attn': 1.0 + nrm(ks[6], (DEPTH, d), 0.05),
        'w_qkv': nrm(ks[7], (DEPTH, d, QKV_DIM), d ** -0.5),
        'w_o': nrm(ks[8], (DEPTH, hd, d), hd ** -0.5),
        'sink_a': nrm(ks[9], (N_A_LAYERS, N_HEADS), 1.0),
        'gq_b': 1.0 + nrm(ks[10], (N_B_LAYERS, HEAD_DIM), 0.05),
        'gk_b': 1.0 + nrm(ks[11], (N_B_LAYERS, HEAD_DIM), 0.05),
        'rpb_c': nrm(ks[12], (N_C_LAYERS, N_HEADS, 2 * NA_WIN_H - 1, 2 * NA_WIN_W - 1), 0.5),
        'g_ffn': 1.0 + nrm(ks[13], (DEPTH, d), 0.05),
        'w_group': nrm(ks[14], (DEPTH, d, N_GROUPS), d ** -0.5),
        'b_group': nrm(ks[15], (DEPTH, N_GROUPS), 0.01),
        'w_router': nrm(ks[16], (DEPTH, d, N_EXPERTS), d ** -0.5),
        'b_router': nrm(ks[17], (DEPTH, N_EXPERTS), 0.01),
        'w_gate': nrm(ks[18], (DEPTH, N_EXPERTS, d, f), d ** -0.5),
        'w_up': nrm(ks[19], (DEPTH, N_EXPERTS, d, f), d ** -0.5),
        'w_down': nrm(ks[20], (DEPTH, N_EXPERTS, f, d), f ** -0.5),
        'g_final': 1.0 + nrm(ks[21], (d,), 0.05),
    }


def reference(x, c, ctx, c_ctx, w_ada, b_ada, g_attn, w_qkv, w_o, sink_a, gq_b, gk_b, rpb_c, g_ffn,
              w_group, b_group, w_router, b_router, w_gate, w_up, w_down, g_final):
    b, n, d = x.shape
    cos, sin = _axial_rope_tables(n, x.dtype)
    silu_c = jax.nn.silu(c)
    silu_cc = jax.nn.silu(c_ctx)
    xc = ctx
    for i in range(DEPTH):
        m = i % N_MIXERS
        j = i // N_MIXERS
        last = i == DEPTH - 1
        mod = (silu_c @ w_ada[i] + b_ada[i])[:, None, :]
        modc = (silu_cc @ w_ada[i] + b_ada[i])[None, None, :]
        sh_a, sc_a, gt_a, sh_f, sc_f, gt_f = jnp.split(mod, 6, axis=-1)
        shc_a, scc_a, gtc_a, shc_f, scc_f, gtc_f = jnp.split(modc, 6, axis=-1)

        h = _modulate(_rmsnorm(x, g_attn[i]), sh_a, sc_a)
        hc = _modulate(_rmsnorm(xc, g_attn[i]), shc_a, scc_a)
        q, k, v = _split_qkv(h, w_qkv[i])
        qc, kc, vc = _split_qkv(hc, w_qkv[i])
        sink = None
        if m == 0:
            sink = sink_a[j]
        elif m == 1:
            q, k = _rmsnorm(q, gq_b[j]), _rmsnorm(k, gk_b[j])
            qc, kc = _rmsnorm(qc, gq_b[j]), _rmsnorm(kc, gk_b[j])
        q = q * ATTN_SCALE
        qc = qc * ATTN_SCALE
        if m == 0:
            o = _mixer_window(q, k, v, kc, vc, sink, cos, sin)
        elif m == 1:
            o = _mixer_global(q, k, v, kc, vc, cos, sin)
        else:
            o = _mixer_neighbourhood(q, k, v, kc, vc, rpb_c[j])
        x = x + gt_a * (o @ w_o[i])
        if not last:
            oc = _ctx_self_attention(qc, kc, vc, sink)
            xc = xc + gtc_a * (oc @ w_o[i])

        hf = _modulate(_rmsnorm(x, g_ffn[i]), sh_f, sc_f).reshape(b * n, d)
        if last:
            tokens = hf
        else:
            hfc = _modulate(_rmsnorm(xc, g_ffn[i]), shc_f, scc_f).reshape(-1, d)
            tokens = jnp.concatenate([hf, hfc], axis=0)
        y = _hier_moe(tokens, w_group[i], b_group[i], w_router[i], b_router[i],
                      w_gate[i], w_up[i], w_down[i]).astype(x.dtype)
        x = x + gt_f * y[:b * n].reshape(b, n, d)
        if not last:
            xc = xc + gtc_f * y[b * n:].reshape(xc.shape)
    return _rmsnorm(x, g_final)
```

```cpp
#include <hip/hip_runtime.h>
#include <cstdio>
#include <cstdint>

#define LAS __attribute__((address_space(3)))
#define GAS __attribute__((address_space(1)))
#define DI __device__ __forceinline__

typedef unsigned short bf16_t;
typedef short bf16x8 __attribute__((ext_vector_type(8)));
typedef short s16x4 __attribute__((ext_vector_type(4)));
typedef float f32x2 __attribute__((ext_vector_type(2)));
typedef float f32x4 __attribute__((ext_vector_type(4)));
typedef float f32x16 __attribute__((ext_vector_type(16)));
typedef unsigned u32x2 __attribute__((ext_vector_type(2)));
typedef unsigned u32x4 __attribute__((ext_vector_type(4)));

constexpr int NB = 16, SEQ = 2048, DM = 1024, DEPTH = 4, CTXL = 256, NH = 16, NKV = 4, HD = 64, QKVN = 1536;
constexpr int TLAT = NB * SEQ, TCTX = NB * CTXL, TALL = TLAT + TCTX;
constexpr int NEXP = 32, FH = 512;
constexpr int KEYS = SEQ + CTXL, KGRP = KEYS / 8;
constexpr int CAPR = 2 * TALL + NEXP * 256;
constexpr int NWAVES = 8, NTHREADS = 512, GRID = 256;
constexpr float NORM_EPS = 1e-6f, LOG2E = 1.4426950408889634f;

constexpr size_t MiB = 1u << 20;
constexpr size_t WS_CTL = 0, CTL_ZERO_BYTES = 1 * MiB;
constexpr size_t WS_MODP = 1 * MiB;
constexpr size_t WS_MOD = 15 * MiB;
constexpr size_t WS_ROPE = 17 * MiB;
constexpr size_t WS_WRT = 17 * MiB + 65536;
constexpr size_t WS_ASG = 18 * MiB;
constexpr size_t WS_ASGW = 18 * MiB + 512 * 1024;
constexpr size_t WS_SLOT = 19 * MiB;
constexpr size_t WS_TOKS = 19 * MiB + 512 * 1024;
constexpr size_t WS_HIST = 20 * MiB;
constexpr size_t WS_TTAB = 20 * MiB + 65536;
constexpr size_t WS_WQKV = 21 * MiB;
constexpr size_t WS_WO = 33 * MiB;
constexpr size_t WS_WGU = 41 * MiB;
constexpr size_t WS_WD = 297 * MiB;
constexpr size_t WS_X = 425 * MiB;
constexpr size_t WS_H = 569 * MiB;
constexpr size_t WS_R1 = 641 * MiB;
constexpr size_t WS_QKV = WS_R1;
constexpr size_t WS_KF = WS_R1 + 108 * MiB;
constexpr size_t WS_VF = WS_R1 + 126 * MiB;
constexpr size_t WS_O = WS_R1 + 144 * MiB;
constexpr size_t WS_Y = WS_R1;
constexpr size_t WS_ACT = WS_R1 + 160 * MiB;
constexpr size_t WS_END = WS_R1 + 240 * MiB;
constexpr int CW_TMO = 0, CW_BAR = 4096;

constexpr int RING_BYTES = 131072;
constexpr int MISC_OFF = RING_BYTES + 320;
constexpr int LDSX_OFF = RING_BYTES + 1024;
constexpr int LDS_BYTES = 147456;

#define LDS_WAIT() asm volatile("s_waitcnt lgkmcnt(0)" ::: "memory")
#define VM_WAIT() asm volatile("s_waitcnt vmcnt(0)" ::: "memory")

DI unsigned f2bf(float f) { unsigned u = __float_as_uint(f); return (u + 0x7fffu + ((u >> 16) & 1u)) >> 16; }
DI float bf2f(unsigned b) { return __uint_as_float(b << 16); }
DI float bfs2f(short b) { return __uint_as_float(((unsigned)(unsigned short)b) << 16); }
DI unsigned pk2(float lo, float hi) { return f2bf(lo) | (f2bf(hi) << 16); }
DI unsigned cvt_pk_bf16(float lo, float hi) { unsigned r; asm volatile("v_cvt_pk_bf16_f32 %0, %1, %2" : "=v"(r) : "v"(lo), "v"(hi)); return r; }
DI float wave_sum(float v) {
#pragma unroll
    for (int o = 1; o < 64; o <<= 1) v += __shfl_xor(v, o);
    return v;
}
DI int crow(int r, int hi) { return (r & 3) + 8 * (r >> 2) + 4 * hi; }

#define XB_TMO      128
#define XB_XCNT(j)  (256  + 64 * (j))
#define XB_XSUB(j)  (1280 + 64 * (j))
#define XB_XGEN(j)  (2304 + 64 * (j))
#define XB_TOP      3328
#define XB_TOPGEN   3392
#define XCD_BAR_WORDS 3456
#define XB_SPIN_CAP (1u << 18)

__device__ __forceinline__ unsigned xb_ld(unsigned* p)              { return __hip_atomic_load(p, __ATOMIC_RELAXED, __HIP_MEMORY_SCOPE_AGENT); }
__device__ __forceinline__ unsigned xb_add(unsigned* p, unsigned v) { return __hip_atomic_fetch_add(p, v, __ATOMIC_RELAXED, __HIP_MEMORY_SCOPE_AGENT); }
__device__ __forceinline__ unsigned xb_xcc_id() { return (unsigned)__builtin_amdgcn_s_getreg((3 << 11) | 20) & 0xFu; }
#define XB_SPIN(cond, bar) do { unsigned _sp = 0; while (cond) { __builtin_amdgcn_s_sleep(1); \
    if ((++_sp & 255u) == 0u) { if (xb_ld(&(bar)[XB_TMO])) break; if (_sp > XB_SPIN_CAP) { atomicAdd(&(bar)[XB_TMO], 1u); break; } } } } while (0)

struct XcdBarrier { unsigned* bar; unsigned x; volatile LAS unsigned* st; };

__device__ __forceinline__ XcdBarrier xcd_barrier_post(unsigned* bar, volatile LAS unsigned* st) {
    XcdBarrier b; b.bar = bar; b.x = xb_xcc_id(); b.st = st;
    if (threadIdx.x == 0) (void)xb_add(&bar[XB_XCNT(b.x)], 1u);
    return b;
}
__device__ __forceinline__ void xcd_barrier_complete(unsigned* bar, unsigned x, unsigned& nloc, unsigned& nx) {
    const unsigned G = gridDim.x * gridDim.y * gridDim.z;
    unsigned sum, cnt, mine, sp = 0u;
    for (;;) {
        sum = 0u; cnt = 0u; mine = 0u;
#pragma unroll
        for (unsigned j = 0; j < 16; ++j) { const unsigned c = xb_ld(&bar[XB_XCNT(j)]); sum += c; cnt += (c > 0u) ? 1u : 0u; mine = (j == x) ? c : mine; }
        if (sum == G) break;
        __builtin_amdgcn_s_sleep(1);
        if ((++sp & 255u) == 0u) { if (xb_ld(&bar[XB_TMO])) break; if (sp > XB_SPIN_CAP) { atomicAdd(&bar[XB_TMO], 1u); break; } }
    }
    nloc = mine > 0u ? mine : 1u; nx = cnt > 0u ? cnt : 1u;
}
__device__ __forceinline__ void xcd_barrier(const XcdBarrier& b0) {
    XcdBarrier b = b0;
    { const unsigned long long w = (unsigned long long)b0.bar; unsigned lo = __builtin_amdgcn_readfirstlane((unsigned)w), hi = __builtin_amdgcn_readfirstlane((unsigned)(w >> 32)), bx = __builtin_amdgcn_readfirstlane(b0.x);
      asm volatile("" : "+s"(lo), "+s"(hi), "+s"(bx)); b.bar = (unsigned*)(((unsigned long long)hi << 32) | lo); b.x = bx; }
    asm volatile("s_waitcnt vmcnt(0)" ::: "memory");
    __syncthreads();
    if (threadIdx.x == 0) {
        unsigned* bar = b.bar;
        __builtin_amdgcn_s_waitcnt(0);
        unsigned nloc = b.st[0], nx = b.st[1];
        if (nloc == 0u) { xcd_barrier_complete(bar, b.x, nloc, nx); b.st[0] = nloc; b.st[1] = nx; }
        const unsigned old = xb_add(&bar[XB_XSUB(b.x)], 1u);
        const unsigned gen = old / nloc;
        if (old + 1u == (gen + 1u) * nloc) {
            __builtin_amdgcn_fence(__ATOMIC_RELEASE, "agent");
            asm volatile("s_waitcnt vmcnt(0)" ::: "memory");
            const unsigned og = xb_add(&bar[XB_TOP], 1u);
            const unsigned tg = og / nx;
            if (og + 1u == (tg + 1u) * nx) xb_add(&bar[XB_TOPGEN], 1u);
            else XB_SPIN(xb_ld(&bar[XB_TOPGEN]) == tg, bar);
            __builtin_amdgcn_fence(__ATOMIC_ACQUIRE, "agent");
            xb_add(&bar[XB_XGEN(b.x)], 1u);
            asm volatile("s_waitcnt vmcnt(0)" ::: "memory");
        } else {
            XB_SPIN(xb_ld(&bar[XB_XGEN(b.x)]) == gen, bar);
            __builtin_amdgcn_fence(__ATOMIC_ACQUIRE, "agent");
            asm volatile("s_waitcnt vmcnt(0)" ::: "memory");
        }
    }
    __syncthreads();
}

namespace pg8 {
constexpr int BM = 256, BK = 64, HALF = 128, HTB = HALF * BK * 2, STAGE_BYTES = 8 * HTB;
DI int lds_byte(int r, int c) { const int st = (r >> 4) * 2 + (c >> 5), rr = r & 15, cc = c & 31, ob = rr * 64 + cc * 2; return st * 1024 + (ob ^ (((ob >> 9) & 1) << 5)); }
DI void stage_rc(int b, int& R, int& C) { const int st = b / 1024, sb = b % 1024, swz = sb ^ (((sb >> 9) & 1) << 5); R = (st >> 1) * 16 + swz / 64; C = (st & 1) * 32 + (swz % 64) / 2; }
DI int perm32(int rho) { const int n = rho >> 4, i = rho & 15; return 8 * (i >> 2) + 4 * n + (i & 3); }
struct Unit { int pm, pn, e; };

template <class Epi, class Sched>
DI void gemm_phase(LAS unsigned char* lds, const bf16_t* A, const int K, const Sched& S, const Epi& E) {
    int tid_ = threadIdx.x; asm volatile("" : "+v"(tid_));
    const int tid = tid_, wid = __builtin_amdgcn_readfirstlane(tid >> 6), lane = tid & 63, wr = wid >> 2, wc = wid & 3, fr = lane & 15, fq = lane >> 4;
    const int nt = K / BK;
    constexpr bool GA = Sched::GATHER;
    int Rr[2], Cc[2]; unsigned voffB[2], voffA[2];
#pragma unroll
    for (int i = 0; i < 2; ++i) { int R, C; stage_rc(tid * 16 + i * 8192, R, C); const int Rb = Epi::PERM ? ((R & ~31) + perm32(R & 31)) : R;
        Rr[i] = R; Cc[i] = C; voffB[i] = (unsigned)(Rb * K + C) * 2u; voffA[i] = (unsigned)(R * K + C) * 2u; }
    const size_t kstep = (size_t)(BK * 2);
    const size_t hstep = (size_t)HALF * K * 2;
    const unsigned ldsw = (unsigned)wid * 1024u;
    const int aoff = lds_byte(wr * 64 + fr, fq * 8), boff = lds_byte(wc * 32 + fr, fq * 8);
#define PG8_SA(b, h) (((b) * 2 + (h)) * HTB)
#define PG8_SB(b, h) ((4 + (b) * 2 + (h)) * HTB)
#define PG8_STAGE(bufoff, gbase, voff) do { _Pragma("unroll") for (int _i = 0; _i < 2; ++_i) \
        __builtin_amdgcn_global_load_lds((const unsigned*)((const char*)(gbase) + (voff)[_i]), (LAS unsigned*)(lds + (bufoff) + ldsw + _i * 8192), 16, 0, 0); } while (0)
#define PG8_LDA(dst, b, h) do { _Pragma("unroll") for (int m = 0; m < 4; ++m) _Pragma("unroll") for (int k = 0; k < 2; ++k) dst[m][k] = *(const LAS bf16x8*)(lds + PG8_SA(b, h) + aoff + m * 2048 + k * 1024); } while (0)
#define PG8_LDB(dst, b, h) do { _Pragma("unroll") for (int n = 0; n < 2; ++n) _Pragma("unroll") for (int k = 0; k < 2; ++k) dst[n][k] = *(const LAS bf16x8*)(lds + PG8_SB(b, h) + boff + n * 2048 + k * 1024); } while (0)
#define PG8_MMA(ai, bj, At, Bt) do { __builtin_amdgcn_s_setprio(1); _Pragma("unroll") for (int m = 0; m < 4; ++m) _Pragma("unroll") for (int n = 0; n < 2; ++n) _Pragma("unroll") for (int k = 0; k < 2; ++k) \
        acc[ai][bj][m][n] = __builtin_amdgcn_mfma_f32_16x16x32_bf16(Bt[n][k], At[m][k], acc[ai][bj][m][n], 0, 0, 0); __builtin_amdgcn_s_setprio(0); } while (0)
#define PG8_WAIT_V(n) asm volatile("s_waitcnt vmcnt(" #n ")" ::: "memory")
#define PG8_WAIT_L(n) asm volatile("s_waitcnt lgkmcnt(" #n ")" ::: "memory")
#define PG8_BAR __builtin_amdgcn_s_barrier()
#define PG8_SCHED __builtin_amdgcn_sched_barrier(0)
    Unit cur, nxt; int ui = 0;
    if (!S.next(0, cur)) return;
    f32x4 acc[2][2][4][2];
#pragma unroll
    for (int a = 0; a < 2; ++a)
#pragma unroll
        for (int b = 0; b < 2; ++b)
#pragma unroll
            for (int m = 0; m < 4; ++m)
#pragma unroll
                for (int n = 0; n < 2; ++n) acc[a][b][m][n] = (f32x4){0.f, 0.f, 0.f, 0.f};
    bf16x8 At[4][2], B0[2][2], B1[2][2];
    unsigned oc0[2], oc1[2], on0[2], on1[2];
#pragma unroll
    for (int i = 0; i < 2; ++i) { if (GA) { oc0[i] = S.a_off(cur, Rr[i]) + (unsigned)Cc[i] * 2u; oc1[i] = S.a_off(cur, HALF + Rr[i]) + (unsigned)Cc[i] * 2u; } else { oc0[i] = voffA[i]; oc1[i] = voffA[i]; } on0[i] = oc0[i]; on1[i] = oc1[i]; }
    const size_t hA = GA ? (size_t)0 : hstep;
    const char* Ab = GA ? (const char*)A : (const char*)A + (size_t)cur.pm * 2 * hstep;
    const char* cB = S.b_ptr(cur);
    PG8_STAGE(PG8_SB(0, 0), cB, voffB); PG8_STAGE(PG8_SB(0, 1), cB + hstep, voffB); PG8_STAGE(PG8_SA(0, 0), Ab, oc0); PG8_STAGE(PG8_SA(0, 1), Ab + hA, oc1);
    if (wr == 1) PG8_BAR;
    PG8_WAIT_V(2); PG8_BAR;
    PG8_STAGE(PG8_SB(1, 0), cB + kstep, voffB); PG8_STAGE(PG8_SA(1, 0), Ab + kstep, oc0); PG8_STAGE(PG8_SB(1, 1), cB + hstep + kstep, voffB);
    PG8_WAIT_V(6); PG8_BAR;
    for (;;) {
        const bool has_next = S.next(ui + 1, nxt);
        const char* nB = has_next ? S.b_ptr(nxt) : cB;
        const char* nA = GA ? Ab : (has_next ? (const char*)A + (size_t)nxt.pm * 2 * hstep : Ab);
        if (GA) {
            if (has_next) {
#pragma unroll
                for (int i = 0; i < 2; ++i) { on0[i] = S.a_off(nxt, Rr[i]) + (unsigned)Cc[i] * 2u; on1[i] = S.a_off(nxt, HALF + Rr[i]) + (unsigned)Cc[i] * 2u; }
            } else {
#pragma unroll
                for (int i = 0; i < 2; ++i) { on0[i] = oc0[i]; on1[i] = oc1[i]; }
            }
        }
        for (int t = 0; t < nt; t += 2) {
            const bool last = (t == nt - 2);
            const char* a1 = Ab + (size_t)(t + 1) * kstep + hA;
            const char* a2 = last ? nA : Ab + (size_t)(t + 2) * kstep; const char* b2 = last ? nB : cB + (size_t)(t + 2) * kstep;
            const char* a3 = a2 + kstep; const char* b3 = b2 + kstep;
            unsigned o20[2], o21[2];
#pragma unroll
            for (int i = 0; i < 2; ++i) { if (GA) { o20[i] = last ? on0[i] : oc0[i]; o21[i] = last ? on1[i] : oc1[i]; } else { o20[i] = voffA[i]; o21[i] = voffA[i]; } }
            PG8_LDB(B0, 0, 0); PG8_LDB(B1, 0, 1); PG8_SCHED; PG8_LDA(At, 0, 0); PG8_STAGE(PG8_SA(1, 1), a1, oc1);
            PG8_WAIT_V(8); PG8_WAIT_L(0); PG8_BAR; PG8_MMA(0, 0, At, B0); PG8_MMA(0, 1, At, B1); PG8_BAR; PG8_SCHED;
            PG8_LDA(At, 0, 1); PG8_STAGE(PG8_SB(0, 0), b2, voffB); PG8_STAGE(PG8_SB(0, 1), b2 + hstep, voffB); PG8_STAGE(PG8_SA(0, 0), a2, o20);
            PG8_WAIT_V(8); PG8_WAIT_L(0); PG8_BAR; PG8_MMA(1, 0, At, B0); PG8_MMA(1, 1, At, B1); PG8_BAR; PG8_SCHED;
            PG8_LDB(B0, 1, 0); PG8_LDB(B1, 1, 1); PG8_SCHED; PG8_LDA(At, 1, 0); PG8_STAGE(PG8_SA(0, 1), a2 + hA, o21);
            PG8_WAIT_V(8); PG8_WAIT_L(0); PG8_BAR; PG8_MMA(0, 0, At, B0); PG8_MMA(0, 1, At, B1); PG8_BAR; PG8_SCHED;
            PG8_LDA(At, 1, 1); PG8_STAGE(PG8_SB(1, 0), b3, voffB); PG8_STAGE(PG8_SB(1, 1), b3 + hstep, voffB); PG8_STAGE(PG8_SA(1, 0), a3, o20);
            PG8_WAIT_V(8); PG8_WAIT_L(0); PG8_BAR; PG8_MMA(1, 0, At, B0); PG8_MMA(1, 1, At, B1); PG8_BAR; PG8_SCHED;
        }
        if (wr == 0) PG8_BAR;
        E(acc, cur, wr, wc, fr, fq);
        if (!has_next) break;
#pragma unroll
        for (int a = 0; a < 2; ++a)
#pragma unroll
            for (int b = 0; b < 2; ++b)
#pragma unroll
                for (int m = 0; m < 4; ++m)
#pragma unroll
                    for (int n = 0; n < 2; ++n) acc[a][b][m][n] = (f32x4){0.f, 0.f, 0.f, 0.f};
        cur = nxt; cB = nB; Ab = nA; ++ui;
        if (GA) {
#pragma unroll
            for (int i = 0; i < 2; ++i) { oc0[i] = on0[i]; oc1[i] = on1[i]; }
        }
        if (wr == 1) PG8_BAR;
    }
    PG8_WAIT_V(0);
    PG8_BAR;
#undef PG8_SA
#undef PG8_SB
#undef PG8_STAGE
#undef PG8_LDA
#undef PG8_LDB
#undef PG8_MMA
#undef PG8_WAIT_V
#undef PG8_WAIT_L
#undef PG8_BAR
#undef PG8_SCHED
}

struct PlainSched {
    static constexpr bool GATHER = false;
    int nN, nwg, G, c, K; const bf16_t* Bt;
    DI bool next(int i, Unit& u) const { const int L = i * G + c; if (L >= nwg) return false; u.pm = L / nN; u.pn = L - u.pm * nN; u.e = 0; return true; }
    DI unsigned a_off(const Unit& u, int r) const { return (unsigned)(u.pm * BM + r) * (unsigned)(K * 2); }
    DI const char* b_ptr(const Unit& u) const { return (const char*)Bt + (size_t)u.pn * BM * K * 2; }
};
template <bool GATHER_> struct MoeSched {
    static constexpr bool GATHER = GATHER_;
    const LAS unsigned* tab; int G, c, K; const bf16_t* Bt; size_t estride; const unsigned* tok;
    DI bool next(int i, Unit& u) const { const int L = i * G + c; const int ntile = (int)tab[0]; if (L >= ntile * 4) return false; u.pm = L >> 2; u.pn = L & 3; u.e = (int)tab[1 + u.pm]; return true; }
    DI unsigned a_off(const Unit& u, int r) const { const unsigned row = GATHER_ ? tok[u.pm * BM + r] : (unsigned)(u.pm * BM + r); return row * (unsigned)(K * 2); }
    DI const char* b_ptr(const Unit& u) const { return (const char*)Bt + (size_t)u.e * estride + (size_t)u.pn * BM * K * 2; }
};

struct EpiStore {
    static constexpr bool PERM = true;
    bf16_t* O; int ldc;
    DI void operator()(const f32x4 (&acc)[2][2][4][2], const Unit& u, int wr, int wc, int fr, int fq) const {
        const int row0 = u.pm * BM + wr * 64 + fr, col0 = u.pn * BM + wc * 32 + 8 * fq;
#pragma unroll
        for (int ai = 0; ai < 2; ++ai)
#pragma unroll
            for (int m = 0; m < 4; ++m) { bf16_t* rowp = O + (size_t)(row0 + ai * HALF + m * 16) * ldc + col0;
#pragma unroll
                for (int bj = 0; bj < 2; ++bj) { const f32x4 v0 = acc[ai][bj][m][0], v1 = acc[ai][bj][m][1];
                    u32x4 w; w.x = cvt_pk_bf16(v0[0], v0[1]); w.y = cvt_pk_bf16(v0[2], v0[3]); w.z = cvt_pk_bf16(v1[0], v1[1]); w.w = cvt_pk_bf16(v1[2], v1[3]);
                    *(u32x4*)(rowp + bj * HALF) = w; } }
    }
};
struct EpiResid {
    static constexpr bool PERM = false;
    float* X; const float* gate;
    DI void operator()(const f32x4 (&acc)[2][2][4][2], const Unit& u, int wr, int wc, int fr, int fq) const {
        const int mb = (u.pm < TLAT / BM) ? (u.pm >> 3) : 16;
        const float* gt = gate + (size_t)mb * 6144;
        const int row0 = u.pm * BM + wr * 64 + fr, col0 = u.pn * BM + wc * 32 + 4 * fq;
        f32x4 g[2][2];
#pragma unroll
        for (int bj = 0; bj < 2; ++bj)
#pragma unroll
            for (int n = 0; n < 2; ++n) g[bj][n] = *(const f32x4*)(gt + col0 + bj * HALF + n * 16);
#pragma unroll
        for (int ai = 0; ai < 2; ++ai)
#pragma unroll
            for (int m = 0; m < 4; ++m) { float* rowp = X + (size_t)(row0 + ai * HALF + m * 16) * DM + col0;
#pragma unroll
                for (int bj = 0; bj < 2; ++bj)
#pragma unroll
                    for (int n = 0; n < 2; ++n) { f32x4* p = (f32x4*)(rowp + bj * HALF + n * 16); *p = *p + g[bj][n] * acc[ai][bj][m][n]; } }
    }
};
DI float silu_mul(float g, float u) { return g * __builtin_amdgcn_rcpf(1.f + __builtin_amdgcn_exp2f(-g * LOG2E)) * u; }
struct EpiSwiglu {
    static constexpr bool PERM = true;
    bf16_t* ACT;
    DI void operator()(const f32x4 (&acc)[2][2][4][2], const Unit& u, int wr, int wc, int fr, int fq) const {
        const int row0 = u.pm * BM + wr * 64 + fr, col0 = u.pn * HALF + wc * 32 + 8 * fq;
#pragma unroll
        for (int ai = 0; ai < 2; ++ai)
#pragma unroll
            for (int m = 0; m < 4; ++m) { bf16_t* rowp = ACT + (size_t)(row0 + ai * HALF + m * 16) * FH + col0;
                const f32x4 g0 = acc[ai][0][m][0], g1 = acc[ai][0][m][1], u0 = acc[ai][1][m][0], u1 = acc[ai][1][m][1];
                u32x4 w; w.x = cvt_pk_bf16(silu_mul(g0[0], u0[0]), silu_mul(g0[1], u0[1])); w.y = cvt_pk_bf16(silu_mul(g0[2], u0[2]), silu_mul(g0[3], u0[3]));
                w.z = cvt_pk_bf16(silu_mul(g1[0], u1[0]), silu_mul(g1[1], u1[1])); w.w = cvt_pk_bf16(silu_mul(g1[2], u1[2]), silu_mul(g1[3], u1[3]));
                *(u32x4*)rowp = w; }
    }
};
}

struct Params { const float* in[22]; float* out; unsigned char* ws; };
enum { IN_X = 0, IN_C, IN_CTX, IN_CCTX, IN_WADA, IN_BADA, IN_GATTN, IN_WQKV, IN_WO, IN_SINK, IN_GQ, IN_GK, IN_RPB, IN_GFFN, IN_WGROUP, IN_BGROUP, IN_WROUTER, IN_BROUTER, IN_WGATE, IN_WUP, IN_WDOWN, IN_GFINAL };

DI const float* inp(const Params& P, int i) { i = __builtin_amdgcn_readfirstlane(i); asm volatile("" : "+s"(i)); return P.in[i]; }
DI unsigned char* wsp(const Params& P) { const unsigned long long w = (unsigned long long)P.ws; unsigned lo = __builtin_amdgcn_readfirstlane((unsigned)w), hi = __builtin_amdgcn_readfirstlane((unsigned)(w >> 32)); asm volatile("" : "+s"(lo), "+s"(hi)); return (unsigned char*)(((unsigned long long)hi << 32) | lo); }
struct Frame { LAS unsigned char* lds; int tid, lane, wave, blk, G, vcu, gw, NGW; };
DI Frame opaque_frame(const Frame& F0) { Frame F = F0; asm volatile("" : "+v"(F.tid), "+v"(F.lane)); asm volatile("" : "+s"(F.wave), "+s"(F.blk), "+s"(F.vcu), "+s"(F.gw)); return F; }

DI void p0_transpose_item(const float* W, int N, int k0, int n0, bf16_t* dst, int Kd, LAS float* scr, int lane) {
#pragma unroll 8
    for (int i = 0; i < 32; ++i) { const int kk = 2 * i + (lane >> 5); scr[kk * 33 + (lane & 31)] = W[(size_t)(k0 + kk) * N + n0 + (lane & 31)]; }
    LDS_WAIT();
    const int c = lane & 7;
#pragma unroll
    for (int j = 0; j < 4; ++j) { const int n = (lane >> 3) + 8 * j; const LAS float* s = scr + (8 * c) * 33 + n;
        u32x4 o; o.x = pk2(s[0 * 33], s[1 * 33]); o.y = pk2(s[2 * 33], s[3 * 33]); o.z = pk2(s[4 * 33], s[5 * 33]); o.w = pk2(s[6 * 33], s[7 * 33]);
        *(u32x4*)(dst + (size_t)n * Kd + 8 * c) = o; }
    LDS_WAIT();
}
DI double dsin_poly(double r) { const double r2 = r * r;
    return r * (1.0 - r2 * (1.0 / 6.0) * (1.0 - r2 * (1.0 / 20.0) * (1.0 - r2 * (1.0 / 42.0) * (1.0 - r2 * (1.0 / 72.0) * (1.0 - r2 * (1.0 / 110.0) * (1.0 - r2 * (1.0 / 156.0) * (1.0 - r2 * (1.0 / 210.0) * (1.0 - r2 * (1.0 / 272.0) * (1.0 - r2 * (1.0 / 342.0) * (1.0 - r2 * (1.0 / 420.0) * (1.0 - r2 * (1.0 / 506.0)))))))))))); }
DI double dcos_poly(double r) { const double r2 = r * r;
    return 1.0 - r2 * (1.0 / 2.0) * (1.0 - r2 * (1.0 / 12.0) * (1.0 - r2 * (1.0 / 30.0) * (1.0 - r2 * (1.0 / 56.0) * (1.0 - r2 * (1.0 / 90.0) * (1.0 - r2 * (1.0 / 132.0) * (1.0 - r2 * (1.0 / 182.0) * (1.0 - r2 * (1.0 / 240.0) * (1.0 - r2 * (1.0 / 306.0) * (1.0 - r2 * (1.0 / 380.0) * (1.0 - r2 * (1.0 / 462.0) * (1.0 - r2 * (1.0 / 552.0)))))))))))); }

constexpr int IT_MOD = DEPTH * 96 * 8;
constexpr int IT_QKV = (DM / 64) * (QKVN / 32), IT_WO = (DM / 64) * (DM / 32), IT_GU = NEXP * (DM / 64) * (FH / 32), IT_DN = NEXP * (FH / 64) * (DM / 32);
constexpr int IT_LAYER = IT_QKV + IT_WO + 2 * IT_GU + IT_DN;
constexpr int IT_TOTAL = IT_MOD + DEPTH * IT_LAYER;

DI void p0_prologue(const Params& P, const Frame& F) {
    LAS float* scr = (LAS float*)(F.lds + F.wave * 16384);
    unsigned char* ws = wsp(P);
    for (int it = F.gw; it < IT_TOTAL; it += F.NGW) {
        if (it < IT_MOD) {
            const int l = it / (96 * 8), rem = it % (96 * 8), cc = rem >> 3, ks = rem & 7;
            for (int idx = F.lane; idx < 17 * 128; idx += 64) { const int b = idx >> 7, k = idx & 127;
                const float cv = (b < 16) ? inp(P, IN_C)[b * DM + ks * 128 + k] : inp(P, IN_CCTX)[ks * 128 + k];
                scr[idx] = cv / (1.f + expf(-cv)); }
            LDS_WAIT();
            float acc[17];
#pragma unroll
            for (int b = 0; b < 17; ++b) acc[b] = 0.f;
            const float* wp = inp(P, IN_WADA) + ((size_t)l * DM + ks * 128) * 6144 + cc * 64 + F.lane;
#pragma unroll 4
            for (int k = 0; k < 128; ++k) { const float w = wp[(size_t)k * 6144];
#pragma unroll
                for (int b = 0; b < 17; ++b) acc[b] += scr[b * 128 + k] * w; }
            float* mp = (float*)(ws + WS_MODP) + ((size_t)(ks * DEPTH + l) * 17) * 6144 + cc * 64 + F.lane;
#pragma unroll
            for (int b = 0; b < 17; ++b) mp[(size_t)b * 6144] = acc[b];
            LDS_WAIT();
            continue;
        }
        int r = it - IT_MOD; const int l = r / IT_LAYER; r -= l * IT_LAYER;
        if (r < IT_QKV) { const int kb = r / (QKVN / 32), nb = r % (QKVN / 32);
            p0_transpose_item(inp(P, IN_WQKV) + (size_t)l * DM * QKVN, QKVN, kb * 64, nb * 32, (bf16_t*)(ws + WS_WQKV) + (size_t)l * QKVN * DM + (size_t)(nb * 32) * DM + kb * 64, DM, scr, F.lane); continue; }
        r -= IT_QKV;
        if (r < IT_WO) { const int kb = r / (DM / 32), nb = r % (DM / 32);
            p0_transpose_item(inp(P, IN_WO) + (size_t)l * DM * DM, DM, kb * 64, nb * 32, (bf16_t*)(ws + WS_WO) + (size_t)l * DM * DM + (size_t)(nb * 32) * DM + kb * 64, DM, scr, F.lane); continue; }
        r -= IT_WO;
        if (r < 2 * IT_GU) { const int which = r / IT_GU; r -= which * IT_GU; const int e = r / 256, kb = (r % 256) / 16, nb = r % 16; const int n0 = nb * 32;
            const int drow0 = 256 * (n0 >> 7) + 128 * which + (n0 & 127);
            p0_transpose_item(inp(P, which ? IN_WUP : IN_WGATE) + (size_t)(l * NEXP + e) * DM * FH, FH, kb * 64, n0,
                              (bf16_t*)(ws + WS_WGU) + (size_t)(l * NEXP + e) * DM * DM + (size_t)drow0 * DM + kb * 64, DM, scr, F.lane); continue; }
        r -= 2 * IT_GU;
        { const int e = r / 256, kb = (r % 256) / 32, nb = r % 32;
            p0_transpose_item(inp(P, IN_WDOWN) + (size_t)(l * NEXP + e) * FH * DM, DM, kb * 64, nb * 32,
                              (bf16_t*)(ws + WS_WD) + (size_t)(l * NEXP + e) * DM * FH + (size_t)(nb * 32) * FH + kb * 64, FH, scr, F.lane); }
    }
    if (F.gw == F.NGW - 1) {
        f32x2* T = (f32x2*)(ws + WS_ROPE);
        for (int idx = F.lane; idx < 64 * 16; idx += 64) { const int pos = idx >> 4, j = idx & 15;
            const float inv = exp2f(-(float)j * (1.f / 16.f) * 13.287712379549449f);
            const float ang = (float)pos * inv;
            const double a = (double)ang; const double rr = a - 6.283185307179586 * rint(a * 0.15915494309189535);
            T[idx] = (f32x2){(float)dcos_poly(rr), (float)dsin_poly(rr)}; }
    }
    { float* wrt = (float*)(ws + WS_WRT);
      for (int idx = F.gw * 64 + F.lane; idx < DEPTH * 36 * DM; idx += F.NGW * 64) { const int l = idx / (36 * DM), rem = idx % (36 * DM), n = rem >> 10, k = rem & 1023;
          wrt[idx] = (n < 4) ? inp(P, IN_WGROUP)[((size_t)l * DM + k) * 4 + n] : inp(P, IN_WROUTER)[((size_t)l * DM + k) * 32 + (n - 4)]; } }
}
DI void p0b_mod_reduce(const Params& P, const Frame& F) {
    unsigned char* const ws = wsp(P);
    const float* mp = (const float*)(ws + WS_MODP); float* mod = (float*)(ws + WS_MOD);
    for (int idx = F.gw * 64 + F.lane; idx < DEPTH * 17 * 6144; idx += F.NGW * 64) {
        const int l = idx / (17 * 6144), c = idx % 6144;
        float s = inp(P, IN_BADA)[l * 6144 + c];
#pragma unroll
        for (int ks = 0; ks < 8; ++ks) s += mp[(size_t)ks * DEPTH * 17 * 6144 + idx];
        mod[idx] = s; }
}

DI void load_row(const float* row, int lane, f32x4 (&v)[4]) {
#pragma unroll
    for (int j = 0; j < 4; ++j) v[j] = *(const f32x4*)(row + 4 * lane + 256 * j);
}
DI float row_rstd(const f32x4 (&v)[4]) {
    float s = 0.f;
#pragma unroll
    for (int j = 0; j < 4; ++j) s += (v[j][0] * v[j][0] + v[j][1] * v[j][1]) + (v[j][2] * v[j][2] + v[j][3] * v[j][3]);
    return 1.0f / sqrtf(wave_sum(s) * (1.f / DM) + NORM_EPS);
}
DI void moe_combine(unsigned char* ws, int prev_layer, int t, int mb, int lane, f32x4 (&v)[4]) {
    const unsigned* slot = (const unsigned*)(ws + WS_SLOT) + (size_t)t * 2; const float* aw = (const float*)(ws + WS_ASGW) + (size_t)t * 2;
    const unsigned s0 = slot[0], s1 = slot[1]; const float w0 = aw[0], w1 = aw[1];
    const bf16_t* Y = (const bf16_t*)(ws + WS_Y);
    const float* gt = (const float*)(ws + WS_MOD) + ((size_t)prev_layer * 17 + mb) * 6144 + 5120;
#pragma unroll
    for (int j = 0; j < 4; ++j) { const int c = 4 * lane + 256 * j;
        const u32x2 a = *(const u32x2*)(Y + (size_t)s0 * DM + c), b = *(const u32x2*)(Y + (size_t)s1 * DM + c); const f32x4 g = *(const f32x4*)(gt + c);
        v[j][0] += g[0] * (w0 * bf2f(a.x & 0xffffu) + w1 * bf2f(b.x & 0xffffu)); v[j][1] += g[1] * (w0 * bf2f(a.x >> 16) + w1 * bf2f(b.x >> 16));
        v[j][2] += g[2] * (w0 * bf2f(a.y & 0xffffu) + w1 * bf2f(b.y & 0xffffu)); v[j][3] += g[3] * (w0 * bf2f(a.y >> 16) + w1 * bf2f(b.y >> 16)); }
}
DI void norm_mod_store(const f32x4 (&v)[4], float rstd, const float* g, const float* shift, const float* scale, bf16_t* hrow, int lane, f32x4 (&hf)[4]) {
#pragma unroll
    for (int j = 0; j < 4; ++j) { const int c = 4 * lane + 256 * j; const f32x4 gg = *(const f32x4*)(g + c), sh = *(const f32x4*)(shift + c), sc = *(const f32x4*)(scale + c);
        hf[j] = (v[j] * rstd * gg) * (1.f + sc) + sh;
        u32x2 w; w.x = pk2(hf[j][0], hf[j][1]); w.y = pk2(hf[j][2], hf[j][3]); *(u32x2*)(hrow + c) = w; }
}
DI void phase_attn_norm(const Params& P, const Frame& F0, int layer) {
    unsigned char* const ws = wsp(P);
    const Frame F = opaque_frame(F0);
    float* X = (float*)(ws + WS_X); bf16_t* H = (bf16_t*)(ws + WS_H);
    for (int t = F.gw; t < TALL; t += F.NGW) {
        const bool lat = t < TLAT; const int mb = lat ? (t >> 11) : 16;
        f32x4 v[4];
        if (layer == 0) load_row(lat ? inp(P, IN_X) + (size_t)t * DM : inp(P, IN_CTX) + (size_t)(t - TLAT) * DM, F.lane, v);
        else { load_row(X + (size_t)t * DM, F.lane, v); moe_combine(ws, layer - 1, t, mb, F.lane, v); }
#pragma unroll
        for (int j = 0; j < 4; ++j) *(f32x4*)(X + (size_t)t * DM + 4 * F.lane + 256 * j) = v[j];
        const float rstd = row_rstd(v);
        const float* md = (const float*)(ws + WS_MOD) + ((size_t)layer * 17 + mb) * 6144;
        f32x4 hf[4];
        norm_mod_store(v, rstd, inp(P, IN_GATTN) + layer * DM, md, md + 1024, H + (size_t)t * DM, F.lane, hf);
    }
}
DI void phase_final(const Params& P, const Frame& F0) {
    unsigned char* const ws = wsp(P);
    const Frame F = opaque_frame(F0);
    const float* X = (const float*)(ws + WS_X);
    for (int t = F.gw; t < TLAT; t += F.NGW) {
        f32x4 v[4]; load_row(X + (size_t)t * DM, F.lane, v); moe_combine(ws, DEPTH - 1, t, t >> 11, F.lane, v);
        const float rstd = row_rstd(v);
#pragma unroll
        for (int j = 0; j < 4; ++j) { const int c = 4 * F.lane + 256 * j; const f32x4 g = *(const f32x4*)(inp(P, IN_GFINAL) + c); *(f32x4*)(P.out + (size_t)t * DM + c) = v[j] * rstd * g; }
    }
}

DI void unpack8(const u32x4 w, float (&x)[8]) { x[0] = bf2f(w.x & 0xffffu); x[1] = bf2f(w.x >> 16); x[2] = bf2f(w.y & 0xffffu); x[3] = bf2f(w.y >> 16); x[4] = bf2f(w.z & 0xffffu); x[5] = bf2f(w.z >> 16); x[6] = bf2f(w.w & 0xffffu); x[7] = bf2f(w.w >> 16); }
DI u32x4 pack8(const float (&x)[8]) { u32x4 w; w.x = pk2(x[0], x[1]); w.y = pk2(x[2], x[3]); w.z = pk2(x[4], x[5]); w.w = pk2(x[6], x[7]); return w; }
DI void head_rmsnorm(float (&x)[8], const float* g8) {
    float s = 0.f;
#pragma unroll
    for (int e = 0; e < 8; ++e) s += x[e] * x[e];
    s += __shfl_xor(s, 1); s += __shfl_xor(s, 2); s += __shfl_xor(s, 4);
    const float rs = 1.0f / sqrtf(s * (1.f / HD) + NORM_EPS);
#pragma unroll
    for (int e = 0; e < 8; ++e) x[e] = x[e] * rs * g8[e];
}
DI void phase_qkv_post(const Params& P, const Frame& F0, int layer) {
    unsigned char* const ws = wsp(P);
    const Frame F = opaque_frame(F0);
    const int m = layer % 3;
    bf16_t* QKV = (bf16_t*)(ws + WS_QKV); unsigned char* KF = ws + WS_KF; unsigned char* VF = ws + WS_VF;
    const f32x2* T = (const f32x2*)(ws + WS_ROPE);
    LAS bf16_t* scr = (LAS bf16_t*)(F.lds + F.wave * 16384);
    const int tt = F.lane >> 3, c = F.lane & 7;
    float gq[8], gk[8];
#pragma unroll
    for (int e = 0; e < 8; ++e) { gq[e] = inp(P, IN_GQ)[8 * c + e]; gk[e] = inp(P, IN_GK)[8 * c + e]; }
    for (int g8 = F.gw; g8 < TALL / 8; g8 += F.NGW) {
        const int t = g8 * 8 + tt; const bool lat = t < TLAT;
        const int b = lat ? (t >> 11) : ((t - TLAT) >> 8);
        const int kidx = lat ? (t & 2047) : (2048 + ((t - TLAT) & 255));
        const int gidx = kidx >> 3;
        bf16_t* row = QKV + (size_t)t * QKVN;
        const bool rope = lat && (m != 2);
        float cs[8], sn[8];
        if (rope) { const int n = t & 2047; const int pos = (c < 4) ? (n >> 6) : (n & 63); const f32x2* tp = T + pos * 16 + 8 * (c & 1);
#pragma unroll
            for (int e = 0; e < 8; ++e) { const f32x2 v = tp[e]; cs[e] = v.x; sn[e] = v.y; } }
        else {
#pragma unroll
            for (int e = 0; e < 8; ++e) { cs[e] = 1.f; sn[e] = 0.f; } }
#pragma unroll 4
        for (int hh = 0; hh < NH; ++hh) { float x[8]; unpack8(*(const u32x4*)(row + hh * HD + 8 * c), x);
            if (m == 1) head_rmsnorm(x, gq);
#pragma unroll
            for (int e = 0; e < 8; ++e) x[e] *= 0.125f;
            *(u32x4*)(row + hh * HD + 8 * c) = pack8(x); }
#pragma unroll
        for (int kh = 0; kh < NKV; ++kh) { float x[8]; unpack8(*(const u32x4*)(row + DM + kh * HD + 8 * c), x);
            if (m == 1) head_rmsnorm(x, gk);
            float y[8];
#pragma unroll
            for (int e = 0; e < 8; ++e) { const float pr = __shfl_xor(x[e], 2); y[e] = x[e] * cs[e] + ((c & 2) ? pr : -pr) * sn[e]; }
            *(u32x4*)(KF + ((size_t)(b * NKV + kh) * KGRP + gidx) * 1024 + c * 128 + tt * 16) = pack8(y); }
#pragma unroll
        for (int kh = 0; kh < NKV; ++kh) { const u32x4 w = *(const u32x4*)(row + DM + NKV * HD + kh * HD + 8 * c);
            const unsigned ww[4] = {w.x, w.y, w.z, w.w};
#pragma unroll
            for (int e = 0; e < 8; ++e) scr[(8 * c + e) * 8 + tt] = (bf16_t)((e & 1) ? (ww[e >> 1] >> 16) : (ww[e >> 1] & 0xffffu));
            LDS_WAIT();
            const u32x4 o = *(const LAS u32x4*)((const LAS unsigned char*)scr + F.lane * 16);
            *(u32x4*)(VF + ((size_t)(b * NKV + kh) * KGRP + gidx) * 1024 + F.lane * 16) = o;
            LDS_WAIT(); }
    }
}

DI float swap_max(float v) { auto rr = __builtin_amdgcn_permlane32_swap(__float_as_uint(v), __float_as_uint(v), false, false); return fmaxf(__uint_as_float(rr[0]), __uint_as_float(rr[1])); }
DI float swap_add(float v) { auto rr = __builtin_amdgcn_permlane32_swap(__float_as_uint(v), __float_as_uint(v), false, false); return __uint_as_float(rr[0]) + __uint_as_float(rr[1]); }
DI bf16x8 pack_p(const f32x16& p, int s) {
    u32x4 w; w.x = cvt_pk_bf16(p[8 * s + 0], p[8 * s + 1]); w.y = cvt_pk_bf16(p[8 * s + 2], p[8 * s + 3]); w.z = cvt_pk_bf16(p[8 * s + 4], p[8 * s + 5]); w.w = cvt_pk_bf16(p[8 * s + 6], p[8 * s + 7]);
    return __builtin_bit_cast(bf16x8, w);
}
struct AttnState { float m, l; f32x16 o[2]; };
DI f32x16 attn_scores(const unsigned char* Kbh, int kg, const bf16x8 (&q)[4], int r32, int hi) {
    const unsigned char* kb = Kbh + (size_t)(kg + (r32 >> 3)) * 1024 + hi * 128 + (r32 & 7) * 16;
    const bf16x8 k0 = *(const bf16x8*)kb, k1 = *(const bf16x8*)(kb + 256), k2 = *(const bf16x8*)(kb + 512), k3 = *(const bf16x8*)(kb + 768);
    f32x16 s;
#pragma unroll
    for (int r = 0; r < 16; ++r) s[r] = 0.f;
    s = __builtin_amdgcn_mfma_f32_32x32x16_bf16(k0, q[0], s, 0, 0, 0);
    s = __builtin_amdgcn_mfma_f32_32x32x16_bf16(k1, q[1], s, 0, 0, 0);
    s = __builtin_amdgcn_mfma_f32_32x32x16_bf16(k2, q[2], s, 0, 0, 0);
    s = __builtin_amdgcn_mfma_f32_32x32x16_bf16(k3, q[3], s, 0, 0, 0);
    return s;
}
DI void attn_softmax_pv(AttnState& st, f32x16& s, const unsigned char* Vbh, int kg, LAS float* wsf, int r32, int hi) {
    const unsigned char* vb = Vbh + (size_t)kg * 1024 + r32 * 16 + hi * 8;
    s16x4 v[2][2][2];
#pragma unroll
    for (int dh = 0; dh < 2; ++dh)
#pragma unroll
        for (int ks = 0; ks < 2; ++ks)
#pragma unroll
            for (int pt = 0; pt < 2; ++pt) v[dh][ks][pt] = *(const s16x4*)(vb + dh * 512 + (2 * ks + pt) * 1024);
    float mt = s[0];
#pragma unroll
    for (int r = 1; r < 16; ++r) mt = fmaxf(mt, s[r]);
    mt = swap_max(mt);
    const float mnew = fmaxf(st.m, mt);
    if (__any(mnew > st.m)) {
        const float al = __builtin_amdgcn_exp2f((st.m - mnew) * LOG2E);
        st.l *= al; st.m = mnew;
        if (hi == 0) wsf[r32] = al;
        LDS_WAIT();
#pragma unroll
        for (int r = 0; r < 16; ++r) { const float f = wsf[crow(r, hi)]; st.o[0][r] *= f; st.o[1][r] *= f; }
        LDS_WAIT();
    }
    const float mb = st.m * LOG2E;
    float ps = 0.f;
#pragma unroll
    for (int r = 0; r < 16; ++r) { s[r] = __builtin_amdgcn_exp2f(s[r] * LOG2E - mb); ps += s[r]; }
    st.l += ps;
    const bf16x8 pa0 = pack_p(s, 0), pa1 = pack_p(s, 1);
#pragma unroll
    for (int dh = 0; dh < 2; ++dh) {
        const bf16x8 vf0 = __builtin_shufflevector(v[dh][0][0], v[dh][0][1], 0, 1, 2, 3, 4, 5, 6, 7);
        const bf16x8 vf1 = __builtin_shufflevector(v[dh][1][0], v[dh][1][1], 0, 1, 2, 3, 4, 5, 6, 7);
        st.o[dh] = __builtin_amdgcn_mfma_f32_32x32x16_bf16(pa0, vf0, st.o[dh], 0, 0, 0);
        st.o[dh] = __builtin_amdgcn_mfma_f32_32x32x16_bf16(pa1, vf1, st.o[dh], 0, 0, 0);
    }
}
template <int MODE>
DI void attn_unit(const Params& P, unsigned char* ws, int layer, int b, int h, int qblk, LAS unsigned char* wl, int lane) {
    const int r32 = lane & 31, hi = lane >> 5, kvh = h >> 2, m = layer % 3;
    LAS float* wsf = (LAS float*)wl; LAS bf16_t* stg = (LAS bf16_t*)(wl + 256); LAS float* rpbt = (LAS float*)(wl + 256 + 4096);
    const bf16_t* QKV = (const bf16_t*)(ws + WS_QKV);
    const unsigned char* Kbh = ws + WS_KF + (size_t)(b * NKV + kvh) * KGRP * 1024;
    const unsigned char* Vbh = ws + WS_VF + (size_t)(b * NKV + kvh) * KGRP * 1024;
    bf16_t* O = (bf16_t*)(ws + WS_O);
    int r0 = 0, c0 = 0;
    if (MODE == 2) { r0 = 2 * (qblk >> 2); c0 = 16 * (qblk & 3); }
    auto qtok = [&](int i) -> int {
        if (MODE == 3) return TLAT + b * CTXL + qblk * 32 + i;
        if (MODE == 2) return b * SEQ + (r0 + (i >> 4)) * 64 + c0 + (i & 15);
        return b * SEQ + qblk * 32 + i; };
    const int tq = qtok(r32);
    bf16x8 qf[4], qr[4];
    { const bf16_t* qp = QKV + (size_t)tq * QKVN + h * HD + hi * 8;
#pragma unroll
      for (int d0 = 0; d0 < 4; ++d0) qf[d0] = *(const bf16x8*)(qp + d0 * 16); }
    if (MODE == 0 || MODE == 1) {
        const int n = tq & 2047; const f32x2* T = (const f32x2*)(ws + WS_ROPE);
        const f32x2* tr = T + (n >> 6) * 16 + 8 * hi; const f32x2* tc = T + (n & 63) * 16 + 8 * hi;
#pragma unroll
        for (int e = 0; e < 8; ++e) { const f32x2 a = tr[e], cc = tc[e];
            const float x1 = bfs2f(qf[0][e]), x2 = bfs2f(qf[1][e]), x3 = bfs2f(qf[2][e]), x4 = bfs2f(qf[3][e]);
            qr[0][e] = (short)f2bf(x1 * a.x - x2 * a.y); qr[1][e] = (short)f2bf(x2 * a.x + x1 * a.y);
            qr[2][e] = (short)f2bf(x3 * cc.x - x4 * cc.y); qr[3][e] = (short)f2bf(x4 * cc.x + x3 * cc.y); }
    } else {
#pragma unroll
        for (int d0 = 0; d0 < 4; ++d0) qr[d0] = qf[d0];
    }
    AttnState st; st.m = -1e30f; st.l = 0.f;
#pragma unroll
    for (int r = 0; r < 16; ++r) { st.o[0][r] = 0.f; st.o[1][r] = 0.f; }
    const float NEG = -INFINITY;
    if (MODE == 0) {
        const int q0 = qblk * 32, qpos = q0 + r32;
        for (int j = 0; j < 9; ++j) { const int kt = q0 - 128 + 32 * j; if (kt < 0 || kt >= SEQ) continue;
            f32x16 s = attn_scores(Kbh, kt >> 3, qr, r32, hi);
            if (j == 0 || j == 8) {
#pragma unroll
                for (int r = 0; r < 16; ++r) { const int d = kt + crow(r, hi) - qpos; if (d > 128 || d < -128) s[r] = NEG; } }
            attn_softmax_pv(st, s, Vbh, kt >> 3, wsf, r32, hi); }
    } else if (MODE == 1) {
        for (int j = 0; j < SEQ / 32; ++j) { f32x16 s = attn_scores(Kbh, 4 * j, qr, r32, hi); attn_softmax_pv(st, s, Vbh, 4 * j, wsf, r32, hi); }
    } else if (MODE == 2) {
        const float* rpb = inp(P, IN_RPB) + (size_t)h * 465;
        for (int i = lane; i < 465; i += 64) rpbt[i] = rpb[i];
        LDS_WAIT();
        const int rq = r0 + (r32 >> 4), cq = c0 + (r32 & 15);
        const int rsq = min(max(rq - 4, 0), 24), csq = min(max(cq - 8, 0), 48);
        const int rs_min = min(max(r0 - 4, 0), 24), rs_max = min(max(r0 + 1 - 4, 0), 24);
        const int cseg = (c0 == 0) ? 0 : (c0 == 16) ? 8 : (c0 == 32) ? 24 : 32;
        for (int kr = rs_min; kr <= rs_max + 7; ++kr) { const int kg = (kr * 64 + cseg) >> 3;
            f32x16 s = attn_scores(Kbh, kg, qr, r32, hi);
            const bool rowok = (kr >= rsq) && (kr < rsq + 8);
            const int ib = (kr - rq + 7) * 31 - cq + 15;
#pragma unroll
            for (int r = 0; r < 16; ++r) { const int kc = cseg + crow(r, hi); const bool ok = rowok && (kc >= csq) && (kc < csq + 16);
                const int idx = min(max(ib + kc, 0), 464); const float bias = rpbt[idx];
                s[r] = ok ? s[r] + bias : NEG; }
            attn_softmax_pv(st, s, Vbh, kg, wsf, r32, hi); }
    }
    for (int j = 0; j < CTXL / 32; ++j) { f32x16 s = attn_scores(Kbh, SEQ / 8 + 4 * j, qf, r32, hi); attn_softmax_pv(st, s, Vbh, SEQ / 8 + 4 * j, wsf, r32, hi); }
    const float lt = swap_add(st.l);
    float inv;
    if (MODE == 0 || (MODE == 3 && m == 0)) { const float sk = inp(P, IN_SINK)[(layer / 3) * NH + h];
        const float mnew = fmaxf(st.m, sk); const float al = __builtin_amdgcn_exp2f((st.m - mnew) * LOG2E), es = __builtin_amdgcn_exp2f((sk - mnew) * LOG2E);
        inv = al / (lt * al + es); }
    else inv = 1.f / lt;
    if (hi == 0) wsf[r32] = inv;
    LDS_WAIT();
#pragma unroll
    for (int r = 0; r < 16; ++r) { const int orow = crow(r, hi); const float f = wsf[orow];
        stg[orow * 64 + r32] = (bf16_t)f2bf(st.o[0][r] * f); stg[orow * 64 + 32 + r32] = (bf16_t)f2bf(st.o[1][r] * f); }
    LDS_WAIT();
#pragma unroll
    for (int i = 0; i < 4; ++i) { const int row = i * 8 + (lane >> 3), ch = lane & 7;
        const u32x4 v = *(const LAS u32x4*)((const LAS unsigned char*)stg + row * 128 + ch * 16);
        *(u32x4*)(O + (size_t)qtok(row) * DM + h * HD + ch * 8) = v; }
    LDS_WAIT();
}
DI void phase_attention(const Params& P, const Frame& F0, int layer) {
    unsigned char* const ws = wsp(P);
    const Frame F = opaque_frame(F0);
    const int m = layer % 3;
    LAS unsigned char* wl = F.lds + F.wave * 16384;
    for (int bu = F.blk; bu < NB * NKV * 32; bu += F.G) {
        const int bkv = (bu >> 8) * 8 + (bu & 7), qp = (bu & 255) >> 3;
        const int b = bkv >> 2, kvh = bkv & 3, h = kvh * 4 + (F.wave & 3), qblk = 2 * qp + (F.wave >> 2);
        if (m == 0) attn_unit<0>(P, ws, layer, b, h, qblk, wl, F.lane);
        else if (m == 1) attn_unit<1>(P, ws, layer, b, h, qblk, wl, F.lane);
        else attn_unit<2>(P, ws, layer, b, h, qblk, wl, F.lane);
    }
    if (layer < DEPTH - 1) {
        for (int bu = F.blk; bu < NB * NKV * 4; bu += F.G) {
            const int b = bu >> 4, kvh = (bu >> 2) & 3, qp = bu & 3, h = kvh * 4 + (F.wave & 3), qblk = 2 * qp + (F.wave >> 2);
            attn_unit<3>(P, ws, layer, b, h, qblk, wl, F.lane);
        }
    }
}

DI void phase_router(const Params& P, const Frame& F0, int layer, int M) {
    unsigned char* const ws = wsp(P);
    const Frame F = opaque_frame(F0);
    const int TPB = M / GRID, TPW = TPB / NWAVES;
    LAS int* hist = (LAS int*)(F.lds + LDSX_OFF);
    if (F.tid < 32) hist[F.tid] = 0;
    __syncthreads();
    const float* X = (const float*)(ws + WS_X); bf16_t* H = (bf16_t*)(ws + WS_H);
    const float* wrt = (const float*)(ws + WS_WRT) + (size_t)layer * 36 * DM;
    unsigned* asg = (unsigned*)(ws + WS_ASG); float* asgw = (float*)(ws + WS_ASGW);
    const float bias = (F.lane < 4) ? inp(P, IN_BGROUP)[layer * 4 + F.lane] : (F.lane < 36 ? inp(P, IN_BROUTER)[layer * 32 + F.lane - 4] : 0.f);
    const int t0 = F.blk * TPB + F.wave * TPW;
    for (int bi = 0; bi < TPW; bi += 4) {
        const int nb = (TPW - bi) < 4 ? (TPW - bi) : 4;
        f32x4 hf[4][4];
#pragma unroll
        for (int tk = 0; tk < 4; ++tk) {
            if (tk < nb) { const int t = t0 + bi + tk; const int mb = (t < TLAT) ? (t >> 11) : 16;
                f32x4 v[4]; load_row(X + (size_t)t * DM, F.lane, v);
                const float rstd = row_rstd(v);
                const float* md = (const float*)(ws + WS_MOD) + ((size_t)layer * 17 + mb) * 6144;
                norm_mod_store(v, rstd, inp(P, IN_GFFN) + layer * DM, md + 3072, md + 4096, H + (size_t)t * DM, F.lane, hf[tk]);
            } else {
#pragma unroll
                for (int j = 0; j < 4; ++j) hf[tk][j] = (f32x4){0.f, 0.f, 0.f, 0.f}; }
        }
        float lg[4] = {0.f, 0.f, 0.f, 0.f};
        for (int n = 0; n < 36; ++n) {
            f32x4 w[4];
#pragma unroll
            for (int j = 0; j < 4; ++j) w[j] = *(const f32x4*)(wrt + n * DM + 4 * F.lane + 256 * j);
#pragma unroll
            for (int tk = 0; tk < 4; ++tk) { float p = 0.f;
#pragma unroll
                for (int j = 0; j < 4; ++j) p += (hf[tk][j][0] * w[j][0] + hf[tk][j][1] * w[j][1]) + (hf[tk][j][2] * w[j][2] + hf[tk][j][3] * w[j][3]);
                p = wave_sum(p);
                if (F.lane == n) lg[tk] = p; }
        }
#pragma unroll
        for (int tk = 0; tk < 4; ++tk) {
            if (tk < nb) { const int t = t0 + bi + tk; const float lgv = lg[tk] + bias;
                const float g0 = __shfl(lgv, 0), g1 = __shfl(lgv, 1), g2 = __shfl(lgv, 2), g3 = __shfl(lgv, 3);
                int grp = 0; float gm = g0; if (g1 > gm) { gm = g1; grp = 1; } if (g2 > gm) { gm = g2; grp = 2; } if (g3 > gm) { gm = g3; grp = 3; }
                const float ptop = 1.f / (expf(g0 - gm) + expf(g1 - gm) + expf(g2 - gm) + expf(g3 - gm));
                float ev[8], em = -INFINITY;
#pragma unroll
                for (int j = 0; j < 8; ++j) { ev[j] = __shfl(lgv, 4 + grp * 8 + j); em = fmaxf(em, ev[j]); }
                float pe[8];
#pragma unroll
                for (int j = 0; j < 8; ++j) pe[j] = expf(ev[j] - em);
                int i1 = 0; float p1 = pe[0];
#pragma unroll
                for (int j = 1; j < 8; ++j) if (pe[j] > p1) { p1 = pe[j]; i1 = j; }
                int i2 = 0; float p2 = -1.f;
#pragma unroll
                for (int j = 0; j < 8; ++j) if (j != i1 && pe[j] > p2) { p2 = pe[j]; i2 = j; }
                const float w1 = ptop * p1 / (p1 + p2), w2 = ptop * p2 / (p1 + p2);
                if (F.lane == 0) { const int e1 = grp * 8 + i1, e2 = grp * 8 + i2;
                    const int q1 = atomicAdd((int*)&hist[e1], 1), q2 = atomicAdd((int*)&hist[e2], 1);
                    asg[(size_t)t * 2] = ((unsigned)e1 << 16) | (unsigned)q1; asg[(size_t)t * 2 + 1] = ((unsigned)e2 << 16) | (unsigned)q2;
                    asgw[(size_t)t * 2] = w1; asgw[(size_t)t * 2 + 1] = w2; }
            }
        }
    }
    __syncthreads();
    if (F.tid < 32) ((unsigned*)(ws + WS_HIST))[F.blk * 32 + F.tid] = (unsigned)hist[F.tid];
}
DI void phase_slots(const Params& P, const Frame& F0, int M) {
    unsigned char* const ws = wsp(P);
    const Frame F = opaque_frame(F0);
    const int TPB = M / GRID;
    LAS unsigned* sm = (LAS unsigned*)(F.lds + LDSX_OFF + 1024);
    const unsigned* hist = (const unsigned*)(ws + WS_HIST);
    { const int e = F.tid & 31, part = F.tid >> 5; unsigned tot = 0, pre = 0;
      for (int bb = part * 16; bb < part * 16 + 16; ++bb) { const unsigned v = hist[bb * 32 + e]; tot += v; if (bb < F.blk) pre += v; }
      sm[part * 32 + e] = tot; sm[512 + part * 32 + e] = pre; }
    __syncthreads();
    LAS unsigned* tot = sm + 1024; LAS unsigned* bas = sm + 1056; LAS unsigned* pst = sm + 1088;
    if (F.tid < 32) { unsigned a = 0, c = 0;
        for (int p = 0; p < 16; ++p) { a += sm[p * 32 + F.tid]; c += sm[512 + p * 32 + F.tid]; }
        tot[F.tid] = a; bas[F.tid] = c; }
    __syncthreads();
    if (F.tid == 0) { unsigned ps = 0; for (int e = 0; e < NEXP; ++e) { pst[e] = ps; ps += (tot[e] + 255u) & ~255u; } sm[1120] = ps >> 8; }
    __syncthreads();
    const unsigned* asg = (const unsigned*)(ws + WS_ASG); unsigned* slot = (unsigned*)(ws + WS_SLOT); unsigned* toks = (unsigned*)(ws + WS_TOKS);
    for (int i = F.tid; i < TPB * 2; i += NTHREADS) { const int t = F.blk * TPB + (i >> 1); const unsigned ep = asg[(size_t)t * 2 + (i & 1)];
        const unsigned e = ep >> 16, s = pst[e] + bas[e] + (ep & 0xffffu); slot[(size_t)t * 2 + (i & 1)] = s; toks[s] = (unsigned)t; }
    for (int e = F.blk; e < NEXP; e += F.G) { const unsigned beg = pst[e] + tot[e], end = pst[e] + ((tot[e] + 255u) & ~255u);
        for (unsigned s = beg + F.tid; s < end; s += NTHREADS) toks[s] = 0u; }
    if (F.blk == 0) { unsigned* tt = (unsigned*)(ws + WS_TTAB); const unsigned ntile = sm[1120];
        if (F.tid == 0) tt[0] = ntile;
        for (unsigned rt = F.tid; rt < ntile; rt += NTHREADS) { unsigned e = 0; for (int k = 1; k < NEXP; ++k) if (rt * 256u >= pst[k]) e = k; tt[1 + rt] = e; } }
}
DI void load_tile_table(const Params& P, const Frame& F, LAS unsigned* tab) {
    unsigned char* const ws = wsp(P);
    const unsigned* tt = (const unsigned*)(ws + WS_TTAB);
    for (int i = F.tid; i < 1 + CAPR / 256; i += NTHREADS) tab[i] = tt[i];
    __syncthreads();
}

__global__ void __launch_bounds__(NTHREADS, 2) dit_fwd(Params P) {
    extern __shared__ __attribute__((aligned(16))) unsigned char lds_raw[];
    Frame F;
    F.lds = (LAS unsigned char*)lds_raw;
    F.tid = threadIdx.x; F.lane = F.tid & 63; F.wave = __builtin_amdgcn_readfirstlane(F.tid >> 6);
    F.blk = blockIdx.x; F.G = gridDim.x; F.vcu = (F.G % 8 == 0) ? (F.blk % 8) * (F.G / 8) + F.blk / 8 : F.blk;
    F.gw = F.vcu * NWAVES + F.wave; F.NGW = F.G * NWAVES;
    for (int u = F.tid; u < (LDS_BYTES - RING_BYTES) / 4; u += NTHREADS) ((LAS unsigned*)(F.lds + RING_BYTES))[u] = 0u;
    __syncthreads();
    unsigned* ctl = (unsigned*)(P.ws + WS_CTL);
    XcdBarrier bar = xcd_barrier_post(ctl + CW_BAR, (volatile LAS unsigned*)(F.lds + MISC_OFF) + 8);

    p0_prologue(P, F);
    xcd_barrier(bar);
    p0b_mod_reduce(P, F);
    xcd_barrier(bar);

    for (int layer = 0; layer < DEPTH; ++layer) {
        const bool last = (layer == DEPTH - 1);
        unsigned char* ws = wsp(P);
        const int Mtok = last ? TLAT : TALL;
        phase_attn_norm(P, F, layer);
        xcd_barrier(bar);
        {
            pg8::PlainSched S; S.nN = QKVN / 256; S.nwg = (TALL / 256) * S.nN; S.G = F.G; S.c = F.vcu; S.K = DM; S.Bt = (const bf16_t*)(ws + WS_WQKV) + (size_t)layer * QKVN * DM;
            pg8::EpiStore E{(bf16_t*)(ws + WS_QKV), QKVN};
            pg8::gemm_phase(F.lds, (const bf16_t*)(ws + WS_H), DM, S, E);
        }
        xcd_barrier(bar);
        phase_qkv_post(P, F, layer);
        xcd_barrier(bar);
        phase_attention(P, F, layer);
        xcd_barrier(bar);
        {
            pg8::PlainSched S; S.nN = DM / 256; S.nwg = (Mtok / 256) * S.nN; S.G = F.G; S.c = F.vcu; S.K = DM; S.Bt = (const bf16_t*)(ws + WS_WO) + (size_t)layer * DM * DM;
            pg8::EpiResid E{(float*)(ws + WS_X), (const float*)(ws + WS_MOD) + (size_t)layer * 17 * 6144 + 2048};
            pg8::gemm_phase(F.lds, (const bf16_t*)(ws + WS_O), DM, S, E);
        }
        xcd_barrier(bar);
        phase_router(P, F, layer, Mtok);
        xcd_barrier(bar);
        phase_slots(P, F, Mtok);
        xcd_barrier(bar);
        LAS unsigned* tab = (LAS unsigned*)(F.lds + LDSX_OFF + 8192);
        load_tile_table(P, F, tab);
        {
            pg8::MoeSched<true> S; S.tab = tab; S.G = F.G; S.c = F.vcu; S.K = DM; S.Bt = (const bf16_t*)(ws + WS_WGU) + (size_t)layer * NEXP * DM * DM; S.estride = (size_t)DM * DM * 2; S.tok = (const unsigned*)(ws + WS_TOKS);
            pg8::EpiSwiglu E{(bf16_t*)(ws + WS_ACT)};
            pg8::gemm_phase(F.lds, (const bf16_t*)(ws + WS_H), DM, S, E);
        }
        xcd_barrier(bar);
        {
            pg8::MoeSched<false> S; S.tab = tab; S.G = F.G; S.c = F.vcu; S.K = FH; S.Bt = (const bf16_t*)(ws + WS_WD) + (size_t)layer * NEXP * DM * FH; S.estride = (size_t)DM * FH * 2; S.tok = nullptr;
            pg8::EpiStore E{(bf16_t*)(ws + WS_Y), DM};
            pg8::gemm_phase(F.lds, (const bf16_t*)(ws + WS_ACT), FH, S, E);
        }
        xcd_barrier(bar);
    }
    phase_final(P, F);
}

extern "C" void kernel_launch(void* const* d_in, const int* in_sizes, int n_in, void* d_out, int out_size, void* d_ws, size_t ws_size, hipStream_t stream) {
    static int ok = 0;
    if (ok == 0) {
        if (n_in != 22 || in_sizes[0] != TLAT * DM || out_size != TLAT * DM || ws_size < WS_END) {
            fprintf(stderr, "kernel_launch: unexpected shapes (n_in %d, in0 %d, out %d, ws %zu < %zu); nothing launched\n", n_in, n_in > 0 ? in_sizes[0] : -1, out_size, ws_size, (size_t)WS_END); ok = -1; return; }
        int dev = 0, cus = 0, per_cu = 0;
        if (hipGetDevice(&dev) != hipSuccess || hipDeviceGetAttribute(&cus, hipDeviceAttributeMultiprocessorCount, dev) != hipSuccess) { ok = -1; return; }
        if (hipFuncSetAttribute((const void*)dit_fwd, hipFuncAttributeMaxDynamicSharedMemorySize, LDS_BYTES) != hipSuccess) { fprintf(stderr, "kernel_launch: hipFuncSetAttribute failed\n"); ok = -1; return; }
        if (hipOccupancyMaxActiveBlocksPerMultiprocessor(&per_cu, (const void*)dit_fwd, NTHREADS, LDS_BYTES) != hipSuccess || per_cu < 1) fprintf(stderr, "kernel_launch: note: occupancy query reports %d\n", per_cu);
        (void)hipGetLastError();
        if (cus < GRID) { fprintf(stderr, "kernel_launch: %d CUs < %d workgroups: grid would not be resident; nothing launched\n", cus, GRID); ok = -1; return; }
        ok = 1;
    }
    if (ok < 0) return;
    if (hipMemsetAsync((char*)d_ws + WS_CTL, 0, CTL_ZERO_BYTES, stream) != hipSuccess) return;
    Params p{};
    for (int i = 0; i < 22; ++i) p.in[i] = (const float*)d_in[i];
    p.out = (float*)d_out; p.ws = (unsigned char*)d_ws;
    hipLaunchKernelGGL(dit_fwd, dim3(GRID), dim3(NTHREADS), LDS_BYTES, stream, p);
}
```

```cpp
#include <hip/hip_runtime.h>
#include <cstdio>
#include <cstdint>

#define LAS __attribute__((address_space(3)))
#define GAS __attribute__((address_space(1)))
#define DI __device__ __forceinline__

typedef unsigned short bf16_t;
typedef short bf16x8 __attribute__((ext_vector_type(8)));
typedef short s16x4 __attribute__((ext_vector_type(4)));
typedef float f32x2 __attribute__((ext_vector_type(2)));
typedef float f32x4 __attribute__((ext_vector_type(4)));
typedef float f32x16 __attribute__((ext_vector_type(16)));
typedef unsigned u32x2 __attribute__((ext_vector_type(2)));
typedef unsigned u32x4 __attribute__((ext_vector_type(4)));

constexpr int NB = 16, SEQ = 2048, DM = 1024, DEPTH = 4, CTXL = 256, NH = 16, NKV = 4, HD = 64, QKVN = 1536;
constexpr int TLAT = NB * SEQ, TCTX = NB * CTXL, TALL = TLAT + TCTX;
constexpr int NEXP = 32, FH = 512;
constexpr int KEYS = SEQ + CTXL, KGRP = KEYS / 8;
constexpr int CAPR = 2 * TALL + NEXP * 256;
constexpr int NWAVES = 8, NTHREADS = 512, GRID = 256;
constexpr float NORM_EPS = 1e-6f, LOG2E = 1.4426950408889634f;

constexpr size_t MiB = 1u << 20;
constexpr size_t WS_CTL = 0, CTL_ZERO_BYTES = 1 * MiB;
constexpr size_t WS_MODP = 1 * MiB;
constexpr size_t WS_MOD = 15 * MiB;
constexpr size_t WS_ROPE = 17 * MiB;
constexpr size_t WS_WRT = 17 * MiB + 65536;
constexpr size_t WS_ASG = 18 * MiB;
constexpr size_t WS_ASGW = 18 * MiB + 512 * 1024;
constexpr size_t WS_SLOT = 19 * MiB;
constexpr size_t WS_TOKS = 19 * MiB + 512 * 1024;
constexpr size_t WS_HIST = 20 * MiB;
constexpr size_t WS_TTAB = 20 * MiB + 65536;
constexpr size_t WS_WQKV = 21 * MiB;
constexpr size_t WS_WO = 33 * MiB;
constexpr size_t WS_WGU = 41 * MiB;
constexpr size_t WS_WD = 297 * MiB;
constexpr size_t WS_X = 425 * MiB;
constexpr size_t WS_H = 569 * MiB;
constexpr size_t WS_R1 = 641 * MiB;
constexpr size_t WS_QKV = WS_R1;
constexpr size_t WS_KF = WS_R1 + 108 * MiB;
constexpr size_t WS_VF = WS_R1 + 126 * MiB;
constexpr size_t WS_O = WS_R1 + 144 * MiB;
constexpr size_t WS_Y = WS_R1;
constexpr size_t WS_ACT = WS_R1 + 160 * MiB;
constexpr size_t WS_END = WS_R1 + 240 * MiB;
constexpr int CW_TMO = 0, CW_BAR = 4096;

constexpr int RING_BYTES = 131072;
constexpr int MISC_OFF = RING_BYTES + 320;
constexpr int LDSX_OFF = RING_BYTES + 1024;
constexpr int LDS_BYTES = 147456;

#define LDS_WAIT() asm volatile("s_waitcnt lgkmcnt(0)" ::: "memory")
#define VM_WAIT() asm volatile("s_waitcnt vmcnt(0)" ::: "memory")

DI unsigned f2bf(float f) { unsigned u = __float_as_uint(f); return (u + 0x7fffu + ((u >> 16) & 1u)) >> 16; }
DI float bf2f(unsigned b) { return __uint_as_float(b << 16); }
DI float bfs2f(short b) { return __uint_as_float(((unsigned)(unsigned short)b) << 16); }
DI unsigned pk2(float lo, float hi) { return f2bf(lo) | (f2bf(hi) << 16); }
DI unsigned cvt_pk_bf16(float lo, float hi) { unsigned r; asm volatile("v_cvt_pk_bf16_f32 %0, %1, %2" : "=v"(r) : "v"(lo), "v"(hi)); return r; }
DI float wave_sum(float v) {
#pragma unroll
    for (int o = 1; o < 64; o <<= 1) v += __shfl_xor(v, o);
    return v;
}
DI int crow(int r, int hi) { return (r & 3) + 8 * (r >> 2) + 4 * hi; }

#define XB_TMO      128
#define XB_XCNT(j)  (256  + 64 * (j))
#define XB_XSUB(j)  (1280 + 64 * (j))
#define XB_XGEN(j)  (2304 + 64 * (j))
#define XB_TOP      3328
#define XB_TOPGEN   3392
#define XCD_BAR_WORDS 3456
#define XB_SPIN_CAP (1u << 18)

__device__ __forceinline__ unsigned xb_ld(unsigned* p)              { return __hip_atomic_load(p, __ATOMIC_RELAXED, __HIP_MEMORY_SCOPE_AGENT); }
__device__ __forceinline__ unsigned xb_add(unsigned* p, unsigned v) { return __hip_atomic_fetch_add(p, v, __ATOMIC_RELAXED, __HIP_MEMORY_SCOPE_AGENT); }
__device__ __forceinline__ unsigned xb_xcc_id() { return (unsigned)__builtin_amdgcn_s_getreg((3 << 11) | 20) & 0xFu; }
#define XB_SPIN(cond, bar) do { unsigned _sp = 0; while (cond) { __builtin_amdgcn_s_sleep(1); \
    if ((++_sp & 255u) == 0u) { if (xb_ld(&(bar)[XB_TMO])) break; if (_sp > XB_SPIN_CAP) { atomicAdd(&(bar)[XB_TMO], 1u); break; } } } } while (0)

struct XcdBarrier { unsigned* bar; unsigned x; volatile LAS unsigned* st; };

__device__ __forceinline__ XcdBarrier xcd_barrier_post(unsigned* bar, volatile LAS unsigned* st) {
    XcdBarrier b; b.bar = bar; b.x = xb_xcc_id(); b.st = st;
    if (threadIdx.x == 0) (void)xb_add(&bar[XB_XCNT(b.x)], 1u);
    return b;
}
__device__ __forceinline__ void xcd_barrier_complete(unsigned* bar, unsigned x, unsigned& nloc, unsigned& nx) {
    const unsigned G = gridDim.x * gridDim.y * gridDim.z;
    unsigned sum, cnt, mine, sp = 0u;
    for (;;) {
        sum = 0u; cnt = 0u; mine = 0u;
#pragma unroll
        for (unsigned j = 0; j < 16; ++j) { const unsigned c = xb_ld(&bar[XB_XCNT(j)]); sum += c; cnt += (c > 0u) ? 1u : 0u; mine = (j == x) ? c : mine; }
        if (sum == G) break;
        __builtin_amdgcn_s_sleep(1);
        if ((++sp & 255u) == 0u) { if (xb_ld(&bar[XB_TMO])) break; if (sp > XB_SPIN_CAP) { atomicAdd(&bar[XB_TMO], 1u); break; } }
    }
    nloc = mine > 0u ? mine : 1u; nx = cnt > 0u ? cnt : 1u;
}
__device__ __forceinline__ void xcd_barrier(const XcdBarrier& b0) {
    XcdBarrier b = b0;
    { const unsigned long long w = (unsigned long long)b0.bar; unsigned lo = __builtin_amdgcn_readfirstlane((unsigned)w), hi = __builtin_amdgcn_readfirstlane((unsigned)(w >> 32)), bx = __builtin_amdgcn_readfirstlane(b0.x);
      asm volatile("" : "+s"(lo), "+s"(hi), "+s"(bx)); b.bar = (unsigned*)(((unsigned long long)hi << 32) | lo); b.x = bx; }
    asm volatile("s_waitcnt vmcnt(0)" ::: "memory");
    __syncthreads();
    if (threadIdx.x == 0) {
        unsigned* bar = b.bar;
        __builtin_amdgcn_s_waitcnt(0);
        unsigned nloc = b.st[0], nx = b.st[1];
        if (nloc == 0u) { xcd_barrier_complete(bar, b.x, nloc, nx); b.st[0] = nloc; b.st[1] = nx; }
        const unsigned old = xb_add(&bar[XB_XSUB(b.x)], 1u);
        const unsigned gen = old / nloc;
        if (old + 1u == (gen + 1u) * nloc) {
            __builtin_amdgcn_fence(__ATOMIC_RELEASE, "agent");
            asm volatile("s_waitcnt vmcnt(0)" ::: "memory");
            const unsigned og = xb_add(&bar[XB_TOP], 1u);
            const unsigned tg = og / nx;
            if (og + 1u == (tg + 1u) * nx) xb_add(&bar[XB_TOPGEN], 1u);
            else XB_SPIN(xb_ld(&bar[XB_TOPGEN]) == tg, bar);
            __builtin_amdgcn_fence(__ATOMIC_ACQUIRE, "agent");
            xb_add(&bar[XB_XGEN(b.x)], 1u);
            asm volatile("s_waitcnt vmcnt(0)" ::: "memory");
        } else {
            XB_SPIN(xb_ld(&bar[XB_XGEN(b.x)]) == gen, bar);
            __builtin_amdgcn_fence(__ATOMIC_ACQUIRE, "agent");
            asm volatile("s_waitcnt vmcnt(0)" ::: "memory");
        }
    }
    __syncthreads();
}

namespace pg8 {
constexpr int BM = 256, BK = 64, HALF = 128, HTB = HALF * BK * 2, STAGE_BYTES = 8 * HTB;
DI int lds_byte(int r, int c) { const int st = (r >> 4) * 2 + (c >> 5), rr = r & 15, cc = c & 31, ob = rr * 64 + cc * 2; return st * 1024 + (ob ^ (((ob >> 9) & 1) << 5)); }
DI void stage_rc(int b, int& R, int& C) { const int st = b / 1024, sb = b % 1024, swz = sb ^ (((sb >> 9) & 1) << 5); R = (st >> 1) * 16 + swz / 64; C = (st & 1) * 32 + (swz % 64) / 2; }
DI int perm32(int rho) { const int n = rho >> 4, i = rho & 15; return 8 * (i >> 2) + 4 * n + (i & 3); }
struct Unit { int pm, pn, e; };

template <class Epi, class Sched>
DI void gemm_phase(LAS unsigned char* lds, const bf16_t* A, const int K, const Sched& S, const Epi& E) {
    int tid_ = threadIdx.x; asm volatile("" : "+v"(tid_));
    const int tid = tid_, wid = __builtin_amdgcn_readfirstlane(tid >> 6), lane = tid & 63, wr = wid >> 2, wc = wid & 3, fr = lane & 15, fq = lane >> 4;
    const int nt = K / BK;
    constexpr bool GA = Sched::GATHER;
    int Rr[2], Cc[2]; unsigned voffB[2], voffA[2];
#pragma unroll
    for (int i = 0; i < 2; ++i) { int R, C; stage_rc(tid * 16 + i * 8192, R, C); const int Rb = Epi::PERM ? ((R & ~31) + perm32(R & 31)) : R;
        Rr[i] = R; Cc[i] = C; voffB[i] = (unsigned)(Rb * K + C) * 2u; voffA[i] = (unsigned)(R * K + C) * 2u; }
    const size_t kstep = (size_t)(BK * 2);
    const size_t hstep = (size_t)HALF * K * 2;
    const unsigned ldsw = (unsigned)wid * 1024u;
    const int aoff = lds_byte(wr * 64 + fr, fq * 8), boff = lds_byte(wc * 32 + fr, fq * 8);
#define PG8_SA(b, h) (((b) * 2 + (h)) * HTB)
#define PG8_SB(b, h) ((4 + (b) * 2 + (h)) * HTB)
#define PG8_STAGE(bufoff, gbase, voff) do { _Pragma("unroll") for (int _i = 0; _i < 2; ++_i) \
        __builtin_amdgcn_global_load_lds((const unsigned*)((const char*)(gbase) + (voff)[_i]), (LAS unsigned*)(lds + (bufoff) + ldsw + _i * 8192), 16, 0, 0); } while (0)
#define PG8_LDA(dst, b, h) do { _Pragma("unroll") for (int m = 0; m < 4; ++m) _Pragma("unroll") for (int k = 0; k < 2; ++k) dst[m][k] = *(const LAS bf16x8*)(lds + PG8_SA(b, h) + aoff + m * 2048 + k * 1024); } while (0)
#define PG8_LDB(dst, b, h) do { _Pragma("unroll") for (int n = 0; n < 2; ++n) _Pragma("unroll") for (int k = 0; k < 2; ++k) dst[n][k] = *(const LAS bf16x8*)(lds + PG8_SB(b, h) + boff + n * 2048 + k * 1024); } while (0)
#define PG8_MMA(ai, bj, At, Bt) do { __builtin_amdgcn_s_setprio(1); _Pragma("unroll") for (int m = 0; m < 4; ++m) _Pragma("unroll") for (int n = 0; n < 2; ++n) _Pragma("unroll") for (int k = 0; k < 2; ++k) \
        acc[ai][bj][m][n] = __builtin_amdgcn_mfma_f32_16x16x32_bf16(Bt[n][k], At[m][k], acc[ai][bj][m][n], 0, 0, 0); __builtin_amdgcn_s_setprio(0); } while (0)
#define PG8_WAIT_V(n) asm volatile("s_waitcnt vmcnt(" #n ")" ::: "memory")
#define PG8_WAIT_L(n) asm volatile("s_waitcnt lgkmcnt(" #n ")" ::: "memory")
#define PG8_BAR __builtin_amdgcn_s_barrier()
#define PG8_SCHED __builtin_amdgcn_sched_barrier(0)
    Unit cur, nxt; int ui = 0;
    if (!S.next(0, cur)) return;
    f32x4 acc[2][2][4][2];
#pragma unroll
    for (int a = 0; a < 2; ++a)
#pragma unroll
        for (int b = 0; b < 2; ++b)
#pragma unroll
            for (int m = 0; m < 4; ++m)
#pragma unroll
                for (int n = 0; n < 2; ++n) acc[a][b][m][n] = (f32x4){0.f, 0.f, 0.f, 0.f};
    bf16x8 At[4][2], B0[2][2], B1[2][2];
    unsigned oc0[2], oc1[2], on0[2], on1[2];
#pragma unroll
    for (int i = 0; i < 2; ++i) { if (GA) { oc0[i] = S.a_off(cur, Rr[i]) + (unsigned)Cc[i] * 2u; oc1[i] = S.a_off(cur, HALF + Rr[i]) + (unsigned)Cc[i] * 2u; } else { oc0[i] = voffA[i]; oc1[i] = voffA[i]; } on0[i] = oc0[i]; on1[i] = oc1[i]; }
    const size_t hA = GA ? (size_t)0 : hstep;
    const char* Ab = GA ? (const char*)A : (const char*)A + (size_t)cur.pm * 2 * hstep;
    const char* cB = S.b_ptr(cur);
    PG8_STAGE(PG8_SB(0, 0), cB, voffB); PG8_STAGE(PG8_SB(0, 1), cB + hstep, voffB); PG8_STAGE(PG8_SA(0, 0), Ab, oc0); PG8_STAGE(PG8_SA(0, 1), Ab + hA, oc1);
    if (wr == 1) PG8_BAR;
    PG8_WAIT_V(2); PG8_BAR;
    PG8_STAGE(PG8_SB(1, 0), cB + kstep, voffB); PG8_STAGE(PG8_SA(1, 0), Ab + kstep, oc0); PG8_STAGE(PG8_SB(1, 1), cB + hstep + kstep, voffB);
    PG8_WAIT_V(6); PG8_BAR;
    for (;;) {
        const bool has_next = S.next(ui + 1, nxt);
        const char* nB = has_next ? S.b_ptr(nxt) : cB;
        const char* nA = GA ? Ab : (has_next ? (const char*)A + (size_t)nxt.pm * 2 * hstep : Ab);
        if (GA) {
            if (has_next) {
#pragma unroll
                for (int i = 0; i < 2; ++i) { on0[i] = S.a_off(nxt, Rr[i]) + (unsigned)Cc[i] * 2u; on1[i] = S.a_off(nxt, HALF + Rr[i]) + (unsigned)Cc[i] * 2u; }
            } else {
#pragma unroll
                for (int i = 0; i < 2; ++i) { on0[i] = oc0[i]; on1[i] = oc1[i]; }
            }
        }
        for (int t = 0; t < nt; t += 2) {
            const bool last = (t == nt - 2);
            const char* a1 = Ab + (size_t)(t + 1) * kstep + hA;
            const char* a2 = last ? nA : Ab + (size_t)(t + 2) * kstep; const char* b2 = last ? nB : cB + (size_t)(t + 2) * kstep;
            const char* a3 = a2 + kstep; const char* b3 = b2 + kstep;
            unsigned o20[2], o21[2];
#pragma unroll
            for (int i = 0; i < 2; ++i) { if (GA) { o20[i] = last ? on0[i] : oc0[i]; o21[i] = last ? on1[i] : oc1[i]; } else { o20[i] = voffA[i]; o21[i] = voffA[i]; } }
            PG8_LDB(B0, 0, 0); PG8_LDB(B1, 0, 1); PG8_SCHED; PG8_LDA(At, 0, 0); PG8_STAGE(PG8_SA(1, 1), a1, oc1);
            PG8_WAIT_V(8); PG8_WAIT_L(0); PG8_BAR; PG8_MMA(0, 0, At, B0); PG8_MMA(0, 1, At, B1); PG8_BAR; PG8_SCHED;
            PG8_LDA(At, 0, 1); PG8_STAGE(PG8_SB(0, 0), b2, voffB); PG8_STAGE(PG8_SB(0, 1), b2 + hstep, voffB); PG8_STAGE(PG8_SA(0, 0), a2, o20);
            PG8_WAIT_V(8); PG8_WAIT_L(0); PG8_BAR; PG8_MMA(1, 0, At, B0); PG8_MMA(1, 1, At, B1); PG8_BAR; PG8_SCHED;
            PG8_LDB(B0, 1, 0); PG8_LDB(B1, 1, 1); PG8_SCHED; PG8_LDA(At, 1, 0); PG8_STAGE(PG8_SA(0, 1), a2 + hA, o21);
            PG8_WAIT_V(8); PG8_WAIT_L(0); PG8_BAR; PG8_MMA(0, 0, At, B0); PG8_MMA(0, 1, At, B1); PG8_BAR; PG8_SCHED;
            PG8_LDA(At, 1, 1); PG8_STAGE(PG8_SB(1, 0), b3, voffB); PG8_STAGE(PG8_SB(1, 1), b3 + hstep, voffB); PG8_STAGE(PG8_SA(1, 0), a3, o20);
            PG8_WAIT_V(8); PG8_WAIT_L(0); PG8_BAR; PG8_MMA(1, 0, At, B0); PG8_MMA(1, 1, At, B1); PG8_BAR; PG8_SCHED;
        }
        if (wr == 0) PG8_BAR;
        E(acc, cur, wr, wc, fr, fq);
        if (!has_next) break;
#pragma unroll
        for (int a = 0; a < 2; ++a)
#pragma unroll
            for (int b = 0; b < 2; ++b)
#pragma unroll
                for (int m = 0; m < 4; ++m)
#pragma unroll
                    for (int n = 0; n < 2; ++n) acc[a][b][m][n] = (f32x4){0.f, 0.f, 0.f, 0.f};
        cur = nxt; cB = nB; Ab = nA; ++ui;
        if (GA) {
#pragma unroll
            for (int i = 0; i < 2; ++i) { oc0[i] = on0[i]; oc1[i] = on1[i]; }
        }
        if (wr == 1) PG8_BAR;
    }
    PG8_WAIT_V(0);
    PG8_BAR;
#undef PG8_SA
#undef PG8_SB
#undef PG8_STAGE
#undef PG8_LDA
#undef PG8_LDB
#undef PG8_MMA
#undef PG8_WAIT_V
#undef PG8_WAIT_L
#undef PG8_BAR
#undef PG8_SCHED
}

struct PlainSched {
    static constexpr bool GATHER = false;
    int nN, nwg, G, c, K; const bf16_t* Bt;
    DI bool next(int i, Unit& u) const { const int L = i * G + c; if (L >= nwg) return false; u.pm = L / nN; u.pn = L - u.pm * nN; u.e = 0; return true; }
    DI unsigned a_off(const Unit& u, int r) const { return (unsigned)(u.pm * BM + r) * (unsigned)(K * 2); }
    DI const char* b_ptr(const Unit& u) const { return (const char*)Bt + (size_t)u.pn * BM * K * 2; }
};
template <bool GATHER_> struct MoeSched {
    static constexpr bool GATHER = GATHER_;
    const LAS unsigned* tab; int G, c, K; const bf16_t* Bt; size_t estride; const unsigned* tok;
    DI bool next(int i, Unit& u) const { const int L = i * G + c; const int ntile = (int)tab[0]; if (L >= ntile * 4) return false; u.pm = L >> 2; u.pn = L & 3; u.e = (int)tab[1 + u.pm]; return true; }
    DI unsigned a_off(const Unit& u, int r) const { const unsigned row = GATHER_ ? tok[u.pm * BM + r] : (unsigned)(u.pm * BM + r); return row * (unsigned)(K * 2); }
    DI const char* b_ptr(const Unit& u) const { return (const char*)Bt + (size_t)u.e * estride + (size_t)u.pn * BM * K * 2; }
};

struct EpiStore {
    static constexpr bool PERM = true;
    bf16_t* O; int ldc;
    DI void operator()(const f32x4 (&acc)[2][2][4][2], const Unit& u, int wr, int wc, int fr, int fq) const {
        const int row0 = u.pm * BM + wr * 64 + fr, col0 = u.pn * BM + wc * 32 + 8 * fq;
#pragma unroll
        for (int ai = 0; ai < 2; ++ai)
#pragma unroll
            for (int m = 0; m < 4; ++m) { bf16_t* rowp = O + (size_t)(row0 + ai * HALF + m * 16) * ldc + col0;
#pragma unroll
                for (int bj = 0; bj < 2; ++bj) { const f32x4 v0 = acc[ai][bj][m][0], v1 = acc[ai][bj][m][1];
                    u32x4 w; w.x = cvt_pk_bf16(v0[0], v0[1]); w.y = cvt_pk_bf16(v0[2], v0[3]); w.z = cvt_pk_bf16(v1[0], v1[1]); w.w = cvt_pk_bf16(v1[2], v1[3]);
                    *(u32x4*)(rowp + bj * HALF) = w; } }
    }
};
struct EpiResid {
    static constexpr bool PERM = false;
    float* X; const float* gate;
    DI void operator()(const f32x4 (&acc)[2][2][4][2], const Unit& u, int wr, int wc, int fr, int fq) const {
        const int mb = (u.pm < TLAT / BM) ? (u.pm >> 3) : 16;
        const float* gt = gate + (size_t)mb * 6144;
        const int row0 = u.pm * BM + wr * 64 + fr, col0 = u.pn * BM + wc * 32 + 4 * fq;
        f32x4 g[2][2];
#pragma unroll
        for (int bj = 0; bj < 2; ++bj)
#pragma unroll
            for (int n = 0; n < 2; ++n) g[bj][n] = *(const f32x4*)(gt + col0 + bj * HALF + n * 16);
#pragma unroll
        for (int ai = 0; ai < 2; ++ai)
#pragma unroll
            for (int m = 0; m < 4; ++m) { float* rowp = X + (size_t)(row0 + ai * HALF + m * 16) * DM + col0;
#pragma unroll
                for (int bj = 0; bj < 2; ++bj)
#pragma unroll
                    for (int n = 0; n < 2; ++n) { f32x4* p = (f32x4*)(rowp + bj * HALF + n * 16); *p = *p + g[bj][n] * acc[ai][bj][m][n]; } }
    }
};
DI float silu_mul(float g, float u) { return g * __builtin_amdgcn_rcpf(1.f + __builtin_amdgcn_exp2f(-g * LOG2E)) * u; }
struct EpiSwiglu {
    static constexpr bool PERM = true;
    bf16_t* ACT;
    DI void operator()(const f32x4 (&acc)[2][2][4][2], const Unit& u, int wr, int wc, int fr, int fq) const {
        const int row0 = u.pm * BM + wr * 64 + fr, col0 = u.pn * HALF + wc * 32 + 8 * fq;
#pragma unroll
        for (int ai = 0; ai < 2; ++ai)
#pragma unroll
            for (int m = 0; m < 4; ++m) { bf16_t* rowp = ACT + (size_t)(row0 + ai * HALF + m * 16) * FH + col0;
                const f32x4 g0 = acc[ai][0][m][0], g1 = acc[ai][0][m][1], u0 = acc[ai][1][m][0], u1 = acc[ai][1][m][1];
                u32x4 w; w.x = cvt_pk_bf16(silu_mul(g0[0], u0[0]), silu_mul(g0[1], u0[1])); w.y = cvt_pk_bf16(silu_mul(g0[2], u0[2]), silu_mul(g0[3], u0[3]));
                w.z = cvt_pk_bf16(silu_mul(g1[0], u1[0]), silu_mul(g1[1], u1[1])); w.w = cvt_pk_bf16(silu_mul(g1[2], u1[2]), silu_mul(g1[3], u1[3]));
                *(u32x4*)rowp = w; }
    }
};
}

struct Params { const float* in[22]; float* out; unsigned char* ws; };
enum { IN_X = 0, IN_C, IN_CTX, IN_CCTX, IN_WADA, IN_BADA, IN_GATTN, IN_WQKV, IN_WO, IN_SINK, IN_GQ, IN_GK, IN_RPB, IN_GFFN, IN_WGROUP, IN_BGROUP, IN_WROUTER, IN_BROUTER, IN_WGATE, IN_WUP, IN_WDOWN, IN_GFINAL };

DI const float* inp(const Params& P, int i) { i = __builtin_amdgcn_readfirstlane(i); asm volatile("" : "+s"(i)); return P.in[i]; }
DI unsigned char* wsp(const Params& P) { const unsigned long long w = (unsigned long long)P.ws; unsigned lo = __builtin_amdgcn_readfirstlane((unsigned)w), hi = __builtin_amdgcn_readfirstlane((unsigned)(w >> 32)); asm volatile("" : "+s"(lo), "+s"(hi)); return (unsigned char*)(((unsigned long long)hi << 32) | lo); }
struct Frame { LAS unsigned char* lds; int tid, lane, wave, blk, G, vcu, gw, NGW; };
DI Frame opaque_frame(const Frame& F0) { Frame F = F0; asm volatile("" : "+v"(F.tid), "+v"(F.lane)); asm volatile("" : "+s"(F.wave), "+s"(F.blk), "+s"(F.vcu), "+s"(F.gw)); return F; }

DI void p0_transpose_item(const float* W, int N, int k0, int n0, bf16_t* dst, int Kd, LAS float* scr, int lane) {
#pragma unroll 8
    for (int i = 0; i < 32; ++i) { const int kk = 2 * i + (lane >> 5); scr[kk * 33 + (lane & 31)] = W[(size_t)(k0 + kk) * N + n0 + (lane & 31)]; }
    LDS_WAIT();
    const int c = lane & 7;
#pragma unroll
    for (int j = 0; j < 4; ++j) { const int n = (lane >> 3) + 8 * j; const LAS float* s = scr + (8 * c) * 33 + n;
        u32x4 o; o.x = pk2(s[0 * 33], s[1 * 33]); o.y = pk2(s[2 * 33], s[3 * 33]); o.z = pk2(s[4 * 33], s[5 * 33]); o.w = pk2(s[6 * 33], s[7 * 33]);
        *(u32x4*)(dst + (size_t)n * Kd + 8 * c) = o; }
    LDS_WAIT();
}
DI double dsin_poly(double r) { const double r2 = r * r;
    return r * (1.0 - r2 * (1.0 / 6.0) * (1.0 - r2 * (1.0 / 20.0) * (1.0 - r2 * (1.0 / 42.0) * (1.0 - r2 * (1.0 / 72.0) * (1.0 - r2 * (1.0 / 110.0) * (1.0 - r2 * (1.0 / 156.0) * (1.0 - r2 * (1.0 / 210.0) * (1.0 - r2 * (1.0 / 272.0) * (1.0 - r2 * (1.0 / 342.0) * (1.0 - r2 * (1.0 / 420.0) * (1.0 - r2 * (1.0 / 506.0)))))))))))); }
DI double dcos_poly(double r) { const double r2 = r * r;
    return 1.0 - r2 * (1.0 / 2.0) * (1.0 - r2 * (1.0 / 12.0) * (1.0 - r2 * (1.0 / 30.0) * (1.0 - r2 * (1.0 / 56.0) * (1.0 - r2 * (1.0 / 90.0) * (1.0 - r2 * (1.0 / 132.0) * (1.0 - r2 * (1.0 / 182.0) * (1.0 - r2 * (1.0 / 240.0) * (1.0 - r2 * (1.0 / 306.0) * (1.0 - r2 * (1.0 / 380.0) * (1.0 - r2 * (1.0 / 462.0) * (1.0 - r2 * (1.0 / 552.0)))))))))))); }

constexpr int IT_MOD = DEPTH * 96 * 8;
constexpr int IT_QKV = (DM / 64) * (QKVN / 32), IT_WO = (DM / 64) * (DM / 32), IT_GU = NEXP * (DM / 64) * (FH / 32), IT_DN = NEXP * (FH / 64) * (DM / 32);
constexpr int IT_LAYER = IT_QKV + IT_WO + 2 * IT_GU + IT_DN;
constexpr int IT_TOTAL = IT_MOD + DEPTH * IT_LAYER;

DI void p0_prologue(const Params& P, const Frame& F) {
    LAS float* scr = (LAS float*)(F.lds + F.wave * 16384);
    unsigned char* ws = wsp(P);
    for (int it = F.gw; it < IT_TOTAL; it += F.NGW) {
        if (it < IT_MOD) {
            const int l = it / (96 * 8), rem = it % (96 * 8), cc = rem >> 3, ks = rem & 7;
            for (int idx = F.lane; idx < 17 * 128; idx += 64) { const int b = idx >> 7, k = idx & 127;
                const float cv = (b < 16) ? inp(P, IN_C)[b * DM + ks * 128 + k] : inp(P, IN_CCTX)[ks * 128 + k];
                scr[idx] = cv / (1.f + expf(-cv)); }
            LDS_WAIT();
            float acc[17];
#pragma unroll
            for (int b = 0; b < 17; ++b) acc[b] = 0.f;
            const float* wp = inp(P, IN_WADA) + ((size_t)l * DM + ks * 128) * 6144 + cc * 64 + F.lane;
#pragma unroll 4
            for (int k = 0; k < 128; ++k) { const float w = wp[(size_t)k * 6144];
#pragma unroll
                for (int b = 0; b < 17; ++b) acc[b] += scr[b * 128 + k] * w; }
            float* mp = (float*)(ws + WS_MODP) + ((size_t)(ks * DEPTH + l) * 17) * 6144 + cc * 64 + F.lane;
#pragma unroll
            for (int b = 0; b < 17; ++b) mp[(size_t)b * 6144] = acc[b];
            LDS_WAIT();
            continue;
        }
        int r = it - IT_MOD; const int l = r / IT_LAYER; r -= l * IT_LAYER;
        if (r < IT_QKV) { const int kb = r / (QKVN / 32), nb = r % (QKVN / 32);
            p0_transpose_item(inp(P, IN_WQKV) + (size_t)l * DM * QKVN, QKVN, kb * 64, nb * 32, (bf16_t*)(ws + WS_WQKV) + (size_t)l * QKVN * DM + (size_t)(nb * 32) * DM + kb * 64, DM, scr, F.lane); continue; }
        r -= IT_QKV;
        if (r < IT_WO) { const int kb = r / (DM / 32), nb = r % (DM / 32);
            p0_transpose_item(inp(P, IN_WO) + (size_t)l * DM * DM, DM, kb * 64, nb * 32, (bf16_t*)(ws + WS_WO) + (size_t)l * DM * DM + (size_t)(nb * 32) * DM + kb * 64, DM, scr, F.lane); continue; }
        r -= IT_WO;
        if (r < 2 * IT_GU) { const int which = r / IT_GU; r -= which * IT_GU; const int e = r / 256, kb = (r % 256) / 16, nb = r % 16; const int n0 = nb * 32;
            const int drow0 = 256 * (n0 >> 7) + 128 * which + (n0 & 127);
            p0_transpose_item(inp(P, which ? IN_WUP : IN_WGATE) + (size_t)(l * NEXP + e) * DM * FH, FH, kb * 64, n0,
                              (bf16_t*)(ws + WS_WGU) + (size_t)(l * NEXP + e) * DM * DM + (size_t)drow0 * DM + kb * 64, DM, scr, F.lane); continue; }
        r -= 2 * IT_GU;
        { const int e = r / 256, kb = (r % 256) / 32, nb = r % 32;
            p0_transpose_item(inp(P, IN_WDOWN) + (size_t)(l * NEXP + e) * FH * DM, DM, kb * 64, nb * 32,
                              (bf16_t*)(ws + WS_WD) + (size_t)(l * NEXP + e) * DM * FH + (size_t)(nb * 32) * FH + kb * 64, FH, scr, F.lane); }
    }
    if (F.gw == F.NGW - 1) {
        f32x2* T = (f32x2*)(ws + WS_ROPE);
        for (int idx = F.lane; idx < 64 * 16; idx += 64) { const int pos = idx >> 4, j = idx & 15;
            const float inv = exp2f(-(float)j * (1.f / 16.f) * 13.287712379549449f);
            const float ang = (float)pos * inv;
            const double a = (double)ang; const double rr = a - 6.283185307179586 * rint(a * 0.15915494309189535);
            T[idx] = (f32x2){(float)dcos_poly(rr), (float)dsin_poly(rr)}; }
    }
    { float* wf = (float*)(ws + WS_WRT); const float* wg = inp(P, IN_WGROUP); const float* wr = inp(P, IN_WROUTER);
      for (int idx = F.gw * 64 + F.lane; idx < DEPTH * 256 * 3 * 64; idx += F.NGW * 64) { const int l = idx / (256 * 3 * 64), rem = idx % (256 * 3 * 64), step = rem / 192, nt = (rem % 192) >> 6, ln = rem & 63;
          const int k = 4 * step + (ln >> 4), n = 16 * nt + (ln & 15);
          wf[idx] = (n < 4) ? wg[((size_t)l * DM + k) * 4 + n] : (n < 36 ? wr[((size_t)l * DM + k) * 32 + (n - 4)] : 0.f); } }
}
DI void p0b_mod_reduce(const Params& P, const Frame& F) {
    unsigned char* const ws = wsp(P);
    const float* mp = (const float*)(ws + WS_MODP); float* mod = (float*)(ws + WS_MOD);
    for (int idx = F.gw * 64 + F.lane; idx < DEPTH * 17 * 6144; idx += F.NGW * 64) {
        const int l = idx / (17 * 6144), c = idx % 6144;
        float s = inp(P, IN_BADA)[l * 6144 + c];
#pragma unroll
        for (int ks = 0; ks < 8; ++ks) s += mp[(size_t)ks * DEPTH * 17 * 6144 + idx];
        mod[idx] = s; }
}

DI void load_row(const float* row, int lane, f32x4 (&v)[4]) {
#pragma unroll
    for (int j = 0; j < 4; ++j) v[j] = *(const f32x4*)(row + 4 * lane + 256 * j);
}
DI float row_rstd(const f32x4 (&v)[4]) {
    float s = 0.f;
#pragma unroll
    for (int j = 0; j < 4; ++j) s += (v[j][0] * v[j][0] + v[j][1] * v[j][1]) + (v[j][2] * v[j][2] + v[j][3] * v[j][3]);
    return 1.0f / sqrtf(wave_sum(s) * (1.f / DM) + NORM_EPS);
}
DI void moe_combine(unsigned char* ws, int prev_layer, int t, int mb, int lane, f32x4 (&v)[4]) {
    const unsigned* slot = (const unsigned*)(ws + WS_SLOT) + (size_t)t * 2; const float* aw = (const float*)(ws + WS_ASGW) + (size_t)t * 2;
    const unsigned s0 = slot[0], s1 = slot[1]; const float w0 = aw[0], w1 = aw[1];
    const bf16_t* Y = (const bf16_t*)(ws + WS_Y);
    const float* gt = (const float*)(ws + WS_MOD) + ((size_t)prev_layer * 17 + mb) * 6144 + 5120;
#pragma unroll
    for (int j = 0; j < 4; ++j) { const int c = 4 * lane + 256 * j;
        const u32x2 a = *(const u32x2*)(Y + (size_t)s0 * DM + c), b = *(const u32x2*)(Y + (size_t)s1 * DM + c); const f32x4 g = *(const f32x4*)(gt + c);
        v[j][0] += g[0] * (w0 * bf2f(a.x & 0xffffu) + w1 * bf2f(b.x & 0xffffu)); v[j][1] += g[1] * (w0 * bf2f(a.x >> 16) + w1 * bf2f(b.x >> 16));
        v[j][2] += g[2] * (w0 * bf2f(a.y & 0xffffu) + w1 * bf2f(b.y & 0xffffu)); v[j][3] += g[3] * (w0 * bf2f(a.y >> 16) + w1 * bf2f(b.y >> 16)); }
}
DI void norm_mod_store(const f32x4 (&v)[4], float rstd, const float* g, const float* shift, const float* scale, bf16_t* hrow, int lane, f32x4 (&hf)[4]) {
#pragma unroll
    for (int j = 0; j < 4; ++j) { const int c = 4 * lane + 256 * j; const f32x4 gg = *(const f32x4*)(g + c), sh = *(const f32x4*)(shift + c), sc = *(const f32x4*)(scale + c);
        hf[j] = (v[j] * rstd * gg) * (1.f + sc) + sh;
        u32x2 w; w.x = pk2(hf[j][0], hf[j][1]); w.y = pk2(hf[j][2], hf[j][3]); *(u32x2*)(hrow + c) = w; }
}
DI void phase_attn_norm(const Params& P, const Frame& F0, int layer) {
    unsigned char* const ws = wsp(P);
    const Frame F = opaque_frame(F0);
    float* X = (float*)(ws + WS_X); bf16_t* H = (bf16_t*)(ws + WS_H);
    for (int t = F.gw; t < TALL; t += F.NGW) {
        const bool lat = t < TLAT; const int mb = lat ? (t >> 11) : 16;
        f32x4 v[4];
        if (layer == 0) load_row(lat ? inp(P, IN_X) + (size_t)t * DM : inp(P, IN_CTX) + (size_t)(t - TLAT) * DM, F.lane, v);
        else { load_row(X + (size_t)t * DM, F.lane, v); moe_combine(ws, layer - 1, t, mb, F.lane, v); }
#pragma unroll
        for (int j = 0; j < 4; ++j) *(f32x4*)(X + (size_t)t * DM + 4 * F.lane + 256 * j) = v[j];
        const float rstd = row_rstd(v);
        const float* md = (const float*)(ws + WS_MOD) + ((size_t)layer * 17 + mb) * 6144;
        f32x4 hf[4];
        norm_mod_store(v, rstd, inp(P, IN_GATTN) + layer * DM, md, md + 1024, H + (size_t)t * DM, F.lane, hf);
    }
}
DI void phase_final(const Params& P, const Frame& F0) {
    unsigned char* const ws = wsp(P);
    const Frame F = opaque_frame(F0);
    const float* X = (const float*)(ws + WS_X);
    for (int t = F.gw; t < TLAT; t += F.NGW) {
        f32x4 v[4]; load_row(X + (size_t)t * DM, F.lane, v); moe_combine(ws, DEPTH - 1, t, t >> 11, F.lane, v);
        const float rstd = row_rstd(v);
#pragma unroll
        for (int j = 0; j < 4; ++j) { const int c = 4 * F.lane + 256 * j; const f32x4 g = *(const f32x4*)(inp(P, IN_GFINAL) + c); *(f32x4*)(P.out + (size_t)t * DM + c) = v[j] * rstd * g; }
    }
}

DI void unpack8(const u32x4 w, float (&x)[8]) { x[0] = bf2f(w.x & 0xffffu); x[1] = bf2f(w.x >> 16); x[2] = bf2f(w.y & 0xffffu); x[3] = bf2f(w.y >> 16); x[4] = bf2f(w.z & 0xffffu); x[5] = bf2f(w.z >> 16); x[6] = bf2f(w.w & 0xffffu); x[7] = bf2f(w.w >> 16); }
DI u32x4 pack8(const float (&x)[8]) { u32x4 w; w.x = pk2(x[0], x[1]); w.y = pk2(x[2], x[3]); w.z = pk2(x[4], x[5]); w.w = pk2(x[6], x[7]); return w; }
DI void head_rmsnorm(float (&x)[8], const float* g8) {
    float s = 0.f;
#pragma unroll
    for (int e = 0; e < 8; ++e) s += x[e] * x[e];
    s += __shfl_xor(s, 1); s += __shfl_xor(s, 2); s += __shfl_xor(s, 4);
    const float rs = 1.0f / sqrtf(s * (1.f / HD) + NORM_EPS);
#pragma unroll
    for (int e = 0; e < 8; ++e) x[e] = x[e] * rs * g8[e];
}
DI void phase_qkv_post(const Params& P, const Frame& F0, int layer) {
    unsigned char* const ws = wsp(P);
    const Frame F = opaque_frame(F0);
    const int m = layer % 3;
    bf16_t* QKV = (bf16_t*)(ws + WS_QKV); unsigned char* KF = ws + WS_KF; unsigned char* VF = ws + WS_VF;
    const f32x2* T = (const f32x2*)(ws + WS_ROPE);
    LAS bf16_t* scr = (LAS bf16_t*)(F.lds + F.wave * 16384);
    const int tt = F.lane >> 3, c = F.lane & 7;
    float gq[8], gk[8];
#pragma unroll
    for (int e = 0; e < 8; ++e) { gq[e] = inp(P, IN_GQ)[8 * c + e]; gk[e] = inp(P, IN_GK)[8 * c + e]; }
    for (int g8 = F.gw; g8 < TALL / 8; g8 += F.NGW) {
        const int t = g8 * 8 + tt; const bool lat = t < TLAT;
        const int b = lat ? (t >> 11) : ((t - TLAT) >> 8);
        const int kidx = lat ? (t & 2047) : (2048 + ((t - TLAT) & 255));
        const int gidx = kidx >> 3;
        bf16_t* row = QKV + (size_t)t * QKVN;
        const bool rope = lat && (m != 2);
        float cs[8], sn[8];
        if (rope) { const int n = t & 2047; const int pos = (c < 4) ? (n >> 6) : (n & 63); const f32x2* tp = T + pos * 16 + 8 * (c & 1);
#pragma unroll
            for (int e = 0; e < 8; ++e) { const f32x2 v = tp[e]; cs[e] = v.x; sn[e] = v.y; } }
        else {
#pragma unroll
            for (int e = 0; e < 8; ++e) { cs[e] = 1.f; sn[e] = 0.f; } }
#pragma unroll 4
        for (int hh = 0; hh < NH; ++hh) { float x[8]; unpack8(*(const u32x4*)(row + hh * HD + 8 * c), x);
            if (m == 1) head_rmsnorm(x, gq);
#pragma unroll
            for (int e = 0; e < 8; ++e) x[e] *= 0.125f * LOG2E;
            *(u32x4*)(row + hh * HD + 8 * c) = pack8(x); }
#pragma unroll
        for (int kh = 0; kh < NKV; ++kh) { float x[8]; unpack8(*(const u32x4*)(row + DM + kh * HD + 8 * c), x);
            if (m == 1) head_rmsnorm(x, gk);
            float y[8];
#pragma unroll
            for (int e = 0; e < 8; ++e) { const float pr = __shfl_xor(x[e], 2); y[e] = x[e] * cs[e] + ((c & 2) ? pr : -pr) * sn[e]; }
            *(u32x4*)(KF + ((size_t)(b * NKV + kh) * KGRP + gidx) * 1024 + c * 128 + tt * 16) = pack8(y); }
#pragma unroll
        for (int kh = 0; kh < NKV; ++kh) { const u32x4 w = *(const u32x4*)(row + DM + NKV * HD + kh * HD + 8 * c);
            const unsigned ww[4] = {w.x, w.y, w.z, w.w};
#pragma unroll
            for (int e = 0; e < 8; ++e) scr[(8 * c + e) * 8 + tt] = (bf16_t)((e & 1) ? (ww[e >> 1] >> 16) : (ww[e >> 1] & 0xffffu));
            LDS_WAIT();
            const u32x4 o = *(const LAS u32x4*)((const LAS unsigned char*)scr + F.lane * 16);
            *(u32x4*)(VF + ((size_t)(b * NKV + kh) * KGRP + gidx) * 1024 + F.lane * 16) = o;
            LDS_WAIT(); }
    }
}

DI float swap_max(float v) { auto rr = __builtin_amdgcn_permlane32_swap(__float_as_uint(v), __float_as_uint(v), false, false); return fmaxf(__uint_as_float(rr[0]), __uint_as_float(rr[1])); }
DI float swap_add(float v) { auto rr = __builtin_amdgcn_permlane32_swap(__float_as_uint(v), __float_as_uint(v), false, false); return __uint_as_float(rr[0]) + __uint_as_float(rr[1]); }
DI bf16x8 pack_p(const f32x16& p, int s) {
    u32x4 w; w.x = cvt_pk_bf16(p[8 * s + 0], p[8 * s + 1]); w.y = cvt_pk_bf16(p[8 * s + 2], p[8 * s + 3]); w.z = cvt_pk_bf16(p[8 * s + 4], p[8 * s + 5]); w.w = cvt_pk_bf16(p[8 * s + 6], p[8 * s + 7]);
    return __builtin_bit_cast(bf16x8, w);
}
struct AttnState { float m, l; f32x16 o[2]; };
DI void load_k(const unsigned char* Kbh, int kg, int r32, int hi, bf16x8 (&k)[4]) {
    const unsigned char* kb = Kbh + (size_t)(kg + (r32 >> 3)) * 1024 + hi * 128 + (r32 & 7) * 16;
#pragma unroll
    for (int d0 = 0; d0 < 4; ++d0) k[d0] = *(const bf16x8*)(kb + d0 * 256);
}
DI void load_v(const unsigned char* Vbh, int kg, int r32, int hi, s16x4 (&v)[2][2][2]) {
    const unsigned char* vb = Vbh + (size_t)kg * 1024 + r32 * 16 + hi * 8;
#pragma unroll
    for (int dh = 0; dh < 2; ++dh)
#pragma unroll
        for (int ks = 0; ks < 2; ++ks)
#pragma unroll
            for (int pt = 0; pt < 2; ++pt) v[dh][ks][pt] = *(const s16x4*)(vb + dh * 512 + (2 * ks + pt) * 1024);
}
DI f32x16 attn_scores(const bf16x8 (&k)[4], const bf16x8 (&q)[4]) {
    f32x16 s;
#pragma unroll
    for (int r = 0; r < 16; ++r) s[r] = 0.f;
#pragma unroll
    for (int d0 = 0; d0 < 4; ++d0) s = __builtin_amdgcn_mfma_f32_32x32x16_bf16(k[d0], q[d0], s, 0, 0, 0);
    return s;
}
DI void attn_softmax_pv(AttnState& st, f32x16& s, const s16x4 (&v)[2][2][2], LAS float* wsf, int r32, int hi) {
    float mt = fmaxf(fmaxf(s[0], s[1]), fmaxf(s[2], s[3]));
#pragma unroll
    for (int r = 4; r < 16; r += 4) mt = fmaxf(mt, fmaxf(fmaxf(s[r], s[r + 1]), fmaxf(s[r + 2], s[r + 3])));
    mt = swap_max(mt);
    const float mnew = fmaxf(st.m, mt);
    if (__any(mnew > st.m)) {
        const float al = __builtin_amdgcn_exp2f(st.m - mnew);
        st.l *= al; st.m = mnew;
        if (hi == 0) wsf[r32] = al;
        LDS_WAIT();
#pragma unroll
        for (int r = 0; r < 16; ++r) { const float f = wsf[crow(r, hi)]; st.o[0][r] *= f; st.o[1][r] *= f; }
        LDS_WAIT();
    }
    float ps = 0.f;
#pragma unroll
    for (int r = 0; r < 16; ++r) { s[r] = __builtin_amdgcn_exp2f(s[r] - st.m); ps += s[r]; }
    st.l += ps;
    const bf16x8 pa0 = pack_p(s, 0), pa1 = pack_p(s, 1);
#pragma unroll
    for (int dh = 0; dh < 2; ++dh) {
        const bf16x8 vf0 = __builtin_shufflevector(v[dh][0][0], v[dh][0][1], 0, 1, 2, 3, 4, 5, 6, 7);
        const bf16x8 vf1 = __builtin_shufflevector(v[dh][1][0], v[dh][1][1], 0, 1, 2, 3, 4, 5, 6, 7);
        st.o[dh] = __builtin_amdgcn_mfma_f32_32x32x16_bf16(pa0, vf0, st.o[dh], 0, 0, 0);
        st.o[dh] = __builtin_amdgcn_mfma_f32_32x32x16_bf16(pa1, vf1, st.o[dh], 0, 0, 0);
    }
}
template <int MODE>
DI void attn_unit(const Params& P, unsigned char* ws, int layer, int b, int h, int qblk, LAS unsigned char* wl, int lane) {
    const int r32 = lane & 31, hi = lane >> 5, kvh = h >> 2, m = layer % 3;
    LAS float* wsf = (LAS float*)wl; LAS bf16_t* stg = (LAS bf16_t*)(wl + 256); LAS float* rpbt = (LAS float*)(wl + 256 + 4096);
    const bf16_t* QKV = (const bf16_t*)(ws + WS_QKV);
    const unsigned char* Kbh = ws + WS_KF + (size_t)(b * NKV + kvh) * KGRP * 1024;
    const unsigned char* Vbh = ws + WS_VF + (size_t)(b * NKV + kvh) * KGRP * 1024;
    bf16_t* O = (bf16_t*)(ws + WS_O);
    int r0 = 0, c0 = 0;
    if (MODE == 2) { r0 = 2 * (qblk >> 2); c0 = 16 * (qblk & 3); }
    auto qtok = [&](int i) -> int {
        if (MODE == 3) return TLAT + b * CTXL + qblk * 32 + i;
        if (MODE == 2) return b * SEQ + (r0 + (i >> 4)) * 64 + c0 + (i & 15);
        return b * SEQ + qblk * 32 + i; };
    const int tq = qtok(r32);
    bf16x8 qf[4], qr[4];
    { const bf16_t* qp = QKV + (size_t)tq * QKVN + h * HD + hi * 8;
#pragma unroll
      for (int d0 = 0; d0 < 4; ++d0) qf[d0] = *(const bf16x8*)(qp + d0 * 16); }
    const int q0 = qblk * 32;
    int nl = 0, jlo = 0, rs_min = 0, cseg = 0;
    if (MODE == 0) { jlo = (q0 < 128) ? (128 - q0) / 32 : 0; const int jhi = min(8, (SEQ - 32 - q0 + 128) / 32); nl = jhi - jlo + 1; }
    if (MODE == 1) nl = SEQ / 32;
    if (MODE == 2) { rs_min = min(max(r0 - 4, 0), 24); const int rs_max = min(max(r0 + 1 - 4, 0), 24); nl = rs_max - rs_min + 8; cseg = (c0 == 0) ? 0 : (c0 == 16) ? 8 : (c0 == 32) ? 24 : 32; }
    auto lat_kg = [&](int i) -> int {
        if (MODE == 0) return (q0 - 128 + 32 * (jlo + i)) >> 3;
        if (MODE == 1) return 4 * i;
        return ((rs_min + i) * 64 + cseg) >> 3; };
    bf16x8 kn[4];
    load_k(Kbh, nl > 0 ? lat_kg(0) : SEQ / 8, r32, hi, kn);
    if (MODE == 0 || MODE == 1) {
        const int n = tq & 2047; const f32x2* T = (const f32x2*)(ws + WS_ROPE);
        const f32x2* tr = T + (n >> 6) * 16 + 8 * hi; const f32x2* tc = T + (n & 63) * 16 + 8 * hi;
#pragma unroll
        for (int e = 0; e < 8; ++e) { const f32x2 a = tr[e], cc = tc[e];
            const float x1 = bfs2f(qf[0][e]), x2 = bfs2f(qf[1][e]), x3 = bfs2f(qf[2][e]), x4 = bfs2f(qf[3][e]);
            qr[0][e] = (short)f2bf(x1 * a.x - x2 * a.y); qr[1][e] = (short)f2bf(x2 * a.x + x1 * a.y);
            qr[2][e] = (short)f2bf(x3 * cc.x - x4 * cc.y); qr[3][e] = (short)f2bf(x4 * cc.x + x3 * cc.y); }
    } else {
#pragma unroll
        for (int d0 = 0; d0 < 4; ++d0) qr[d0] = qf[d0];
    }
    int rq = 0, cq = 0, rsq = 0, csq = 0;
    if (MODE == 2) {
        const float* rpb = inp(P, IN_RPB) + (size_t)h * 465;
        for (int i = lane; i < 465; i += 64) rpbt[i] = rpb[i] * LOG2E;
        LDS_WAIT();
        rq = r0 + (r32 >> 4); cq = c0 + (r32 & 15); rsq = min(max(rq - 4, 0), 24); csq = min(max(cq - 8, 0), 48);
    }
    AttnState st; st.m = -1e30f; st.l = 0.f;
#pragma unroll
    for (int r = 0; r < 16; ++r) { st.o[0][r] = 0.f; st.o[1][r] = 0.f; }
    const float NEG = -INFINITY;
    for (int i = 0; i < nl; ++i) {
        const int kg = lat_kg(i), kgn = (i + 1 < nl) ? lat_kg(i + 1) : SEQ / 8;
        bf16x8 kc[4];
#pragma unroll
        for (int d0 = 0; d0 < 4; ++d0) kc[d0] = kn[d0];
        s16x4 v[2][2][2];
        load_v(Vbh, kg, r32, hi, v);
        load_k(Kbh, kgn, r32, hi, kn);
        f32x16 s = attn_scores(kc, qr);
        if (MODE == 0) {
            const int j = jlo + i;
            if (j == 0 || j == 8) { const int kt = q0 - 128 + 32 * j, qpos = q0 + r32;
#pragma unroll
                for (int r = 0; r < 16; ++r) { const int d = kt + crow(r, hi) - qpos; if (d > 128 || d < -128) s[r] = NEG; } }
        }
        if (MODE == 2) {
            const int kr = rs_min + i;
            const bool rowok = (kr >= rsq) && (kr < rsq + 8);
            const int ib = (kr - rq + 7) * 31 - cq + 15;
#pragma unroll
            for (int r = 0; r < 16; ++r) { const int kc2 = cseg + crow(r, hi); const bool ok = rowok && (kc2 >= csq) && (kc2 < csq + 16);
                const int idx = min(max(ib + kc2, 0), 464); const float bias = rpbt[idx];
                s[r] = ok ? s[r] + bias : NEG; }
        }
        attn_softmax_pv(st, s, v, wsf, r32, hi);
    }
    for (int j = 0; j < CTXL / 32; ++j) {
        const int kg = SEQ / 8 + 4 * j, kgn = (j + 1 < CTXL / 32) ? kg + 4 : kg;
        bf16x8 kc[4];
#pragma unroll
        for (int d0 = 0; d0 < 4; ++d0) kc[d0] = kn[d0];
        s16x4 v[2][2][2];
        load_v(Vbh, kg, r32, hi, v);
        load_k(Kbh, kgn, r32, hi, kn);
        f32x16 s = attn_scores(kc, qf);
        attn_softmax_pv(st, s, v, wsf, r32, hi);
    }
    const float lt = swap_add(st.l);
    float inv;
    if (MODE == 0 || (MODE == 3 && m == 0)) { const float sk = inp(P, IN_SINK)[(layer / 3) * NH + h] * LOG2E;
        const float mnew = fmaxf(st.m, sk); const float al = __builtin_amdgcn_exp2f(st.m - mnew), es = __builtin_amdgcn_exp2f(sk - mnew);
        inv = al / (lt * al + es); }
    else inv = 1.f / lt;
    if (hi == 0) wsf[r32] = inv;
    LDS_WAIT();
#pragma unroll
    for (int r = 0; r < 16; ++r) { const int orow = crow(r, hi); const float f = wsf[orow];
        stg[orow * 64 + r32] = (bf16_t)f2bf(st.o[0][r] * f); stg[orow * 64 + 32 + r32] = (bf16_t)f2bf(st.o[1][r] * f); }
    LDS_WAIT();
#pragma unroll
    for (int i = 0; i < 4; ++i) { const int row = i * 8 + (lane >> 3), ch = lane & 7;
        const u32x4 v = *(const LAS u32x4*)((const LAS unsigned char*)stg + row * 128 + ch * 16);
        *(u32x4*)(O + (size_t)qtok(row) * DM + h * HD + ch * 8) = v; }
    LDS_WAIT();
}
DI void phase_attention(const Params& P, const Frame& F0, int layer) {
    unsigned char* const ws = wsp(P);
    const Frame F = opaque_frame(F0);
    const int m = layer % 3;
    LAS unsigned char* wl = F.lds + F.wave * 16384;
    for (int bu = F.blk; bu < NB * NKV * 32; bu += F.G) {
        const int bkv = (bu >> 8) * 8 + (bu & 7), qp = (bu & 255) >> 3;
        const int b = bkv >> 2, kvh = bkv & 3, h = kvh * 4 + (F.wave & 3), qblk = 2 * qp + (F.wave >> 2);
        if (m == 0) attn_unit<0>(P, ws, layer, b, h, qblk, wl, F.lane);
        else if (m == 1) attn_unit<1>(P, ws, layer, b, h, qblk, wl, F.lane);
        else attn_unit<2>(P, ws, layer, b, h, qblk, wl, F.lane);
    }
    if (layer < DEPTH - 1) {
        for (int bu = F.blk; bu < NB * NKV * 4; bu += F.G) {
            const int b = bu >> 4, kvh = (bu >> 2) & 3, qp = bu & 3, h = kvh * 4 + (F.wave & 3), qblk = 2 * qp + (F.wave >> 2);
            attn_unit<3>(P, ws, layer, b, h, qblk, wl, F.lane);
        }
    }
}

constexpr int RT_STRIDE = 1026;
constexpr int RT_PART_OFF = 16 * RT_STRIDE * 4 + 896;
DI void route_token(float lgv, int t, int lane, LAS int* hist, unsigned* asg, float* asgw) {
    const float g0 = __shfl(lgv, 0), g1 = __shfl(lgv, 1), g2 = __shfl(lgv, 2), g3 = __shfl(lgv, 3);
    int grp = 0; float gm = g0; if (g1 > gm) { gm = g1; grp = 1; } if (g2 > gm) { gm = g2; grp = 2; } if (g3 > gm) { gm = g3; grp = 3; }
    const float ptop = 1.f / (expf(g0 - gm) + expf(g1 - gm) + expf(g2 - gm) + expf(g3 - gm));
    float ev[8], em = -INFINITY;
#pragma unroll
    for (int j = 0; j < 8; ++j) { ev[j] = __shfl(lgv, 4 + grp * 8 + j); em = fmaxf(em, ev[j]); }
    float pe[8];
#pragma unroll
    for (int j = 0; j < 8; ++j) pe[j] = expf(ev[j] - em);
    int i1 = 0; float p1 = pe[0];
#pragma unroll
    for (int j = 1; j < 8; ++j) if (pe[j] > p1) { p1 = pe[j]; i1 = j; }
    int i2 = 0; float p2 = -1.f;
#pragma unroll
    for (int j = 0; j < 8; ++j) if (j != i1 && pe[j] > p2) { p2 = pe[j]; i2 = j; }
    const float w1 = ptop * p1 / (p1 + p2), w2 = ptop * p2 / (p1 + p2);
    if (lane == 0) { const int e1 = grp * 8 + i1, e2 = grp * 8 + i2;
        const int q1 = atomicAdd((int*)&hist[e1], 1), q2 = atomicAdd((int*)&hist[e2], 1);
        asg[(size_t)t * 2] = ((unsigned)e1 << 16) | (unsigned)q1; asg[(size_t)t * 2 + 1] = ((unsigned)e2 << 16) | (unsigned)q2;
        asgw[(size_t)t * 2] = w1; asgw[(size_t)t * 2 + 1] = w2; }
}
DI void phase_router(const Params& P, const Frame& F0, int layer, int M) {
    const Frame F = opaque_frame(F0);
    unsigned char* const ws = wsp(P);
    const int TPB = M / GRID, nchunk = TPB / 16;
    LAS int* hist = (LAS int*)(F.lds + LDSX_OFF);
    LAS float* tile = (LAS float*)F.lds; LAS float* part = (LAS float*)(F.lds + RT_PART_OFF);
    if (F.tid < 32) hist[F.tid] = 0;
    const float* X = (const float*)(ws + WS_X); bf16_t* H = (bf16_t*)(ws + WS_H);
    unsigned* asg = (unsigned*)(ws + WS_ASG); float* asgw = (float*)(ws + WS_ASGW);
    const float bias = (F.lane < 4) ? inp(P, IN_BGROUP)[layer * 4 + F.lane] : (F.lane < 36 ? inp(P, IN_BROUTER)[layer * 32 + F.lane - 4] : 0.f);
    const float* gffn = inp(P, IN_GFFN) + layer * DM;
    float wreg[32][3];
    { const float* wf = (const float*)(ws + WS_WRT) + ((size_t)layer * 256 + 32 * F.wave) * 192 + F.lane;
#pragma unroll
      for (int s = 0; s < 32; ++s)
#pragma unroll
          for (int nt = 0; nt < 3; ++nt) wreg[s][nt] = wf[s * 192 + nt * 64]; }
    const int tb = F.blk * TPB + 2 * F.wave;
    f32x4 vn[2][4];
#pragma unroll
    for (int tk = 0; tk < 2; ++tk) load_row(X + (size_t)(tb + tk) * DM, F.lane, vn[tk]);
    for (int c = 0; c < nchunk; ++c) {
#pragma unroll
        for (int tk = 0; tk < 2; ++tk) { const int t = tb + c * 16 + tk; const int mb = (t < TLAT) ? (t >> 11) : 16;
            const float rstd = row_rstd(vn[tk]);
            const float* md = (const float*)(ws + WS_MOD) + ((size_t)layer * 17 + mb) * 6144;
            f32x4 hf[4];
            norm_mod_store(vn[tk], rstd, gffn, md + 3072, md + 4096, H + (size_t)t * DM, F.lane, hf);
            LAS float* trow = tile + (2 * F.wave + tk) * RT_STRIDE + 4 * F.lane;
#pragma unroll
            for (int j = 0; j < 4; ++j) { *(LAS f32x2*)(trow + 256 * j) = (f32x2){hf[j][0], hf[j][1]}; *(LAS f32x2*)(trow + 256 * j + 2) = (f32x2){hf[j][2], hf[j][3]}; } }
        if (c + 1 < nchunk) {
#pragma unroll
            for (int tk = 0; tk < 2; ++tk) load_row(X + (size_t)(tb + (c + 1) * 16 + tk) * DM, F.lane, vn[tk]);
        }
        LDS_WAIT(); __syncthreads();
        f32x4 acc[3];
#pragma unroll
        for (int nt = 0; nt < 3; ++nt) acc[nt] = (f32x4){0.f, 0.f, 0.f, 0.f};
        { const LAS float* ap = tile + (F.lane & 15) * RT_STRIDE + 128 * F.wave + (F.lane >> 4);
#pragma unroll
          for (int s = 0; s < 32; ++s) { const float a = ap[4 * s];
#pragma unroll
              for (int nt = 0; nt < 3; ++nt) acc[nt] = __builtin_amdgcn_mfma_f32_16x16x4f32(a, wreg[s][nt], acc[nt], 0, 0, 0); } }
        { LAS float* pp = part + F.wave * 768 + (4 * (F.lane >> 4)) * 48 + (F.lane & 15);
#pragma unroll
          for (int nt = 0; nt < 3; ++nt)
#pragma unroll
              for (int r = 0; r < 4; ++r) pp[r * 48 + 16 * nt] = acc[nt][r]; }
        LDS_WAIT(); __syncthreads();
#pragma unroll
        for (int tk = 0; tk < 2; ++tk) { const int t = tb + c * 16 + tk;
            float lgv = bias;
            if (F.lane < 36) {
#pragma unroll
                for (int w = 0; w < 8; ++w) lgv += part[w * 768 + (2 * F.wave + tk) * 48 + F.lane]; }
            route_token(lgv, t, F.lane, hist, asg, asgw); }
    }
    __syncthreads();
    if (F.tid < 32) ((unsigned*)(ws + WS_HIST))[F.blk * 32 + F.tid] = (unsigned)hist[F.tid];
}
DI void phase_slots(const Params& P, const Frame& F0, int M) {
    unsigned char* const ws = wsp(P);
    const Frame F = opaque_frame(F0);
    const int TPB = M / GRID;
    LAS unsigned* sm = (LAS unsigned*)(F.lds + LDSX_OFF + 1024);
    const unsigned* hist = (const unsigned*)(ws + WS_HIST);
    { const int e = F.tid & 31, part = F.tid >> 5; unsigned tot = 0, pre = 0;
      for (int bb = part * 16; bb < part * 16 + 16; ++bb) { const unsigned v = hist[bb * 32 + e]; tot += v; if (bb < F.blk) pre += v; }
      sm[part * 32 + e] = tot; sm[512 + part * 32 + e] = pre; }
    __syncthreads();
    LAS unsigned* tot = sm + 1024; LAS unsigned* bas = sm + 1056; LAS unsigned* pst = sm + 1088;
    if (F.tid < 32) { unsigned a = 0, c = 0;
        for (int p = 0; p < 16; ++p) { a += sm[p * 32 + F.tid]; c += sm[512 + p * 32 + F.tid]; }
        tot[F.tid] = a; bas[F.tid] = c; }
    __syncthreads();
    if (F.tid == 0) { unsigned ps = 0; for (int e = 0; e < NEXP; ++e) { pst[e] = ps; ps += (tot[e] + 255u) & ~255u; } sm[1120] = ps >> 8; }
    __syncthreads();
    const unsigned* asg = (const unsigned*)(ws + WS_ASG); unsigned* slot = (unsigned*)(ws + WS_SLOT); unsigned* toks = (unsigned*)(ws + WS_TOKS);
    for (int i = F.tid; i < TPB * 2; i += NTHREADS) { const int t = F.blk * TPB + (i >> 1); const unsigned ep = asg[(size_t)t * 2 + (i & 1)];
        const unsigned e = ep >> 16, s = pst[e] + bas[e] + (ep & 0xffffu); slot[(size_t)t * 2 + (i & 1)] = s; toks[s] = (unsigned)t; }
    for (int e = F.blk; e < NEXP; e += F.G) { const unsigned beg = pst[e] + tot[e], end = pst[e] + ((tot[e] + 255u) & ~255u);
        for (unsigned s = beg + F.tid; s < end; s += NTHREADS) toks[s] = 0u; }
    if (F.blk == 0) { unsigned* tt = (unsigned*)(ws + WS_TTAB); const unsigned ntile = sm[1120];
        if (F.tid == 0) tt[0] = ntile;
        for (unsigned rt = F.tid; rt < ntile; rt += NTHREADS) { unsigned e = 0; for (int k = 1; k < NEXP; ++k) if (rt * 256u >= pst[k]) e = k; tt[1 + rt] = e; } }
}
DI void load_tile_table(const Params& P, const Frame& F, LAS unsigned* tab) {
    unsigned char* const ws = wsp(P);
    const unsigned* tt = (const unsigned*)(ws + WS_TTAB);
    for (int i = F.tid; i < 1 + CAPR / 256; i += NTHREADS) tab[i] = tt[i];
    __syncthreads();
}

#ifndef RPT
#define RPT 0
#endif
__global__ void __launch_bounds__(NTHREADS, 2) dit_fwd(Params P) {
    extern __shared__ __attribute__((aligned(16))) unsigned char lds_raw[];
    Frame F;
    F.lds = (LAS unsigned char*)lds_raw;
    F.tid = threadIdx.x; F.lane = F.tid & 63; F.wave = __builtin_amdgcn_readfirstlane(F.tid >> 6);
    F.blk = blockIdx.x; F.G = gridDim.x; F.vcu = (F.G % 8 == 0) ? (F.blk % 8) * (F.G / 8) + F.blk / 8 : F.blk;
    F.gw = F.vcu * NWAVES + F.wave; F.NGW = F.G * NWAVES;
    for (int u = F.tid; u < (LDS_BYTES - RING_BYTES) / 4; u += NTHREADS) ((LAS unsigned*)(F.lds + RING_BYTES))[u] = 0u;
    __syncthreads();
    unsigned* ctl = (unsigned*)(P.ws + WS_CTL);
    XcdBarrier bar = xcd_barrier_post(ctl + CW_BAR, (volatile LAS unsigned*)(F.lds + MISC_OFF) + 8);

    p0_prologue(P, F);
    if (RPT & 1) p0_prologue(P, F);
    xcd_barrier(bar);
    p0b_mod_reduce(P, F);
    xcd_barrier(bar);

    for (int layer = 0; layer < DEPTH; ++layer) {
        const bool last = (layer == DEPTH - 1);
        unsigned char* ws = wsp(P);
        const int Mtok = last ? TLAT : TALL;
        phase_attn_norm(P, F, layer);
        xcd_barrier(bar);
        {
            pg8::PlainSched S; S.nN = QKVN / 256; S.nwg = (TALL / 256) * S.nN; S.G = F.G; S.c = F.vcu; S.K = DM; S.Bt = (const bf16_t*)(ws + WS_WQKV) + (size_t)layer * QKVN * DM;
            pg8::EpiStore E{(bf16_t*)(ws + WS_QKV), QKVN};
            pg8::gemm_phase(F.lds, (const bf16_t*)(ws + WS_H), DM, S, E);
            if (RPT & 2) pg8::gemm_phase(F.lds, (const bf16_t*)(ws + WS_H), DM, S, E);
        }
        xcd_barrier(bar);
        phase_qkv_post(P, F, layer);
        xcd_barrier(bar);
        phase_attention(P, F, layer);
        if (((RPT & 4) && layer == 1) || ((RPT & 8) && layer != 1)) phase_attention(P, F, layer);
        xcd_barrier(bar);
        {
            pg8::PlainSched S; S.nN = DM / 256; S.nwg = (Mtok / 256) * S.nN; S.G = F.G; S.c = F.vcu; S.K = DM; S.Bt = (const bf16_t*)(ws + WS_WO) + (size_t)layer * DM * DM;
            pg8::EpiResid E{(float*)(ws + WS_X), (const float*)(ws + WS_MOD) + (size_t)layer * 17 * 6144 + 2048};
            pg8::gemm_phase(F.lds, (const bf16_t*)(ws + WS_O), DM, S, E);
        }
        xcd_barrier(bar);
        phase_router(P, F, layer, Mtok);
        if (RPT & 16) { __syncthreads(); phase_router(P, F, layer, Mtok); }
        xcd_barrier(bar);
        phase_slots(P, F, Mtok);
        xcd_barrier(bar);
        if (RPT & 128) { for (int xb = 0; xb < 9; ++xb) xcd_barrier(bar); }
        LAS unsigned* tab = (LAS unsigned*)(F.lds + LDSX_OFF + 8192);
        load_tile_table(P, F, tab);
        {
            pg8::MoeSched<true> S; S.tab = tab; S.G = F.G; S.c = F.vcu; S.K = DM; S.Bt = (const bf16_t*)(ws + WS_WGU) + (size_t)layer * NEXP * DM * DM; S.estride = (size_t)DM * DM * 2; S.tok = (const unsigned*)(ws + WS_TOKS);
            pg8::EpiSwiglu E{(bf16_t*)(ws + WS_ACT)};
            pg8::gemm_phase(F.lds, (const bf16_t*)(ws + WS_H), DM, S, E);
            if (RPT & 32) pg8::gemm_phase(F.lds, (const bf16_t*)(ws + WS_H), DM, S, E);
        }
        xcd_barrier(bar);
        {
            pg8::MoeSched<false> S; S.tab = tab; S.G = F.G; S.c = F.vcu; S.K = FH; S.Bt = (const bf16_t*)(ws + WS_WD) + (size_t)layer * NEXP * DM * FH; S.estride = (size_t)DM * FH * 2; S.tok = nullptr;
            pg8::EpiStore E{(bf16_t*)(ws + WS_Y), DM};
            pg8::gemm_phase(F.lds, (const bf16_t*)(ws + WS_ACT), FH, S, E);
            if (RPT & 64) pg8::gemm_phase(F.lds, (const bf16_t*)(ws + WS_ACT), FH, S, E);
        }
        xcd_barrier(bar);
    }
    phase_final(P, F);
}

extern "C" void kernel_launch(void* const* d_in, const int* in_sizes, int n_in, void* d_out, int out_size, void* d_ws, size_t ws_size, hipStream_t stream) {
    static int ok = 0;
    if (ok == 0) {
        if (n_in != 22 || in_sizes[0] != TLAT * DM || out_size != TLAT * DM || ws_size < WS_END) {
            fprintf(stderr, "kernel_launch: unexpected shapes (n_in %d, in0 %d, out %d, ws %zu < %zu); nothing launched\n", n_in, n_in > 0 ? in_sizes[0] : -1, out_size, ws_size, (size_t)WS_END); ok = -1; return; }
        int dev = 0, cus = 0, per_cu = 0;
        if (hipGetDevice(&dev) != hipSuccess || hipDeviceGetAttribute(&cus, hipDeviceAttributeMultiprocessorCount, dev) != hipSuccess) { ok = -1; return; }
        if (hipFuncSetAttribute((const void*)dit_fwd, hipFuncAttributeMaxDynamicSharedMemorySize, LDS_BYTES) != hipSuccess) { fprintf(stderr, "kernel_launch: hipFuncSetAttribute failed\n"); ok = -1; return; }
        if (hipOccupancyMaxActiveBlocksPerMultiprocessor(&per_cu, (const void*)dit_fwd, NTHREADS, LDS_BYTES) != hipSuccess || per_cu < 1) fprintf(stderr, "kernel_launch: note: occupancy query reports %d\n", per_cu);
        (void)hipGetLastError();
        if (cus < GRID) { fprintf(stderr, "kernel_launch: %d CUs < %d workgroups: grid would not be resident; nothing launched\n", cus, GRID); ok = -1; return; }
        ok = 1;
    }
    if (ok < 0) return;
    if (hipMemsetAsync((char*)d_ws + WS_CTL, 0, CTL_ZERO_BYTES, stream) != hipSuccess) return;
    Params p{};
    for (int i = 0; i < 22; ++i) p.in[i] = (const float*)d_in[i];
    p.out = (float*)d_out; p.ws = (unsigned char*)d_ws;
    hipLaunchKernelGGL(dit_fwd, dim3(GRID), dim3(NTHREADS), LDS_BYTES, stream, p);
}
```

```cpp
#include <hip/hip_runtime.h>
#include <cstdio>
#include <cstdint>

#define LAS __attribute__((address_space(3)))
#define GAS __attribute__((address_space(1)))
#define DI __device__ __forceinline__

typedef unsigned short bf16_t;
typedef short bf16x8 __attribute__((ext_vector_type(8)));
typedef short s16x4 __attribute__((ext_vector_type(4)));
typedef float f32x2 __attribute__((ext_vector_type(2)));
typedef float f32x4 __attribute__((ext_vector_type(4)));
typedef float f32x16 __attribute__((ext_vector_type(16)));
typedef unsigned u32x2 __attribute__((ext_vector_type(2)));
typedef unsigned u32x4 __attribute__((ext_vector_type(4)));

constexpr int NB = 16, SEQ = 2048, DM = 1024, DEPTH = 4, CTXL = 256, NH = 16, NKV = 4, HD = 64, QKVN = 1536;
constexpr int TLAT = NB * SEQ, TCTX = NB * CTXL, TALL = TLAT + TCTX;
constexpr int NEXP = 32, FH = 512;
constexpr int KEYS = SEQ + CTXL, KGRP = KEYS / 8;
constexpr int CAPR = 2 * TALL + NEXP * 256;
constexpr int NWAVES = 8, NTHREADS = 512, GRID = 256;
constexpr float NORM_EPS = 1e-6f, LOG2E = 1.4426950408889634f;

constexpr size_t MiB = 1u << 20;
constexpr size_t WS_CTL = 0, CTL_ZERO_BYTES = 1 * MiB;
constexpr size_t WS_MODP = 1 * MiB;
constexpr size_t WS_MOD = 15 * MiB;
constexpr size_t WS_ROPE = 17 * MiB;
constexpr size_t WS_WRT = 17 * MiB + 65536;
constexpr size_t WS_ASG = 18 * MiB;
constexpr size_t WS_ASGW = 18 * MiB + 512 * 1024;
constexpr size_t WS_SLOT = 19 * MiB;
constexpr size_t WS_TOKS = 19 * MiB + 512 * 1024;
constexpr size_t WS_HIST = 20 * MiB;
constexpr size_t WS_TTAB = 20 * MiB + 65536;
constexpr size_t WS_WQKV = 21 * MiB;
constexpr size_t WS_WO = 33 * MiB;
constexpr size_t WS_WGU = 41 * MiB;
constexpr size_t WS_WD = 297 * MiB;
constexpr size_t WS_X = 425 * MiB;
constexpr size_t WS_H = 569 * MiB;
constexpr size_t WS_R1 = 641 * MiB;
constexpr size_t WS_QKV = WS_R1;
constexpr size_t WS_KF = WS_R1 + 108 * MiB;
constexpr size_t WS_VF = WS_R1 + 126 * MiB;
constexpr size_t WS_O = WS_R1 + 144 * MiB;
constexpr size_t WS_Y = WS_R1;
constexpr size_t WS_ACT = WS_R1 + 160 * MiB;
constexpr size_t WS_END = WS_R1 + 240 * MiB;
constexpr int CW_TMO = 0, CW_BAR = 4096;

constexpr int RING_BYTES = 131072;
constexpr int MISC_OFF = RING_BYTES + 320;
constexpr int LDSX_OFF = RING_BYTES + 1024;
constexpr int LDS_BYTES = 147456;

#define LDS_WAIT() asm volatile("s_waitcnt lgkmcnt(0)" ::: "memory")
#define VM_WAIT() asm volatile("s_waitcnt vmcnt(0)" ::: "memory")

DI unsigned f2bf(float f) { unsigned u = __float_as_uint(f); return (u + 0x7fffu + ((u >> 16) & 1u)) >> 16; }
DI float bf2f(unsigned b) { return __uint_as_float(b << 16); }
DI float bfs2f(short b) { return __uint_as_float(((unsigned)(unsigned short)b) << 16); }
DI unsigned pk2(float lo, float hi) { return f2bf(lo) | (f2bf(hi) << 16); }
DI unsigned cvt_pk_bf16(float lo, float hi) { unsigned r; asm volatile("v_cvt_pk_bf16_f32 %0, %1, %2" : "=v"(r) : "v"(lo), "v"(hi)); return r; }
DI float wave_sum(float v) {
#pragma unroll
    for (int o = 1; o < 64; o <<= 1) v += __shfl_xor(v, o);
    return v;
}
DI int crow(int r, int hi) { return (r & 3) + 8 * (r >> 2) + 4 * hi; }

#define XB_TMO      128
#define XB_XCNT(j)  (256  + 64 * (j))
#define XB_XSUB(j)  (1280 + 64 * (j))
#define XB_XGEN(j)  (2304 + 64 * (j))
#define XB_TOP      3328
#define XB_TOPGEN   3392
#define XCD_BAR_WORDS 3456
#define XB_SPIN_CAP (1u << 18)

__device__ __forceinline__ unsigned xb_ld(unsigned* p)              { return __hip_atomic_load(p, __ATOMIC_RELAXED, __HIP_MEMORY_SCOPE_AGENT); }
__device__ __forceinline__ unsigned xb_add(unsigned* p, unsigned v) { return __hip_atomic_fetch_add(p, v, __ATOMIC_RELAXED, __HIP_MEMORY_SCOPE_AGENT); }
__device__ __forceinline__ unsigned xb_xcc_id() { return (unsigned)__builtin_amdgcn_s_getreg((3 << 11) | 20) & 0xFu; }
#define XB_SPIN(cond, bar) do { unsigned _sp = 0; while (cond) { __builtin_amdgcn_s_sleep(1); \
    if ((++_sp & 255u) == 0u) { if (xb_ld(&(bar)[XB_TMO])) break; if (_sp > XB_SPIN_CAP) { atomicAdd(&(bar)[XB_TMO], 1u); break; } } } } while (0)

struct XcdBarrier { unsigned* bar; unsigned x; volatile LAS unsigned* st; };

__device__ __forceinline__ XcdBarrier xcd_barrier_post(unsigned* bar, volatile LAS unsigned* st) {
    XcdBarrier b; b.bar = bar; b.x = xb_xcc_id(); b.st = st;
    if (threadIdx.x == 0) (void)xb_add(&bar[XB_XCNT(b.x)], 1u);
    return b;
}
__device__ __forceinline__ void xcd_barrier_complete(unsigned* bar, unsigned x, unsigned& nloc, unsigned& nx) {
    const unsigned G = gridDim.x * gridDim.y * gridDim.z;
    unsigned sum, cnt, mine, sp = 0u;
    for (;;) {
        sum = 0u; cnt = 0u; mine = 0u;
#pragma unroll
        for (unsigned j = 0; j < 16; ++j) { const unsigned c = xb_ld(&bar[XB_XCNT(j)]); sum += c; cnt += (c > 0u) ? 1u : 0u; mine = (j == x) ? c : mine; }
        if (sum == G) break;
        __builtin_amdgcn_s_sleep(1);
        if ((++sp & 255u) == 0u) { if (xb_ld(&bar[XB_TMO])) break; if (sp > XB_SPIN_CAP) { atomicAdd(&bar[XB_TMO], 1u); break; } }
    }
    nloc = mine > 0u ? mine : 1u; nx = cnt > 0u ? cnt : 1u;
}
__device__ __forceinline__ void xcd_barrier(const XcdBarrier& b0) {
    XcdBarrier b = b0;
    { unsigned z = 0, bx = __builtin_amdgcn_readfirstlane(b0.x); asm volatile("s_mov_b32 %0, 0" : "=s"(z)); asm volatile("" : "+s"(bx)); b.bar = b0.bar + z; b.x = bx; }
    asm volatile("s_waitcnt vmcnt(0)" ::: "memory");
    __syncthreads();
    if (threadIdx.x == 0) {
        unsigned* bar = b.bar;
        __builtin_amdgcn_s_waitcnt(0);
        unsigned nloc = b.st[0], nx = b.st[1];
        if (nloc == 0u) { xcd_barrier_complete(bar, b.x, nloc, nx); b.st[0] = nloc; b.st[1] = nx; }
        const unsigned old = xb_add(&bar[XB_XSUB(b.x)], 1u);
        const unsigned gen = old / nloc;
        if (old + 1u == (gen + 1u) * nloc) {
            __builtin_amdgcn_fence(__ATOMIC_RELEASE, "agent");
            asm volatile("s_waitcnt vmcnt(0)" ::: "memory");
            const unsigned og = xb_add(&bar[XB_TOP], 1u);
            const unsigned tg = og / nx;
            if (og + 1u == (tg + 1u) * nx) xb_add(&bar[XB_TOPGEN], 1u);
            else XB_SPIN(xb_ld(&bar[XB_TOPGEN]) == tg, bar);
            __builtin_amdgcn_fence(__ATOMIC_ACQUIRE, "agent");
            xb_add(&bar[XB_XGEN(b.x)], 1u);
            asm volatile("s_waitcnt vmcnt(0)" ::: "memory");
        } else {
            XB_SPIN(xb_ld(&bar[XB_XGEN(b.x)]) == gen, bar);
            __builtin_amdgcn_fence(__ATOMIC_ACQUIRE, "agent");
            asm volatile("s_waitcnt vmcnt(0)" ::: "memory");
        }
    }
    __syncthreads();
}

namespace pg8 {
constexpr int BM = 256, BK = 64, HALF = 128, HTB = HALF * BK * 2, STAGE_BYTES = 8 * HTB;
DI int lds_byte(int r, int c) { const int st = (r >> 4) * 2 + (c >> 5), rr = r & 15, cc = c & 31, ob = rr * 64 + cc * 2; return st * 1024 + (ob ^ (((ob >> 9) & 1) << 5)); }
DI void stage_rc(int b, int& R, int& C) { const int st = b / 1024, sb = b % 1024, swz = sb ^ (((sb >> 9) & 1) << 5); R = (st >> 1) * 16 + swz / 64; C = (st & 1) * 32 + (swz % 64) / 2; }
DI int perm32(int rho) { const int n = rho >> 4, i = rho & 15; return 8 * (i >> 2) + 4 * n + (i & 3); }
struct Unit { int pm, pn, e; };

template <class Epi, class Sched>
DI void gemm_phase(LAS unsigned char* lds, const bf16_t* A, const int K, const Sched& S, const Epi& E) {
    int tid_ = threadIdx.x; asm volatile("" : "+v"(tid_));
    const int tid = tid_, wid = __builtin_amdgcn_readfirstlane(tid >> 6), lane = tid & 63, wr = wid >> 2, wc = wid & 3, fr = lane & 15, fq = lane >> 4;
    const int nt = K / BK;
    constexpr bool GA = Sched::GATHER;
    int Rr[2], Cc[2]; unsigned voffB[2], voffA[2];
#pragma unroll
    for (int i = 0; i < 2; ++i) { int R, C; stage_rc(tid * 16 + i * 8192, R, C); const int Rb = Epi::PERM ? ((R & ~31) + perm32(R & 31)) : R;
        Rr[i] = R; Cc[i] = C; voffB[i] = (unsigned)(Rb * K + C) * 2u; voffA[i] = (unsigned)(R * K + C) * 2u; }
    const size_t kstep = (size_t)(BK * 2);
    const size_t hstep = (size_t)HALF * K * 2;
    const unsigned ldsw = (unsigned)wid * 1024u;
    const int aoff = lds_byte(wr * 64 + fr, fq * 8), boff = lds_byte(wc * 32 + fr, fq * 8);
#define PG8_SA(b, h) (((b) * 2 + (h)) * HTB)
#define PG8_SB(b, h) ((4 + (b) * 2 + (h)) * HTB)
#define PG8_STAGE(bufoff, gbase, voff) do { _Pragma("unroll") for (int _i = 0; _i < 2; ++_i) \
        __builtin_amdgcn_global_load_lds((const unsigned*)((const char*)(gbase) + (voff)[_i]), (LAS unsigned*)(lds + (bufoff) + ldsw + _i * 8192), 16, 0, 0); } while (0)
#define PG8_LDA(dst, b, h) do { _Pragma("unroll") for (int m = 0; m < 4; ++m) _Pragma("unroll") for (int k = 0; k < 2; ++k) dst[m][k] = *(const LAS bf16x8*)(lds + PG8_SA(b, h) + aoff + m * 2048 + k * 1024); } while (0)
#define PG8_LDB(dst, b, h) do { _Pragma("unroll") for (int n = 0; n < 2; ++n) _Pragma("unroll") for (int k = 0; k < 2; ++k) dst[n][k] = *(const LAS bf16x8*)(lds + PG8_SB(b, h) + boff + n * 2048 + k * 1024); } while (0)
#define PG8_MMA(ai, bj, At, Bt) do { __builtin_amdgcn_s_setprio(1); _Pragma("unroll") for (int m = 0; m < 4; ++m) _Pragma("unroll") for (int n = 0; n < 2; ++n) _Pragma("unroll") for (int k = 0; k < 2; ++k) \
        acc[ai][bj][m][n] = __builtin_amdgcn_mfma_f32_16x16x32_bf16(Bt[n][k], At[m][k], acc[ai][bj][m][n], 0, 0, 0); __builtin_amdgcn_s_setprio(0); } while (0)
#define PG8_WAIT_V(n) asm volatile("s_waitcnt vmcnt(" #n ")" ::: "memory")
#define PG8_WAIT_L(n) asm volatile("s_waitcnt lgkmcnt(" #n ")" ::: "memory")
#define PG8_BAR __builtin_amdgcn_s_barrier()
#define PG8_SCHED __builtin_amdgcn_sched_barrier(0)
    Unit cur, nxt; int ui = 0;
    if (!S.next(0, cur)) return;
    f32x4 acc[2][2][4][2];
#pragma unroll
    for (int a = 0; a < 2; ++a)
#pragma unroll
        for (int b = 0; b < 2; ++b)
#pragma unroll
            for (int m = 0; m < 4; ++m)
#pragma unroll
                for (int n = 0; n < 2; ++n) acc[a][b][m][n] = (f32x4){0.f, 0.f, 0.f, 0.f};
    bf16x8 At[4][2], B0[2][2], B1[2][2];
    unsigned oc0[2], oc1[2], on0[2], on1[2];
#pragma unroll
    for (int i = 0; i < 2; ++i) { if (GA) { oc0[i] = S.a_off(cur, Rr[i]) + (unsigned)Cc[i] * 2u; oc1[i] = S.a_off(cur, HALF + Rr[i]) + (unsigned)Cc[i] * 2u; } else { oc0[i] = voffA[i]; oc1[i] = voffA[i]; } on0[i] = oc0[i]; on1[i] = oc1[i]; }
    const size_t hA = GA ? (size_t)0 : hstep;
    const char* Ab = GA ? (const char*)A : (const char*)A + (size_t)cur.pm * 2 * hstep;
    const char* cB = S.b_ptr(cur);
    PG8_STAGE(PG8_SB(0, 0), cB, voffB); PG8_STAGE(PG8_SB(0, 1), cB + hstep, voffB); PG8_STAGE(PG8_SA(0, 0), Ab, oc0); PG8_STAGE(PG8_SA(0, 1), Ab + hA, oc1);
    if (wr == 1) PG8_BAR;
    PG8_WAIT_V(2); PG8_BAR;
    PG8_STAGE(PG8_SB(1, 0), cB + kstep, voffB); PG8_STAGE(PG8_SA(1, 0), Ab + kstep, oc0); PG8_STAGE(PG8_SB(1, 1), cB + hstep + kstep, voffB);
    PG8_WAIT_V(6); PG8_BAR;
    for (;;) {
        const bool has_next = S.next(ui + 1, nxt);
        const char* nB = has_next ? S.b_ptr(nxt) : cB;
        const char* nA = GA ? Ab : (has_next ? (const char*)A + (size_t)nxt.pm * 2 * hstep : Ab);
        if (GA) {
            if (has_next) {
#pragma unroll
                for (int i = 0; i < 2; ++i) { on0[i] = S.a_off(nxt, Rr[i]) + (unsigned)Cc[i] * 2u; on1[i] = S.a_off(nxt, HALF + Rr[i]) + (unsigned)Cc[i] * 2u; }
            } else {
#pragma unroll
                for (int i = 0; i < 2; ++i) { on0[i] = oc0[i]; on1[i] = oc1[i]; }
            }
        }
        for (int t = 0; t < nt; t += 2) {
            const bool last = (t == nt - 2);
            const char* a1 = Ab + (size_t)(t + 1) * kstep + hA;
            const char* a2 = last ? nA : Ab + (size_t)(t + 2) * kstep; const char* b2 = last ? nB : cB + (size_t)(t + 2) * kstep;
            const char* a3 = a2 + kstep; const char* b3 = b2 + kstep;
            unsigned o20[2], o21[2];
#pragma unroll
            for (int i = 0; i < 2; ++i) { if (GA) { o20[i] = last ? on0[i] : oc0[i]; o21[i] = last ? on1[i] : oc1[i]; } else { o20[i] = voffA[i]; o21[i] = voffA[i]; } }
            PG8_LDB(B0, 0, 0); PG8_LDB(B1, 0, 1); PG8_SCHED; PG8_LDA(At, 0, 0); PG8_STAGE(PG8_SA(1, 1), a1, oc1);
            PG8_WAIT_V(8); PG8_WAIT_L(0); PG8_BAR; PG8_MMA(0, 0, At, B0); PG8_MMA(0, 1, At, B1); PG8_BAR; PG8_SCHED;
            PG8_LDA(At, 0, 1); PG8_STAGE(PG8_SB(0, 0), b2, voffB); PG8_STAGE(PG8_SB(0, 1), b2 + hstep, voffB); PG8_STAGE(PG8_SA(0, 0), a2, o20);
            PG8_WAIT_V(8); PG8_WAIT_L(0); PG8_BAR; PG8_MMA(1, 0, At, B0); PG8_MMA(1, 1, At, B1); PG8_BAR; PG8_SCHED;
            PG8_LDB(B0, 1, 0); PG8_LDB(B1, 1, 1); PG8_SCHED; PG8_LDA(At, 1, 0); PG8_STAGE(PG8_SA(0, 1), a2 + hA, o21);
            PG8_WAIT_V(8); PG8_WAIT_L(0); PG8_BAR; PG8_MMA(0, 0, At, B0); PG8_MMA(0, 1, At, B1); PG8_BAR; PG8_SCHED;
            PG8_LDA(At, 1, 1); PG8_STAGE(PG8_SB(1, 0), b3, voffB); PG8_STAGE(PG8_SB(1, 1), b3 + hstep, voffB); PG8_STAGE(PG8_SA(1, 0), a3, o20);
            PG8_WAIT_V(8); PG8_WAIT_L(0); PG8_BAR; PG8_MMA(1, 0, At, B0); PG8_MMA(1, 1, At, B1); PG8_BAR; PG8_SCHED;
        }
        if (wr == 0) PG8_BAR;
        E(acc, cur, wr, wc, fr, fq);
        if (!has_next) break;
#pragma unroll
        for (int a = 0; a < 2; ++a)
#pragma unroll
            for (int b = 0; b < 2; ++b)
#pragma unroll
                for (int m = 0; m < 4; ++m)
#pragma unroll
                    for (int n = 0; n < 2; ++n) acc[a][b][m][n] = (f32x4){0.f, 0.f, 0.f, 0.f};
        cur = nxt; cB = nB; Ab = nA; ++ui;
        if (GA) {
#pragma unroll
            for (int i = 0; i < 2; ++i) { oc0[i] = on0[i]; oc1[i] = on1[i]; }
        }
        if (wr == 1) PG8_BAR;
    }
    PG8_WAIT_V(0);
    PG8_BAR;
#undef PG8_SA
#undef PG8_SB
#undef PG8_STAGE
#undef PG8_LDA
#undef PG8_LDB
#undef PG8_MMA
#undef PG8_WAIT_V
#undef PG8_WAIT_L
#undef PG8_BAR
#undef PG8_SCHED
}

struct PlainSched {
    static constexpr bool GATHER = false;
    int nN, nwg, G, c, K; const bf16_t* Bt;
    DI bool next(int i, Unit& u) const { const int L = i * G + c; if (L >= nwg) return false; u.pm = L / nN; u.pn = L - u.pm * nN; u.e = 0; return true; }
    DI unsigned a_off(const Unit& u, int r) const { return (unsigned)(u.pm * BM + r) * (unsigned)(K * 2); }
    DI const char* b_ptr(const Unit& u) const { return (const char*)Bt + (size_t)u.pn * BM * K * 2; }
};
template <bool GATHER_> struct MoeSched {
    static constexpr bool GATHER = GATHER_;
    const LAS unsigned* tab; int G, c, K; const bf16_t* Bt; size_t estride; const unsigned* tok;
    DI bool next(int i, Unit& u) const { const int L = i * G + c; const int ntile = (int)tab[0]; if (L >= ntile * 4) return false; u.pm = L >> 2; u.pn = L & 3; u.e = (int)tab[1 + u.pm]; return true; }
    DI unsigned a_off(const Unit& u, int r) const { const unsigned row = GATHER_ ? tok[u.pm * BM + r] : (unsigned)(u.pm * BM + r); return row * (unsigned)(K * 2); }
    DI const char* b_ptr(const Unit& u) const { return (const char*)Bt + (size_t)u.e * estride + (size_t)u.pn * BM * K * 2; }
};

struct EpiStore {
    static constexpr bool PERM = true;
    bf16_t* O; int ldc;
    DI void operator()(const f32x4 (&acc)[2][2][4][2], const Unit& u, int wr, int wc, int fr, int fq) const {
        const int row0 = u.pm * BM + wr * 64 + fr, col0 = u.pn * BM + wc * 32 + 8 * fq;
#pragma unroll
        for (int ai = 0; ai < 2; ++ai)
#pragma unroll
            for (int m = 0; m < 4; ++m) { bf16_t* rowp = O + (size_t)(row0 + ai * HALF + m * 16) * ldc + col0;
#pragma unroll
                for (int bj = 0; bj < 2; ++bj) { const f32x4 v0 = acc[ai][bj][m][0], v1 = acc[ai][bj][m][1];
                    u32x4 w; w.x = cvt_pk_bf16(v0[0], v0[1]); w.y = cvt_pk_bf16(v0[2], v0[3]); w.z = cvt_pk_bf16(v1[0], v1[1]); w.w = cvt_pk_bf16(v1[2], v1[3]);
                    *(u32x4*)(rowp + bj * HALF) = w; } }
    }
};
struct EpiResid {
    static constexpr bool PERM = false;
    float* X; const float* gate;
    DI void operator()(const f32x4 (&acc)[2][2][4][2], const Unit& u, int wr, int wc, int fr, int fq) const {
        const int mb = (u.pm < TLAT / BM) ? (u.pm >> 3) : 16;
        const float* gt = gate + (size_t)mb * 6144;
        const int row0 = u.pm * BM + wr * 64 + fr, col0 = u.pn * BM + wc * 32 + 4 * fq;
        f32x4 g[2][2];
#pragma unroll
        for (int bj = 0; bj < 2; ++bj)
#pragma unroll
            for (int n = 0; n < 2; ++n) g[bj][n] = *(const f32x4*)(gt + col0 + bj * HALF + n * 16);
#pragma unroll
        for (int ai = 0; ai < 2; ++ai)
#pragma unroll
            for (int m = 0; m < 4; ++m) { float* rowp = X + (size_t)(row0 + ai * HALF + m * 16) * DM + col0;
#pragma unroll
                for (int bj = 0; bj < 2; ++bj)
#pragma unroll
                    for (int n = 0; n < 2; ++n) { f32x4* p = (f32x4*)(rowp + bj * HALF + n * 16); *p = *p + g[bj][n] * acc[ai][bj][m][n]; } }
    }
};
struct EpiQKV {
    static constexpr bool PERM = false;
    bf16_t* QKV; unsigned char* KF; unsigned char* VF; const f32x2* T; const float* gq; const float* gk; int m;
    DI void operator()(const f32x4 (&acc)[2][2][4][2], const Unit& u, int wr, int wc, int fr, int fq) const {
        const bool lat = u.pm < TLAT / BM; const int b = lat ? (u.pm >> 3) : (u.pm - TLAT / BM);
        const int trow0 = u.pm * BM + wr * 64 + fr;
        if (u.pn < 4) {
            const int h = 4 * u.pn + wc;
            f32x4 g[2][2];
#pragma unroll
            for (int bj = 0; bj < 2; ++bj)
#pragma unroll
                for (int n = 0; n < 2; ++n) g[bj][n] = (m == 1) ? *(const f32x4*)(gq + 32 * bj + 16 * n + 4 * fq) : (f32x4){1.f, 1.f, 1.f, 1.f};
#pragma unroll
            for (int ai = 0; ai < 2; ++ai)
#pragma unroll
                for (int mm = 0; mm < 4; ++mm) {
                    f32x4 x[2][2]; float ss = 0.f;
#pragma unroll
                    for (int bj = 0; bj < 2; ++bj)
#pragma unroll
                        for (int n = 0; n < 2; ++n) { x[bj][n] = acc[ai][bj][mm][n]; ss += (x[bj][n][0] * x[bj][n][0] + x[bj][n][1] * x[bj][n][1]) + (x[bj][n][2] * x[bj][n][2] + x[bj][n][3] * x[bj][n][3]); }
                    float sc = 0.125f * LOG2E;
                    if (m == 1) { ss += __shfl_xor(ss, 16); ss += __shfl_xor(ss, 32); sc *= 1.0f / sqrtf(ss * (1.f / HD) + NORM_EPS); }
                    bf16_t* qrow = QKV + (size_t)(trow0 + ai * HALF + mm * 16) * QKVN + h * HD + 4 * fq;
#pragma unroll
                    for (int bj = 0; bj < 2; ++bj)
#pragma unroll
                        for (int n = 0; n < 2; ++n) { const f32x4 y = x[bj][n] * g[bj][n] * sc; u32x2 w; w.x = cvt_pk_bf16(y[0], y[1]); w.y = cvt_pk_bf16(y[2], y[3]); *(u32x2*)(qrow + 32 * bj + 16 * n) = w; }
                }
        } else if (u.pn == 4) {
            f32x4 g[2][2];
#pragma unroll
            for (int bj = 0; bj < 2; ++bj)
#pragma unroll
                for (int n = 0; n < 2; ++n) g[bj][n] = (m == 1) ? *(const f32x4*)(gk + 32 * bj + 16 * n + 4 * fq) : (f32x4){1.f, 1.f, 1.f, 1.f};
            const bool rope = lat && (m != 2);
            unsigned char* kbase = KF + (size_t)(b * NKV + wc) * KGRP * 1024 + (fq >> 1) * 128 + (fq & 1) * 8;
#pragma unroll
            for (int ai = 0; ai < 2; ++ai)
#pragma unroll
                for (int mm = 0; mm < 4; ++mm) {
                    const int t = trow0 + ai * HALF + mm * 16;
                    const int kidx = lat ? (t & 2047) : (2048 + ((t - TLAT) & 255));
                    f32x4 x[2][2]; float ss = 0.f;
#pragma unroll
                    for (int bj = 0; bj < 2; ++bj)
#pragma unroll
                        for (int n = 0; n < 2; ++n) { x[bj][n] = acc[ai][bj][mm][n]; ss += (x[bj][n][0] * x[bj][n][0] + x[bj][n][1] * x[bj][n][1]) + (x[bj][n][2] * x[bj][n][2] + x[bj][n][3] * x[bj][n][3]); }
                    if (m == 1) { ss += __shfl_xor(ss, 16); ss += __shfl_xor(ss, 32); const float rs = 1.0f / sqrtf(ss * (1.f / HD) + NORM_EPS);
#pragma unroll
                        for (int bj = 0; bj < 2; ++bj)
#pragma unroll
                            for (int n = 0; n < 2; ++n) x[bj][n] = x[bj][n] * g[bj][n] * rs; }
                    if (rope) {
#pragma unroll
                        for (int bj = 0; bj < 2; ++bj) { const int pos = bj ? (kidx & 63) : (kidx >> 6); const f32x4* tp = (const f32x4*)(T + pos * 16 + 4 * fq);
                            const f32x4 t0 = tp[0], t1 = tp[1];
                            const f32x4 cs = (f32x4){t0[0], t0[2], t1[0], t1[2]}, sn = (f32x4){t0[1], t0[3], t1[1], t1[3]};
                            const f32x4 a = x[bj][0], c = x[bj][1];
                            x[bj][0] = a * cs - c * sn; x[bj][1] = c * cs + a * sn; }
                    }
                    unsigned char* kp = kbase + (size_t)(kidx >> 3) * 1024 + (kidx & 7) * 16;
#pragma unroll
                    for (int bj = 0; bj < 2; ++bj)
#pragma unroll
                        for (int n = 0; n < 2; ++n) { u32x2 w; w.x = cvt_pk_bf16(x[bj][n][0], x[bj][n][1]); w.y = cvt_pk_bf16(x[bj][n][2], x[bj][n][3]); *(u32x2*)(kp + (4 * bj + 2 * n) * 128) = w; }
                }
        } else {
            const int q4 = fr & 3;
            unsigned char* vbase = VF + (size_t)(b * NKV + wc) * KGRP * 1024 + (4 * fq + q4) * 16;
#pragma unroll
            for (int ai = 0; ai < 2; ++ai)
#pragma unroll
                for (int mm = 0; mm < 4; ++mm) {
                    const int t = trow0 + ai * HALF + mm * 16;
                    const int kidx = lat ? (t & 2047) : (2048 + ((t - TLAT) & 255));
                    unsigned char* vp = vbase + (size_t)(kidx >> 3) * 1024 + (kidx & 4) * 2;
#pragma unroll
                    for (int bj = 0; bj < 2; ++bj)
#pragma unroll
                        for (int n = 0; n < 2; ++n) {
                            f32x4 x = acc[ai][bj][mm][n];
                            { const float s0 = (q4 & 1) ? x[0] : x[1], s1 = (q4 & 1) ? x[2] : x[3]; const float r0 = __shfl_xor(s0, 1), r1 = __shfl_xor(s1, 1);
                              if (q4 & 1) { x[0] = r0; x[2] = r1; } else { x[1] = r0; x[3] = r1; } }
                            { const float s0 = (q4 & 2) ? x[0] : x[2], s1 = (q4 & 2) ? x[1] : x[3]; const float r0 = __shfl_xor(s0, 2), r1 = __shfl_xor(s1, 2);
                              if (q4 & 2) { x[0] = r0; x[1] = r1; } else { x[2] = r0; x[3] = r1; } }
                            u32x2 w; w.x = cvt_pk_bf16(x[0], x[1]); w.y = cvt_pk_bf16(x[2], x[3]);
                            *(u32x2*)(vp + (32 * bj + 16 * n) * 16) = w; }
                }
        }
    }
};
DI float silu_mul(float g, float u) { return g * __builtin_amdgcn_rcpf(1.f + __builtin_amdgcn_exp2f(-g * LOG2E)) * u; }
struct EpiSwiglu {
    static constexpr bool PERM = true;
    bf16_t* ACT;
    DI void operator()(const f32x4 (&acc)[2][2][4][2], const Unit& u, int wr, int wc, int fr, int fq) const {
        const int row0 = u.pm * BM + wr * 64 + fr, col0 = u.pn * HALF + wc * 32 + 8 * fq;
#pragma unroll
        for (int ai = 0; ai < 2; ++ai)
#pragma unroll
            for (int m = 0; m < 4; ++m) { bf16_t* rowp = ACT + (size_t)(row0 + ai * HALF + m * 16) * FH + col0;
                const f32x4 g0 = acc[ai][0][m][0], g1 = acc[ai][0][m][1], u0 = acc[ai][1][m][0], u1 = acc[ai][1][m][1];
                u32x4 w; w.x = cvt_pk_bf16(silu_mul(g0[0], u0[0]), silu_mul(g0[1], u0[1])); w.y = cvt_pk_bf16(silu_mul(g0[2], u0[2]), silu_mul(g0[3], u0[3]));
                w.z = cvt_pk_bf16(silu_mul(g1[0], u1[0]), silu_mul(g1[1], u1[1])); w.w = cvt_pk_bf16(silu_mul(g1[2], u1[2]), silu_mul(g1[3], u1[3]));
                *(u32x4*)rowp = w; }
    }
};
}

struct Params { const float* in[22]; float* out; unsigned char* ws; };
enum { IN_X = 0, IN_C, IN_CTX, IN_CCTX, IN_WADA, IN_BADA, IN_GATTN, IN_WQKV, IN_WO, IN_SINK, IN_GQ, IN_GK, IN_RPB, IN_GFFN, IN_WGROUP, IN_BGROUP, IN_WROUTER, IN_BROUTER, IN_WGATE, IN_WUP, IN_WDOWN, IN_GFINAL };

DI const float* inp(const Params& P, int i) { i = __builtin_amdgcn_readfirstlane(i); asm volatile("" : "+s"(i)); return P.in[i]; }
DI unsigned char* wsp(const Params& P) { unsigned z = 0; asm volatile("s_mov_b32 %0, 0" : "=s"(z)); return P.ws + z; }
struct Frame { LAS unsigned char* lds; int tid, lane, wave, blk, G, vcu, gw, NGW; };
DI Frame opaque_frame(const Frame& F0) { Frame F = F0; asm volatile("" : "+v"(F.tid), "+v"(F.lane)); asm volatile("" : "+s"(F.wave), "+s"(F.blk), "+s"(F.vcu), "+s"(F.gw)); return F; }

DI void p0_transpose_item(const float* W, int N, int k0, int n0, bf16_t* dst, int Kd, LAS float* scr, int lane) {
#pragma unroll 8
    for (int i = 0; i < 32; ++i) { const int kk = 2 * i + (lane >> 5); scr[kk * 33 + (lane & 31)] = W[(size_t)(k0 + kk) * N + n0 + (lane & 31)]; }
    LDS_WAIT();
    const int c = lane & 7;
#pragma unroll
    for (int j = 0; j < 4; ++j) { const int n = (lane >> 3) + 8 * j; const LAS float* s = scr + (8 * c) * 33 + n;
        u32x4 o; o.x = pk2(s[0 * 33], s[1 * 33]); o.y = pk2(s[2 * 33], s[3 * 33]); o.z = pk2(s[4 * 33], s[5 * 33]); o.w = pk2(s[6 * 33], s[7 * 33]);
        *(u32x4*)(dst + (size_t)n * Kd + 8 * c) = o; }
    LDS_WAIT();
}
DI double dsin_poly(double r) { const double r2 = r * r;
    return r * (1.0 - r2 * (1.0 / 6.0) * (1.0 - r2 * (1.0 / 20.0) * (1.0 - r2 * (1.0 / 42.0) * (1.0 - r2 * (1.0 / 72.0) * (1.0 - r2 * (1.0 / 110.0) * (1.0 - r2 * (1.0 / 156.0) * (1.0 - r2 * (1.0 / 210.0) * (1.0 - r2 * (1.0 / 272.0) * (1.0 - r2 * (1.0 / 342.0) * (1.0 - r2 * (1.0 / 420.0) * (1.0 - r2 * (1.0 / 506.0)))))))))))); }
DI double dcos_poly(double r) { const double r2 = r * r;
    return 1.0 - r2 * (1.0 / 2.0) * (1.0 - r2 * (1.0 / 12.0) * (1.0 - r2 * (1.0 / 30.0) * (1.0 - r2 * (1.0 / 56.0) * (1.0 - r2 * (1.0 / 90.0) * (1.0 - r2 * (1.0 / 132.0) * (1.0 - r2 * (1.0 / 182.0) * (1.0 - r2 * (1.0 / 240.0) * (1.0 - r2 * (1.0 / 306.0) * (1.0 - r2 * (1.0 / 380.0) * (1.0 - r2 * (1.0 / 462.0) * (1.0 - r2 * (1.0 / 552.0)))))))))))); }

constexpr int IT_MOD = DEPTH * 96 * 8;
constexpr int IT_QKV = (DM / 64) * (QKVN / 32), IT_WO = (DM / 64) * (DM / 32), IT_GU = NEXP * (DM / 64) * (FH / 32), IT_DN = NEXP * (FH / 64) * (DM / 32);
constexpr int IT_LAYER = IT_QKV + IT_WO + 2 * IT_GU + IT_DN;
constexpr int IT_TOTAL = IT_MOD + DEPTH * IT_LAYER;

DI void p0_prologue(const Params& P, const Frame& F) {
    LAS float* scr = (LAS float*)(F.lds + F.wave * 16384);
    unsigned char* ws = wsp(P);
    for (int it = F.gw; it < IT_TOTAL; it += F.NGW) {
        if (it < IT_MOD) {
            const int l = it / (96 * 8), rem = it % (96 * 8), cc = rem >> 3, ks = rem & 7;
            for (int idx = F.lane; idx < 17 * 128; idx += 64) { const int b = idx >> 7, k = idx & 127;
                const float cv = (b < 16) ? inp(P, IN_C)[b * DM + ks * 128 + k] : inp(P, IN_CCTX)[ks * 128 + k];
                scr[idx] = cv / (1.f + expf(-cv)); }
            LDS_WAIT();
            float acc[17];
#pragma unroll
            for (int b = 0; b < 17; ++b) acc[b] = 0.f;
            const float* wp = inp(P, IN_WADA) + ((size_t)l * DM + ks * 128) * 6144 + cc * 64 + F.lane;
#pragma unroll 4
            for (int k = 0; k < 128; ++k) { const float w = wp[(size_t)k * 6144];
#pragma unroll
                for (int b = 0; b < 17; ++b) acc[b] += scr[b * 128 + k] * w; }
            float* mp = (float*)(ws + WS_MODP) + ((size_t)(ks * DEPTH + l) * 17) * 6144 + cc * 64 + F.lane;
#pragma unroll
            for (int b = 0; b < 17; ++b) mp[(size_t)b * 6144] = acc[b];
            LDS_WAIT();
            continue;
        }
        int r = it - IT_MOD; const int l = r / IT_LAYER; r -= l * IT_LAYER;
        if (r < IT_QKV) { const int kb = r / (QKVN / 32), nb = r % (QKVN / 32); const int n0 = nb * 32;
            const int drow0 = 256 * (n0 >> 8) + 128 * ((n0 >> 5) & 1) + 32 * ((n0 >> 6) & 3);
            p0_transpose_item(inp(P, IN_WQKV) + (size_t)l * DM * QKVN, QKVN, kb * 64, n0, (bf16_t*)(ws + WS_WQKV) + (size_t)l * QKVN * DM + (size_t)drow0 * DM + kb * 64, DM, scr, F.lane); continue; }
        r -= IT_QKV;
        if (r < IT_WO) { const int kb = r / (DM / 32), nb = r % (DM / 32);
            p0_transpose_item(inp(P, IN_WO) + (size_t)l * DM * DM, DM, kb * 64, nb * 32, (bf16_t*)(ws + WS_WO) + (size_t)l * DM * DM + (size_t)(nb * 32) * DM + kb * 64, DM, scr, F.lane); continue; }
        r -= IT_WO;
        if (r < 2 * IT_GU) { const int which = r / IT_GU; r -= which * IT_GU; const int e = r / 256, kb = (r % 256) / 16, nb = r % 16; const int n0 = nb * 32;
            const int drow0 = 256 * (n0 >> 7) + 128 * which + (n0 & 127);
            p0_transpose_item(inp(P, which ? IN_WUP : IN_WGATE) + (size_t)(l * NEXP + e) * DM * FH, FH, kb * 64, n0,
                              (bf16_t*)(ws + WS_WGU) + (size_t)(l * NEXP + e) * DM * DM + (size_t)drow0 * DM + kb * 64, DM, scr, F.lane); continue; }
        r -= 2 * IT_GU;
        { const int e = r / 256, kb = (r % 256) / 32, nb = r % 32;
            p0_transpose_item(inp(P, IN_WDOWN) + (size_t)(l * NEXP + e) * FH * DM, DM, kb * 64, nb * 32,
                              (bf16_t*)(ws + WS_WD) + (size_t)(l * NEXP + e) * DM * FH + (size_t)(nb * 32) * FH + kb * 64, FH, scr, F.lane); }
    }
    if (F.gw == F.NGW - 1) {
        f32x2* T = (f32x2*)(ws + WS_ROPE);
        for (int idx = F.lane; idx < 64 * 16; idx += 64) { const int pos = idx >> 4, j = idx & 15;
            const float inv = exp2f(-(float)j * (1.f / 16.f) * 13.287712379549449f);
            const float ang = (float)pos * inv;
            const double a = (double)ang; const double rr = a - 6.283185307179586 * rint(a * 0.15915494309189535);
            T[idx] = (f32x2){(float)dcos_poly(rr), (float)dsin_poly(rr)}; }
    }
    { float* wf = (float*)(ws + WS_WRT); const float* wg = inp(P, IN_WGROUP); const float* wr = inp(P, IN_WROUTER);
      for (int idx = F.gw * 64 + F.lane; idx < DEPTH * 256 * 3 * 64; idx += F.NGW * 64) { const int l = idx / (256 * 3 * 64), rem = idx % (256 * 3 * 64), step = rem / 192, nt = (rem % 192) >> 6, ln = rem & 63;
          const int k = 4 * step + (ln >> 4), n = 16 * nt + (ln & 15);
          wf[idx] = (n < 4) ? wg[((size_t)l * DM + k) * 4 + n] : (n < 36 ? wr[((size_t)l * DM + k) * 32 + (n - 4)] : 0.f); } }
}
DI void p0b_mod_reduce(const Params& P, const Frame& F) {
    unsigned char* const ws = wsp(P);
    const float* mp = (const float*)(ws + WS_MODP); float* mod = (float*)(ws + WS_MOD);
    for (int idx = F.gw * 64 + F.lane; idx < DEPTH * 17 * 6144; idx += F.NGW * 64) {
        const int l = idx / (17 * 6144), c = idx % 6144;
        float s = inp(P, IN_BADA)[l * 6144 + c];
#pragma unroll
        for (int ks = 0; ks < 8; ++ks) s += mp[(size_t)ks * DEPTH * 17 * 6144 + idx];
        mod[idx] = s; }
}

DI void load_row(const float* row, int lane, f32x4 (&v)[4]) {
#pragma unroll
    for (int j = 0; j < 4; ++j) v[j] = *(const f32x4*)(row + 4 * lane + 256 * j);
}
DI float row_rstd(const f32x4 (&v)[4]) {
    float s = 0.f;
#pragma unroll
    for (int j = 0; j < 4; ++j) s += (v[j][0] * v[j][0] + v[j][1] * v[j][1]) + (v[j][2] * v[j][2] + v[j][3] * v[j][3]);
    return 1.0f / sqrtf(wave_sum(s) * (1.f / DM) + NORM_EPS);
}
DI void moe_combine(unsigned char* ws, int prev_layer, int t, int mb, int lane, f32x4 (&v)[4]) {
    const unsigned* slot = (const unsigned*)(ws + WS_SLOT) + (size_t)t * 2; const float* aw = (const float*)(ws + WS_ASGW) + (size_t)t * 2;
    const unsigned s0 = slot[0], s1 = slot[1]; const float w0 = aw[0], w1 = aw[1];
    const bf16_t* Y = (const bf16_t*)(ws + WS_Y);
    const float* gt = (const float*)(ws + WS_MOD) + ((size_t)prev_layer * 17 + mb) * 6144 + 5120;
#pragma unroll
    for (int j = 0; j < 4; ++j) { const int c = 4 * lane + 256 * j;
        const u32x2 a = *(const u32x2*)(Y + (size_t)s0 * DM + c), b = *(const u32x2*)(Y + (size_t)s1 * DM + c); const f32x4 g = *(const f32x4*)(gt + c);
        v[j][0] += g[0] * (w0 * bf2f(a.x & 0xffffu) + w1 * bf2f(b.x & 0xffffu)); v[j][1] += g[1] * (w0 * bf2f(a.x >> 16) + w1 * bf2f(b.x >> 16));
        v[j][2] += g[2] * (w0 * bf2f(a.y & 0xffffu) + w1 * bf2f(b.y & 0xffffu)); v[j][3] += g[3] * (w0 * bf2f(a.y >> 16) + w1 * bf2f(b.y >> 16)); }
}
DI void norm_mod_store(const f32x4 (&v)[4], float rstd, const float* g, const float* shift, const float* scale, bf16_t* hrow, int lane, f32x4 (&hf)[4]) {
#pragma unroll
    for (int j = 0; j < 4; ++j) { const int c = 4 * lane + 256 * j; const f32x4 gg = *(const f32x4*)(g + c), sh = *(const f32x4*)(shift + c), sc = *(const f32x4*)(scale + c);
        hf[j] = (v[j] * rstd * gg) * (1.f + sc) + sh;
        u32x2 w; w.x = pk2(hf[j][0], hf[j][1]); w.y = pk2(hf[j][2], hf[j][3]); *(u32x2*)(hrow + c) = w; }
}
DI void phase_attn_norm(const Params& P, const Frame& F0, int layer) {
    unsigned char* const ws = wsp(P);
    const Frame F = opaque_frame(F0);
    float* X = (float*)(ws + WS_X); bf16_t* H = (bf16_t*)(ws + WS_H);
    for (int t = F.gw; t < TALL; t += F.NGW) {
        const bool lat = t < TLAT; const int mb = lat ? (t >> 11) : 16;
        f32x4 v[4];
        if (layer == 0) load_row(lat ? inp(P, IN_X) + (size_t)t * DM : inp(P, IN_CTX) + (size_t)(t - TLAT) * DM, F.lane, v);
        else { load_row(X + (size_t)t * DM, F.lane, v); moe_combine(ws, layer - 1, t, mb, F.lane, v); }
#pragma unroll
        for (int j = 0; j < 4; ++j) *(f32x4*)(X + (size_t)t * DM + 4 * F.lane + 256 * j) = v[j];
        const float rstd = row_rstd(v);
        const float* md = (const float*)(ws + WS_MOD) + ((size_t)layer * 17 + mb) * 6144;
        f32x4 hf[4];
        norm_mod_store(v, rstd, inp(P, IN_GATTN) + layer * DM, md, md + 1024, H + (size_t)t * DM, F.lane, hf);
    }
}
DI void phase_final(const Params& P, const Frame& F0) {
    unsigned char* const ws = wsp(P);
    const Frame F = opaque_frame(F0);
    const float* X = (const float*)(ws + WS_X);
    for (int t = F.gw; t < TLAT; t += F.NGW) {
        f32x4 v[4]; load_row(X + (size_t)t * DM, F.lane, v); moe_combine(ws, DEPTH - 1, t, t >> 11, F.lane, v);
        const float rstd = row_rstd(v);
#pragma unroll
        for (int j = 0; j < 4; ++j) { const int c = 4 * F.lane + 256 * j; const f32x4 g = *(const f32x4*)(inp(P, IN_GFINAL) + c); *(f32x4*)(P.out + (size_t)t * DM + c) = v[j] * rstd * g; }
    }
}

DI void unpack8(const u32x4 w, float (&x)[8]) { x[0] = bf2f(w.x & 0xffffu); x[1] = bf2f(w.x >> 16); x[2] = bf2f(w.y & 0xffffu); x[3] = bf2f(w.y >> 16); x[4] = bf2f(w.z & 0xffffu); x[5] = bf2f(w.z >> 16); x[6] = bf2f(w.w & 0xffffu); x[7] = bf2f(w.w >> 16); }
DI u32x4 pack8(const float (&x)[8]) { u32x4 w; w.x = pk2(x[0], x[1]); w.y = pk2(x[2], x[3]); w.z = pk2(x[4], x[5]); w.w = pk2(x[6], x[7]); return w; }
DI void head_rmsnorm(float (&x)[8], const float* g8) {
    float s = 0.f;
#pragma unroll
    for (int e = 0; e < 8; ++e) s += x[e] * x[e];
    s += __shfl_xor(s, 1); s += __shfl_xor(s, 2); s += __shfl_xor(s, 4);
    const float rs = 1.0f / sqrtf(s * (1.f / HD) + NORM_EPS);
#pragma unroll
    for (int e = 0; e < 8; ++e) x[e] = x[e] * rs * g8[e];
}
DI void phase_qkv_post(const Params& P, const Frame& F0, int layer) {
    unsigned char* const ws = wsp(P);
    const Frame F = opaque_frame(F0);
    const int m = layer % 3;
    bf16_t* QKV = (bf16_t*)(ws + WS_QKV); unsigned char* KF = ws + WS_KF; unsigned char* VF = ws + WS_VF;
    const f32x2* T = (const f32x2*)(ws + WS_ROPE);
    LAS bf16_t* scr = (LAS bf16_t*)(F.lds + F.wave * 16384);
    const int tt = F.lane >> 3, c = F.lane & 7;
    float gq[8], gk[8];
#pragma unroll
    for (int e = 0; e < 8; ++e) { gq[e] = inp(P, IN_GQ)[8 * c + e]; gk[e] = inp(P, IN_GK)[8 * c + e]; }
    for (int g8 = F.gw; g8 < TALL / 8; g8 += F.NGW) {
        const int t = g8 * 8 + tt; const bool lat = t < TLAT;
        const int b = lat ? (t >> 11) : ((t - TLAT) >> 8);
        const int kidx = lat ? (t & 2047) : (2048 + ((t - TLAT) & 255));
        const int gidx = kidx >> 3;
        bf16_t* row = QKV + (size_t)t * QKVN;
        const bool rope = lat && (m != 2);
        float cs[8], sn[8];
        if (rope) { const int n = t & 2047; const int pos = (c < 4) ? (n >> 6) : (n & 63); const f32x2* tp = T + pos * 16 + 8 * (c & 1);
#pragma unroll
            for (int e = 0; e < 8; ++e) { const f32x2 v = tp[e]; cs[e] = v.x; sn[e] = v.y; } }
        else {
#pragma unroll
            for (int e = 0; e < 8; ++e) { cs[e] = 1.f; sn[e] = 0.f; } }
#pragma unroll 4
        for (int hh = 0; hh < NH; ++hh) { float x[8]; unpack8(*(const u32x4*)(row + hh * HD + 8 * c), x);
            if (m == 1) head_rmsnorm(x, gq);
#pragma unroll
            for (int e = 0; e < 8; ++e) x[e] *= 0.125f * LOG2E;
            *(u32x4*)(row + hh * HD + 8 * c) = pack8(x); }
#pragma unroll
        for (int kh = 0; kh < NKV; ++kh) { float x[8]; unpack8(*(const u32x4*)(row + DM + kh * HD + 8 * c), x);
            if (m == 1) head_rmsnorm(x, gk);
            float y[8];
#pragma unroll
            for (int e = 0; e < 8; ++e) { const float pr = __shfl_xor(x[e], 2); y[e] = x[e] * cs[e] + ((c & 2) ? pr : -pr) * sn[e]; }
            *(u32x4*)(KF + ((size_t)(b * NKV + kh) * KGRP + gidx) * 1024 + c * 128 + tt * 16) = pack8(y); }
#pragma unroll
        for (int kh = 0; kh < NKV; ++kh) { const u32x4 w = *(const u32x4*)(row + DM + NKV * HD + kh * HD + 8 * c);
            const unsigned ww[4] = {w.x, w.y, w.z, w.w};
#pragma unroll
            for (int e = 0; e < 8; ++e) scr[(8 * c + e) * 8 + tt] = (bf16_t)((e & 1) ? (ww[e >> 1] >> 16) : (ww[e >> 1] & 0xffffu));
            LDS_WAIT();
            const u32x4 o = *(const LAS u32x4*)((const LAS unsigned char*)scr + F.lane * 16);
            *(u32x4*)(VF + ((size_t)(b * NKV + kh) * KGRP + gidx) * 1024 + F.lane * 16) = o;
            LDS_WAIT(); }
    }
}

DI float swap_max(float v) { auto rr = __builtin_amdgcn_permlane32_swap(__float_as_uint(v), __float_as_uint(v), false, false); return fmaxf(__uint_as_float(rr[0]), __uint_as_float(rr[1])); }
DI float swap_add(float v) { auto rr = __builtin_amdgcn_permlane32_swap(__float_as_uint(v), __float_as_uint(v), false, false); return __uint_as_float(rr[0]) + __uint_as_float(rr[1]); }
DI bf16x8 pack_p(const f32x16& p, int s) {
    u32x4 w; w.x = cvt_pk_bf16(p[8 * s + 0], p[8 * s + 1]); w.y = cvt_pk_bf16(p[8 * s + 2], p[8 * s + 3]); w.z = cvt_pk_bf16(p[8 * s + 4], p[8 * s + 5]); w.w = cvt_pk_bf16(p[8 * s + 6], p[8 * s + 7]);
    return __builtin_bit_cast(bf16x8, w);
}
struct AttnState { float m, l; f32x16 o[2]; };
DI void load_k(const unsigned char* Kbh, int kg, int r32, int hi, bf16x8 (&k)[4]) {
    const unsigned char* kb = Kbh + (size_t)(kg + (r32 >> 3)) * 1024 + hi * 128 + (r32 & 7) * 16;
#pragma unroll
    for (int d0 = 0; d0 < 4; ++d0) k[d0] = *(const bf16x8*)(kb + d0 * 256);
}
DI void load_v(const unsigned char* Vbh, int kg, int r32, int hi, s16x4 (&v)[2][2][2]) {
    const unsigned char* vb = Vbh + (size_t)kg * 1024 + r32 * 16 + hi * 8;
#pragma unroll
    for (int dh = 0; dh < 2; ++dh)
#pragma unroll
        for (int ks = 0; ks < 2; ++ks)
#pragma unroll
            for (int pt = 0; pt < 2; ++pt) v[dh][ks][pt] = *(const s16x4*)(vb + dh * 512 + (2 * ks + pt) * 1024);
}
DI f32x16 attn_scores(const bf16x8 (&k)[4], const bf16x8 (&q)[4]) {
    f32x16 s;
#pragma unroll
    for (int r = 0; r < 16; ++r) s[r] = 0.f;
#pragma unroll
    for (int d0 = 0; d0 < 4; ++d0) s = __builtin_amdgcn_mfma_f32_32x32x16_bf16(k[d0], q[d0], s, 0, 0, 0);
    return s;
}
DI void attn_softmax_pv(AttnState& st, f32x16& s, const s16x4 (&v)[2][2][2], LAS float* wsf, int r32, int hi) {
    float mt = fmaxf(fmaxf(s[0], s[1]), fmaxf(s[2], s[3]));
#pragma unroll
    for (int r = 4; r < 16; r += 4) mt = fmaxf(mt, fmaxf(fmaxf(s[r], s[r + 1]), fmaxf(s[r + 2], s[r + 3])));
    mt = swap_max(mt);
    const float mnew = fmaxf(st.m, mt);
    if (__any(mnew > st.m)) {
        const float al = __builtin_amdgcn_exp2f(st.m - mnew);
        st.l *= al; st.m = mnew;
        if (hi == 0) wsf[r32] = al;
        LDS_WAIT();
#pragma unroll
        for (int r = 0; r < 16; ++r) { const float f = wsf[crow(r, hi)]; st.o[0][r] *= f; st.o[1][r] *= f; }
        LDS_WAIT();
    }
    float ps = 0.f;
#pragma unroll
    for (int r = 0; r < 16; ++r) { s[r] = __builtin_amdgcn_exp2f(s[r] - st.m); ps += s[r]; }
    st.l += ps;
    const bf16x8 pa0 = pack_p(s, 0), pa1 = pack_p(s, 1);
#pragma unroll
    for (int dh = 0; dh < 2; ++dh) {
        const bf16x8 vf0 = __builtin_shufflevector(v[dh][0][0], v[dh][0][1], 0, 1, 2, 3, 4, 5, 6, 7);
        const bf16x8 vf1 = __builtin_shufflevector(v[dh][1][0], v[dh][1][1], 0, 1, 2, 3, 4, 5, 6, 7);
        st.o[dh] = __builtin_amdgcn_mfma_f32_32x32x16_bf16(pa0, vf0, st.o[dh], 0, 0, 0);
        st.o[dh] = __builtin_amdgcn_mfma_f32_32x32x16_bf16(pa1, vf1, st.o[dh], 0, 0, 0);
    }
}
template <int MODE>
DI void attn_unit(const Params& P, unsigned char* ws, int layer, int b, int h0, int qblk, LAS unsigned char* wl, int lane) {
    const int r32 = lane & 31, hi = lane >> 5, kvh = h0 >> 2, m = layer % 3;
    LAS float* wsf = (LAS float*)wl; LAS bf16_t* stg = (LAS bf16_t*)(wl + 256); LAS float* rpbt = (LAS float*)(wl + 256 + 4096);
    const bf16_t* QKV = (const bf16_t*)(ws + WS_QKV);
    const unsigned char* Kbh = ws + WS_KF + (size_t)(b * NKV + kvh) * KGRP * 1024;
    const unsigned char* Vbh = ws + WS_VF + (size_t)(b * NKV + kvh) * KGRP * 1024;
    bf16_t* O = (bf16_t*)(ws + WS_O);
    int r0 = 0, c0 = 0;
    if (MODE == 2) { r0 = 2 * (qblk >> 2); c0 = 16 * (qblk & 3); }
    auto qtok = [&](int i) -> int {
        if (MODE == 3) return TLAT + b * CTXL + qblk * 32 + i;
        if (MODE == 2) return b * SEQ + (r0 + (i >> 4)) * 64 + c0 + (i & 15);
        return b * SEQ + qblk * 32 + i; };
    const int tq = qtok(r32);
    const bf16_t* qp = QKV + (size_t)tq * QKVN + h0 * HD + hi * 8;
    bf16x8 qr[2][4];
#pragma unroll
    for (int hh = 0; hh < 2; ++hh)
#pragma unroll
        for (int d0 = 0; d0 < 4; ++d0) qr[hh][d0] = *(const bf16x8*)(qp + hh * HD + d0 * 16);
    const int q0 = qblk * 32;
    int nl = 0, jlo = 0, rs_min = 0, cseg = 0;
    if (MODE == 0) { jlo = (q0 < 128) ? (128 - q0) / 32 : 0; const int jhi = min(8, (SEQ - 32 - q0 + 128) / 32); nl = jhi - jlo + 1; }
    if (MODE == 1) nl = SEQ / 32;
    if (MODE == 2) { rs_min = min(max(r0 - 4, 0), 24); const int rs_max = min(max(r0 + 1 - 4, 0), 24); nl = rs_max - rs_min + 8; cseg = (c0 == 0) ? 0 : (c0 == 16) ? 8 : (c0 == 32) ? 24 : 32; }
    auto lat_kg = [&](int i) -> int {
        if (MODE == 0) return (q0 - 128 + 32 * (jlo + i)) >> 3;
        if (MODE == 1) return 4 * i;
        return ((rs_min + i) * 64 + cseg) >> 3; };
    bf16x8 kn[4];
    load_k(Kbh, nl > 0 ? lat_kg(0) : SEQ / 8, r32, hi, kn);
    if (MODE == 0 || MODE == 1) {
        const int n = tq & 2047; const f32x2* T = (const f32x2*)(ws + WS_ROPE);
        const f32x2* tr = T + (n >> 6) * 16 + 8 * hi; const f32x2* tc = T + (n & 63) * 16 + 8 * hi;
#pragma unroll
        for (int e = 0; e < 8; ++e) { const f32x2 a = tr[e], cc = tc[e];
#pragma unroll
            for (int hh = 0; hh < 2; ++hh) {
                const float x1 = bfs2f(qr[hh][0][e]), x2 = bfs2f(qr[hh][1][e]), x3 = bfs2f(qr[hh][2][e]), x4 = bfs2f(qr[hh][3][e]);
                qr[hh][0][e] = (short)f2bf(x1 * a.x - x2 * a.y); qr[hh][1][e] = (short)f2bf(x2 * a.x + x1 * a.y);
                qr[hh][2][e] = (short)f2bf(x3 * cc.x - x4 * cc.y); qr[hh][3][e] = (short)f2bf(x4 * cc.x + x3 * cc.y); } }
    }
    int rq = 0, cq = 0, rsq = 0, csq = 0;
    if (MODE == 2) {
        const float* rpb = inp(P, IN_RPB) + (size_t)h0 * 465;
        for (int i = lane; i < 930; i += 64) rpbt[i + (i >= 465 ? 7 : 0)] = rpb[i] * LOG2E;
        LDS_WAIT();
        rq = r0 + (r32 >> 4); cq = c0 + (r32 & 15); rsq = min(max(rq - 4, 0), 24); csq = min(max(cq - 8, 0), 48);
    }
    AttnState st[2];
#pragma unroll
    for (int hh = 0; hh < 2; ++hh) { st[hh].m = -1e30f; st[hh].l = 0.f;
#pragma unroll
        for (int r = 0; r < 16; ++r) { st[hh].o[0][r] = 0.f; st[hh].o[1][r] = 0.f; } }
    const float NEG = -INFINITY;
    for (int i = 0; i < nl; ++i) {
        const int kg = lat_kg(i), kgn = (i + 1 < nl) ? lat_kg(i + 1) : SEQ / 8;
        s16x4 v[2][2][2];
        load_v(Vbh, kg, r32, hi, v);
        f32x16 s[2];
        s[0] = attn_scores(kn, qr[0]); s[1] = attn_scores(kn, qr[1]);
        load_k(Kbh, kgn, r32, hi, kn);
        if (MODE == 0) {
            const int j = jlo + i;
            if (j == 0 || j == 8) { const int kt = q0 - 128 + 32 * j, qpos = q0 + r32;
#pragma unroll
                for (int r = 0; r < 16; ++r) { const int d = kt + crow(r, hi) - qpos; if (d > 128 || d < -128) { s[0][r] = NEG; s[1][r] = NEG; } } }
        }
        if (MODE == 2) {
            const int kr = rs_min + i;
            const bool rowok = (kr >= rsq) && (kr < rsq + 8);
            const int ib = (kr - rq + 7) * 31 - cq + 15;
#pragma unroll
            for (int r = 0; r < 16; ++r) { const int kc2 = cseg + crow(r, hi); const bool ok = rowok && (kc2 >= csq) && (kc2 < csq + 16);
                const int idx = min(max(ib + kc2, 0), 464);
                s[0][r] = ok ? s[0][r] + rpbt[idx] : NEG; s[1][r] = ok ? s[1][r] + rpbt[472 + idx] : NEG; }
        }
        attn_softmax_pv(st[0], s[0], v, wsf, r32, hi);
        __builtin_amdgcn_sched_barrier(0);
        attn_softmax_pv(st[1], s[1], v, wsf + 32, r32, hi);
    }
    if (MODE == 0 || MODE == 1) {
#pragma unroll
        for (int hh = 0; hh < 2; ++hh)
#pragma unroll
            for (int d0 = 0; d0 < 4; ++d0) qr[hh][d0] = *(const bf16x8*)(qp + hh * HD + d0 * 16);
    }
    for (int j = 0; j < CTXL / 32; ++j) {
        const int kg = SEQ / 8 + 4 * j, kgn = (j + 1 < CTXL / 32) ? kg + 4 : kg;
        s16x4 v[2][2][2];
        load_v(Vbh, kg, r32, hi, v);
        f32x16 s[2];
        s[0] = attn_scores(kn, qr[0]); s[1] = attn_scores(kn, qr[1]);
        load_k(Kbh, kgn, r32, hi, kn);
        attn_softmax_pv(st[0], s[0], v, wsf, r32, hi);
        __builtin_amdgcn_sched_barrier(0);
        attn_softmax_pv(st[1], s[1], v, wsf + 32, r32, hi);
    }
    int lane2 = lane; asm volatile("" : "+v"(lane2));
    const int r32b = lane2 & 31, hib = lane2 >> 5;
#pragma unroll
    for (int hh = 0; hh < 2; ++hh) {
        const float lt = swap_add(st[hh].l);
        float inv;
        if (MODE == 0 || (MODE == 3 && m == 0)) { const float sk = inp(P, IN_SINK)[(layer / 3) * NH + h0 + hh] * LOG2E;
            const float mnew = fmaxf(st[hh].m, sk); const float al = __builtin_amdgcn_exp2f(st[hh].m - mnew), es = __builtin_amdgcn_exp2f(sk - mnew);
            inv = al / (lt * al + es); }
        else inv = 1.f / lt;
        if (hib == 0) wsf[r32b] = inv;
        LDS_WAIT();
        LAS bf16_t* sb = stg + hib * 256 + r32b;
        const LAS float* wf = wsf + 4 * hib;
#pragma unroll
        for (int r = 0; r < 16; ++r) { const float f = wf[(r & 3) + 8 * (r >> 2)];
            sb[((r & 3) + 8 * (r >> 2)) * 64] = (bf16_t)f2bf(st[hh].o[0][r] * f); sb[((r & 3) + 8 * (r >> 2)) * 64 + 32] = (bf16_t)f2bf(st[hh].o[1][r] * f); }
        LDS_WAIT();
        const int rw = lane2 >> 3, ch = lane2 & 7;
        const LAS unsigned char* rb = (const LAS unsigned char*)stg + rw * 128 + ch * 16;
#pragma unroll
        for (int i = 0; i < 4; ++i) { const u32x4 vv = *(const LAS u32x4*)(rb + i * 1024);
            *(u32x4*)(O + (size_t)qtok(i * 8 + rw) * DM + (h0 + hh) * HD + ch * 8) = vv; }
        LDS_WAIT();
    }
}
DI void phase_attention(const Params& P, const Frame& F0, int layer) {
    const Frame F = opaque_frame(F0);
    unsigned char* const ws = wsp(P);
    const int m = layer % 3;
    LAS unsigned char* wl = F.lds + F.wave * 16384;
    for (int bu = F.blk; bu < NB * NKV * 16; bu += F.G) {
        const int rnd = bu >> 8, x = bu & 7, loc = (bu & 255) >> 3;
        const int bkv = rnd * 16 + x * 2 + (loc >> 4), qg = loc & 15;
        const int b = bkv >> 2, kvh = bkv & 3, h0 = kvh * 4 + 2 * (F.wave & 1), qblk = 4 * qg + (F.wave >> 1);
        if (m == 0) attn_unit<0>(P, ws, layer, b, h0, qblk, wl, F.lane);
        else if (m == 1) attn_unit<1>(P, ws, layer, b, h0, qblk, wl, F.lane);
        else attn_unit<2>(P, ws, layer, b, h0, qblk, wl, F.lane);
    }
    if (layer < DEPTH - 1) {
        for (int bu = F.blk; bu < NB * NKV * 2; bu += F.G) {
            const int bkv = bu >> 1, b = bkv >> 2, kvh = bkv & 3, h0 = kvh * 4 + 2 * (F.wave & 1), qblk = 4 * (bu & 1) + (F.wave >> 1);
            attn_unit<3>(P, ws, layer, b, h0, qblk, wl, F.lane);
        }
    }
}

constexpr int RT_STRIDE = 1026;
constexpr int RT_PART_OFF = 16 * RT_STRIDE * 4 + 896;
DI void route_token(float lgv, int t, int lane, LAS int* hist, unsigned* asg, float* asgw) {
    const float g0 = __shfl(lgv, 0), g1 = __shfl(lgv, 1), g2 = __shfl(lgv, 2), g3 = __shfl(lgv, 3);
    int grp = 0; float gm = g0; if (g1 > gm) { gm = g1; grp = 1; } if (g2 > gm) { gm = g2; grp = 2; } if (g3 > gm) { gm = g3; grp = 3; }
    const float ptop = 1.f / (expf(g0 - gm) + expf(g1 - gm) + expf(g2 - gm) + expf(g3 - gm));
    float ev[8], em = -INFINITY;
#pragma unroll
    for (int j = 0; j < 8; ++j) { ev[j] = __shfl(lgv, 4 + grp * 8 + j); em = fmaxf(em, ev[j]); }
    float pe[8];
#pragma unroll
    for (int j = 0; j < 8; ++j) pe[j] = expf(ev[j] - em);
    int i1 = 0; float p1 = pe[0];
#pragma unroll
    for (int j = 1; j < 8; ++j) if (pe[j] > p1) { p1 = pe[j]; i1 = j; }
    int i2 = 0; float p2 = -1.f;
#pragma unroll
    for (int j = 0; j < 8; ++j) if (j != i1 && pe[j] > p2) { p2 = pe[j]; i2 = j; }
    const float w1 = ptop * p1 / (p1 + p2), w2 = ptop * p2 / (p1 + p2);
    if (lane == 0) { const int e1 = grp * 8 + i1, e2 = grp * 8 + i2;
        const int q1 = atomicAdd((int*)&hist[e1], 1), q2 = atomicAdd((int*)&hist[e2], 1);
        asg[(size_t)t * 2] = ((unsigned)e1 << 16) | (unsigned)q1; asg[(size_t)t * 2 + 1] = ((unsigned)e2 << 16) | (unsigned)q2;
        asgw[(size_t)t * 2] = w1; asgw[(size_t)t * 2 + 1] = w2; }
}
DI void phase_router(const Params& P, const Frame& F0, int layer, int M) {
    const Frame F = opaque_frame(F0);
    unsigned char* const ws = wsp(P);
    const int TPB = M / GRID, nchunk = TPB / 16;
    LAS int* hist = (LAS int*)(F.lds + LDSX_OFF);
    LAS float* tile = (LAS float*)F.lds; LAS float* part = (LAS float*)(F.lds + RT_PART_OFF);
    if (F.tid < 32) hist[F.tid] = 0;
    const float* X = (const float*)(ws + WS_X); bf16_t* H = (bf16_t*)(ws + WS_H);
    unsigned* asg = (unsigned*)(ws + WS_ASG); float* asgw = (float*)(ws + WS_ASGW);
    const float bias = (F.lane < 4) ? inp(P, IN_BGROUP)[layer * 4 + F.lane] : (F.lane < 36 ? inp(P, IN_BROUTER)[layer * 32 + F.lane - 4] : 0.f);
    const float* gffn = inp(P, IN_GFFN) + layer * DM;
    float wreg[32][3];
    { const float* wf = (const float*)(ws + WS_WRT) + ((size_t)layer * 256 + 32 * F.wave) * 192 + F.lane;
#pragma unroll
      for (int s = 0; s < 32; ++s)
#pragma unroll
          for (int nt = 0; nt < 3; ++nt) wreg[s][nt] = wf[s * 192 + nt * 64]; }
    const int tb = F.blk * TPB + 2 * F.wave;
    f32x4 vn[2][4];
#pragma unroll
    for (int tk = 0; tk < 2; ++tk) load_row(X + (size_t)(tb + tk) * DM, F.lane, vn[tk]);
    for (int c = 0; c < nchunk; ++c) {
#pragma unroll
        for (int tk = 0; tk < 2; ++tk) { const int t = tb + c * 16 + tk; const int mb = (t < TLAT) ? (t >> 11) : 16;
            const float rstd = row_rstd(vn[tk]);
            const float* md = (const float*)(ws + WS_MOD) + ((size_t)layer * 17 + mb) * 6144;
            f32x4 hf[4];
            norm_mod_store(vn[tk], rstd, gffn, md + 3072, md + 4096, H + (size_t)t * DM, F.lane, hf);
            LAS float* trow = tile + (2 * F.wave + tk) * RT_STRIDE + 4 * F.lane;
#pragma unroll
            for (int j = 0; j < 4; ++j) { *(LAS f32x2*)(trow + 256 * j) = (f32x2){hf[j][0], hf[j][1]}; *(LAS f32x2*)(trow + 256 * j + 2) = (f32x2){hf[j][2], hf[j][3]}; } }
        if (c + 1 < nchunk) {
#pragma unroll
            for (int tk = 0; tk < 2; ++tk) load_row(X + (size_t)(tb + (c + 1) * 16 + tk) * DM, F.lane, vn[tk]);
        }
        LDS_WAIT(); __syncthreads();
        f32x4 acc[3];
#pragma unroll
        for (int nt = 0; nt < 3; ++nt) acc[nt] = (f32x4){0.f, 0.f, 0.f, 0.f};
        { const LAS float* ap = tile + (F.lane & 15) * RT_STRIDE + 128 * F.wave + (F.lane >> 4);
#pragma unroll
          for (int s = 0; s < 32; ++s) { const float a = ap[4 * s];
#pragma unroll
              for (int nt = 0; nt < 3; ++nt) acc[nt] = __builtin_amdgcn_mfma_f32_16x16x4f32(a, wreg[s][nt], acc[nt], 0, 0, 0); } }
        { LAS float* pp = part + F.wave * 768 + (4 * (F.lane >> 4)) * 48 + (F.lane & 15);
#pragma unroll
          for (int nt = 0; nt < 3; ++nt)
#pragma unroll
              for (int r = 0; r < 4; ++r) pp[r * 48 + 16 * nt] = acc[nt][r]; }
        LDS_WAIT(); __syncthreads();
#pragma unroll
        for (int tk = 0; tk < 2; ++tk) { const int t = tb + c * 16 + tk;
            float lgv = bias;
            if (F.lane < 36) {
#pragma unroll
                for (int w = 0; w < 8; ++w) lgv += part[w * 768 + (2 * F.wave + tk) * 48 + F.lane]; }
            route_token(lgv, t, F.lane, hist, asg, asgw); }
    }
    __syncthreads();
    if (F.tid < 32) ((unsigned*)(ws + WS_HIST))[F.blk * 32 + F.tid] = (unsigned)hist[F.tid];
}
DI void phase_slots(const Params& P, const Frame& F0, int M) {
    unsigned char* const ws = wsp(P);
    const Frame F = opaque_frame(F0);
    const int TPB = M / GRID;
    LAS unsigned* sm = (LAS unsigned*)(F.lds + LDSX_OFF + 1024);
    const unsigned* hist = (const unsigned*)(ws + WS_HIST);
    { const int e = F.tid & 31, part = F.tid >> 5; unsigned tot = 0, pre = 0;
      for (int bb = part * 16; bb < part * 16 + 16; ++bb) { const unsigned v = hist[bb * 32 + e]; tot += v; if (bb < F.blk) pre += v; }
      sm[part * 32 + e] = tot; sm[512 + part * 32 + e] = pre; }
    __syncthreads();
    LAS unsigned* tot = sm + 1024; LAS unsigned* bas = sm + 1056; LAS unsigned* pst = sm + 1088;
    if (F.tid < 32) { unsigned a = 0, c = 0;
        for (int p = 0; p < 16; ++p) { a += sm[p * 32 + F.tid]; c += sm[512 + p * 32 + F.tid]; }
        tot[F.tid] = a; bas[F.tid] = c; }
    __syncthreads();
    if (F.tid == 0) { unsigned ps = 0; for (int e = 0; e < NEXP; ++e) { pst[e] = ps; ps += (tot[e] + 255u) & ~255u; } sm[1120] = ps >> 8; }
    __syncthreads();
    const unsigned* asg = (const unsigned*)(ws + WS_ASG); unsigned* slot = (unsigned*)(ws + WS_SLOT); unsigned* toks = (unsigned*)(ws + WS_TOKS);
    for (int i = F.tid; i < TPB * 2; i += NTHREADS) { const int t = F.blk * TPB + (i >> 1); const unsigned ep = asg[(size_t)t * 2 + (i & 1)];
        const unsigned e = ep >> 16, s = pst[e] + bas[e] + (ep & 0xffffu); slot[(size_t)t * 2 + (i & 1)] = s; toks[s] = (unsigned)t; }
    for (int e = F.blk; e < NEXP; e += F.G) { const unsigned beg = pst[e] + tot[e], end = pst[e] + ((tot[e] + 255u) & ~255u);
        for (unsigned s = beg + F.tid; s < end; s += NTHREADS) toks[s] = 0u; }
    if (F.blk == 0) { unsigned* tt = (unsigned*)(ws + WS_TTAB); const unsigned ntile = sm[1120];
        if (F.tid == 0) tt[0] = ntile;
        for (unsigned rt = F.tid; rt < ntile; rt += NTHREADS) { unsigned e = 0; for (int k = 1; k < NEXP; ++k) if (rt * 256u >= pst[k]) e = k; tt[1 + rt] = e; } }
}
DI void load_tile_table(const Params& P, const Frame& F, LAS unsigned* tab) {
    unsigned char* const ws = wsp(P);
    const unsigned* tt = (const unsigned*)(ws + WS_TTAB);
    for (int i = F.tid; i < 1 + CAPR / 256; i += NTHREADS) tab[i] = tt[i];
    __syncthreads();
}

#ifndef RPT
#define RPT 0
#endif
__global__ void __launch_bounds__(NTHREADS, 2) dit_fwd(Params P) {
    extern __shared__ __attribute__((aligned(16))) unsigned char lds_raw[];
    Frame F;
    F.lds = (LAS unsigned char*)lds_raw;
    F.tid = threadIdx.x; F.lane = F.tid & 63; F.wave = __builtin_amdgcn_readfirstlane(F.tid >> 6);
    F.blk = blockIdx.x; F.G = gridDim.x; F.vcu = (F.G % 8 == 0) ? (F.blk % 8) * (F.G / 8) + F.blk / 8 : F.blk;
    F.gw = F.vcu * NWAVES + F.wave; F.NGW = F.G * NWAVES;
    for (int u = F.tid; u < (LDS_BYTES - RING_BYTES) / 4; u += NTHREADS) ((LAS unsigned*)(F.lds + RING_BYTES))[u] = 0u;
    __syncthreads();
    unsigned* ctl = (unsigned*)(P.ws + WS_CTL);
    XcdBarrier bar = xcd_barrier_post(ctl + CW_BAR, (volatile LAS unsigned*)(F.lds + MISC_OFF) + 8);

    p0_prologue(P, F);
    if (RPT & 1) p0_prologue(P, F);
    xcd_barrier(bar);
    p0b_mod_reduce(P, F);
    xcd_barrier(bar);

    for (int layer = 0; layer < DEPTH; ++layer) {
        const bool last = (layer == DEPTH - 1);
        unsigned char* ws = wsp(P);
        const int Mtok = last ? TLAT : TALL;
        phase_attn_norm(P, F, layer);
        xcd_barrier(bar);
        {
            pg8::PlainSched S; S.nN = QKVN / 256; S.nwg = (TALL / 256) * S.nN; S.G = F.G; S.c = F.vcu; S.K = DM; S.Bt = (const bf16_t*)(ws + WS_WQKV) + (size_t)layer * QKVN * DM;
            pg8::EpiQKV E{(bf16_t*)(ws + WS_QKV), ws + WS_KF, ws + WS_VF, (const f32x2*)(ws + WS_ROPE), inp(P, IN_GQ), inp(P, IN_GK), layer % 3};
            pg8::gemm_phase(F.lds, (const bf16_t*)(ws + WS_H), DM, S, E);
            if (RPT & 2) pg8::gemm_phase(F.lds, (const bf16_t*)(ws + WS_H), DM, S, E);
        }
        xcd_barrier(bar);
        phase_attention(P, F, layer);
        if (((RPT & 4) && layer == 1) || ((RPT & 8) && layer != 1)) phase_attention(P, F, layer);
        xcd_barrier(bar);
        {
            pg8::PlainSched S; S.nN = DM / 256; S.nwg = (Mtok / 256) * S.nN; S.G = F.G; S.c = F.vcu; S.K = DM; S.Bt = (const bf16_t*)(ws + WS_WO) + (size_t)layer * DM * DM;
            pg8::EpiResid E{(float*)(ws + WS_X), (const float*)(ws + WS_MOD) + (size_t)layer * 17 * 6144 + 2048};
            pg8::gemm_phase(F.lds, (const bf16_t*)(ws + WS_O), DM, S, E);
        }
        xcd_barrier(bar);
        phase_router(P, F, layer, Mtok);
        if (RPT & 16) { __syncthreads(); phase_router(P, F, layer, Mtok); }
        xcd_barrier(bar);
        phase_slots(P, F, Mtok);
        xcd_barrier(bar);
        if (RPT & 128) { for (int xb = 0; xb < 9; ++xb) xcd_barrier(bar); }
        LAS unsigned* tab = (LAS unsigned*)(F.lds + LDSX_OFF + 8192);
        load_tile_table(P, F, tab);
        {
            pg8::MoeSched<true> S; S.tab = tab; S.G = F.G; S.c = F.vcu; S.K = DM; S.Bt = (const bf16_t*)(ws + WS_WGU) + (size_t)layer * NEXP * DM * DM; S.estride = (size_t)DM * DM * 2; S.tok = (const unsigned*)(ws + WS_TOKS);
            pg8::EpiSwiglu E{(bf16_t*)(ws + WS_ACT)};
            pg8::gemm_phase(F.lds, (const bf16_t*)(ws + WS_H), DM, S, E);
            if (RPT & 32) pg8::gemm_phase(F.lds, (const bf16_t*)(ws + WS_H), DM, S, E);
        }
        xcd_barrier(bar);
        {
            pg8::MoeSched<false> S; S.tab = tab; S.G = F.G; S.c = F.vcu; S.K = FH; S.Bt = (const bf16_t*)(ws + WS_WD) + (size_t)layer * NEXP * DM * FH; S.estride = (size_t)DM * FH * 2; S.tok = nullptr;
            pg8::EpiStore E{(bf16_t*)(ws + WS_Y), DM};
            pg8::gemm_phase(F.lds, (const bf16_t*)(ws + WS_ACT), FH, S, E);
            if (RPT & 64) pg8::gemm_phase(F.lds, (const bf16_t*)(ws + WS_ACT), FH, S, E);
        }
        xcd_barrier(bar);
    }
    phase_final(P, F);
}

extern "C" void kernel_launch(void* const* d_in, const int* in_sizes, int n_in, void* d_out, int out_size, void* d_ws, size_t ws_size, hipStream_t stream) {
    static int ok = 0;
    if (ok == 0) {
        if (n_in != 22 || in_sizes[0] != TLAT * DM || out_size != TLAT * DM || ws_size < WS_END) {
            fprintf(stderr, "kernel_launch: unexpected shapes (n_in %d, in0 %d, out %d, ws %zu < %zu); nothing launched\n", n_in, n_in > 0 ? in_sizes[0] : -1, out_size, ws_size, (size_t)WS_END); ok = -1; return; }
        int dev = 0, cus = 0, per_cu = 0;
        if (hipGetDevice(&dev) != hipSuccess || hipDeviceGetAttribute(&cus, hipDeviceAttributeMultiprocessorCount, dev) != hipSuccess) { ok = -1; return; }
        if (hipFuncSetAttribute((const void*)dit_fwd, hipFuncAttributeMaxDynamicSharedMemorySize, LDS_BYTES) != hipSuccess) { fprintf(stderr, "kernel_launch: hipFuncSetAttribute failed\n"); ok = -1; return; }
        if (hipOccupancyMaxActiveBlocksPerMultiprocessor(&per_cu, (const void*)dit_fwd, NTHREADS, LDS_BYTES) != hipSuccess || per_cu < 1) fprintf(stderr, "kernel_launch: note: occupancy query reports %d\n", per_cu);
        (void)hipGetLastError();
        if (cus < GRID) { fprintf(stderr, "kernel_launch: %d CUs < %d workgroups: grid would not be resident; nothing launched\n", cus, GRID); ok = -1; return; }
        ok = 1;
    }
    if (ok < 0) return;
    if (hipMemsetAsync((char*)d_ws + WS_CTL, 0, CTL_ZERO_BYTES, stream) != hipSuccess) return;
    Params p{};
    for (int i = 0; i < 22; ++i) p.in[i] = (const float*)d_in[i];
    p.out = (float*)d_out; p.ws = (unsigned char*)d_ws;
    hipLaunchKernelGGL(dit_fwd, dim3(GRID), dim3(NTHREADS), LDS_BYTES, stream, p);
}
```

```cpp
#include <hip/hip_runtime.h>
#include <cstdio>
#include <cstdint>

#ifndef PROBE_SEL
#define PROBE_SEL 0
#endif
#ifndef RPT
#define RPT 0
#endif

#define LAS __attribute__((address_space(3)))
#define GAS __attribute__((address_space(1)))
#define DI __device__ __forceinline__

typedef unsigned short bf16_t;
typedef short bf16x8 __attribute__((ext_vector_type(8)));
typedef short s16x4 __attribute__((ext_vector_type(4)));
typedef float f32x2 __attribute__((ext_vector_type(2)));
typedef float f32x4 __attribute__((ext_vector_type(4)));
typedef float f32x16 __attribute__((ext_vector_type(16)));
typedef unsigned u32x2 __attribute__((ext_vector_type(2)));
typedef unsigned u32x4 __attribute__((ext_vector_type(4)));

constexpr int NB = 16, SEQ = 2048, DM = 1024, DEPTH = 4, CTXL = 256, NH = 16, NKV = 4, HD = 64, QKVN = 1536;
constexpr int TLAT = NB * SEQ, TCTX = NB * CTXL, TALL = TLAT + TCTX;
constexpr int NEXP = 32, FH = 512;
constexpr int KEYS = SEQ + CTXL, KGRP = KEYS / 8;
constexpr int CAPR = 2 * TALL + NEXP * 256;
constexpr int NWAVES = 8, NTHREADS = 512, GRID = 256;
constexpr float NORM_EPS = 1e-6f, LOG2E = 1.4426950408889634f;

constexpr size_t MiB = 1u << 20;
constexpr size_t WS_CTL = 0, CTL_ZERO_BYTES = 1 * MiB;
constexpr size_t WS_MODP = 1 * MiB;
constexpr size_t WS_MOD = 15 * MiB;
constexpr size_t WS_ROPE = 17 * MiB;
constexpr size_t WS_WRT = 17 * MiB + 65536;
constexpr size_t WS_ASG = 18 * MiB;
constexpr size_t WS_ASGW = 18 * MiB + 512 * 1024;
constexpr size_t WS_TOKE = 1 * MiB;
constexpr size_t WS_WQKV = 21 * MiB;
constexpr size_t WS_WO = 33 * MiB;
constexpr size_t WS_WGU = 41 * MiB;
constexpr size_t WS_WD = 297 * MiB;
constexpr size_t WS_X = 425 * MiB;
constexpr size_t WS_H = 569 * MiB;
constexpr size_t WS_R1 = 641 * MiB;
constexpr size_t WS_QKV = WS_R1;
constexpr size_t WS_KF = WS_R1 + 108 * MiB;
constexpr size_t WS_VF = WS_R1 + 126 * MiB;
constexpr size_t WS_O = WS_R1 + 144 * MiB;
constexpr size_t WS_Y = WS_R1;
constexpr size_t WS_ACT = WS_R1 + 160 * MiB;
constexpr size_t WS_END = WS_R1 + 240 * MiB;
constexpr int CW_TMO = 0, CW_BAR = 4096, CW_CNT = 65536, CNT_STRIDE = 32;

constexpr int RING_BYTES = 131072;
constexpr int MISC_OFF = RING_BYTES + 320;
constexpr int LDSX_OFF = RING_BYTES + 1024;
constexpr int LDS_BYTES = 147456;

#define LDS_WAIT() asm volatile("s_waitcnt lgkmcnt(0)" ::: "memory")
#define VM_WAIT() asm volatile("s_waitcnt vmcnt(0)" ::: "memory")

DI unsigned f2bf(float f) { unsigned u = __float_as_uint(f); return (u + 0x7fffu + ((u >> 16) & 1u)) >> 16; }
DI float bf2f(unsigned b) { return __uint_as_float(b << 16); }
DI float bfs2f(short b) { return __uint_as_float(((unsigned)(unsigned short)b) << 16); }
DI unsigned cvt_pk_bf16(float lo, float hi);
DI unsigned pk2(float lo, float hi) { return cvt_pk_bf16(lo, hi); }
DI unsigned cvt_pk_bf16(float lo, float hi) { unsigned r; asm volatile("v_cvt_pk_bf16_f32 %0, %1, %2" : "=v"(r) : "v"(lo), "v"(hi)); return r; }
DI float wave_sum(float v) {
#pragma unroll
    for (int o = 1; o < 64; o <<= 1) v += __shfl_xor(v, o);
    return v;
}
DI int crow(int r, int hi) { return (r & 3) + 8 * (r >> 2) + 4 * hi; }

#define XB_TMO      128
#define XB_XCNT(j)  (256  + 64 * (j))
#define XB_XSUB(j)  (1280 + 64 * (j))
#define XB_XGEN(j)  (2304 + 64 * (j))
#define XB_TOP      3328
#define XB_TOPGEN   3392
#define XCD_BAR_WORDS 3456
#define XB_SPIN_CAP (1u << 18)

__device__ __forceinline__ unsigned xb_ld(unsigned* p)              { return __hip_atomic_load(p, __ATOMIC_RELAXED, __HIP_MEMORY_SCOPE_AGENT); }
__device__ __forceinline__ unsigned xb_add(unsigned* p, unsigned v) { return __hip_atomic_fetch_add(p, v, __ATOMIC_RELAXED, __HIP_MEMORY_SCOPE_AGENT); }
__device__ __forceinline__ unsigned xb_xcc_id() { return (unsigned)__builtin_amdgcn_s_getreg((3 << 11) | 20) & 0xFu; }
#define XB_SPIN(cond, bar) do { unsigned _sp = 0; while (cond) { __builtin_amdgcn_s_sleep(1); \
    if ((++_sp & 255u) == 0u) { if (xb_ld(&(bar)[XB_TMO])) break; if (_sp > XB_SPIN_CAP) { atomicAdd(&(bar)[XB_TMO], 1u); break; } } } } while (0)

struct XcdBarrier { unsigned* bar; unsigned x; volatile LAS unsigned* st; };

__device__ __forceinline__ XcdBarrier xcd_barrier_post(unsigned* bar, volatile LAS unsigned* st) {
    XcdBarrier b; b.bar = bar; b.x = xb_xcc_id(); b.st = st;
    if (threadIdx.x == 0) (void)xb_add(&bar[XB_XCNT(b.x)], 1u);
    return b;
}
__device__ __forceinline__ void xcd_barrier_complete(unsigned* bar, unsigned x, unsigned& nloc, unsigned& nx) {
    const unsigned G = gridDim.x * gridDim.y * gridDim.z;
    unsigned sum, cnt, mine, sp = 0u;
    for (;;) {
        sum = 0u; cnt = 0u; mine = 0u;
#pragma unroll
        for (unsigned j = 0; j < 16; ++j) { const unsigned c = xb_ld(&bar[XB_XCNT(j)]); sum += c; cnt += (c > 0u) ? 1u : 0u; mine = (j == x) ? c : mine; }
        if (sum == G) break;
        __builtin_amdgcn_s_sleep(1);
        if ((++sp & 255u) == 0u) { if (xb_ld(&bar[XB_TMO])) break; if (sp > XB_SPIN_CAP) { atomicAdd(&bar[XB_TMO], 1u); break; } }
    }
    nloc = mine > 0u ? mine : 1u; nx = cnt > 0u ? cnt : 1u;
}
__device__ __forceinline__ void xcd_barrier(const XcdBarrier& b0) {
    XcdBarrier b = b0;
    { unsigned z = 0, bx = __builtin_amdgcn_readfirstlane(b0.x); asm volatile("s_mov_b32 %0, 0" : "=s"(z)); asm volatile("" : "+s"(bx)); b.bar = b0.bar + z; b.x = bx; }
    asm volatile("s_waitcnt vmcnt(0)" ::: "memory");
    __syncthreads();
    if (threadIdx.x == 0) {
        unsigned* bar = b.bar;
        __builtin_amdgcn_s_waitcnt(0);
        unsigned nloc = b.st[0], nx = b.st[1];
        if (nloc == 0u) { xcd_barrier_complete(bar, b.x, nloc, nx); b.st[0] = nloc; b.st[1] = nx; }
        const unsigned old = xb_add(&bar[XB_XSUB(b.x)], 1u);
        const unsigned gen = old / nloc;
        if (old + 1u == (gen + 1u) * nloc) {
            __builtin_amdgcn_fence(__ATOMIC_RELEASE, "agent");
            asm volatile("s_waitcnt vmcnt(0)" ::: "memory");
            const unsigned og = xb_add(&bar[XB_TOP], 1u);
            const unsigned tg = og / nx;
            if (og + 1u == (tg + 1u) * nx) xb_add(&bar[XB_TOPGEN], 1u);
            else XB_SPIN(xb_ld(&bar[XB_TOPGEN]) == tg, bar);
            __builtin_amdgcn_fence(__ATOMIC_ACQUIRE, "agent");
            xb_add(&bar[XB_XGEN(b.x)], 1u);
            asm volatile("s_waitcnt vmcnt(0)" ::: "memory");
        } else {
            XB_SPIN(xb_ld(&bar[XB_XGEN(b.x)]) == gen, bar);
            __builtin_amdgcn_fence(__ATOMIC_ACQUIRE, "agent");
            asm volatile("s_waitcnt vmcnt(0)" ::: "memory");
        }
    }
    __syncthreads();
}

namespace pg8 {
constexpr int BM = 256, BK = 64, HALF = 128, HTB = HALF * BK * 2, STAGE_BYTES = 8 * HTB;
DI int lds_byte(int r, int c) { const int st = (r >> 4) * 2 + (c >> 5), rr = r & 15, cc = c & 31, ob = rr * 64 + cc * 2; return st * 1024 + (ob ^ (((ob >> 9) & 1) << 5)); }
DI void stage_rc(int b, int& R, int& C) { const int st = b / 1024, sb = b % 1024, swz = sb ^ (((sb >> 9) & 1) << 5); R = (st >> 1) * 16 + swz / 64; C = (st & 1) * 32 + (swz % 64) / 2; }
DI int perm32(int rho) { const int n = rho >> 4, i = rho & 15; return 8 * (i >> 2) + 4 * n + (i & 3); }
struct Unit { int pm, pn, e, r0, na; };

template <class Epi, class Sched>
DI void gemm_phase(LAS unsigned char* lds, const bf16_t* A, const int K, const Sched& S, const Epi& E) {
    int tid_ = threadIdx.x; asm volatile("" : "+v"(tid_));
    const int tid = tid_, wid = __builtin_amdgcn_readfirstlane(tid >> 6), lane = tid & 63, wr = wid >> 2, wc = wid & 3, fr = lane & 15, fq = lane >> 4;
    const int nt = K / BK;
    constexpr bool GA = Sched::GATHER;
    int Rr[2], Cc[2]; unsigned voffB[2], voffA[2];
#pragma unroll
    for (int i = 0; i < 2; ++i) { int R, C; stage_rc(tid * 16 + i * 8192, R, C); const int Rb = Epi::PERM ? ((R & ~31) + perm32(R & 31)) : R;
        Rr[i] = R; Cc[i] = C; voffB[i] = (unsigned)(Rb * K + C) * 2u; voffA[i] = (unsigned)(R * K + C) * 2u; }
    const size_t kstep = (size_t)(BK * 2);
    const size_t hstep = (size_t)HALF * K * 2;
    const unsigned ldsw = (unsigned)wid * 1024u;
    const int aoff = lds_byte(wr * 64 + fr, fq * 8), boff = lds_byte(wc * 32 + fr, fq * 8);
#define PG8_SA(b, h) (((b) * 2 + (h)) * HTB)
#define PG8_SB(b, h) ((4 + (b) * 2 + (h)) * HTB)
#define PG8_STAGE(bufoff, gbase, voff) do { _Pragma("unroll") for (int _i = 0; _i < 2; ++_i) \
        __builtin_amdgcn_global_load_lds((const unsigned*)((const char*)(gbase) + (voff)[_i]), (LAS unsigned*)(lds + (bufoff) + ldsw + _i * 8192), 16, 0, 0); } while (0)
#define PG8_LDA(dst, b, h) do { _Pragma("unroll") for (int m = 0; m < 4; ++m) _Pragma("unroll") for (int k = 0; k < 2; ++k) dst[m][k] = *(const LAS bf16x8*)(lds + PG8_SA(b, h) + aoff + m * 2048 + k * 1024); } while (0)
#define PG8_LDB(dst, b, h) do { _Pragma("unroll") for (int n = 0; n < 2; ++n) _Pragma("unroll") for (int k = 0; k < 2; ++k) dst[n][k] = *(const LAS bf16x8*)(lds + PG8_SB(b, h) + boff + n * 2048 + k * 1024); } while (0)
#define PG8_MMA(ai, bj, At, Bt) do { __builtin_amdgcn_s_setprio(1); _Pragma("unroll") for (int m = 0; m < 4; ++m) _Pragma("unroll") for (int n = 0; n < 2; ++n) _Pragma("unroll") for (int k = 0; k < 2; ++k) \
        acc[ai][bj][m][n] = __builtin_amdgcn_mfma_f32_16x16x32_bf16(Bt[n][k], At[m][k], acc[ai][bj][m][n], 0, 0, 0); __builtin_amdgcn_s_setprio(0); } while (0)
#define PG8_WAIT_V(n) asm volatile("s_waitcnt vmcnt(" #n ")" ::: "memory")
#define PG8_WAIT_L(n) asm volatile("s_waitcnt lgkmcnt(" #n ")" ::: "memory")
#define PG8_BAR __builtin_amdgcn_s_barrier()
#define PG8_SCHED __builtin_amdgcn_sched_barrier(0)
    Unit cur, nxt; int ui = 0;
    if (!S.next(0, cur)) return;
    f32x4 acc[2][2][4][2];
#pragma unroll
    for (int a = 0; a < 2; ++a)
#pragma unroll
        for (int b = 0; b < 2; ++b)
#pragma unroll
            for (int m = 0; m < 4; ++m)
#pragma unroll
                for (int n = 0; n < 2; ++n) acc[a][b][m][n] = (f32x4){0.f, 0.f, 0.f, 0.f};
    bf16x8 At[4][2], B0[2][2], B1[2][2];
    unsigned oc0[2], oc1[2], on0[2], on1[2];
#pragma unroll
    for (int i = 0; i < 2; ++i) { if (GA) { oc0[i] = S.a_off(cur, Rr[i]) + (unsigned)Cc[i] * 2u; oc1[i] = S.a_off(cur, HALF + Rr[i]) + (unsigned)Cc[i] * 2u; } else { oc0[i] = voffA[i]; oc1[i] = voffA[i]; } on0[i] = oc0[i]; on1[i] = oc1[i]; }
    size_t hA = (GA || (Sched::HALVES && cur.na == 1)) ? (size_t)0 : hstep, hAn = hA;
    const char* Ab = GA ? (const char*)A : (const char*)A + (size_t)cur.r0 * K * 2;
    const char* cB = S.b_ptr(cur);
    PG8_STAGE(PG8_SB(0, 0), cB, voffB); PG8_STAGE(PG8_SB(0, 1), cB + hstep, voffB); PG8_STAGE(PG8_SA(0, 0), Ab, oc0); PG8_STAGE(PG8_SA(0, 1), Ab + hA, oc1);
    if (wr == 1) PG8_BAR;
    PG8_WAIT_V(2); PG8_BAR;
    PG8_STAGE(PG8_SB(1, 0), cB + kstep, voffB); PG8_STAGE(PG8_SA(1, 0), Ab + kstep, oc0); PG8_STAGE(PG8_SB(1, 1), cB + hstep + kstep, voffB);
    PG8_WAIT_V(6); PG8_BAR;
    for (;;) {
        const bool has_next = S.next(ui + 1, nxt);
        const char* nB = has_next ? S.b_ptr(nxt) : cB;
        const char* nA = GA ? Ab : (has_next ? (const char*)A + (size_t)nxt.r0 * K * 2 : Ab);
        if (!GA && Sched::HALVES) hAn = (has_next && nxt.na == 1) ? (size_t)0 : (has_next ? hstep : hA);
        if (GA) {
            if (has_next) {
#pragma unroll
                for (int i = 0; i < 2; ++i) { on0[i] = S.a_off(nxt, Rr[i]) + (unsigned)Cc[i] * 2u; on1[i] = S.a_off(nxt, HALF + Rr[i]) + (unsigned)Cc[i] * 2u; }
            } else {
#pragma unroll
                for (int i = 0; i < 2; ++i) { on0[i] = oc0[i]; on1[i] = oc1[i]; }
            }
        }
#define PG8_KLOOP(FULL) \
        for (int t = 0; t < nt; t += 2) { \
            const bool last = (t == nt - 2); \
            const char* a1 = Ab + (size_t)(t + 1) * kstep + hA; \
            const char* a2 = last ? nA : Ab + (size_t)(t + 2) * kstep; const char* b2 = last ? nB : cB + (size_t)(t + 2) * kstep; \
            const char* a3 = a2 + kstep; const char* b3 = b2 + kstep; const size_t hA2 = last ? hAn : hA; \
            unsigned o20[2], o21[2]; \
            for (int i = 0; i < 2; ++i) { if (GA) { o20[i] = last ? on0[i] : oc0[i]; o21[i] = last ? on1[i] : oc1[i]; } else { o20[i] = voffA[i]; o21[i] = voffA[i]; } } \
              \
            PG8_LDB(B0, 0, 0); PG8_LDB(B1, 0, 1); PG8_SCHED; PG8_LDA(At, 0, 0); PG8_STAGE(PG8_SA(1, 1), a1, oc1); \
            PG8_WAIT_V(8); PG8_WAIT_L(0); PG8_BAR; PG8_MMA(0, 0, At, B0); PG8_MMA(0, 1, At, B1); PG8_BAR; PG8_SCHED; \
              \
            if (FULL) { PG8_LDA(At, 0, 1); } PG8_STAGE(PG8_SB(0, 0), b2, voffB); PG8_STAGE(PG8_SB(0, 1), b2 + hstep, voffB); PG8_STAGE(PG8_SA(0, 0), a2, o20); \
            PG8_WAIT_V(8); PG8_WAIT_L(0); PG8_BAR; if (FULL) { PG8_MMA(1, 0, At, B0); PG8_MMA(1, 1, At, B1); } PG8_BAR; PG8_SCHED; \
              \
            PG8_LDB(B0, 1, 0); PG8_LDB(B1, 1, 1); PG8_SCHED; PG8_LDA(At, 1, 0); PG8_STAGE(PG8_SA(0, 1), a2 + hA2, o21); \
            PG8_WAIT_V(8); PG8_WAIT_L(0); PG8_BAR; PG8_MMA(0, 0, At, B0); PG8_MMA(0, 1, At, B1); PG8_BAR; PG8_SCHED; \
              \
            if (FULL) { PG8_LDA(At, 1, 1); } PG8_STAGE(PG8_SB(1, 0), b3, voffB); PG8_STAGE(PG8_SB(1, 1), b3 + hstep, voffB); PG8_STAGE(PG8_SA(1, 0), a3, o20); \
            PG8_WAIT_V(8); PG8_WAIT_L(0); PG8_BAR; if (FULL) { PG8_MMA(1, 0, At, B0); PG8_MMA(1, 1, At, B1); } PG8_BAR; PG8_SCHED; \
        }
        if (Sched::HALVES && cur.na == 1) { PG8_KLOOP(0) } else { PG8_KLOOP(1) }
#undef PG8_KLOOP
        if (wr == 0) PG8_BAR;
        E(acc, cur, wr, wc, fr, fq);
        if (!has_next) break;
#pragma unroll
        for (int a = 0; a < 2; ++a)
#pragma unroll
            for (int b = 0; b < 2; ++b)
#pragma unroll
                for (int m = 0; m < 4; ++m)
#pragma unroll
                    for (int n = 0; n < 2; ++n) acc[a][b][m][n] = (f32x4){0.f, 0.f, 0.f, 0.f};
        cur = nxt; cB = nB; Ab = nA; hA = hAn; ++ui;
        if (GA) {
#pragma unroll
            for (int i = 0; i < 2; ++i) { oc0[i] = on0[i]; oc1[i] = on1[i]; }
        }
        if (wr == 1) PG8_BAR;
    }
    PG8_WAIT_V(0);
    PG8_BAR;
#undef PG8_SA
#undef PG8_SB
#undef PG8_STAGE
#undef PG8_LDA
#undef PG8_LDB
#undef PG8_MMA
#undef PG8_WAIT_V
#undef PG8_WAIT_L
#undef PG8_BAR
#undef PG8_SCHED
}

struct PlainSched {
    static constexpr bool GATHER = false, HALVES = true;
    int nN, nwg, G, c, K; const bf16_t* Bt;
    DI bool next(int i, Unit& u) const { const int L = i * G + c; const int nfull = (nwg / G) * G, rem = nwg - nfull; int Lu = L, hf = 0; u.na = 2;
        if (L >= nfull) { if (2 * rem <= G) { const int h = L - nfull; if (h >= 2 * rem) return false; Lu = nfull + (h >> 1); hf = h & 1; u.na = 1; } else if (L >= nwg) return false; }
        u.pm = Lu / nN; u.pn = Lu - u.pm * nN; u.e = 0; u.r0 = u.pm * BM + hf * HALF; return true; }
    DI unsigned a_off(const Unit& u, int r) const { return (unsigned)(u.r0 + r) * (unsigned)(K * 2); }
    DI const char* b_ptr(const Unit& u) const { return (const char*)Bt + (size_t)u.pn * BM * K * 2; }
};
template <bool GATHER_> struct MoeSched {
    static constexpr bool GATHER = GATHER_, HALVES = true;
    static constexpr int TAB_PST = 384, TAB_CNT = 416;
    const LAS unsigned* tab; int G, c, K; const bf16_t* Bt; size_t estride; const unsigned* tok;
    DI bool next(int i, Unit& u) const { const int L = i * G + c; const int nwg = (int)tab[0] * 4, nfull = (nwg / G) * G, rem = nwg - nfull; int Lu = L, hf = 0; u.na = 2;
        if (L >= nfull) { if (2 * rem <= G) { const int h = L - nfull; if (h >= 2 * rem) return false; Lu = nfull + (h >> 1); hf = h & 1; u.na = 1; } else if (L >= nwg) return false; }
        u.pm = Lu >> 2; u.pn = Lu & 3; u.e = (int)tab[1 + u.pm]; u.r0 = u.pm * BM + hf * HALF; return true; }
    DI unsigned a_off(const Unit& u, int r) const {
        unsigned row = (unsigned)(u.r0 + (u.na == 1 ? (r & (HALF - 1)) : r));
        if (GATHER_) { const unsigned last = tab[TAB_CNT + u.e] - 1u; unsigned idx = row - tab[TAB_PST + u.e]; idx = idx < last ? idx : last; row = tok[(unsigned)u.e * (unsigned)TALL + idx]; }
        return row * (unsigned)(K * 2); }
    DI const char* b_ptr(const Unit& u) const { return (const char*)Bt + (size_t)u.e * estride + (size_t)u.pn * BM * K * 2; }
};

struct EpiStore {
    static constexpr bool PERM = true;
    bf16_t* O; int ldc;
    DI void operator()(const f32x4 (&acc)[2][2][4][2], const Unit& u, int wr, int wc, int fr, int fq) const {
        const int row0 = u.r0 + wr * 64 + fr, col0 = u.pn * BM + wc * 32 + 8 * fq;
#pragma unroll
        for (int ai = 0; ai < 2; ++ai) if (ai < u.na)
#pragma unroll
            for (int m = 0; m < 4; ++m) { bf16_t* rowp = O + (size_t)(row0 + ai * HALF + m * 16) * ldc + col0;
#pragma unroll
                for (int bj = 0; bj < 2; ++bj) { const f32x4 v0 = acc[ai][bj][m][0], v1 = acc[ai][bj][m][1];
                    u32x4 w; w.x = cvt_pk_bf16(v0[0], v0[1]); w.y = cvt_pk_bf16(v0[2], v0[3]); w.z = cvt_pk_bf16(v1[0], v1[1]); w.w = cvt_pk_bf16(v1[2], v1[3]);
                    *(u32x4*)(rowp + bj * HALF) = w; } }
    }
};
struct EpiQKV {
    static constexpr bool PERM = false;
    bf16_t* QKV; unsigned char* KF; unsigned char* VF; const f32x2* T; const float* gq; const float* gk; int m;
    DI void operator()(const f32x4 (&acc)[2][2][4][2], const Unit& u, int wr, int wc, int fr, int fq) const {
        const bool lat = u.pm < TLAT / BM; const int b = lat ? (u.pm >> 3) : (u.pm - TLAT / BM);
        const int trow0 = u.r0 + wr * 64 + fr;
        if (u.pn < 4) {
            const int h = 4 * u.pn + wc;
            f32x4 g[2][2];
#pragma unroll
            for (int bj = 0; bj < 2; ++bj)
#pragma unroll
                for (int n = 0; n < 2; ++n) g[bj][n] = (m == 1) ? *(const f32x4*)(gq + 32 * bj + 16 * n + 4 * fq) : (f32x4){1.f, 1.f, 1.f, 1.f};
#pragma unroll
            for (int ai = 0; ai < 2; ++ai) if (ai < u.na)
#pragma unroll
                for (int mm = 0; mm < 4; ++mm) {
                    f32x4 x[2][2]; float ss = 0.f;
#pragma unroll
                    for (int bj = 0; bj < 2; ++bj)
#pragma unroll
                        for (int n = 0; n < 2; ++n) { x[bj][n] = acc[ai][bj][mm][n]; ss += (x[bj][n][0] * x[bj][n][0] + x[bj][n][1] * x[bj][n][1]) + (x[bj][n][2] * x[bj][n][2] + x[bj][n][3] * x[bj][n][3]); }
                    float sc = 0.125f * LOG2E;
                    if (m == 1) { ss += __shfl_xor(ss, 16); ss += __shfl_xor(ss, 32); sc *= 1.0f / sqrtf(ss * (1.f / HD) + NORM_EPS); }
                    bf16_t* qrow = QKV + (size_t)(trow0 + ai * HALF + mm * 16) * QKVN + h * HD + 4 * fq;
#pragma unroll
                    for (int bj = 0; bj < 2; ++bj)
#pragma unroll
                        for (int n = 0; n < 2; ++n) { const f32x4 y = x[bj][n] * g[bj][n] * sc; u32x2 w; w.x = cvt_pk_bf16(y[0], y[1]); w.y = cvt_pk_bf16(y[2], y[3]); *(u32x2*)(qrow + 32 * bj + 16 * n) = w; }
                }
        } else if (u.pn == 4) {
            f32x4 g[2][2];
#pragma unroll
            for (int bj = 0; bj < 2; ++bj)
#pragma unroll
                for (int n = 0; n < 2; ++n) g[bj][n] = (m == 1) ? *(const f32x4*)(gk + 32 * bj + 16 * n + 4 * fq) : (f32x4){1.f, 1.f, 1.f, 1.f};
            const bool rope = lat && (m != 2);
            unsigned char* kbase = KF + (size_t)(b * NKV + wc) * KGRP * 1024 + (fq >> 1) * 128 + (fq & 1) * 8;
#pragma unroll
            for (int ai = 0; ai < 2; ++ai) if (ai < u.na)
#pragma unroll
                for (int mm = 0; mm < 4; ++mm) {
                    const int t = trow0 + ai * HALF + mm * 16;
                    const int kidx = lat ? (t & 2047) : (2048 + ((t - TLAT) & 255));
                    f32x4 x[2][2]; float ss = 0.f;
#pragma unroll
                    for (int bj = 0; bj < 2; ++bj)
#pragma unroll
                        for (int n = 0; n < 2; ++n) { x[bj][n] = acc[ai][bj][mm][n]; ss += (x[bj][n][0] * x[bj][n][0] + x[bj][n][1] * x[bj][n][1]) + (x[bj][n][2] * x[bj][n][2] + x[bj][n][3] * x[bj][n][3]); }
                    if (m == 1) { ss += __shfl_xor(ss, 16); ss += __shfl_xor(ss, 32); const float rs = 1.0f / sqrtf(ss * (1.f / HD) + NORM_EPS);
#pragma unroll
                        for (int bj = 0; bj < 2; ++bj)
#pragma unroll
                            for (int n = 0; n < 2; ++n) x[bj][n] = x[bj][n] * g[bj][n] * rs; }
                    if (rope) {
#pragma unroll
                        for (int bj = 0; bj < 2; ++bj) { const int pos = bj ? (kidx & 63) : (kidx >> 6); const f32x4* tp = (const f32x4*)(T + pos * 16 + 4 * fq);
                            const f32x4 t0 = tp[0], t1 = tp[1];
                            const f32x4 cs = (f32x4){t0[0], t0[2], t1[0], t1[2]}, sn = (f32x4){t0[1], t0[3], t1[1], t1[3]};
                            const f32x4 a = x[bj][0], c = x[bj][1];
                            x[bj][0] = a * cs - c * sn; x[bj][1] = c * cs + a * sn; }
                    }
                    unsigned char* kp = kbase + (size_t)(kidx >> 3) * 1024 + (kidx & 7) * 16;
#pragma unroll
                    for (int bj = 0; bj < 2; ++bj)
#pragma unroll
                        for (int n = 0; n < 2; ++n) { u32x2 w; w.x = cvt_pk_bf16(x[bj][n][0], x[bj][n][1]); w.y = cvt_pk_bf16(x[bj][n][2], x[bj][n][3]); *(u32x2*)(kp + (4 * bj + 2 * n) * 128) = w; }
                }
        } else {
            const int q4 = fr & 3;
            unsigned char* vbase = VF + (size_t)(b * NKV + wc) * KGRP * 1024 + (4 * fq + q4) * 16;
#pragma unroll
            for (int ai = 0; ai < 2; ++ai) if (ai < u.na)
#pragma unroll
                for (int mm = 0; mm < 4; ++mm) {
                    const int t = trow0 + ai * HALF + mm * 16;
                    const int kidx = lat ? (t & 2047) : (2048 + ((t - TLAT) & 255));
                    unsigned char* vp = vbase + (size_t)(kidx >> 3) * 1024 + (kidx & 4) * 2;
#pragma unroll
                    for (int bj = 0; bj < 2; ++bj)
#pragma unroll
                        for (int n = 0; n < 2; ++n) {
                            f32x4 x = acc[ai][bj][mm][n];
                            { const float s0 = (q4 & 1) ? x[0] : x[1], s1 = (q4 & 1) ? x[2] : x[3]; const float r0 = __shfl_xor(s0, 1), r1 = __shfl_xor(s1, 1);
                              if (q4 & 1) { x[0] = r0; x[2] = r1; } else { x[1] = r0; x[3] = r1; } }
                            { const float s0 = (q4 & 2) ? x[0] : x[2], s1 = (q4 & 2) ? x[1] : x[3]; const float r0 = __shfl_xor(s0, 2), r1 = __shfl_xor(s1, 2);
                              if (q4 & 2) { x[0] = r0; x[1] = r1; } else { x[2] = r0; x[3] = r1; } }
                            u32x2 w; w.x = cvt_pk_bf16(x[0], x[1]); w.y = cvt_pk_bf16(x[2], x[3]);
                            *(u32x2*)(vp + (32 * bj + 16 * n) * 16) = w; }
                }
        }
    }
};
DI float silu_mul(float g, float u) { return g * __builtin_amdgcn_rcpf(1.f + __builtin_amdgcn_exp2f(-g * LOG2E)) * u; }
struct EpiResidBf {
    static constexpr bool PERM = true;
    bf16_t* X; const float* gate;
    DI void operator()(const f32x4 (&acc)[2][2][4][2], const Unit& u, int wr, int wc, int fr, int fq) const {
        const int mb = (u.pm < TLAT / BM) ? (u.pm >> 3) : 16;
        const float* gt = gate + (size_t)mb * 6144;
        const int row0 = u.r0 + wr * 64 + fr, col0 = u.pn * BM + wc * 32 + 8 * fq;
        f32x4 g[2][2];
#pragma unroll
        for (int bj = 0; bj < 2; ++bj)
#pragma unroll
            for (int n = 0; n < 2; ++n) g[bj][n] = *(const f32x4*)(gt + col0 + bj * HALF + 4 * n);
        u32x4 old[2][4][2];
#pragma unroll
        for (int ai = 0; ai < 2; ++ai) if (ai < u.na)
#pragma unroll
            for (int m = 0; m < 4; ++m)
#pragma unroll
                for (int bj = 0; bj < 2; ++bj) old[ai][m][bj] = *(const u32x4*)(X + (size_t)(row0 + ai * HALF + m * 16) * DM + col0 + bj * HALF);
#pragma unroll
        for (int ai = 0; ai < 2; ++ai) if (ai < u.na) {
#pragma unroll
            for (int m = 0; m < 4; ++m)
#pragma unroll
                for (int bj = 0; bj < 2; ++bj) { const u32x4 o = old[ai][m][bj]; const f32x4 a0 = acc[ai][bj][m][0] * g[bj][0], a1 = acc[ai][bj][m][1] * g[bj][1];
                    u32x4 w; w.x = cvt_pk_bf16(bf2f(o.x & 0xffffu) + a0[0], bf2f(o.x >> 16) + a0[1]); w.y = cvt_pk_bf16(bf2f(o.y & 0xffffu) + a0[2], bf2f(o.y >> 16) + a0[3]);
                    w.z = cvt_pk_bf16(bf2f(o.z & 0xffffu) + a1[0], bf2f(o.z >> 16) + a1[1]); w.w = cvt_pk_bf16(bf2f(o.w & 0xffffu) + a1[2], bf2f(o.w >> 16) + a1[3]);
                    *(u32x4*)(X + (size_t)(row0 + ai * HALF + m * 16) * DM + col0 + bj * HALF) = w; }
        }
    }
};
struct EpiSwiglu {
    static constexpr bool PERM = true;
    bf16_t* ACT;
    DI void operator()(const f32x4 (&acc)[2][2][4][2], const Unit& u, int wr, int wc, int fr, int fq) const {
        const int row0 = u.r0 + wr * 64 + fr, col0 = u.pn * HALF + wc * 32 + 8 * fq;
#pragma unroll
        for (int ai = 0; ai < 2; ++ai) if (ai < u.na)
#pragma unroll
            for (int m = 0; m < 4; ++m) { bf16_t* rowp = ACT + (size_t)(row0 + ai * HALF + m * 16) * FH + col0;
                const f32x4 g0 = acc[ai][0][m][0], g1 = acc[ai][0][m][1], u0 = acc[ai][1][m][0], u1 = acc[ai][1][m][1];
                u32x4 w; w.x = cvt_pk_bf16(silu_mul(g0[0], u0[0]), silu_mul(g0[1], u0[1])); w.y = cvt_pk_bf16(silu_mul(g0[2], u0[2]), silu_mul(g0[3], u0[3]));
                w.z = cvt_pk_bf16(silu_mul(g1[0], u1[0]), silu_mul(g1[1], u1[1])); w.w = cvt_pk_bf16(silu_mul(g1[2], u1[2]), silu_mul(g1[3], u1[3]));
                *(u32x4*)rowp = w; }
    }
};
}

struct Params { const float* in[22]; float* out; unsigned char* ws; };
enum { IN_X = 0, IN_C, IN_CTX, IN_CCTX, IN_WADA, IN_BADA, IN_GATTN, IN_WQKV, IN_WO, IN_SINK, IN_GQ, IN_GK, IN_RPB, IN_GFFN, IN_WGROUP, IN_BGROUP, IN_WROUTER, IN_BROUTER, IN_WGATE, IN_WUP, IN_WDOWN, IN_GFINAL };

DI const float* inp(const Params& P, int i) { i = __builtin_amdgcn_readfirstlane(i); asm volatile("" : "+s"(i)); return P.in[i]; }
DI unsigned char* wsp(const Params& P) { unsigned z = 0; asm volatile("s_mov_b32 %0, 0" : "=s"(z)); return P.ws + z; }
struct Frame { LAS unsigned char* lds; int tid, lane, wave, blk, G, vcu, gw, NGW; };
DI Frame opaque_frame(const Frame& F0) { Frame F = F0; asm volatile("" : "+v"(F.tid), "+v"(F.lane)); asm volatile("" : "+s"(F.wave), "+s"(F.blk), "+s"(F.vcu), "+s"(F.gw)); return F; }

DI void p0_transpose_item(const float* W, int N, int k0, int n0, bf16_t* dst, int Kd, LAS float* scr, int lane) {
#pragma unroll 8
    for (int i = 0; i < 32; ++i) { const int kk = 2 * i + (lane >> 5); scr[kk * 33 + (lane & 31)] = W[(size_t)(k0 + kk) * N + n0 + (lane & 31)]; }
    LDS_WAIT();
    const int c = lane & 7;
#pragma unroll
    for (int j = 0; j < 4; ++j) { const int n = (lane >> 3) + 8 * j; const LAS float* s = scr + (8 * c) * 33 + n;
        u32x4 o; o.x = pk2(s[0 * 33], s[1 * 33]); o.y = pk2(s[2 * 33], s[3 * 33]); o.z = pk2(s[4 * 33], s[5 * 33]); o.w = pk2(s[6 * 33], s[7 * 33]);
        *(u32x4*)(dst + (size_t)n * Kd + 8 * c) = o; }
    LDS_WAIT();
}
DI double dsin_poly(double r) { const double r2 = r * r;
    return r * (1.0 - r2 * (1.0 / 6.0) * (1.0 - r2 * (1.0 / 20.0) * (1.0 - r2 * (1.0 / 42.0) * (1.0 - r2 * (1.0 / 72.0) * (1.0 - r2 * (1.0 / 110.0) * (1.0 - r2 * (1.0 / 156.0) * (1.0 - r2 * (1.0 / 210.0) * (1.0 - r2 * (1.0 / 272.0) * (1.0 - r2 * (1.0 / 342.0) * (1.0 - r2 * (1.0 / 420.0) * (1.0 - r2 * (1.0 / 506.0)))))))))))); }
DI double dcos_poly(double r) { const double r2 = r * r;
    return 1.0 - r2 * (1.0 / 2.0) * (1.0 - r2 * (1.0 / 12.0) * (1.0 - r2 * (1.0 / 30.0) * (1.0 - r2 * (1.0 / 56.0) * (1.0 - r2 * (1.0 / 90.0) * (1.0 - r2 * (1.0 / 132.0) * (1.0 - r2 * (1.0 / 182.0) * (1.0 - r2 * (1.0 / 240.0) * (1.0 - r2 * (1.0 / 306.0) * (1.0 - r2 * (1.0 / 380.0) * (1.0 - r2 * (1.0 / 462.0) * (1.0 - r2 * (1.0 / 552.0)))))))))))); }

constexpr int IT_MOD = DEPTH * 96 * 8;
constexpr int IT_QKV = (DM / 64) * (QKVN / 32), IT_WO = (DM / 64) * (DM / 32), IT_GU = NEXP * (DM / 64) * (FH / 32), IT_DN = NEXP * (FH / 64) * (DM / 32);
constexpr int IT_LAYER = IT_QKV + IT_WO + 2 * IT_GU + IT_DN;
constexpr int IT_TOTAL = IT_MOD + DEPTH * IT_LAYER;

DI void p0_prologue(const Params& P, const Frame& F) {
    LAS float* scr = (LAS float*)(F.lds + F.wave * 16384);
    unsigned char* ws = wsp(P);
    for (int it = F.gw; it < IT_TOTAL; it += F.NGW) {
        if (it < IT_MOD) {
            const int l = it / (96 * 8), rem = it % (96 * 8), cc = rem >> 3, ks = rem & 7;
            for (int idx = F.lane; idx < 17 * 128; idx += 64) { const int b = idx >> 7, k = idx & 127;
                const float cv = (b < 16) ? inp(P, IN_C)[b * DM + ks * 128 + k] : inp(P, IN_CCTX)[ks * 128 + k];
                scr[idx] = cv / (1.f + expf(-cv)); }
            LDS_WAIT();
            float acc[17];
#pragma unroll
            for (int b = 0; b < 17; ++b) acc[b] = 0.f;
            const float* wp = inp(P, IN_WADA) + ((size_t)l * DM + ks * 128) * 6144 + cc * 64 + F.lane;
#pragma unroll 4
            for (int k = 0; k < 128; ++k) { const float w = wp[(size_t)k * 6144];
#pragma unroll
                for (int b = 0; b < 17; ++b) acc[b] += scr[b * 128 + k] * w; }
            float* mp = (float*)(ws + WS_MODP) + ((size_t)(ks * DEPTH + l) * 17) * 6144 + cc * 64 + F.lane;
#pragma unroll
            for (int b = 0; b < 17; ++b) mp[(size_t)b * 6144] = acc[b];
            LDS_WAIT();
            continue;
        }
        int r = it - IT_MOD; const int l = r / IT_LAYER; r -= l * IT_LAYER;
        if (r < IT_QKV) { const int kb = r / (QKVN / 32), nb = r % (QKVN / 32); const int n0 = nb * 32;
            const int drow0 = 256 * (n0 >> 8) + 128 * ((n0 >> 5) & 1) + 32 * ((n0 >> 6) & 3);
            p0_transpose_item(inp(P, IN_WQKV) + (size_t)l * DM * QKVN, QKVN, kb * 64, n0, (bf16_t*)(ws + WS_WQKV) + (size_t)l * QKVN * DM + (size_t)drow0 * DM + kb * 64, DM, scr, F.lane); continue; }
        r -= IT_QKV;
        if (r < IT_WO) { const int kb = r / (DM / 32), nb = r % (DM / 32);
            p0_transpose_item(inp(P, IN_WO) + (size_t)l * DM * DM, DM, kb * 64, nb * 32, (bf16_t*)(ws + WS_WO) + (size_t)l * DM * DM + (size_t)(nb * 32) * DM + kb * 64, DM, scr, F.lane); continue; }
        r -= IT_WO;
        if (r < 2 * IT_GU) { const int which = r / IT_GU; r -= which * IT_GU; const int e = r / 256, kb = (r % 256) / 16, nb = r % 16; const int n0 = nb * 32;
            const int drow0 = 256 * (n0 >> 7) + 128 * which + (n0 & 127);
            p0_transpose_item(inp(P, which ? IN_WUP : IN_WGATE) + (size_t)(l * NEXP + e) * DM * FH, FH, kb * 64, n0,
                              (bf16_t*)(ws + WS_WGU) + (size_t)(l * NEXP + e) * DM * DM + (size_t)drow0 * DM + kb * 64, DM, scr, F.lane); continue; }
        r -= 2 * IT_GU;
        { const int e = r / 256, kb = (r % 256) / 32, nb = r % 32;
            p0_transpose_item(inp(P, IN_WDOWN) + (size_t)(l * NEXP + e) * FH * DM, DM, kb * 64, nb * 32,
                              (bf16_t*)(ws + WS_WD) + (size_t)(l * NEXP + e) * DM * FH + (size_t)(nb * 32) * FH + kb * 64, FH, scr, F.lane); }
    }
    if (F.gw == F.NGW - 1) {
        f32x2* T = (f32x2*)(ws + WS_ROPE);
        for (int idx = F.lane; idx < 64 * 16; idx += 64) { const int pos = idx >> 4, j = idx & 15;
            const float inv = exp2f(-(float)j * (1.f / 16.f) * 13.287712379549449f);
            const float ang = (float)pos * inv;
            const double a = (double)ang; const double rr = a - 6.283185307179586 * rint(a * 0.15915494309189535);
            T[idx] = (f32x2){(float)dcos_poly(rr), (float)dsin_poly(rr)}; }
    }
    { u32x4* wf = (u32x4*)(ws + WS_WRT); const float* wg = inp(P, IN_WGROUP); const float* wr = inp(P, IN_WROUTER);
      for (int idx = F.gw * 64 + F.lane; idx < DEPTH * 32 * 3 * 2 * 64; idx += F.NGW * 64) { const int l = idx / (32 * 3 * 2 * 64), rem = idx % (32 * 3 * 2 * 64), step = rem / 384, nt = (rem % 384) >> 7, which = (rem >> 6) & 1, ln = rem & 63;
          const int n = 16 * nt + (ln & 15); float w[8];
#pragma unroll
          for (int j = 0; j < 8; ++j) { const int k = 32 * step + 8 * (ln >> 4) + j;
              const float wv = (n < 4) ? wg[((size_t)l * DM + k) * 4 + n] : (n < 36 ? wr[((size_t)l * DM + k) * 32 + (n - 4)] : 0.f);
              const float w1 = bf2f(f2bf(wv)); w[j] = which ? (wv - w1) : wv; }
          u32x4 o; o.x = pk2(w[0], w[1]); o.y = pk2(w[2], w[3]); o.z = pk2(w[4], w[5]); o.w = pk2(w[6], w[7]); wf[idx] = o; } }
}
DI void p0b_mod_reduce(const Params& P, const Frame& F) {
    unsigned char* const ws = wsp(P);
    const float* mp = (const float*)(ws + WS_MODP); float* mod = (float*)(ws + WS_MOD);
    for (int idx = F.gw * 64 + F.lane; idx < DEPTH * 17 * 6144; idx += F.NGW * 64) {
        const int l = idx / (17 * 6144), c = idx % 6144;
        float s = inp(P, IN_BADA)[l * 6144 + c];
#pragma unroll
        for (int ks = 0; ks < 8; ++ks) s += mp[(size_t)ks * DEPTH * 17 * 6144 + idx];
        mod[idx] = s; }
}

DI unsigned expert_count(const unsigned char* ws, int layer, int e) { return __hip_atomic_load((const unsigned*)(ws + WS_CTL) + CW_CNT + (layer * NEXP + e) * CNT_STRIDE, __ATOMIC_RELAXED, __HIP_MEMORY_SCOPE_AGENT); }
DI unsigned expert_starts(const unsigned char* ws, int layer, int lane) {
    const unsigned p = (lane < NEXP) ? ((expert_count(ws, layer, lane & 31) + 255u) & ~255u) : 0u; unsigned incl = p;
#pragma unroll
    for (int d = 1; d < 32; d <<= 1) { const unsigned v = __shfl_up(incl, d); if ((lane & 31) >= d) incl += v; }
    return incl - p;
}

DI void load_row(const float* row, int lane, f32x4 (&v)[4]) {
#pragma unroll
    for (int j = 0; j < 4; ++j) v[j] = *(const f32x4*)(row + 4 * lane + 256 * j);
}
DI void load_row_bf(const bf16_t* row, int lane, f32x4 (&v)[4]) {
#pragma unroll
    for (int j = 0; j < 4; ++j) { const u32x2 w = *(const u32x2*)(row + 4 * lane + 256 * j); v[j] = (f32x4){bf2f(w.x & 0xffffu), bf2f(w.x >> 16), bf2f(w.y & 0xffffu), bf2f(w.y >> 16)}; }
}
DI float row_rstd(const f32x4 (&v)[4]) {
    float s = 0.f;
#pragma unroll
    for (int j = 0; j < 4; ++j) s += (v[j][0] * v[j][0] + v[j][1] * v[j][1]) + (v[j][2] * v[j][2] + v[j][3] * v[j][3]);
    return 1.0f / sqrtf(wave_sum(s) * (1.f / DM) + NORM_EPS);
}
DI void load_vec(const float* p, int lane, f32x4 (&v)[4]) {
#pragma unroll
    for (int j = 0; j < 4; ++j) v[j] = *(const f32x4*)(p + 4 * lane + 256 * j);
}
DI void norm_mod_store(const f32x4 (&v)[4], float rstd, const f32x4 (&gg)[4], const f32x4 (&sh)[4], const f32x4 (&sc)[4], bf16_t* hrow, int lane) {
#pragma unroll
    for (int j = 0; j < 4; ++j) { const int c = 4 * lane + 256 * j;
        const f32x4 hf = (v[j] * rstd * gg[j]) * (1.f + sc[j]) + sh[j];
        u32x2 w; w.x = pk2(hf[0], hf[1]); w.y = pk2(hf[2], hf[3]); *(u32x2*)(hrow + c) = w; }
}
struct RowIn { f32x4 x[4]; u32x2 ya[4], yb[4]; };
DI void row_fetch(const unsigned char* ws, const float* xrow, const bf16_t* xrow_bf, int t, unsigned s0, unsigned s1, int lane, bool prev, RowIn& R) {
    if (xrow_bf) load_row_bf(xrow_bf, lane, R.x); else load_row(xrow, lane, R.x);
    if (prev) {
        const bf16_t* Y = (const bf16_t*)(ws + WS_Y);
#pragma unroll
        for (int j = 0; j < 4; ++j) { R.ya[j] = *(const u32x2*)(Y + (size_t)s0 * DM + 4 * lane + 256 * j); R.yb[j] = *(const u32x2*)(Y + (size_t)s1 * DM + 4 * lane + 256 * j); } }
}
DI void row_apply(const f32x4 (&gt)[4], float w0, float w1, RowIn& R) {
#pragma unroll
    for (int j = 0; j < 4; ++j) { const f32x4 g = gt[j]; const u32x2 a = R.ya[j], b = R.yb[j];
        R.x[j][0] += g[0] * (w0 * bf2f(a.x & 0xffffu) + w1 * bf2f(b.x & 0xffffu)); R.x[j][1] += g[1] * (w0 * bf2f(a.x >> 16) + w1 * bf2f(b.x >> 16));
        R.x[j][2] += g[2] * (w0 * bf2f(a.y & 0xffffu) + w1 * bf2f(b.y & 0xffffu)); R.x[j][3] += g[3] * (w0 * bf2f(a.y >> 16) + w1 * bf2f(b.y >> 16)); }
}
DI void phase_attn_norm(const Params& P, const Frame& F0, int layer) {
    const Frame F = opaque_frame(F0);
    unsigned char* const ws = wsp(P);
    bf16_t* X = (bf16_t*)(ws + WS_X); bf16_t* H = (bf16_t*)(ws + WS_H);
    const bool prev = layer > 0;
    const int nrow = (TALL - F.gw + F.NGW - 1) / F.NGW;
    unsigned ms0 = 0, ms1 = 0; float mw0 = 0.f, mw1 = 0.f;
    if (prev) { const unsigned pst = expert_starts(ws, layer - 1, F.lane); u32x2 a = (u32x2){0u, 0u};
        if (F.lane < nrow) { const int tl = F.gw + F.lane * F.NGW; a = *(const u32x2*)((const unsigned*)(ws + WS_ASG) + (size_t)tl * 2); const f32x2 w = *(const f32x2*)((const float*)(ws + WS_ASGW) + (size_t)tl * 2); mw0 = w.x; mw1 = w.y; }
        ms0 = (unsigned)__shfl((int)pst, (int)(a.x >> 20)) + (a.x & 0xfffffu); ms1 = (unsigned)__shfl((int)pst, (int)(a.y >> 20)) + (a.y & 0xfffffu); }
    auto xsrc = [&](int t) -> const float* { return (t < TLAT ? inp(P, IN_X) + (size_t)t * DM : inp(P, IN_CTX) + (size_t)(t - TLAT) * DM); };
    auto xbf = [&](int t) -> const bf16_t* { return prev ? X + (size_t)t * DM : (const bf16_t*)nullptr; };
    RowIn cur, nxt;
    f32x4 gat[4]; load_vec(inp(P, IN_GATTN) + layer * DM, F.lane, gat);
    row_fetch(ws, xsrc(F.gw), xbf(F.gw), F.gw, __shfl(ms0, 0), __shfl(ms1, 0), F.lane, prev, cur);
    for (int i = 0; i < nrow; ++i) {
        const int t = F.gw + i * F.NGW; const int mb = (t < TLAT) ? (t >> 11) : 16;
        const float* md = (const float*)(ws + WS_MOD) + ((size_t)layer * 17 + mb) * 6144;
        f32x4 gt[4], sh[4], sc[4];
        if (prev) load_vec(md - 17 * 6144 + 5120, F.lane, gt);
        load_vec(md, F.lane, sh); load_vec(md + 1024, F.lane, sc);
        asm volatile("" ::: "memory");
        if (i + 1 < nrow) row_fetch(ws, xsrc(t + F.NGW), xbf(t + F.NGW), t + F.NGW, __shfl(ms0, i + 1), __shfl(ms1, i + 1), F.lane, prev, nxt);
        if (prev) row_apply(gt, __shfl(mw0, i), __shfl(mw1, i), cur);
#pragma unroll
        for (int j = 0; j < 4; ++j) { u32x2 w; w.x = pk2(cur.x[j][0], cur.x[j][1]); w.y = pk2(cur.x[j][2], cur.x[j][3]); *(u32x2*)(X + (size_t)t * DM + 4 * F.lane + 256 * j) = w; }
        const float rstd = row_rstd(cur.x);
        norm_mod_store(cur.x, rstd, gat, sh, sc, H + (size_t)t * DM, F.lane);
        cur = nxt;
    }
}
DI void phase_final(const Params& P, const Frame& F0) {
    const Frame F = opaque_frame(F0);
    unsigned char* const ws = wsp(P);
    const bf16_t* X = (const bf16_t*)(ws + WS_X);
    const float pc = PROBE_SEL ? *((const float*)(ws + WS_CTL) + 64) : 0.f;
    const int nrow = (TLAT - F.gw + F.NGW - 1) / F.NGW;
    unsigned ms0 = 0, ms1 = 0; float mw0 = 0.f, mw1 = 0.f;
    { const unsigned pst = expert_starts(ws, DEPTH - 1, F.lane); u32x2 a = (u32x2){0u, 0u};
      if (F.lane < nrow) { const int tl = F.gw + F.lane * F.NGW; a = *(const u32x2*)((const unsigned*)(ws + WS_ASG) + (size_t)tl * 2); const f32x2 w = *(const f32x2*)((const float*)(ws + WS_ASGW) + (size_t)tl * 2); mw0 = w.x; mw1 = w.y; }
      ms0 = (unsigned)__shfl((int)pst, (int)(a.x >> 20)) + (a.x & 0xfffffu); ms1 = (unsigned)__shfl((int)pst, (int)(a.y >> 20)) + (a.y & 0xfffffu); }
    RowIn cur, nxt;
    row_fetch(ws, nullptr, X + (size_t)F.gw * DM, F.gw, __shfl(ms0, 0), __shfl(ms1, 0), F.lane, true, cur);
    f32x4 gfin[4]; load_vec(inp(P, IN_GFINAL), F.lane, gfin);
    for (int i = 0; i < nrow; ++i) {
        const int t = F.gw + i * F.NGW;
        f32x4 gt[4]; load_vec((const float*)(ws + WS_MOD) + ((size_t)(DEPTH - 1) * 17 + (t >> 11)) * 6144 + 5120, F.lane, gt);
        asm volatile("" ::: "memory");
        if (i + 1 < nrow) row_fetch(ws, nullptr, X + (size_t)(t + F.NGW) * DM, t + F.NGW, __shfl(ms0, i + 1), __shfl(ms1, i + 1), F.lane, true, nxt);
        row_apply(gt, __shfl(mw0, i), __shfl(mw1, i), cur);
        const float rstd = row_rstd(cur.x);
#pragma unroll
        for (int j = 0; j < 4; ++j) { const int c = 4 * F.lane + 256 * j; *(f32x4*)(P.out + (size_t)t * DM + c) = cur.x[j] * rstd * gfin[j] + pc; }
        cur = nxt;
    }
}

DI float swap_max(float v) { auto rr = __builtin_amdgcn_permlane32_swap(__float_as_uint(v), __float_as_uint(v), false, false); return fmaxf(__uint_as_float(rr[0]), __uint_as_float(rr[1])); }
DI float swap_add(float v) { auto rr = __builtin_amdgcn_permlane32_swap(__float_as_uint(v), __float_as_uint(v), false, false); return __uint_as_float(rr[0]) + __uint_as_float(rr[1]); }
DI bf16x8 pack_p(const f32x16& p, int s) {
    u32x4 w; w.x = cvt_pk_bf16(p[8 * s + 0], p[8 * s + 1]); w.y = cvt_pk_bf16(p[8 * s + 2], p[8 * s + 3]); w.z = cvt_pk_bf16(p[8 * s + 4], p[8 * s + 5]); w.w = cvt_pk_bf16(p[8 * s + 6], p[8 * s + 7]);
    return __builtin_bit_cast(bf16x8, w);
}
struct AttnState { float m, l; f32x16 o[2]; };
DI void load_k(const unsigned char* Kbh, int kg, int r32, int hi, bf16x8 (&k)[4]) {
    const unsigned char* kb = Kbh + (size_t)(kg + (r32 >> 3)) * 1024 + hi * 128 + (r32 & 7) * 16;
#pragma unroll
    for (int d0 = 0; d0 < 4; ++d0) k[d0] = *(const bf16x8*)(kb + d0 * 256);
}
DI void load_v(const unsigned char* Vbh, int kg, int r32, int hi, s16x4 (&v)[2][2][2]) {
    const unsigned char* vb = Vbh + (size_t)kg * 1024 + r32 * 16 + hi * 8;
#pragma unroll
    for (int dh = 0; dh < 2; ++dh)
#pragma unroll
        for (int ks = 0; ks < 2; ++ks)
#pragma unroll
            for (int pt = 0; pt < 2; ++pt) v[dh][ks][pt] = *(const s16x4*)(vb + dh * 512 + (2 * ks + pt) * 1024);
}
DI f32x16 attn_scores(const bf16x8 (&k)[4], const bf16x8 (&q)[4]) {
    f32x16 s;
#pragma unroll
    for (int r = 0; r < 16; ++r) s[r] = 0.f;
#pragma unroll
    for (int d0 = 0; d0 < 4; ++d0) s = __builtin_amdgcn_mfma_f32_32x32x16_bf16(k[d0], q[d0], s, 0, 0, 0);
    return s;
}
DI float row_max16(const f32x16& s) {
    float mt = fmaxf(fmaxf(s[0], s[1]), fmaxf(s[2], s[3]));
#pragma unroll
    for (int r = 4; r < 16; r += 4) mt = fmaxf(mt, fmaxf(fmaxf(s[r], s[r + 1]), fmaxf(s[r + 2], s[r + 3])));
    return mt;
}
DI void attn_rescale(AttnState& st, f32x16& s, float mt, LAS float* wsf, int r32, int hi) {
    mt = swap_max(mt);
    const float dm = fmaxf(mt, 0.f);
    const float al = __builtin_amdgcn_exp2f(-dm);
    st.l *= al; st.m += dm;
#pragma unroll
    for (int r = 0; r < 16; ++r) s[r] -= dm;
    if (hi == 0) wsf[r32] = al;
    LDS_WAIT();
#pragma unroll
    for (int r = 0; r < 16; ++r) { const float f = wsf[crow(r, hi)]; st.o[0][r] *= f; st.o[1][r] *= f; }
    LDS_WAIT();
}
DI void attn_exp_pv(AttnState& st, f32x16& s, const s16x4 (&v)[2][2][2]) {
    float p0 = 0.f, p1 = 0.f;
#pragma unroll
    for (int r = 0; r < 16; r += 2) { s[r] = __builtin_amdgcn_exp2f(s[r]); s[r + 1] = __builtin_amdgcn_exp2f(s[r + 1]); p0 += s[r]; p1 += s[r + 1]; }
    st.l += p0 + p1;
    const bf16x8 pa0 = pack_p(s, 0), pa1 = pack_p(s, 1);
#pragma unroll
    for (int dh = 0; dh < 2; ++dh) {
        const bf16x8 vf0 = __builtin_shufflevector(v[dh][0][0], v[dh][0][1], 0, 1, 2, 3, 4, 5, 6, 7);
        const bf16x8 vf1 = __builtin_shufflevector(v[dh][1][0], v[dh][1][1], 0, 1, 2, 3, 4, 5, 6, 7);
        st.o[dh] = __builtin_amdgcn_mfma_f32_32x32x16_bf16(pa0, vf0, st.o[dh], 0, 0, 0);
        st.o[dh] = __builtin_amdgcn_mfma_f32_32x32x16_bf16(pa1, vf1, st.o[dh], 0, 0, 0);
    }
}
DI void attn_softmax_pv2(AttnState (&st)[2], f32x16 (&s)[2], const s16x4 (&v)[2][2][2], LAS float* wsf, int r32, int hi) {
#pragma unroll
    for (int r = 0; r < 16; ++r) { s[0][r] -= st[0].m; s[1][r] -= st[1].m; }
    const float mt0 = row_max16(s[0]), mt1 = row_max16(s[1]);
    if (__any(fmaxf(mt0, mt1) > 8.f)) { attn_rescale(st[0], s[0], mt0, wsf, r32, hi); attn_rescale(st[1], s[1], mt1, wsf + 32, r32, hi); }
    attn_exp_pv(st[0], s[0], v);
    attn_exp_pv(st[1], s[1], v);
}
template <int MODE>
DI void attn_unit(const Params& P, unsigned char* ws, int layer, int b, int h0, int qblk, LAS unsigned char* wl, int lane) {
    const int r32 = lane & 31, hi = lane >> 5, kvh = h0 >> 2, m = layer % 3;
    constexpr bool VDB = false;
    LAS float* wsf = (LAS float*)wl; LAS bf16_t* stg = (LAS bf16_t*)(wl + 256); LAS float* rpbt = (LAS float*)(wl + 256 + 4096);
    const bf16_t* QKV = (const bf16_t*)(ws + WS_QKV);
    const unsigned char* Kbh = ws + WS_KF + (size_t)(b * NKV + kvh) * KGRP * 1024;
    const unsigned char* Vbh = ws + WS_VF + (size_t)(b * NKV + kvh) * KGRP * 1024;
    bf16_t* O = (bf16_t*)(ws + WS_O);
    int r0 = 0, c0 = 0;
    if (MODE == 2) { r0 = 2 * (qblk >> 2); c0 = 16 * (qblk & 3); }
    auto qtok = [&](int i) -> int {
        if (MODE == 3) return TLAT + b * CTXL + qblk * 32 + i;
        if (MODE == 2) return b * SEQ + (r0 + (i >> 4)) * 64 + c0 + (i & 15);
        return b * SEQ + qblk * 32 + i; };
    const int tq = qtok(r32);
    const bf16_t* qp = QKV + (size_t)tq * QKVN + h0 * HD + hi * 8;
    bf16x8 qr[2][4];
#pragma unroll
    for (int hh = 0; hh < 2; ++hh)
#pragma unroll
        for (int d0 = 0; d0 < 4; ++d0) qr[hh][d0] = *(const bf16x8*)(qp + hh * HD + d0 * 16);
    const int q0 = qblk * 32;
    int nl = 0, jlo = 0, rs_min = 0, cseg = 0;
    if (MODE == 0) { jlo = (q0 < 128) ? (128 - q0) / 32 : 0; const int jhi = min(8, (SEQ - 32 - q0 + 128) / 32); nl = jhi - jlo + 1; }
    if (MODE == 1) nl = SEQ / 32;
    if (MODE == 2) { rs_min = min(max(r0 - 4, 0), 24); const int rs_max = min(max(r0 + 1 - 4, 0), 24); nl = rs_max - rs_min + 8; cseg = (c0 == 0) ? 0 : (c0 == 16) ? 8 : (c0 == 32) ? 24 : 32; }
    auto lat_kg = [&](int i) -> int {
        if (MODE == 0) return (q0 - 128 + 32 * (jlo + i)) >> 3;
        if (MODE == 1) return 4 * i;
        return ((rs_min + i) * 64 + cseg) >> 3; };
    bf16x8 kn[4];
    load_k(Kbh, nl > 0 ? lat_kg(0) : SEQ / 8, r32, hi, kn);
    if (MODE == 0 || MODE == 1) {
        const int n = tq & 2047; const f32x2* T = (const f32x2*)(ws + WS_ROPE);
        const f32x2* tr = T + (n >> 6) * 16 + 8 * hi; const f32x2* tc = T + (n & 63) * 16 + 8 * hi;
#pragma unroll
        for (int e = 0; e < 8; ++e) { const f32x2 a = tr[e], cc = tc[e];
#pragma unroll
            for (int hh = 0; hh < 2; ++hh) {
                const float x1 = bfs2f(qr[hh][0][e]), x2 = bfs2f(qr[hh][1][e]), x3 = bfs2f(qr[hh][2][e]), x4 = bfs2f(qr[hh][3][e]);
                qr[hh][0][e] = (short)f2bf(x1 * a.x - x2 * a.y); qr[hh][1][e] = (short)f2bf(x2 * a.x + x1 * a.y);
                qr[hh][2][e] = (short)f2bf(x3 * cc.x - x4 * cc.y); qr[hh][3][e] = (short)f2bf(x4 * cc.x + x3 * cc.y); } }
    }
    LAS bf16x8* qlds = (LAS bf16x8*)(wl + 8192) + lane;
    if (VDB) {
#pragma unroll
        for (int d0 = 0; d0 < 4; ++d0) qlds[d0 * 64] = qr[1][d0];
        LDS_WAIT();
    }
    int rq = 0, cq = 0, rsq = 0, csq = 0;
    if (MODE == 2) {
        const float* rpb = inp(P, IN_RPB) + (size_t)h0 * 465;
        for (int i = lane; i < 930; i += 64) rpbt[i + (i >= 465 ? 7 : 0)] = rpb[i] * LOG2E;
        LDS_WAIT();
        rq = r0 + (r32 >> 4); cq = c0 + (r32 & 15); rsq = min(max(rq - 4, 0), 24); csq = min(max(cq - 8, 0), 48);
    }
    AttnState st[2];
#pragma unroll
    for (int hh = 0; hh < 2; ++hh) { st[hh].m = -1024.f; st[hh].l = 0.f;
#pragma unroll
        for (int r = 0; r < 16; ++r) { st[hh].o[0][r] = 0.f; st[hh].o[1][r] = 0.f; } }
    const float NEG = -INFINITY;
    s16x4 vn[2][2][2];
    if (VDB) load_v(Vbh, nl > 0 ? lat_kg(0) : SEQ / 8, r32, hi, vn);
    for (int i = 0; i < nl; ++i) {
        const int kgn = (i + 1 < nl) ? lat_kg(i + 1) : SEQ / 8;
        s16x4 v[2][2][2];
        if (VDB) {
#pragma unroll
            for (int a = 0; a < 2; ++a)
#pragma unroll
                for (int c = 0; c < 2; ++c)
#pragma unroll
                    for (int e = 0; e < 2; ++e) v[a][c][e] = vn[a][c][e];
        } else load_v(Vbh, lat_kg(i), r32, hi, v);
        f32x16 s[2];
        s[0] = attn_scores(kn, qr[0]);
        if (VDB) { bf16x8 q1[4];
#pragma unroll
            for (int d0 = 0; d0 < 4; ++d0) q1[d0] = qlds[d0 * 64];
            s[1] = attn_scores(kn, q1); }
        else s[1] = attn_scores(kn, qr[1]);
        load_k(Kbh, kgn, r32, hi, kn);
        if (VDB) load_v(Vbh, kgn, r32, hi, vn);
        if (MODE == 0) {
            const int j = jlo + i;
            if (j == 0 || j == 8) { const int kt = q0 - 128 + 32 * j, qpos = q0 + r32;
#pragma unroll
                for (int r = 0; r < 16; ++r) { const int d = kt + crow(r, hi) - qpos; if (d > 128 || d < -128) { s[0][r] = NEG; s[1][r] = NEG; } } }
        }
        if (MODE == 2) {
            const int kr = rs_min + i;
            const bool rowok = (kr >= rsq) && (kr < rsq + 8);
            const int ib = (kr - rq + 7) * 31 - cq + 15;
#pragma unroll
            for (int r = 0; r < 16; ++r) { const int kc2 = cseg + crow(r, hi); const bool ok = rowok && (kc2 >= csq) && (kc2 < csq + 16);
                const int idx = min(max(ib + kc2, 0), 464);
                s[0][r] = ok ? s[0][r] + rpbt[idx] : NEG; s[1][r] = ok ? s[1][r] + rpbt[472 + idx] : NEG; }
        }
        attn_softmax_pv2(st, s, v, wsf, r32, hi);
    }
    if (MODE == 0 || MODE == 1) {
#pragma unroll
        for (int hh = 0; hh < 2; ++hh)
#pragma unroll
            for (int d0 = 0; d0 < 4; ++d0) qr[hh][d0] = *(const bf16x8*)(qp + hh * HD + d0 * 16);
        if (VDB) {
#pragma unroll
            for (int d0 = 0; d0 < 4; ++d0) qlds[d0 * 64] = qr[1][d0];
            LDS_WAIT();
        }
    }
    for (int j = 0; j < CTXL / 32; ++j) {
        const int kg = SEQ / 8 + 4 * j, kgn = (j + 1 < CTXL / 32) ? kg + 4 : kg;
        s16x4 v[2][2][2];
        if (VDB) {
#pragma unroll
            for (int a = 0; a < 2; ++a)
#pragma unroll
                for (int c = 0; c < 2; ++c)
#pragma unroll
                    for (int e = 0; e < 2; ++e) v[a][c][e] = vn[a][c][e];
        } else load_v(Vbh, kg, r32, hi, v);
        f32x16 s[2];
        s[0] = attn_scores(kn, qr[0]);
        if (VDB) { bf16x8 q1[4];
#pragma unroll
            for (int d0 = 0; d0 < 4; ++d0) q1[d0] = qlds[d0 * 64];
            s[1] = attn_scores(kn, q1); }
        else s[1] = attn_scores(kn, qr[1]);
        load_k(Kbh, kgn, r32, hi, kn);
        if (VDB) load_v(Vbh, kgn, r32, hi, vn);
        attn_softmax_pv2(st, s, v, wsf, r32, hi);
    }
    int lane2 = lane; asm volatile("" : "+v"(lane2));
    const int r32b = lane2 & 31, hib = lane2 >> 5;
#pragma unroll
    for (int hh = 0; hh < 2; ++hh) {
        const float lt = swap_add(st[hh].l);
        float inv;
        if (MODE == 0 || (MODE == 3 && m == 0)) { const float sk = inp(P, IN_SINK)[(layer / 3) * NH + h0 + hh] * LOG2E;
            const float mnew = fmaxf(st[hh].m, sk); const float al = __builtin_amdgcn_exp2f(st[hh].m - mnew), es = __builtin_amdgcn_exp2f(sk - mnew);
            inv = al / (lt * al + es); }
        else inv = 1.f / lt;
        if (hib == 0) wsf[r32b] = inv;
        LDS_WAIT();
        LAS bf16_t* sb = stg + hib * 256 + r32b;
        const LAS float* wf = wsf + 4 * hib;
#pragma unroll
        for (int r = 0; r < 16; ++r) { const float f = wf[(r & 3) + 8 * (r >> 2)];
            sb[((r & 3) + 8 * (r >> 2)) * 64] = (bf16_t)f2bf(st[hh].o[0][r] * f); sb[((r & 3) + 8 * (r >> 2)) * 64 + 32] = (bf16_t)f2bf(st[hh].o[1][r] * f); }
        LDS_WAIT();
        const int rw = lane2 >> 3, ch = lane2 & 7;
        const LAS unsigned char* rb = (const LAS unsigned char*)stg + rw * 128 + ch * 16;
#pragma unroll
        for (int i = 0; i < 4; ++i) { const u32x4 vv = *(const LAS u32x4*)(rb + i * 1024);
            *(u32x4*)(O + (size_t)qtok(i * 8 + rw) * DM + (h0 + hh) * HD + ch * 8) = vv; }
        LDS_WAIT();
    }
}
DI void phase_attention(const Params& P, const Frame& F0, int layer) {
    const Frame F = opaque_frame(F0);
    unsigned char* const ws = wsp(P);
    const int m = layer % 3;
    LAS unsigned char* wl = F.lds + F.wave * 16384;
    for (int bu = F.blk; bu < NB * NKV * 16; bu += F.G) {
        const int rnd = bu >> 8, x = bu & 7, loc = (bu & 255) >> 3;
        const int bkv = rnd * 16 + x * 2 + (loc >> 4), qg = loc & 15;
        const int b = bkv >> 2, kvh = bkv & 3, h0 = kvh * 4 + 2 * (F.wave & 1), qblk = 4 * qg + (F.wave >> 1);
        if (m == 0) attn_unit<0>(P, ws, layer, b, h0, qblk, wl, F.lane);
        else if (m == 1) attn_unit<1>(P, ws, layer, b, h0, qblk, wl, F.lane);
        else attn_unit<2>(P, ws, layer, b, h0, qblk, wl, F.lane);
    }
    if (layer < DEPTH - 1) {
        for (int bu = F.blk; bu < NB * NKV * 2; bu += F.G) {
            const int bkv = bu >> 1, b = bkv >> 2, kvh = bkv & 3, h0 = kvh * 4 + 2 * (F.wave & 1), qblk = 4 * (bu & 1) + (F.wave >> 1);
            attn_unit<3>(P, ws, layer, b, h0, qblk, wl, F.lane);
        }
    }
}

DI int blk_token(int blk, int i) { return i < 128 ? blk * 128 + i : TLAT + blk * 16 + (i - 128); }
constexpr int RT_ROWB = 2064;
constexpr int RT_X2_OFF = 16 * RT_ROWB, RT_PART_OFF = 2 * 16 * RT_ROWB, RT_LOG_OFF = RT_PART_OFF + 8 * 16 * 48 * 4, RT_LOGS = 37, RT_VEC_OFF = RT_LOG_OFF + 144 * RT_LOGS * 4;
DI void phase_router(const Params& P, const Frame& F0, int layer, int M) {
    const Frame F = opaque_frame(F0);
    unsigned char* const ws = wsp(P);
    const int TPB = M / GRID, nchunk = TPB / 16;
    LAS int* hist = (LAS int*)(F.lds + LDSX_OFF);
    LAS float* part = (LAS float*)(F.lds + RT_PART_OFF); LAS float* logit = (LAS float*)(F.lds + RT_LOG_OFF);
    if (F.tid < 32) hist[F.tid] = 0;
    const bf16_t* X = (const bf16_t*)(ws + WS_X); bf16_t* H = (bf16_t*)(ws + WS_H);
    const float* gffn = inp(P, IN_GFFN) + layer * DM;
    const u32x4* wf = (const u32x4*)(ws + WS_WRT) + ((size_t)layer * 32 + 4 * F.wave) * 384 + F.lane;
    bf16x8 wreg[4][2][2];
#pragma unroll
    for (int s = 0; s < 4; ++s)
#pragma unroll
        for (int nt = 0; nt < 2; ++nt)
#pragma unroll
            for (int wh = 0; wh < 2; ++wh) wreg[s][nt][wh] = __builtin_bit_cast(bf16x8, wf[s * 384 + nt * 128 + wh * 64]);
    bf16x8 w2t[4][2];
#pragma unroll
    for (int s = 0; s < 4; ++s)
#pragma unroll
        for (int wh = 0; wh < 2; ++wh) w2t[s][wh] = __builtin_bit_cast(bf16x8, wf[s * 384 + 256 + wh * 64]);
    LAS float* vec = (LAS float*)(F.lds + RT_VEC_OFF);
    auto load_vecs = [&](int mb) {
        const float* md = (const float*)(ws + WS_MOD) + ((size_t)layer * 17 + mb) * 6144;
        for (int i = F.tid; i < 256; i += NTHREADS) { const f32x4 g = *(const f32x4*)(gffn + 4 * i), sc = *(const f32x4*)(md + 4096 + 4 * i);
            *(LAS f32x4*)(vec + 4 * i) = *(const f32x4*)(md + 2048 + 4 * i); *(LAS f32x4*)(vec + 1024 + 4 * i) = g * (1.f + sc); *(LAS f32x4*)(vec + 2048 + 4 * i) = *(const f32x4*)(md + 3072 + 4 * i); } };
    load_vecs(F.blk >> 4);
    const int ib = 2 * F.wave;
    f32x4 vn[2][4];
#pragma unroll
    for (int tk = 0; tk < 2; ++tk) { const int t = blk_token(F.blk, ib + tk); load_row_bf(X + (size_t)t * DM, F.lane, vn[tk]); }
    LDS_WAIT(); __syncthreads();
    for (int c = 0; c < nchunk; ++c) {
        if (c == 8) { load_vecs(16); LDS_WAIT(); __syncthreads(); }
#pragma unroll
        for (int tk = 0; tk < 2; ++tk) { const int t = blk_token(F.blk, c * 16 + ib + tk);
            const float rstd = row_rstd(vn[tk]);
            LAS unsigned char* r1 = F.lds + (ib + tk) * RT_ROWB + 8 * F.lane; bf16_t* hrow = H + (size_t)t * DM;
#pragma unroll
            for (int j = 0; j < 4; ++j) { const int cc = 4 * F.lane + 256 * j; const f32x4 ga = *(const LAS f32x4*)(vec + 1024 + cc), sh = *(const LAS f32x4*)(vec + 2048 + cc);
                const f32x4 hf = (vn[tk][j] * rstd) * ga + sh;
                u32x2 a; a.x = pk2(hf[0], hf[1]); a.y = pk2(hf[2], hf[3]);
                u32x2 b; b.x = pk2(hf[0] - bf2f(a.x & 0xffffu), hf[1] - bf2f(a.x >> 16)); b.y = pk2(hf[2] - bf2f(a.y & 0xffffu), hf[3] - bf2f(a.y >> 16));
                *(u32x2*)(hrow + cc) = a; *(LAS u32x2*)(r1 + 512 * j) = a; *(LAS u32x2*)(r1 + RT_X2_OFF + 512 * j) = b; } }
        if (c + 1 < nchunk) {
#pragma unroll
            for (int tk = 0; tk < 2; ++tk) { const int t = blk_token(F.blk, (c + 1) * 16 + ib + tk); load_row_bf(X + (size_t)t * DM, F.lane, vn[tk]); }
        }
        LDS_WAIT(); __syncthreads();
        f32x4 acc[3];
#pragma unroll
        for (int nt = 0; nt < 3; ++nt) acc[nt] = (f32x4){0.f, 0.f, 0.f, 0.f};
        { const LAS unsigned char* ap = F.lds + (F.lane & 15) * RT_ROWB + 256 * F.wave + 16 * (F.lane >> 4);
#pragma unroll
          for (int s = 0; s < 4; ++s) { const bf16x8 a1 = *(const LAS bf16x8*)(ap + 64 * s), a2 = *(const LAS bf16x8*)(ap + RT_X2_OFF + 64 * s);
#pragma unroll
              for (int nt = 0; nt < 2; ++nt) { acc[nt] = __builtin_amdgcn_mfma_f32_16x16x32_bf16(a1, wreg[s][nt][0], acc[nt], 0, 0, 0);
                  acc[nt] = __builtin_amdgcn_mfma_f32_16x16x32_bf16(a1, wreg[s][nt][1], acc[nt], 0, 0, 0); acc[nt] = __builtin_amdgcn_mfma_f32_16x16x32_bf16(a2, wreg[s][nt][0], acc[nt], 0, 0, 0); }
              acc[2] = __builtin_amdgcn_mfma_f32_16x16x32_bf16(a1, w2t[s][0], acc[2], 0, 0, 0);
              acc[2] = __builtin_amdgcn_mfma_f32_16x16x32_bf16(a1, w2t[s][1], acc[2], 0, 0, 0); acc[2] = __builtin_amdgcn_mfma_f32_16x16x32_bf16(a2, w2t[s][0], acc[2], 0, 0, 0); } }
        { LAS float* pp = part + F.wave * 768 + (4 * (F.lane >> 4)) * 48 + (F.lane & 15);
#pragma unroll
          for (int nt = 0; nt < 3; ++nt)
#pragma unroll
              for (int r = 0; r < 4; ++r) pp[r * 48 + 16 * nt] = acc[nt][r]; }
        LDS_WAIT(); __syncthreads();
        { const int tk = F.tid >> 5, n = F.tid & 31; float s = 0.f;
#pragma unroll
          for (int w = 0; w < 8; ++w) s += part[w * 768 + tk * 48 + n];
          logit[(c * 16 + tk) * RT_LOGS + n] = s;
          if (F.tid < 64) { const int tk2 = F.tid >> 2, n2 = 32 + (F.tid & 3); float s2 = 0.f;
#pragma unroll
              for (int w = 0; w < 8; ++w) s2 += part[w * 768 + tk2 * 48 + n2];
              logit[(c * 16 + tk2) * RT_LOGS + n2] = s2; } }
    }
    LDS_WAIT(); __syncthreads();
    int rt_t = 0, rt_e1 = 0, rt_e2 = 0, rt_q1 = 0, rt_q2 = 0; float rt_w1 = 0.f, rt_w2 = 0.f;
    if (F.tid < TPB) { const int t = blk_token(F.blk, F.tid); const LAS float* lg = logit + F.tid * RT_LOGS;
        const float* bg = inp(P, IN_BGROUP) + layer * 4; const float* br = inp(P, IN_BROUTER) + layer * 32;
        const float g0 = lg[0] + bg[0], g1 = lg[1] + bg[1], g2 = lg[2] + bg[2], g3 = lg[3] + bg[3];
        int grp = 0; float gm = g0; if (g1 > gm) { gm = g1; grp = 1; } if (g2 > gm) { gm = g2; grp = 2; } if (g3 > gm) { gm = g3; grp = 3; }
        const float ptop = 1.f / (expf(g0 - gm) + expf(g1 - gm) + expf(g2 - gm) + expf(g3 - gm));
        float ev[8], em = -INFINITY;
#pragma unroll
        for (int j = 0; j < 8; ++j) { ev[j] = lg[4 + grp * 8 + j] + br[grp * 8 + j]; em = fmaxf(em, ev[j]); }
        float pe[8];
#pragma unroll
        for (int j = 0; j < 8; ++j) pe[j] = expf(ev[j] - em);
        int i1 = 0; float p1 = pe[0];
#pragma unroll
        for (int j = 1; j < 8; ++j) if (pe[j] > p1) { p1 = pe[j]; i1 = j; }
        int i2 = 0; float p2 = -1.f;
#pragma unroll
        for (int j = 0; j < 8; ++j) if (j != i1 && pe[j] > p2) { p2 = pe[j]; i2 = j; }
        const float w1 = ptop * p1 / (p1 + p2), w2 = ptop * p2 / (p1 + p2);
        const int e1 = grp * 8 + i1, e2 = grp * 8 + i2;
        rt_q1 = atomicAdd((int*)&hist[e1], 1); rt_q2 = atomicAdd((int*)&hist[e2], 1);
        rt_t = t; rt_e1 = e1; rt_e2 = e2; rt_w1 = w1; rt_w2 = w2; }
    __syncthreads();
    LAS unsigned* gbase = (LAS unsigned*)(hist + 32);
    if (F.tid < 32) gbase[F.tid] = __hip_atomic_fetch_add((unsigned*)(ws + WS_CTL) + CW_CNT + (layer * NEXP + F.tid) * CNT_STRIDE, (unsigned)hist[F.tid], __ATOMIC_RELAXED, __HIP_MEMORY_SCOPE_AGENT);
    LDS_WAIT(); __syncthreads();
    if (F.tid < TPB) { const unsigned i1 = gbase[rt_e1] + (unsigned)rt_q1, i2 = gbase[rt_e2] + (unsigned)rt_q2;
        unsigned* asg = (unsigned*)(ws + WS_ASG); float* asgw = (float*)(ws + WS_ASGW); unsigned* toke = (unsigned*)(ws + WS_TOKE);
        *(u32x2*)(asg + (size_t)rt_t * 2) = (u32x2){((unsigned)rt_e1 << 20) | i1, ((unsigned)rt_e2 << 20) | i2};
        *(f32x2*)(asgw + (size_t)rt_t * 2) = (f32x2){rt_w1, rt_w2};
        toke[(size_t)rt_e1 * TALL + i1] = (unsigned)rt_t; toke[(size_t)rt_e2 * TALL + i2] = (unsigned)rt_t; }
}
DI void build_tile_table(const Params& P, const Frame& F0, LAS unsigned* tab, int layer) {
    const Frame F = opaque_frame(F0);
    unsigned char* const ws = wsp(P);
    constexpr int TP = pg8::MoeSched<true>::TAB_PST, TC = pg8::MoeSched<true>::TAB_CNT;
    if (F.tid < NEXP) tab[TC + F.tid] = expert_count(ws, layer, F.tid);
    LDS_WAIT(); __syncthreads();
    if (F.tid == 0) { unsigned ps = 0; for (int e = 0; e < NEXP; ++e) { tab[TP + e] = ps; ps += (tab[TC + e] + 255u) & ~255u; } tab[0] = ps >> 8; }
    LDS_WAIT(); __syncthreads();
    const unsigned ntile = tab[0];
    for (unsigned rt = F.tid; rt < ntile; rt += NTHREADS) { unsigned e = 0; for (int k = 1; k < NEXP; ++k) if (rt * 256u >= tab[TP + k]) e = k; tab[1 + rt] = e; }
    LDS_WAIT(); __syncthreads();
}
__global__ void __launch_bounds__(NTHREADS, 2) dit_fwd(Params P) {
    extern __shared__ __attribute__((aligned(16))) unsigned char lds_raw[];
    Frame F;
    F.lds = (LAS unsigned char*)lds_raw;
    F.tid = threadIdx.x; F.lane = F.tid & 63; F.wave = __builtin_amdgcn_readfirstlane(F.tid >> 6);
    F.blk = blockIdx.x; F.G = gridDim.x; F.vcu = (F.G % 8 == 0) ? (F.blk % 8) * (F.G / 8) + F.blk / 8 : F.blk;
    F.gw = F.vcu * NWAVES + F.wave; F.NGW = F.G * NWAVES;
    for (int u = F.tid; u < (LDS_BYTES - RING_BYTES) / 4; u += NTHREADS) ((LAS unsigned*)(F.lds + RING_BYTES))[u] = 0u;
    __syncthreads();
    unsigned* ctl = (unsigned*)(P.ws + WS_CTL);
    XcdBarrier bar = xcd_barrier_post(ctl + CW_BAR, (volatile LAS unsigned*)(F.lds + MISC_OFF) + 8);

    unsigned long long pr_t0 = 0, pr_prev = 0, pr_acc = 0;
    if (PROBE_SEL) { pr_t0 = __builtin_amdgcn_s_memrealtime(); pr_prev = pr_t0; }
#define PSTAMP(id) do { if (PROBE_SEL) { const unsigned long long now_ = __builtin_amdgcn_s_memrealtime(); if ((id) == PROBE_SEL) pr_acc += now_ - pr_prev; pr_prev = now_; } } while (0)
    p0_prologue(P, F);
    if (RPT & 1) p0_prologue(P, F);
    xcd_barrier(bar);
    p0b_mod_reduce(P, F);
    xcd_barrier(bar);
    PSTAMP(1);

    for (int layer = 0; layer < DEPTH; ++layer) {
        const bool last = (layer == DEPTH - 1);
        unsigned char* ws = wsp(P);
        const int Mtok = last ? TLAT : TALL;
        phase_attn_norm(P, F, layer);
        if ((RPT & 256) && layer == 0) { phase_attn_norm(P, F, layer); phase_attn_norm(P, F, layer); phase_attn_norm(P, F, layer); }
        xcd_barrier(bar);
        PSTAMP(2);
        {
            pg8::PlainSched S; S.nN = QKVN / 256; S.nwg = (TALL / 256) * S.nN; S.G = F.G; S.c = F.vcu; S.K = DM; S.Bt = (const bf16_t*)(ws + WS_WQKV) + (size_t)layer * QKVN * DM;
            pg8::EpiQKV E{(bf16_t*)(ws + WS_QKV), ws + WS_KF, ws + WS_VF, (const f32x2*)(ws + WS_ROPE), inp(P, IN_GQ), inp(P, IN_GK), layer % 3};
            pg8::gemm_phase(F.lds, (const bf16_t*)(ws + WS_H), DM, S, E);
            if (RPT & 2) pg8::gemm_phase(F.lds, (const bf16_t*)(ws + WS_H), DM, S, E);
        }
        xcd_barrier(bar);
        PSTAMP(3);
        phase_attention(P, F, layer);
        if (((RPT & 4) && layer == 1) || ((RPT & 8) && layer != 1)) phase_attention(P, F, layer);
        xcd_barrier(bar);
        PSTAMP(4);
        {
            pg8::PlainSched S; S.nN = DM / 256; S.nwg = (Mtok / 256) * S.nN; S.G = F.G; S.c = F.vcu; S.K = DM; S.Bt = (const bf16_t*)(ws + WS_WO) + (size_t)layer * DM * DM;
            pg8::EpiResidBf E{(bf16_t*)(ws + WS_X), (const float*)(ws + WS_MOD) + (size_t)layer * 17 * 6144 + 2048};
            pg8::gemm_phase(F.lds, (const bf16_t*)(ws + WS_O), DM, S, E);
        }
        xcd_barrier(bar);
        PSTAMP(5);
        phase_router(P, F, layer, Mtok);
        xcd_barrier(bar);
        PSTAMP(6);
        if (RPT & 128) { for (int xb = 0; xb < 9; ++xb) xcd_barrier(bar); }
        LAS unsigned* tab = (LAS unsigned*)(F.lds + LDSX_OFF + 8192);
        build_tile_table(P, F, tab, layer);
        {
            pg8::MoeSched<true> S; S.tab = tab; S.G = F.G; S.c = F.vcu; S.K = DM; S.Bt = (const bf16_t*)(ws + WS_WGU) + (size_t)layer * NEXP * DM * DM; S.estride = (size_t)DM * DM * 2; S.tok = (const unsigned*)(ws + WS_TOKE);
            pg8::EpiSwiglu E{(bf16_t*)(ws + WS_ACT)};
            pg8::gemm_phase(F.lds, (const bf16_t*)(ws + WS_H), DM, S, E);
            if (RPT & 32) pg8::gemm_phase(F.lds, (const bf16_t*)(ws + WS_H), DM, S, E);
        }
        xcd_barrier(bar);
        PSTAMP(8);
        {
            pg8::MoeSched<false> S; S.tab = tab; S.G = F.G; S.c = F.vcu; S.K = FH; S.Bt = (const bf16_t*)(ws + WS_WD) + (size_t)layer * NEXP * DM * FH; S.estride = (size_t)DM * FH * 2; S.tok = nullptr;
            pg8::EpiStore E{(bf16_t*)(ws + WS_Y), DM};
            pg8::gemm_phase(F.lds, (const bf16_t*)(ws + WS_ACT), FH, S, E);
            if (RPT & 64) pg8::gemm_phase(F.lds, (const bf16_t*)(ws + WS_ACT), FH, S, E);
        }
        xcd_barrier(bar);
        PSTAMP(9);
    }
    if (PROBE_SEL) {
        if (F.blk == 0 && F.tid == 0) { const unsigned long long tot = __builtin_amdgcn_s_memrealtime() - pr_t0;
            const float f = (PROBE_SEL == 15) ? 0.5f : (float)pr_acc / (float)tot;
            __hip_atomic_store((float*)(P.ws + WS_CTL) + 64, sqrtf(4e-4f * f), __ATOMIC_RELAXED, __HIP_MEMORY_SCOPE_AGENT); }
        xcd_barrier(bar);
    }
    phase_final(P, F);
    if (RPT & 512) { phase_final(P, F); phase_final(P, F); phase_final(P, F); }
}

extern "C" void kernel_launch(void* const* d_in, const int* in_sizes, int n_in, void* d_out, int out_size, void* d_ws, size_t ws_size, hipStream_t stream) {
    static int ok = 0;
    if (ok == 0) {
        if (n_in != 22 || in_sizes[0] != TLAT * DM || out_size != TLAT * DM || ws_size < WS_END) {
            fprintf(stderr, "kernel_launch: unexpected shapes (n_in %d, in0 %d, out %d, ws %zu < %zu); nothing launched\n", n_in, n_in > 0 ? in_sizes[0] : -1, out_size, ws_size, (size_t)WS_END); ok = -1; return; }
        int dev = 0, cus = 0, per_cu = 0;
        if (hipGetDevice(&dev) != hipSuccess || hipDeviceGetAttribute(&cus, hipDeviceAttributeMultiprocessorCount, dev) != hipSuccess) { ok = -1; return; }
        if (hipFuncSetAttribute((const void*)dit_fwd, hipFuncAttributeMaxDynamicSharedMemorySize, LDS_BYTES) != hipSuccess) { fprintf(stderr, "kernel_launch: hipFuncSetAttribute failed\n"); ok = -1; return; }
        if (hipOccupancyMaxActiveBlocksPerMultiprocessor(&per_cu, (const void*)dit_fwd, NTHREADS, LDS_BYTES) != hipSuccess || per_cu < 1) fprintf(stderr, "kernel_launch: note: occupancy query reports %d\n", per_cu);
        (void)hipGetLastError();
        if (cus < GRID) { fprintf(stderr, "kernel_launch: %d CUs < %d workgroups: grid would not be resident; nothing launched\n", cus, GRID); ok = -1; return; }
        ok = 1;
    }
    if (ok < 0) return;
    if (hipMemsetAsync((char*)d_ws + WS_CTL, 0, CTL_ZERO_BYTES, stream) != hipSuccess) return;
    Params p{};
    for (int i = 0; i < 22; ++i) p.in[i] = (const float*)d_in[i];
    p.out = (float*)d_out; p.ws = (unsigned char*)d_ws;
    hipLaunchKernelGGL(dit_fwd, dim3(GRID), dim3(NTHREADS), LDS_BYTES, stream, p);
}
```

```cpp
#include <hip/hip_runtime.h>
#include <cstdio>
#include <cstdint>

#ifndef PROBE_SEL
#define PROBE_SEL 0
#endif
#ifndef RPT
#define RPT 0
#endif

#define LAS __attribute__((address_space(3)))
#define GAS __attribute__((address_space(1)))
#define DI __device__ __forceinline__

typedef unsigned short bf16_t;
typedef short bf16x8 __attribute__((ext_vector_type(8)));
typedef short s16x4 __attribute__((ext_vector_type(4)));
typedef float f32x2 __attribute__((ext_vector_type(2)));
typedef float f32x4 __attribute__((ext_vector_type(4)));
typedef float f32x16 __attribute__((ext_vector_type(16)));
typedef unsigned u32x2 __attribute__((ext_vector_type(2)));
typedef unsigned u32x4 __attribute__((ext_vector_type(4)));

constexpr int NB = 16, SEQ = 2048, DM = 1024, DEPTH = 4, CTXL = 256, NH = 16, NKV = 4, HD = 64, QKVN = 1536;
constexpr int TLAT = NB * SEQ, TCTX = NB * CTXL, TALL = TLAT + TCTX;
constexpr int NEXP = 32, FH = 512;
constexpr int KEYS = SEQ + CTXL, KGRP = KEYS / 8;
constexpr int CAPR = 2 * TALL + NEXP * 256;
constexpr int NWAVES = 8, NTHREADS = 512, GRID = 256;
constexpr float NORM_EPS = 1e-6f, LOG2E = 1.4426950408889634f;

constexpr size_t MiB = 1u << 20;
constexpr size_t WS_CTL = 0, CTL_ZERO_BYTES = 1 * MiB;
constexpr size_t WS_MODP = 1 * MiB;
constexpr size_t WS_MOD = 15 * MiB;
constexpr size_t WS_ROPE = 17 * MiB;
constexpr size_t WS_WRT = 17 * MiB + 65536;
constexpr size_t WS_ASG = 18 * MiB;
constexpr size_t WS_ASGW = 18 * MiB + 512 * 1024;
constexpr size_t WS_TOKE = 1 * MiB;
constexpr size_t WS_WQKV = 21 * MiB;
constexpr size_t WS_WO = 33 * MiB;
constexpr size_t WS_WGU = 41 * MiB;
constexpr size_t WS_WD = 297 * MiB;
constexpr size_t WS_X = 425 * MiB;
constexpr size_t WS_H = 569 * MiB;
constexpr size_t WS_R1 = 641 * MiB;
constexpr size_t WS_QKV = WS_R1;
constexpr size_t WS_KF = WS_R1 + 108 * MiB;
constexpr size_t WS_VF = WS_R1 + 126 * MiB;
constexpr size_t WS_O = WS_R1 + 144 * MiB;
constexpr size_t WS_Y = WS_R1;
constexpr size_t WS_ACT = WS_R1 + 160 * MiB;
constexpr size_t WS_END = WS_R1 + 240 * MiB;
constexpr int CW_TMO = 0, CW_BAR = 4096, CW_CNT = 65536, CNT_STRIDE = 32;

constexpr int RING_BYTES = 131072;
constexpr int MISC_OFF = RING_BYTES + 320;
constexpr int LDSX_OFF = RING_BYTES + 1024;
constexpr int LDS_BYTES = 147456;

#define LDS_WAIT() asm volatile("s_waitcnt lgkmcnt(0)" ::: "memory")
#define VM_WAIT() asm volatile("s_waitcnt vmcnt(0)" ::: "memory")

DI unsigned f2bf(float f) { unsigned u = __float_as_uint(f); return (u + 0x7fffu + ((u >> 16) & 1u)) >> 16; }
DI float bf2f(unsigned b) { return __uint_as_float(b << 16); }
DI float bfs2f(short b) { return __uint_as_float(((unsigned)(unsigned short)b) << 16); }
DI unsigned cvt_pk_bf16(float lo, float hi);
DI unsigned pk2(float lo, float hi) { return cvt_pk_bf16(lo, hi); }
DI unsigned cvt_pk_bf16(float lo, float hi) { unsigned r; asm volatile("v_cvt_pk_bf16_f32 %0, %1, %2" : "=v"(r) : "v"(lo), "v"(hi)); return r; }
DI float wave_sum(float v) {
#pragma unroll
    for (int o = 1; o < 64; o <<= 1) v += __shfl_xor(v, o);
    return v;
}
DI int crow(int r, int hi) { return (r & 3) + 8 * (r >> 2) + 4 * hi; }

#define XB_TMO      128
#define XB_XCNT(j)  (256  + 64 * (j))
#define XB_XSUB(j)  (1280 + 64 * (j))
#define XB_XGEN(j)  (2304 + 64 * (j))
#define XB_TOP      3328
#define XB_TOPGEN   3392
#define XCD_BAR_WORDS 3456
#define XB_SPIN_CAP (1u << 18)

__device__ __forceinline__ unsigned xb_ld(unsigned* p)              { return __hip_atomic_load(p, __ATOMIC_RELAXED, __HIP_MEMORY_SCOPE_AGENT); }
__device__ __forceinline__ unsigned xb_add(unsigned* p, unsigned v) { return __hip_atomic_fetch_add(p, v, __ATOMIC_RELAXED, __HIP_MEMORY_SCOPE_AGENT); }
__device__ __forceinline__ unsigned xb_xcc_id() { return (unsigned)__builtin_amdgcn_s_getreg((3 << 11) | 20) & 0xFu; }
#define XB_SPIN(cond, bar) do { unsigned _sp = 0; while (cond) { __builtin_amdgcn_s_sleep(1); \
    if ((++_sp & 255u) == 0u) { if (xb_ld(&(bar)[XB_TMO])) break; if (_sp > XB_SPIN_CAP) { atomicAdd(&(bar)[XB_TMO], 1u); break; } } } } while (0)

struct XcdBarrier { unsigned* bar; unsigned x; volatile LAS unsigned* st; };

__device__ __forceinline__ XcdBarrier xcd_barrier_post(unsigned* bar, volatile LAS unsigned* st) {
    XcdBarrier b; b.bar = bar; b.x = xb_xcc_id(); b.st = st;
    if (threadIdx.x == 0) (void)xb_add(&bar[XB_XCNT(b.x)], 1u);
    return b;
}
__device__ __forceinline__ void xcd_barrier_complete(unsigned* bar, unsigned x, unsigned& nloc, unsigned& nx) {
    const unsigned G = gridDim.x * gridDim.y * gridDim.z;
    unsigned sum, cnt, mine, sp = 0u;
    for (;;) {
        sum = 0u; cnt = 0u; mine = 0u;
#pragma unroll
        for (unsigned j = 0; j < 16; ++j) { const unsigned c = xb_ld(&bar[XB_XCNT(j)]); sum += c; cnt += (c > 0u) ? 1u : 0u; mine = (j == x) ? c : mine; }
        if (sum == G) break;
        __builtin_amdgcn_s_sleep(1);
        if ((++sp & 255u) == 0u) { if (xb_ld(&bar[XB_TMO])) break; if (sp > XB_SPIN_CAP) { atomicAdd(&bar[XB_TMO], 1u); break; } }
    }
    nloc = mine > 0u ? mine : 1u; nx = cnt > 0u ? cnt : 1u;
}
__device__ __forceinline__ void xcd_barrier(const XcdBarrier& b0) {
    XcdBarrier b = b0;
    { unsigned z = 0, bx = __builtin_amdgcn_readfirstlane(b0.x); asm volatile("s_mov_b32 %0, 0" : "=s"(z)); asm volatile("" : "+s"(bx)); b.bar = b0.bar + z; b.x = bx; }
    asm volatile("s_waitcnt vmcnt(0)" ::: "memory");
    __syncthreads();
    if (threadIdx.x == 0) {
        unsigned* bar = b.bar;
        __builtin_amdgcn_s_waitcnt(0);
        unsigned nloc = b.st[0], nx = b.st[1];
        if (nloc == 0u) { xcd_barrier_complete(bar, b.x, nloc, nx); b.st[0] = nloc; b.st[1] = nx; }
        const unsigned old = xb_add(&bar[XB_XSUB(b.x)], 1u);
        const unsigned gen = old / nloc;
        if (old + 1u == (gen + 1u) * nloc) {
            __builtin_amdgcn_fence(__ATOMIC_RELEASE, "agent");
            asm volatile("s_waitcnt vmcnt(0)" ::: "memory");
            const unsigned og = xb_add(&bar[XB_TOP], 1u);
            const unsigned tg = og / nx;
            if (og + 1u == (tg + 1u) * nx) xb_add(&bar[XB_TOPGEN], 1u);
            else XB_SPIN(xb_ld(&bar[XB_TOPGEN]) == tg, bar);
            __builtin_amdgcn_fence(__ATOMIC_ACQUIRE, "agent");
            xb_add(&bar[XB_XGEN(b.x)], 1u);
            asm volatile("s_waitcnt vmcnt(0)" ::: "memory");
        } else {
            XB_SPIN(xb_ld(&bar[XB_XGEN(b.x)]) == gen, bar);
            __builtin_amdgcn_fence(__ATOMIC_ACQUIRE, "agent");
            asm volatile("s_waitcnt vmcnt(0)" ::: "memory");
        }
    }
    __syncthreads();
}

namespace pg8 {
constexpr int BM = 256, BK = 64, HALF = 128, HTB = HALF * BK * 2, STAGE_BYTES = 8 * HTB;
DI int lds_byte(int r, int c) { const int st = (r >> 4) * 2 + (c >> 5), rr = r & 15, cc = c & 31, ob = rr * 64 + cc * 2; return st * 1024 + (ob ^ (((ob >> 9) & 1) << 5)); }
DI void stage_rc(int b, int& R, int& C) { const int st = b / 1024, sb = b % 1024, swz = sb ^ (((sb >> 9) & 1) << 5); R = (st >> 1) * 16 + swz / 64; C = (st & 1) * 32 + (swz % 64) / 2; }
DI int perm32(int rho) { const int n = rho >> 4, i = rho & 15; return 8 * (i >> 2) + 4 * n + (i & 3); }
struct Unit { int pm, pn, e, r0, na; };

template <class Epi, class Sched>
DI void gemm_phase(LAS unsigned char* lds, const bf16_t* A, const int K, const Sched& S, const Epi& E) {
    int tid_ = threadIdx.x; asm volatile("" : "+v"(tid_));
    const int tid = tid_, wid = __builtin_amdgcn_readfirstlane(tid >> 6), lane = tid & 63, wr = wid >> 2, wc = wid & 3, fr = lane & 15, fq = lane >> 4;
    const int nt = K / BK;
    constexpr bool GA = Sched::GATHER;
    int Rr[2], Cc[2]; unsigned voffB[2], voffA[2];
#pragma unroll
    for (int i = 0; i < 2; ++i) { int R, C; stage_rc(tid * 16 + i * 8192, R, C); const int Rb = Epi::PERM ? ((R & ~31) + perm32(R & 31)) : R;
        Rr[i] = R; Cc[i] = C; voffB[i] = (unsigned)(Rb * K + C) * 2u; voffA[i] = (unsigned)(R * K + C) * 2u; }
    const size_t kstep = (size_t)(BK * 2);
    const size_t hstep = (size_t)HALF * K * 2;
    const unsigned ldsw = (unsigned)wid * 1024u;
    const int aoff = lds_byte(wr * 64 + fr, fq * 8), boff = lds_byte(wc * 32 + fr, fq * 8);
#define PG8_SA(b, h) (((b) * 2 + (h)) * HTB)
#define PG8_SB(b, h) ((4 + (b) * 2 + (h)) * HTB)
#define PG8_STAGE(bufoff, gbase, voff) do { _Pragma("unroll") for (int _i = 0; _i < 2; ++_i) \
        __builtin_amdgcn_global_load_lds((const unsigned*)((const char*)(gbase) + (voff)[_i]), (LAS unsigned*)(lds + (bufoff) + ldsw + _i * 8192), 16, 0, 0); } while (0)
#define PG8_LDA(dst, b, h) do { _Pragma("unroll") for (int m = 0; m < 4; ++m) _Pragma("unroll") for (int k = 0; k < 2; ++k) dst[m][k] = *(const LAS bf16x8*)(lds + PG8_SA(b, h) + aoff + m * 2048 + k * 1024); } while (0)
#define PG8_LDB(dst, b, h) do { _Pragma("unroll") for (int n = 0; n < 2; ++n) _Pragma("unroll") for (int k = 0; k < 2; ++k) dst[n][k] = *(const LAS bf16x8*)(lds + PG8_SB(b, h) + boff + n * 2048 + k * 1024); } while (0)
#define PG8_MMA(ai, bj, At, Bt) do { __builtin_amdgcn_s_setprio(1); _Pragma("unroll") for (int m = 0; m < 4; ++m) _Pragma("unroll") for (int n = 0; n < 2; ++n) _Pragma("unroll") for (int k = 0; k < 2; ++k) \
        acc[ai][bj][m][n] = __builtin_amdgcn_mfma_f32_16x16x32_bf16(Bt[n][k], At[m][k], acc[ai][bj][m][n], 0, 0, 0); __builtin_amdgcn_s_setprio(0); } while (0)
#define PG8_WAIT_V(n) asm volatile("s_waitcnt vmcnt(" #n ")" ::: "memory")
#define PG8_WAIT_L(n) asm volatile("s_waitcnt lgkmcnt(" #n ")" ::: "memory")
#define PG8_BAR __builtin_amdgcn_s_barrier()
#define PG8_SCHED __builtin_amdgcn_sched_barrier(0)
    Unit cur, nxt; int ui = 0;
    if (!S.next(0, cur)) return;
    f32x4 acc[2][2][4][2];
#pragma unroll
    for (int a = 0; a < 2; ++a)
#pragma unroll
        for (int b = 0; b < 2; ++b)
#pragma unroll
            for (int m = 0; m < 4; ++m)
#pragma unroll
                for (int n = 0; n < 2; ++n) acc[a][b][m][n] = (f32x4){0.f, 0.f, 0.f, 0.f};
    bf16x8 At[4][2], B0[2][2], B1[2][2];
    unsigned oc0[2], oc1[2], on0[2], on1[2];
#pragma unroll
    for (int i = 0; i < 2; ++i) { if (GA) { oc0[i] = S.a_off(cur, Rr[i]) + (unsigned)Cc[i] * 2u; oc1[i] = S.a_off(cur, HALF + Rr[i]) + (unsigned)Cc[i] * 2u; } else { oc0[i] = voffA[i]; oc1[i] = voffA[i]; } on0[i] = oc0[i]; on1[i] = oc1[i]; }
    size_t hA = (GA || (Sched::HALVES && cur.na == 1)) ? (size_t)0 : hstep, hAn = hA;
    const char* Ab = GA ? (const char*)A : (const char*)A + (size_t)cur.r0 * K * 2;
    const char* cB = S.b_ptr(cur);
    PG8_STAGE(PG8_SB(0, 0), cB, voffB); PG8_STAGE(PG8_SB(0, 1), cB + hstep, voffB); PG8_STAGE(PG8_SA(0, 0), Ab, oc0); PG8_STAGE(PG8_SA(0, 1), Ab + hA, oc1);
    if (wr == 1) PG8_BAR;
    PG8_WAIT_V(2); PG8_BAR;
    PG8_STAGE(PG8_SB(1, 0), cB + kstep, voffB); PG8_STAGE(PG8_SA(1, 0), Ab + kstep, oc0); PG8_STAGE(PG8_SB(1, 1), cB + hstep + kstep, voffB);
    PG8_WAIT_V(6); PG8_BAR;
    for (;;) {
        const bool has_next = S.next(ui + 1, nxt);
        const char* nB = has_next ? S.b_ptr(nxt) : cB;
        const char* nA = GA ? Ab : (has_next ? (const char*)A + (size_t)nxt.r0 * K * 2 : Ab);
        if (!GA && Sched::HALVES) hAn = (has_next && nxt.na == 1) ? (size_t)0 : (has_next ? hstep : hA);
        if (GA) {
            if (has_next) {
#pragma unroll
                for (int i = 0; i < 2; ++i) { on0[i] = S.a_off(nxt, Rr[i]) + (unsigned)Cc[i] * 2u; on1[i] = S.a_off(nxt, HALF + Rr[i]) + (unsigned)Cc[i] * 2u; }
            } else {
#pragma unroll
                for (int i = 0; i < 2; ++i) { on0[i] = oc0[i]; on1[i] = oc1[i]; }
            }
        }
#define PG8_KLOOP(FULL) \
        for (int t = 0; t < nt; t += 2) { \
            const bool last = (t == nt - 2); \
            const char* a1 = Ab + (size_t)(t + 1) * kstep + hA; \
            const char* a2 = last ? nA : Ab + (size_t)(t + 2) * kstep; const char* b2 = last ? nB : cB + (size_t)(t + 2) * kstep; \
            const char* a3 = a2 + kstep; const char* b3 = b2 + kstep; const size_t hA2 = last ? hAn : hA; \
            unsigned o20[2], o21[2]; \
            for (int i = 0; i < 2; ++i) { if (GA) { o20[i] = last ? on0[i] : oc0[i]; o21[i] = last ? on1[i] : oc1[i]; } else { o20[i] = voffA[i]; o21[i] = voffA[i]; } } \
              \
            PG8_LDB(B0, 0, 0); PG8_LDB(B1, 0, 1); PG8_SCHED; PG8_LDA(At, 0, 0); PG8_STAGE(PG8_SA(1, 1), a1, oc1); \
            PG8_WAIT_V(8); PG8_WAIT_L(0); PG8_BAR; PG8_MMA(0, 0, At, B0); PG8_MMA(0, 1, At, B1); PG8_BAR; PG8_SCHED; \
              \
            if (FULL) { PG8_LDA(At, 0, 1); } PG8_STAGE(PG8_SB(0, 0), b2, voffB); PG8_STAGE(PG8_SB(0, 1), b2 + hstep, voffB); PG8_STAGE(PG8_SA(0, 0), a2, o20); \
            PG8_WAIT_V(8); PG8_WAIT_L(0); PG8_BAR; if (FULL) { PG8_MMA(1, 0, At, B0); PG8_MMA(1, 1, At, B1); } PG8_BAR; PG8_SCHED; \
              \
            PG8_LDB(B0, 1, 0); PG8_LDB(B1, 1, 1); PG8_SCHED; PG8_LDA(At, 1, 0); PG8_STAGE(PG8_SA(0, 1), a2 + hA2, o21); \
            PG8_WAIT_V(8); PG8_WAIT_L(0); PG8_BAR; PG8_MMA(0, 0, At, B0); PG8_MMA(0, 1, At, B1); PG8_BAR; PG8_SCHED; \
              \
            if (FULL) { PG8_LDA(At, 1, 1); } PG8_STAGE(PG8_SB(1, 0), b3, voffB); PG8_STAGE(PG8_SB(1, 1), b3 + hstep, voffB); PG8_STAGE(PG8_SA(1, 0), a3, o20); \
            PG8_WAIT_V(8); PG8_WAIT_L(0); PG8_BAR; if (FULL) { PG8_MMA(1, 0, At, B0); PG8_MMA(1, 1, At, B1); } PG8_BAR; PG8_SCHED; \
        }
        if (Sched::HALVES && cur.na == 1) { PG8_KLOOP(0) } else { PG8_KLOOP(1) }
#undef PG8_KLOOP
        if (wr == 0) PG8_BAR;
        E(acc, cur, wr, wc, fr, fq);
        if (!has_next) break;
#pragma unroll
        for (int a = 0; a < 2; ++a)
#pragma unroll
            for (int b = 0; b < 2; ++b)
#pragma unroll
                for (int m = 0; m < 4; ++m)
#pragma unroll
                    for (int n = 0; n < 2; ++n) acc[a][b][m][n] = (f32x4){0.f, 0.f, 0.f, 0.f};
        cur = nxt; cB = nB; Ab = nA; hA = hAn; ++ui;
        if (GA) {
#pragma unroll
            for (int i = 0; i < 2; ++i) { oc0[i] = on0[i]; oc1[i] = on1[i]; }
        }
        if (wr == 1) PG8_BAR;
    }
    PG8_WAIT_V(0);
    PG8_BAR;
#undef PG8_SA
#undef PG8_SB
#undef PG8_STAGE
#undef PG8_LDA
#undef PG8_LDB
#undef PG8_MMA
#undef PG8_WAIT_V
#undef PG8_WAIT_L
#undef PG8_BAR
#undef PG8_SCHED
}

struct PlainSched {
    static constexpr bool GATHER = false, HALVES = true;
    int nN, nwg, G, c, K; const bf16_t* Bt;
    DI bool next(int i, Unit& u) const { const int L = i * G + c; const int nfull = (nwg / G) * G, rem = nwg - nfull; int Lu = L, hf = 0; u.na = 2;
        if (L >= nfull) { if (2 * rem <= G) { const int h = L - nfull; if (h >= 2 * rem) return false; Lu = nfull + (h >> 1); hf = h & 1; u.na = 1; } else if (L >= nwg) return false; }
        u.pm = Lu / nN; u.pn = Lu - u.pm * nN; u.e = 0; u.r0 = u.pm * BM + hf * HALF; return true; }
    DI unsigned a_off(const Unit& u, int r) const { return (unsigned)(u.r0 + r) * (unsigned)(K * 2); }
    DI const char* b_ptr(const Unit& u) const { return (const char*)Bt + (size_t)u.pn * BM * K * 2; }
};
template <bool GATHER_> struct MoeSched {
    static constexpr bool GATHER = GATHER_, HALVES = true;
    static constexpr int TAB_PST = 384, TAB_CNT = 416;
    const LAS unsigned* tab; int G, c, K; const bf16_t* Bt; size_t estride; const unsigned* tok;
    DI bool next(int i, Unit& u) const { const int L = i * G + c; const int nwg = (int)tab[0] * 4, nfull = (nwg / G) * G, rem = nwg - nfull; int Lu = L, hf = 0; u.na = 2;
        if (L >= nfull) { if (2 * rem <= G) { const int h = L - nfull; if (h >= 2 * rem) return false; Lu = nfull + (h >> 1); hf = h & 1; u.na = 1; } else if (L >= nwg) return false; }
        u.pm = Lu >> 2; u.pn = Lu & 3; u.e = (int)tab[1 + u.pm]; u.r0 = u.pm * BM + hf * HALF; return true; }
    DI unsigned a_off(const Unit& u, int r) const {
        unsigned row = (unsigned)(u.r0 + (u.na == 1 ? (r & (HALF - 1)) : r));
        if (GATHER_) { const unsigned last = tab[TAB_CNT + u.e] - 1u; unsigned idx = row - tab[TAB_PST + u.e]; idx = idx < last ? idx : last; row = tok[(unsigned)u.e * (unsigned)TALL + idx]; }
        return row * (unsigned)(K * 2); }
    DI const char* b_ptr(const Unit& u) const { return (const char*)Bt + (size_t)u.e * estride + (size_t)u.pn * BM * K * 2; }
};

struct EpiStore {
    static constexpr bool PERM = true;
    bf16_t* O; int ldc;
    DI void operator()(const f32x4 (&acc)[2][2][4][2], const Unit& u, int wr, int wc, int fr, int fq) const {
        const int row0 = u.r0 + wr * 64 + fr, col0 = u.pn * BM + wc * 32 + 8 * fq;
#pragma unroll
        for (int ai = 0; ai < 2; ++ai) if (ai < u.na)
#pragma unroll
            for (int m = 0; m < 4; ++m) { bf16_t* rowp = O + (size_t)(row0 + ai * HALF + m * 16) * ldc + col0;
#pragma unroll
                for (int bj = 0; bj < 2; ++bj) { const f32x4 v0 = acc[ai][bj][m][0], v1 = acc[ai][bj][m][1];
                    u32x4 w; w.x = cvt_pk_bf16(v0[0], v0[1]); w.y = cvt_pk_bf16(v0[2], v0[3]); w.z = cvt_pk_bf16(v1[0], v1[1]); w.w = cvt_pk_bf16(v1[2], v1[3]);
                    *(u32x4*)(rowp + bj * HALF) = w; } }
    }
};
struct EpiQKV {
    static constexpr bool PERM = false;
    bf16_t* QKV; unsigned char* KF; unsigned char* VF; const f32x2* T; const float* gq; const float* gk; int m;
    DI void operator()(const f32x4 (&acc)[2][2][4][2], const Unit& u, int wr, int wc, int fr, int fq) const {
        const bool lat = u.pm < TLAT / BM; const int b = lat ? (u.pm >> 3) : (u.pm - TLAT / BM);
        const int trow0 = u.r0 + wr * 64 + fr;
        if (u.pn < 4) {
            const int h = 4 * u.pn + wc;
            f32x4 g[2][2];
#pragma unroll
            for (int bj = 0; bj < 2; ++bj)
#pragma unroll
                for (int n = 0; n < 2; ++n) g[bj][n] = (m == 1) ? *(const f32x4*)(gq + 32 * bj + 16 * n + 4 * fq) : (f32x4){1.f, 1.f, 1.f, 1.f};
#pragma unroll
            for (int ai = 0; ai < 2; ++ai) if (ai < u.na)
#pragma unroll
                for (int mm = 0; mm < 4; ++mm) {
                    f32x4 x[2][2]; float ss = 0.f;
#pragma unroll
                    for (int bj = 0; bj < 2; ++bj)
#pragma unroll
                        for (int n = 0; n < 2; ++n) { x[bj][n] = acc[ai][bj][mm][n]; ss += (x[bj][n][0] * x[bj][n][0] + x[bj][n][1] * x[bj][n][1]) + (x[bj][n][2] * x[bj][n][2] + x[bj][n][3] * x[bj][n][3]); }
                    float sc = 0.125f * LOG2E;
                    if (m == 1) { ss += __shfl_xor(ss, 16); ss += __shfl_xor(ss, 32); sc *= 1.0f / sqrtf(ss * (1.f / HD) + NORM_EPS); }
                    bf16_t* qrow = QKV + (size_t)(trow0 + ai * HALF + mm * 16) * QKVN + h * HD + 4 * fq;
#pragma unroll
                    for (int bj = 0; bj < 2; ++bj)
#pragma unroll
                        for (int n = 0; n < 2; ++n) { const f32x4 y = x[bj][n] * g[bj][n] * sc; u32x2 w; w.x = cvt_pk_bf16(y[0], y[1]); w.y = cvt_pk_bf16(y[2], y[3]); *(u32x2*)(qrow + 32 * bj + 16 * n) = w; }
                }
        } else if (u.pn == 4) {
            f32x4 g[2][2];
#pragma unroll
            for (int bj = 0; bj < 2; ++bj)
#pragma unroll
                for (int n = 0; n < 2; ++n) g[bj][n] = (m == 1) ? *(const f32x4*)(gk + 32 * bj + 16 * n + 4 * fq) : (f32x4){1.f, 1.f, 1.f, 1.f};
            const bool rope = lat && (m != 2);
            unsigned char* kbase = KF + (size_t)(b * NKV + wc) * KGRP * 1024 + (fq >> 1) * 128 + (fq & 1) * 8;
#pragma unroll
            for (int ai = 0; ai < 2; ++ai) if (ai < u.na)
#pragma unroll
                for (int mm = 0; mm < 4; ++mm) {
                    const int t = trow0 + ai * HALF + mm * 16;
                    const int kidx = lat ? (t & 2047) : (2048 + ((t - TLAT) & 255));
                    f32x4 x[2][2]; float ss = 0.f;
#pragma unroll
                    for (int bj = 0; bj < 2; ++bj)
#pragma unroll
                        for (int n = 0; n < 2; ++n) { x[bj][n] = acc[ai][bj][mm][n]; ss += (x[bj][n][0] * x[bj][n][0] + x[bj][n][1] * x[bj][n][1]) + (x[bj][n][2] * x[bj][n][2] + x[bj][n][3] * x[bj][n][3]); }
                    if (m == 1) { ss += __shfl_xor(ss, 16); ss += __shfl_xor(ss, 32); const float rs = 1.0f / sqrtf(ss * (1.f / HD) + NORM_EPS);
#pragma unroll
                        for (int bj = 0; bj < 2; ++bj)
#pragma unroll
                            for (int n = 0; n < 2; ++n) x[bj][n] = x[bj][n] * g[bj][n] * rs; }
                    if (rope) {
#pragma unroll
                        for (int bj = 0; bj < 2; ++bj) { const int pos = bj ? (kidx & 63) : (kidx >> 6); const f32x4* tp = (const f32x4*)(T + pos * 16 + 4 * fq);
                            const f32x4 t0 = tp[0], t1 = tp[1];
                            const f32x4 cs = (f32x4){t0[0], t0[2], t1[0], t1[2]}, sn = (f32x4){t0[1], t0[3], t1[1], t1[3]};
                            const f32x4 a = x[bj][0], c = x[bj][1];
                            x[bj][0] = a * cs - c * sn; x[bj][1] = c * cs + a * sn; }
                    }
                    unsigned char* kp = kbase + (size_t)(kidx >> 3) * 1024 + (kidx & 7) * 16;
#pragma unroll
                    for (int bj = 0; bj < 2; ++bj)
#pragma unroll
                        for (int n = 0; n < 2; ++n) { u32x2 w; w.x = cvt_pk_bf16(x[bj][n][0], x[bj][n][1]); w.y = cvt_pk_bf16(x[bj][n][2], x[bj][n][3]); *(u32x2*)(kp + (4 * bj + 2 * n) * 128) = w; }
                }
        } else {
            const int q4 = fr & 3;
            unsigned char* vbase = VF + (size_t)(b * NKV + wc) * KGRP * 1024 + (4 * fq + q4) * 16;
#pragma unroll
            for (int ai = 0; ai < 2; ++ai) if (ai < u.na)
#pragma unroll
                for (int mm = 0; mm < 4; ++mm) {
                    const int t = trow0 + ai * HALF + mm * 16;
                    const int kidx = lat ? (t & 2047) : (2048 + ((t - TLAT) & 255));
                    unsigned char* vp = vbase + (size_t)(kidx >> 3) * 1024 + (kidx & 4) * 2;
#pragma unroll
                    for (int bj = 0; bj < 2; ++bj)
#pragma unroll
                        for (int n = 0; n < 2; ++n) {
                            f32x4 x = acc[ai][bj][mm][n];
                            { const float s0 = (q4 & 1) ? x[0] : x[1], s1 = (q4 & 1) ? x[2] : x[3]; const float r0 = __shfl_xor(s0, 1), r1 = __shfl_xor(s1, 1);
                              if (q4 & 1) { x[0] = r0; x[2] = r1; } else { x[1] = r0; x[3] = r1; } }
                            { const float s0 = (q4 & 2) ? x[0] : x[2], s1 = (q4 & 2) ? x[1] : x[3]; const float r0 = __shfl_xor(s0, 2), r1 = __shfl_xor(s1, 2);
                              if (q4 & 2) { x[0] = r0; x[1] = r1; } else { x[2] = r0; x[3] = r1; } }
                            u32x2 w; w.x = cvt_pk_bf16(x[0], x[1]); w.y = cvt_pk_bf16(x[2], x[3]);
                            *(u32x2*)(vp + (32 * bj + 16 * n) * 16) = w; }
                }
        }
    }
};
DI float silu_mul(float g, float u) { return g * __builtin_amdgcn_rcpf(1.f + __builtin_amdgcn_exp2f(-g * LOG2E)) * u; }
struct EpiResidBf {
    static constexpr bool PERM = true;
    bf16_t* X; const float* gate;
    DI void operator()(const f32x4 (&acc)[2][2][4][2], const Unit& u, int wr, int wc, int fr, int fq) const {
        const int mb = (u.pm < TLAT / BM) ? (u.pm >> 3) : 16;
        const float* gt = gate + (size_t)mb * 6144;
        const int row0 = u.r0 + wr * 64 + fr, col0 = u.pn * BM + wc * 32 + 8 * fq;
        f32x4 g[2][2];
#pragma unroll
        for (int bj = 0; bj < 2; ++bj)
#pragma unroll
            for (int n = 0; n < 2; ++n) g[bj][n] = *(const f32x4*)(gt + col0 + bj * HALF + 4 * n);
#pragma unroll
        for (int ai = 0; ai < 2; ++ai) if (ai < u.na) {
            u32x4 old[4][2];
#pragma unroll
            for (int m = 0; m < 4; ++m)
#pragma unroll
                for (int bj = 0; bj < 2; ++bj) old[m][bj] = *(const u32x4*)(X + (size_t)(row0 + ai * HALF + m * 16) * DM + col0 + bj * HALF);
#pragma unroll
            for (int m = 0; m < 4; ++m)
#pragma unroll
                for (int bj = 0; bj < 2; ++bj) { const u32x4 o = old[m][bj]; const f32x4 a0 = acc[ai][bj][m][0] * g[bj][0], a1 = acc[ai][bj][m][1] * g[bj][1];
                    u32x4 w; w.x = cvt_pk_bf16(bf2f(o.x & 0xffffu) + a0[0], bf2f(o.x >> 16) + a0[1]); w.y = cvt_pk_bf16(bf2f(o.y & 0xffffu) + a0[2], bf2f(o.y >> 16) + a0[3]);
                    w.z = cvt_pk_bf16(bf2f(o.z & 0xffffu) + a1[0], bf2f(o.z >> 16) + a1[1]); w.w = cvt_pk_bf16(bf2f(o.w & 0xffffu) + a1[2], bf2f(o.w >> 16) + a1[3]);
                    *(u32x4*)(X + (size_t)(row0 + ai * HALF + m * 16) * DM + col0 + bj * HALF) = w; }
        }
    }
};
struct EpiSwiglu {
    static constexpr bool PERM = true;
    bf16_t* ACT;
    DI void operator()(const f32x4 (&acc)[2][2][4][2], const Unit& u, int wr, int wc, int fr, int fq) const {
        const int row0 = u.r0 + wr * 64 + fr, col0 = u.pn * HALF + wc * 32 + 8 * fq;
#pragma unroll
        for (int ai = 0; ai < 2; ++ai) if (ai < u.na)
#pragma unroll
            for (int m = 0; m < 4; ++m) { bf16_t* rowp = ACT + (size_t)(row0 + ai * HALF + m * 16) * FH + col0;
                const f32x4 g0 = acc[ai][0][m][0], g1 = acc[ai][0][m][1], u0 = acc[ai][1][m][0], u1 = acc[ai][1][m][1];
                u32x4 w; w.x = cvt_pk_bf16(silu_mul(g0[0], u0[0]), silu_mul(g0[1], u0[1])); w.y = cvt_pk_bf16(silu_mul(g0[2], u0[2]), silu_mul(g0[3], u0[3]));
                w.z = cvt_pk_bf16(silu_mul(g1[0], u1[0]), silu_mul(g1[1], u1[1])); w.w = cvt_pk_bf16(silu_mul(g1[2], u1[2]), silu_mul(g1[3], u1[3]));
                *(u32x4*)rowp = w; }
    }
};
}

struct Params { const float* in[22]; float* out; unsigned char* ws; };
enum { IN_X = 0, IN_C, IN_CTX, IN_CCTX, IN_WADA, IN_BADA, IN_GATTN, IN_WQKV, IN_WO, IN_SINK, IN_GQ, IN_GK, IN_RPB, IN_GFFN, IN_WGROUP, IN_BGROUP, IN_WROUTER, IN_BROUTER, IN_WGATE, IN_WUP, IN_WDOWN, IN_GFINAL };

DI const float* inp(const Params& P, int i) { i = __builtin_amdgcn_readfirstlane(i); asm volatile("" : "+s"(i)); return P.in[i]; }
DI unsigned char* wsp(const Params& P) { unsigned z = 0; asm volatile("s_mov_b32 %0, 0" : "=s"(z)); return P.ws + z; }
struct Frame { LAS unsigned char* lds; int tid, lane, wave, blk, G, vcu, gw, NGW; };
DI Frame opaque_frame(const Frame& F0) { Frame F = F0; asm volatile("" : "+v"(F.tid), "+v"(F.lane)); asm volatile("" : "+s"(F.wave), "+s"(F.blk), "+s"(F.vcu), "+s"(F.gw)); return F; }

DI void p0_transpose_item(const float* W, int N, int k0, int n0, bf16_t* dst, int Kd, LAS float* scr, int lane) {
#pragma unroll 8
    for (int i = 0; i < 32; ++i) { const int kk = 2 * i + (lane >> 5); scr[kk * 33 + (lane & 31)] = W[(size_t)(k0 + kk) * N + n0 + (lane & 31)]; }
    LDS_WAIT();
    const int c = lane & 7;
#pragma unroll
    for (int j = 0; j < 4; ++j) { const int n = (lane >> 3) + 8 * j; const LAS float* s = scr + (8 * c) * 33 + n;
        u32x4 o; o.x = pk2(s[0 * 33], s[1 * 33]); o.y = pk2(s[2 * 33], s[3 * 33]); o.z = pk2(s[4 * 33], s[5 * 33]); o.w = pk2(s[6 * 33], s[7 * 33]);
        *(u32x4*)(dst + (size_t)n * Kd + 8 * c) = o; }
    LDS_WAIT();
}
DI double dsin_poly(double r) { const double r2 = r * r;
    return r * (1.0 - r2 * (1.0 / 6.0) * (1.0 - r2 * (1.0 / 20.0) * (1.0 - r2 * (1.0 / 42.0) * (1.0 - r2 * (1.0 / 72.0) * (1.0 - r2 * (1.0 / 110.0) * (1.0 - r2 * (1.0 / 156.0) * (1.0 - r2 * (1.0 / 210.0) * (1.0 - r2 * (1.0 / 272.0) * (1.0 - r2 * (1.0 / 342.0) * (1.0 - r2 * (1.0 / 420.0) * (1.0 - r2 * (1.0 / 506.0)))))))))))); }
DI double dcos_poly(double r) { const double r2 = r * r;
    return 1.0 - r2 * (1.0 / 2.0) * (1.0 - r2 * (1.0 / 12.0) * (1.0 - r2 * (1.0 / 30.0) * (1.0 - r2 * (1.0 / 56.0) * (1.0 - r2 * (1.0 / 90.0) * (1.0 - r2 * (1.0 / 132.0) * (1.0 - r2 * (1.0 / 182.0) * (1.0 - r2 * (1.0 / 240.0) * (1.0 - r2 * (1.0 / 306.0) * (1.0 - r2 * (1.0 / 380.0) * (1.0 - r2 * (1.0 / 462.0) * (1.0 - r2 * (1.0 / 552.0)))))))))))); }

constexpr int IT_MOD = DEPTH * 96 * 8;
constexpr int IT_QKV = (DM / 64) * (QKVN / 32), IT_WO = (DM / 64) * (DM / 32), IT_GU = NEXP * (DM / 64) * (FH / 32), IT_DN = NEXP * (FH / 64) * (DM / 32);
constexpr int IT_LAYER = IT_QKV + IT_WO + 2 * IT_GU + IT_DN;
constexpr int IT_TOTAL = IT_MOD + DEPTH * IT_LAYER;

DI void p0_prologue(const Params& P, const Frame& F) {
    LAS float* scr = (LAS float*)(F.lds + F.wave * 16384);
    unsigned char* ws = wsp(P);
    for (int it = F.gw; it < IT_TOTAL; it += F.NGW) {
        if (it < IT_MOD) {
            const int l = it / (96 * 8), rem = it % (96 * 8), cc = rem >> 3, ks = rem & 7;
            for (int idx = F.lane; idx < 17 * 128; idx += 64) { const int b = idx >> 7, k = idx & 127;
                const float cv = (b < 16) ? inp(P, IN_C)[b * DM + ks * 128 + k] : inp(P, IN_CCTX)[ks * 128 + k];
                scr[idx] = cv / (1.f + expf(-cv)); }
            LDS_WAIT();
            float acc[17];
#pragma unroll
            for (int b = 0; b < 17; ++b) acc[b] = 0.f;
            const float* wp = inp(P, IN_WADA) + ((size_t)l * DM + ks * 128) * 6144 + cc * 64 + F.lane;
#pragma unroll 4
            for (int k = 0; k < 128; ++k) { const float w = wp[(size_t)k * 6144];
#pragma unroll
                for (int b = 0; b < 17; ++b) acc[b] += scr[b * 128 + k] * w; }
            float* mp = (float*)(ws + WS_MODP) + ((size_t)(ks * DEPTH + l) * 17) * 6144 + cc * 64 + F.lane;
#pragma unroll
            for (int b = 0; b < 17; ++b) mp[(size_t)b * 6144] = acc[b];
            LDS_WAIT();
            continue;
        }
        int r = it - IT_MOD; const int l = r / IT_LAYER; r -= l * IT_LAYER;
        if (r < IT_QKV) { const int kb = r / (QKVN / 32), nb = r % (QKVN / 32); const int n0 = nb * 32;
            const int drow0 = 256 * (n0 >> 8) + 128 * ((n0 >> 5) & 1) + 32 * ((n0 >> 6) & 3);
            p0_transpose_item(inp(P, IN_WQKV) + (size_t)l * DM * QKVN, QKVN, kb * 64, n0, (bf16_t*)(ws + WS_WQKV) + (size_t)l * QKVN * DM + (size_t)drow0 * DM + kb * 64, DM, scr, F.lane); continue; }
        r -= IT_QKV;
        if (r < IT_WO) { const int kb = r / (DM / 32), nb = r % (DM / 32);
            p0_transpose_item(inp(P, IN_WO) + (size_t)l * DM * DM, DM, kb * 64, nb * 32, (bf16_t*)(ws + WS_WO) + (size_t)l * DM * DM + (size_t)(nb * 32) * DM + kb * 64, DM, scr, F.lane); continue; }
        r -= IT_WO;
        if (r < 2 * IT_GU) { const int which = r / IT_GU; r -= which * IT_GU; const int e = r / 256, kb = (r % 256) / 16, nb = r % 16; const int n0 = nb * 32;
            const int drow0 = 256 * (n0 >> 7) + 128 * which + (n0 & 127);
            p0_transpose_item(inp(P, which ? IN_WUP : IN_WGATE) + (size_t)(l * NEXP + e) * DM * FH, FH, kb * 64, n0,
                              (bf16_t*)(ws + WS_WGU) + (size_t)(l * NEXP + e) * DM * DM + (size_t)drow0 * DM + kb * 64, DM, scr, F.lane); continue; }
        r -= 2 * IT_GU;
        { const int e = r / 256, kb = (r % 256) / 32, nb = r % 32;
            p0_transpose_item(inp(P, IN_WDOWN) + (size_t)(l * NEXP + e) * FH * DM, DM, kb * 64, nb * 32,
                              (bf16_t*)(ws + WS_WD) + (size_t)(l * NEXP + e) * DM * FH + (size_t)(nb * 32) * FH + kb * 64, FH, scr, F.lane); }
    }
    if (F.gw == F.NGW - 1) {
        f32x2* T = (f32x2*)(ws + WS_ROPE);
        for (int idx = F.lane; idx < 64 * 16; idx += 64) { const int pos = idx >> 4, j = idx & 15;
            const float inv = exp2f(-(float)j * (1.f / 16.f) * 13.287712379549449f);
            const float ang = (float)pos * inv;
            const double a = (double)ang; const double rr = a - 6.283185307179586 * rint(a * 0.15915494309189535);
            T[idx] = (f32x2){(float)dcos_poly(rr), (float)dsin_poly(rr)}; }
    }
    { u32x4* wf = (u32x4*)(ws + WS_WRT); const float* wg = inp(P, IN_WGROUP); const float* wr = inp(P, IN_WROUTER);
      for (int idx = F.gw * 64 + F.lane; idx < DEPTH * 32 * 3 * 2 * 64; idx += F.NGW * 64) { const int l = idx / (32 * 3 * 2 * 64), rem = idx % (32 * 3 * 2 * 64), step = rem / 384, nt = (rem % 384) >> 7, which = (rem >> 6) & 1, ln = rem & 63;
          const int n = 16 * nt + (ln & 15); float w[8];
#pragma unroll
          for (int j = 0; j < 8; ++j) { const int k = 32 * step + 8 * (ln >> 4) + j;
              const float wv = (n < 4) ? wg[((size_t)l * DM + k) * 4 + n] : (n < 36 ? wr[((size_t)l * DM + k) * 32 + (n - 4)] : 0.f);
              const float w1 = bf2f(f2bf(wv)); w[j] = which ? (wv - w1) : wv; }
          u32x4 o; o.x = pk2(w[0], w[1]); o.y = pk2(w[2], w[3]); o.z = pk2(w[4], w[5]); o.w = pk2(w[6], w[7]); wf[idx] = o; } }
}
DI void p0b_mod_reduce(const Params& P, const Frame& F) {
    unsigned char* const ws = wsp(P);
    const float* mp = (const float*)(ws + WS_MODP); float* mod = (float*)(ws + WS_MOD);
    for (int idx = F.gw * 64 + F.lane; idx < DEPTH * 17 * 6144; idx += F.NGW * 64) {
        const int l = idx / (17 * 6144), c = idx % 6144;
        float s = inp(P, IN_BADA)[l * 6144 + c];
#pragma unroll
        for (int ks = 0; ks < 8; ++ks) s += mp[(size_t)ks * DEPTH * 17 * 6144 + idx];
        mod[idx] = s; }
}

DI unsigned expert_count(const unsigned char* ws, int layer, int e) { return __hip_atomic_load((const unsigned*)(ws + WS_CTL) + CW_CNT + (layer * NEXP + e) * CNT_STRIDE, __ATOMIC_RELAXED, __HIP_MEMORY_SCOPE_AGENT); }
DI unsigned expert_starts(const unsigned char* ws, int layer, int lane) {
    const unsigned p = (lane < NEXP) ? ((expert_count(ws, layer, lane & 31) + 255u) & ~255u) : 0u; unsigned incl = p;
#pragma unroll
    for (int d = 1; d < 32; d <<= 1) { const unsigned v = __shfl_up(incl, d); if ((lane & 31) >= d) incl += v; }
    return incl - p;
}

DI void load_row(const float* row, int lane, f32x4 (&v)[4]) {
#pragma unroll
    for (int j = 0; j < 4; ++j) v[j] = *(const f32x4*)(row + 4 * lane + 256 * j);
}
DI void load_row_bf(const bf16_t* row, int lane, f32x4 (&v)[4]) {
#pragma unroll
    for (int j = 0; j < 4; ++j) { const u32x2 w = *(const u32x2*)(row + 4 * lane + 256 * j); v[j] = (f32x4){bf2f(w.x & 0xffffu), bf2f(w.x >> 16), bf2f(w.y & 0xffffu), bf2f(w.y >> 16)}; }
}
DI float row_rstd(const f32x4 (&v)[4]) {
    float s = 0.f;
#pragma unroll
    for (int j = 0; j < 4; ++j) s += (v[j][0] * v[j][0] + v[j][1] * v[j][1]) + (v[j][2] * v[j][2] + v[j][3] * v[j][3]);
    return 1.0f / sqrtf(wave_sum(s) * (1.f / DM) + NORM_EPS);
}
DI void load_vec(const float* p, int lane, f32x4 (&v)[4]) {
#pragma unroll
    for (int j = 0; j < 4; ++j) v[j] = *(const f32x4*)(p + 4 * lane + 256 * j);
}
DI void norm_mod_store(const f32x4 (&v)[4], float rstd, const f32x4 (&gg)[4], const f32x4 (&sh)[4], const f32x4 (&sc)[4], bf16_t* hrow, int lane) {
#pragma unroll
    for (int j = 0; j < 4; ++j) { const int c = 4 * lane + 256 * j;
        const f32x4 hf = (v[j] * rstd * gg[j]) * (1.f + sc[j]) + sh[j];
        u32x2 w; w.x = pk2(hf[0], hf[1]); w.y = pk2(hf[2], hf[3]); *(u32x2*)(hrow + c) = w; }
}
struct RowIn { f32x4 x[4]; u32x2 ya[4], yb[4]; };
DI void row_fetch(const unsigned char* ws, const float* xrow, const bf16_t* xrow_bf, int t, unsigned s0, unsigned s1, int lane, bool prev, RowIn& R) {
    if (xrow_bf) load_row_bf(xrow_bf, lane, R.x); else load_row(xrow, lane, R.x);
    if (prev) {
        const bf16_t* Y = (const bf16_t*)(ws + WS_Y);
#pragma unroll
        for (int j = 0; j < 4; ++j) { R.ya[j] = *(const u32x2*)(Y + (size_t)s0 * DM + 4 * lane + 256 * j); R.yb[j] = *(const u32x2*)(Y + (size_t)s1 * DM + 4 * lane + 256 * j); } }
}
DI void row_apply(const f32x4 (&gt)[4], float w0, float w1, RowIn& R) {
#pragma unroll
    for (int j = 0; j < 4; ++j) { const f32x4 g = gt[j]; const u32x2 a = R.ya[j], b = R.yb[j];
        R.x[j][0] += g[0] * (w0 * bf2f(a.x & 0xffffu) + w1 * bf2f(b.x & 0xffffu)); R.x[j][1] += g[1] * (w0 * bf2f(a.x >> 16) + w1 * bf2f(b.x >> 16));
        R.x[j][2] += g[2] * (w0 * bf2f(a.y & 0xffffu) + w1 * bf2f(b.y & 0xffffu)); R.x[j][3] += g[3] * (w0 * bf2f(a.y >> 16) + w1 * bf2f(b.y >> 16)); }
}
DI void phase_attn_norm(const Params& P, const Frame& F0, int layer) {
    const Frame F = opaque_frame(F0);
    unsigned char* const ws = wsp(P);
    bf16_t* X = (bf16_t*)(ws + WS_X); bf16_t* H = (bf16_t*)(ws + WS_H);
    const bool prev = layer > 0;
    const int nrow = (TALL - F.gw + F.NGW - 1) / F.NGW;
    unsigned ms0 = 0, ms1 = 0; float mw0 = 0.f, mw1 = 0.f;
    if (prev) { const unsigned pst = expert_starts(ws, layer - 1, F.lane); u32x2 a = (u32x2){0u, 0u};
        if (F.lane < nrow) { const int tl = F.gw + F.lane * F.NGW; a = *(const u32x2*)((const unsigned*)(ws + WS_ASG) + (size_t)tl * 2); const f32x2 w = *(const f32x2*)((const float*)(ws + WS_ASGW) + (size_t)tl * 2); mw0 = w.x; mw1 = w.y; }
        ms0 = (unsigned)__shfl((int)pst, (int)(a.x >> 20)) + (a.x & 0xfffffu); ms1 = (unsigned)__shfl((int)pst, (int)(a.y >> 20)) + (a.y & 0xfffffu); }
    auto xsrc = [&](int t) -> const float* { return (t < TLAT ? inp(P, IN_X) + (size_t)t * DM : inp(P, IN_CTX) + (size_t)(t - TLAT) * DM); };
    auto xbf = [&](int t) -> const bf16_t* { return prev ? X + (size_t)t * DM : (const bf16_t*)nullptr; };
    RowIn cur, nxt;
    f32x4 gat[4]; load_vec(inp(P, IN_GATTN) + layer * DM, F.lane, gat);
    row_fetch(ws, xsrc(F.gw), xbf(F.gw), F.gw, __shfl(ms0, 0), __shfl(ms1, 0), F.lane, prev, cur);
    for (int i = 0; i < nrow; ++i) {
        const int t = F.gw + i * F.NGW; const int mb = (t < TLAT) ? (t >> 11) : 16;
        const float* md = (const float*)(ws + WS_MOD) + ((size_t)layer * 17 + mb) * 6144;
        f32x4 gt[4], sh[4], sc[4];
        if (prev) load_vec(md - 17 * 6144 + 5120, F.lane, gt);
        load_vec(md, F.lane, sh); load_vec(md + 1024, F.lane, sc);
        asm volatile("" ::: "memory");
        if (i + 1 < nrow) row_fetch(ws, xsrc(t + F.NGW), xbf(t + F.NGW), t + F.NGW, __shfl(ms0, i + 1), __shfl(ms1, i + 1), F.lane, prev, nxt);
        if (prev) row_apply(gt, __shfl(mw0, i), __shfl(mw1, i), cur);
#pragma unroll
        for (int j = 0; j < 4; ++j) { u32x2 w; w.x = pk2(cur.x[j][0], cur.x[j][1]); w.y = pk2(cur.x[j][2], cur.x[j][3]); *(u32x2*)(X + (size_t)t * DM + 4 * F.lane + 256 * j) = w; }
        const float rstd = row_rstd(cur.x);
        norm_mod_store(cur.x, rstd, gat, sh, sc, H + (size_t)t * DM, F.lane);
        cur = nxt;
    }
}
DI void phase_final(const Params& P, const Frame& F0) {
    const Frame F = opaque_frame(F0);
    unsigned char* const ws = wsp(P);
    const bf16_t* X = (const bf16_t*)(ws + WS_X);
    const float pc = PROBE_SEL ? *((const float*)(ws + WS_CTL) + 64) : 0.f;
    const int nrow = (TLAT - F.gw + F.NGW - 1) / F.NGW;
    unsigned ms0 = 0, ms1 = 0; float mw0 = 0.f, mw1 = 0.f;
    { const unsigned pst = expert_starts(ws, DEPTH - 1, F.lane); u32x2 a = (u32x2){0u, 0u};
      if (F.lane < nrow) { const int tl = F.gw + F.lane * F.NGW; a = *(const u32x2*)((const unsigned*)(ws + WS_ASG) + (size_t)tl * 2); const f32x2 w = *(const f32x2*)((const float*)(ws + WS_ASGW) + (size_t)tl * 2); mw0 = w.x; mw1 = w.y; }
      ms0 = (unsigned)__shfl((int)pst, (int)(a.x >> 20)) + (a.x & 0xfffffu); ms1 = (unsigned)__shfl((int)pst, (int)(a.y >> 20)) + (a.y & 0xfffffu); }
    RowIn cur, nxt;
    row_fetch(ws, nullptr, X + (size_t)F.gw * DM, F.gw, __shfl(ms0, 0), __shfl(ms1, 0), F.lane, true, cur);
    f32x4 gfin[4]; load_vec(inp(P, IN_GFINAL), F.lane, gfin);
    for (int i = 0; i < nrow; ++i) {
        const int t = F.gw + i * F.NGW;
        f32x4 gt[4]; load_vec((const float*)(ws + WS_MOD) + ((size_t)(DEPTH - 1) * 17 + (t >> 11)) * 6144 + 5120, F.lane, gt);
        asm volatile("" ::: "memory");
        if (i + 1 < nrow) row_fetch(ws, nullptr, X + (size_t)(t + F.NGW) * DM, t + F.NGW, __shfl(ms0, i + 1), __shfl(ms1, i + 1), F.lane, true, nxt);
        row_apply(gt, __shfl(mw0, i), __shfl(mw1, i), cur);
        const float rstd = row_rstd(cur.x);
#pragma unroll
        for (int j = 0; j < 4; ++j) { const int c = 4 * F.lane + 256 * j; *(f32x4*)(P.out + (size_t)t * DM + c) = cur.x[j] * rstd * gfin[j] + pc; }
        cur = nxt;
    }
}

DI float swap_max(float v) { auto rr = __builtin_amdgcn_permlane32_swap(__float_as_uint(v), __float_as_uint(v), false, false); return fmaxf(__uint_as_float(rr[0]), __uint_as_float(rr[1])); }
DI float swap_add(float v) { auto rr = __builtin_amdgcn_permlane32_swap(__float_as_uint(v), __float_as_uint(v), false, false); return __uint_as_float(rr[0]) + __uint_as_float(rr[1]); }
DI bf16x8 pack_p(const f32x16& p, int s) {
    u32x4 w; w.x = cvt_pk_bf16(p[8 * s + 0], p[8 * s + 1]); w.y = cvt_pk_bf16(p[8 * s + 2], p[8 * s + 3]); w.z = cvt_pk_bf16(p[8 * s + 4], p[8 * s + 5]); w.w = cvt_pk_bf16(p[8 * s + 6], p[8 * s + 7]);
    return __builtin_bit_cast(bf16x8, w);
}
struct AttnState { float m, l; f32x16 o[2]; };
DI void load_k(const unsigned char* Kbh, int kg, int r32, int hi, bf16x8 (&k)[4]) {
    const unsigned char* kb = Kbh + (size_t)(kg + (r32 >> 3)) * 1024 + hi * 128 + (r32 & 7) * 16;
#pragma unroll
    for (int d0 = 0; d0 < 4; ++d0) k[d0] = *(const bf16x8*)(kb + d0 * 256);
}
DI void load_v(const unsigned char* Vbh, int kg, int r32, int hi, s16x4 (&v)[2][2][2]) {
    const unsigned char* vb = Vbh + (size_t)kg * 1024 + r32 * 16 + hi * 8;
#pragma unroll
    for (int dh = 0; dh < 2; ++dh)
#pragma unroll
        for (int ks = 0; ks < 2; ++ks)
#pragma unroll
            for (int pt = 0; pt < 2; ++pt) v[dh][ks][pt] = *(const s16x4*)(vb + dh * 512 + (2 * ks + pt) * 1024);
}
DI f32x16 attn_scores(const bf16x8 (&k)[4], const bf16x8 (&q)[4]) {
    f32x16 s;
#pragma unroll
    for (int r = 0; r < 16; ++r) s[r] = 0.f;
#pragma unroll
    for (int d0 = 0; d0 < 4; ++d0) s = __builtin_amdgcn_mfma_f32_32x32x16_bf16(k[d0], q[d0], s, 0, 0, 0);
    return s;
}
DI float row_max16(const f32x16& s) {
    float mt = fmaxf(fmaxf(s[0], s[1]), fmaxf(s[2], s[3]));
#pragma unroll
    for (int r = 4; r < 16; r += 4) mt = fmaxf(mt, fmaxf(fmaxf(s[r], s[r + 1]), fmaxf(s[r + 2], s[r + 3])));
    return mt;
}
DI void attn_rescale(AttnState& st, f32x16& s, float mt, LAS float* wsf, int r32, int hi) {
    mt = swap_max(mt);
    const float dm = fmaxf(mt, 0.f);
    const float al = __builtin_amdgcn_exp2f(-dm);
    st.l *= al; st.m += dm;
#pragma unroll
    for (int r = 0; r < 16; ++r) s[r] -= dm;
    if (hi == 0) wsf[r32] = al;
    LDS_WAIT();
#pragma unroll
    for (int r = 0; r < 16; ++r) { const float f = wsf[crow(r, hi)]; st.o[0][r] *= f; st.o[1][r] *= f; }
    LDS_WAIT();
}
DI void attn_exp_pv(AttnState& st, f32x16& s, const s16x4 (&v)[2][2][2]) {
    float p0 = 0.f, p1 = 0.f;
#pragma unroll
    for (int r = 0; r < 16; r += 2) { s[r] = __builtin_amdgcn_exp2f(s[r]); s[r + 1] = __builtin_amdgcn_exp2f(s[r + 1]); p0 += s[r]; p1 += s[r + 1]; }
    st.l += p0 + p1;
    const bf16x8 pa0 = pack_p(s, 0), pa1 = pack_p(s, 1);
#pragma unroll
    for (int dh = 0; dh < 2; ++dh) {
        const bf16x8 vf0 = __builtin_shufflevector(v[dh][0][0], v[dh][0][1], 0, 1, 2, 3, 4, 5, 6, 7);
        const bf16x8 vf1 = __builtin_shufflevector(v[dh][1][0], v[dh][1][1], 0, 1, 2, 3, 4, 5, 6, 7);
        st.o[dh] = __builtin_amdgcn_mfma_f32_32x32x16_bf16(pa0, vf0, st.o[dh], 0, 0, 0);
        st.o[dh] = __builtin_amdgcn_mfma_f32_32x32x16_bf16(pa1, vf1, st.o[dh], 0, 0, 0);
    }
}
DI void attn_softmax_pv2(AttnState (&st)[2], f32x16 (&s)[2], const s16x4 (&v)[2][2][2], LAS float* wsf, int r32, int hi) {
#pragma unroll
    for (int r = 0; r < 16; ++r) { s[0][r] -= st[0].m; s[1][r] -= st[1].m; }
    const float mt0 = row_max16(s[0]), mt1 = row_max16(s[1]);
    if (__any(fmaxf(mt0, mt1) > 8.f)) { attn_rescale(st[0], s[0], mt0, wsf, r32, hi); attn_rescale(st[1], s[1], mt1, wsf + 32, r32, hi); }
    attn_exp_pv(st[0], s[0], v);
    attn_exp_pv(st[1], s[1], v);
}
template <int MODE>
DI void attn_unit(const Params& P, unsigned char* ws, int layer, int b, int h0, int qblk, LAS unsigned char* wl, int lane) {
    const int r32 = lane & 31, hi = lane >> 5, kvh = h0 >> 2, m = layer % 3;
    constexpr bool VDB = false;
    LAS float* wsf = (LAS float*)wl; LAS bf16_t* stg = (LAS bf16_t*)(wl + 256); LAS float* rpbt = (LAS float*)(wl + 256 + 4096);
    const bf16_t* QKV = (const bf16_t*)(ws + WS_QKV);
    const unsigned char* Kbh = ws + WS_KF + (size_t)(b * NKV + kvh) * KGRP * 1024;
    const unsigned char* Vbh = ws + WS_VF + (size_t)(b * NKV + kvh) * KGRP * 1024;
    bf16_t* O = (bf16_t*)(ws + WS_O);
    int r0 = 0, c0 = 0;
    if (MODE == 2) { r0 = 2 * (qblk >> 2); c0 = 16 * (qblk & 3); }
    auto qtok = [&](int i) -> int {
        if (MODE == 3) return TLAT + b * CTXL + qblk * 32 + i;
        if (MODE == 2) return b * SEQ + (r0 + (i >> 4)) * 64 + c0 + (i & 15);
        return b * SEQ + qblk * 32 + i; };
    const int tq = qtok(r32);
    const bf16_t* qp = QKV + (size_t)tq * QKVN + h0 * HD + hi * 8;
    bf16x8 qr[2][4];
#pragma unroll
    for (int hh = 0; hh < 2; ++hh)
#pragma unroll
        for (int d0 = 0; d0 < 4; ++d0) qr[hh][d0] = *(const bf16x8*)(qp + hh * HD + d0 * 16);
    const int q0 = qblk * 32;
    int nl = 0, jlo = 0, rs_min = 0, cseg = 0;
    if (MODE == 0) { jlo = (q0 < 128) ? (128 - q0) / 32 : 0; const int jhi = min(8, (SEQ - 32 - q0 + 128) / 32); nl = jhi - jlo + 1; }
    if (MODE == 1) nl = SEQ / 32;
    if (MODE == 2) { rs_min = min(max(r0 - 4, 0), 24); const int rs_max = min(max(r0 + 1 - 4, 0), 24); nl = rs_max - rs_min + 8; cseg = (c0 == 0) ? 0 : (c0 == 16) ? 8 : (c0 == 32) ? 24 : 32; }
    auto lat_kg = [&](int i) -> int {
        if (MODE == 0) return (q0 - 128 + 32 * (jlo + i)) >> 3;
        if (MODE == 1) return 4 * i;
        return ((rs_min + i) * 64 + cseg) >> 3; };
    bf16x8 kn[4];
    load_k(Kbh, nl > 0 ? lat_kg(0) : SEQ / 8, r32, hi, kn);
    if (MODE == 0 || MODE == 1) {
        const int n = tq & 2047; const f32x2* T = (const f32x2*)(ws + WS_ROPE);
        const f32x2* tr = T + (n >> 6) * 16 + 8 * hi; const f32x2* tc = T + (n & 63) * 16 + 8 * hi;
#pragma unroll
        for (int e = 0; e < 8; ++e) { const f32x2 a = tr[e], cc = tc[e];
#pragma unroll
            for (int hh = 0; hh < 2; ++hh) {
                const float x1 = bfs2f(qr[hh][0][e]), x2 = bfs2f(qr[hh][1][e]), x3 = bfs2f(qr[hh][2][e]), x4 = bfs2f(qr[hh][3][e]);
                qr[hh][0][e] = (short)f2bf(x1 * a.x - x2 * a.y); qr[hh][1][e] = (short)f2bf(x2 * a.x + x1 * a.y);
                qr[hh][2][e] = (short)f2bf(x3 * cc.x - x4 * cc.y); qr[hh][3][e] = (short)f2bf(x4 * cc.x + x3 * cc.y); } }
    }
    LAS bf16x8* qlds = (LAS bf16x8*)(wl + 8192) + lane;
    if (VDB) {
#pragma unroll
        for (int d0 = 0; d0 < 4; ++d0) qlds[d0 * 64] = qr[1][d0];
        LDS_WAIT();
    }
    int rq = 0, cq = 0, rsq = 0, csq = 0;
    if (MODE == 2) {
        const float* rpb = inp(P, IN_RPB) + (size_t)h0 * 465;
#pragma unroll 1
        for (int k0 = 0; k0 < 15; k0 += 5) {
            float tv[5];
#pragma unroll
            for (int k = 0; k < 5; ++k) { const int i = lane + 64 * (k0 + k); tv[k] = rpb[i < 930 ? i : 929]; }
#pragma unroll
            for (int k = 0; k < 5; ++k) { const int i = lane + 64 * (k0 + k); if (i < 930) rpbt[i + (i >= 465 ? 7 : 0)] = tv[k] * LOG2E; } }
        LDS_WAIT();
        rq = r0 + (r32 >> 4); cq = c0 + (r32 & 15); rsq = min(max(rq - 4, 0), 24); csq = min(max(cq - 8, 0), 48);
    }
    AttnState st[2];
#pragma unroll
    for (int hh = 0; hh < 2; ++hh) { st[hh].m = -1024.f; st[hh].l = 0.f;
#pragma unroll
        for (int r = 0; r < 16; ++r) { st[hh].o[0][r] = 0.f; st[hh].o[1][r] = 0.f; } }
    const float NEG = -INFINITY;
    s16x4 vn[2][2][2];
    if (VDB) load_v(Vbh, nl > 0 ? lat_kg(0) : SEQ / 8, r32, hi, vn);
    for (int i = 0; i < nl; ++i) {
        const int kgn = (i + 1 < nl) ? lat_kg(i + 1) : SEQ / 8;
        s16x4 v[2][2][2];
        if (VDB) {
#pragma unroll
            for (int a = 0; a < 2; ++a)
#pragma unroll
                for (int c = 0; c < 2; ++c)
#pragma unroll
                    for (int e = 0; e < 2; ++e) v[a][c][e] = vn[a][c][e];
        } else load_v(Vbh, lat_kg(i), r32, hi, v);
        f32x16 s[2];
        s[0] = attn_scores(kn, qr[0]);
        if (VDB) { bf16x8 q1[4];
#pragma unroll
            for (int d0 = 0; d0 < 4; ++d0) q1[d0] = qlds[d0 * 64];
            s[1] = attn_scores(kn, q1); }
        else s[1] = attn_scores(kn, qr[1]);
        load_k(Kbh, kgn, r32, hi, kn);
        if (VDB) load_v(Vbh, kgn, r32, hi, vn);
        if (MODE == 0) {
            const int j = jlo + i;
            if (j == 0 || j == 8) { const int kt = q0 - 128 + 32 * j, qpos = q0 + r32;
#pragma unroll
                for (int r = 0; r < 16; ++r) { const int d = kt + crow(r, hi) - qpos; if (d > 128 || d < -128) { s[0][r] = NEG; s[1][r] = NEG; } } }
        }
        if (MODE == 2) {
            const int kr = rs_min + i;
            const bool rowok = (kr >= rsq) && (kr < rsq + 8);
            const int ib = (kr - rq + 7) * 31 - cq + 15;
#pragma unroll
            for (int r = 0; r < 16; ++r) { const int kc2 = cseg + crow(r, hi); const bool ok = rowok && (kc2 >= csq) && (kc2 < csq + 16);
                const int idx = min(max(ib + kc2, 0), 464);
                s[0][r] = ok ? s[0][r] + rpbt[idx] : NEG; s[1][r] = ok ? s[1][r] + rpbt[472 + idx] : NEG; }
        }
        attn_softmax_pv2(st, s, v, wsf, r32, hi);
    }
    if (MODE == 0 || MODE == 1) {
#pragma unroll
        for (int hh = 0; hh < 2; ++hh)
#pragma unroll
            for (int d0 = 0; d0 < 4; ++d0) qr[hh][d0] = *(const bf16x8*)(qp + hh * HD + d0 * 16);
        if (VDB) {
#pragma unroll
            for (int d0 = 0; d0 < 4; ++d0) qlds[d0 * 64] = qr[1][d0];
            LDS_WAIT();
        }
    }
    for (int j = 0; j < CTXL / 32; ++j) {
        const int kg = SEQ / 8 + 4 * j, kgn = (j + 1 < CTXL / 32) ? kg + 4 : kg;
        s16x4 v[2][2][2];
        if (VDB) {
#pragma unroll
            for (int a = 0; a < 2; ++a)
#pragma unroll
                for (int c = 0; c < 2; ++c)
#pragma unroll
                    for (int e = 0; e < 2; ++e) v[a][c][e] = vn[a][c][e];
        } else load_v(Vbh, kg, r32, hi, v);
        f32x16 s[2];
        s[0] = attn_scores(kn, qr[0]);
        if (VDB) { bf16x8 q1[4];
#pragma unroll
            for (int d0 = 0; d0 < 4; ++d0) q1[d0] = qlds[d0 * 64];
            s[1] = attn_scores(kn, q1); }
        else s[1] = attn_scores(kn, qr[1]);
        load_k(Kbh, kgn, r32, hi, kn);
        if (VDB) load_v(Vbh, kgn, r32, hi, vn);
        attn_softmax_pv2(st, s, v, wsf, r32, hi);
    }
    int lane2 = lane; asm volatile("" : "+v"(lane2));
    const int r32b = lane2 & 31, hib = lane2 >> 5;
#pragma unroll
    for (int hh = 0; hh < 2; ++hh) {
        const float lt = swap_add(st[hh].l);
        float inv;
        if (MODE == 0 || (MODE == 3 && m == 0)) { const float sk = inp(P, IN_SINK)[(layer / 3) * NH + h0 + hh] * LOG2E;
            const float mnew = fmaxf(st[hh].m, sk); const float al = __builtin_amdgcn_exp2f(st[hh].m - mnew), es = __builtin_amdgcn_exp2f(sk - mnew);
            inv = al / (lt * al + es); }
        else inv = 1.f / lt;
        if (hib == 0) wsf[r32b] = inv;
        LDS_WAIT();
        LAS bf16_t* sb = stg + hib * 256 + r32b;
        const LAS float* wf = wsf + 4 * hib;
#pragma unroll
        for (int r = 0; r < 16; ++r) { const float f = wf[(r & 3) + 8 * (r >> 2)];
            sb[((r & 3) + 8 * (r >> 2)) * 64] = (bf16_t)f2bf(st[hh].o[0][r] * f); sb[((r & 3) + 8 * (r >> 2)) * 64 + 32] = (bf16_t)f2bf(st[hh].o[1][r] * f); }
        LDS_WAIT();
        const int rw = lane2 >> 3, ch = lane2 & 7;
        const LAS unsigned char* rb = (const LAS unsigned char*)stg + rw * 128 + ch * 16;
#pragma unroll
        for (int i = 0; i < 4; ++i) { const u32x4 vv = *(const LAS u32x4*)(rb + i * 1024);
            *(u32x4*)(O + (size_t)qtok(i * 8 + rw) * DM + (h0 + hh) * HD + ch * 8) = vv; }
        LDS_WAIT();
    }
}
DI void phase_attention(const Params& P, const Frame& F0, int layer) {
    const Frame F = opaque_frame(F0);
    unsigned char* const ws = wsp(P);
    const int m = layer % 3;
    LAS unsigned char* wl = F.lds + F.wave * 16384;
    for (int bu = F.blk; bu < NB * NKV * 16; bu += F.G) {
        const int rnd = bu >> 8, x = bu & 7, loc = (bu & 255) >> 3;
        const int bkv = rnd * 16 + x * 2 + (loc >> 4), qg = loc & 15;
        const int b = bkv >> 2, kvh = bkv & 3, h0 = kvh * 4 + 2 * (F.wave & 1), qblk = 4 * qg + (F.wave >> 1);
        if (m == 0) attn_unit<0>(P, ws, layer, b, h0, qblk, wl, F.lane);
        else if (m == 1) attn_unit<1>(P, ws, layer, b, h0, qblk, wl, F.lane);
        else attn_unit<2>(P, ws, layer, b, h0, qblk, wl, F.lane);
    }
    if (layer < DEPTH - 1) {
        for (int bu = F.blk; bu < NB * NKV * 2; bu += F.G) {
            const int bkv = bu >> 1, b = bkv >> 2, kvh = bkv & 3, h0 = kvh * 4 + 2 * (F.wave & 1), qblk = 4 * (bu & 1) + (F.wave >> 1);
            attn_unit<3>(P, ws, layer, b, h0, qblk, wl, F.lane);
        }
    }
}

DI int blk_token(int blk, int i) { return i < 128 ? blk * 128 + i : TLAT + blk * 16 + (i - 128); }
constexpr int RT_ROWB = 2064;
constexpr int RT_X2_OFF = 16 * RT_ROWB, RT_PART_OFF = 2 * 16 * RT_ROWB, RT_LOG_OFF = RT_PART_OFF + 8 * 16 * 48 * 4, RT_LOGS = 37, RT_VEC_OFF = RT_LOG_OFF + 144 * RT_LOGS * 4;
DI void phase_router(const Params& P, const Frame& F0, int layer, int M) {
    const Frame F = opaque_frame(F0);
    unsigned char* const ws = wsp(P);
    const int TPB = M / GRID, nchunk = TPB / 16;
    LAS int* hist = (LAS int*)(F.lds + LDSX_OFF);
    LAS float* part = (LAS float*)(F.lds + RT_PART_OFF); LAS float* logit = (LAS float*)(F.lds + RT_LOG_OFF);
    if (F.tid < 32) hist[F.tid] = 0;
    const bf16_t* X = (const bf16_t*)(ws + WS_X); bf16_t* H = (bf16_t*)(ws + WS_H);
    const float* gffn = inp(P, IN_GFFN) + layer * DM;
    const u32x4* wf = (const u32x4*)(ws + WS_WRT) + ((size_t)layer * 32 + 4 * F.wave) * 384 + F.lane;
    bf16x8 wreg[4][2][2];
#pragma unroll
    for (int s = 0; s < 4; ++s)
#pragma unroll
        for (int nt = 0; nt < 2; ++nt)
#pragma unroll
            for (int wh = 0; wh < 2; ++wh) wreg[s][nt][wh] = __builtin_bit_cast(bf16x8, wf[s * 384 + nt * 128 + wh * 64]);
    bf16x8 w2t[4][2];
#pragma unroll
    for (int s = 0; s < 4; ++s)
#pragma unroll
        for (int wh = 0; wh < 2; ++wh) w2t[s][wh] = __builtin_bit_cast(bf16x8, wf[s * 384 + 256 + wh * 64]);
    LAS float* vec = (LAS float*)(F.lds + RT_VEC_OFF);
    auto load_vecs = [&](int mb) {
        const float* md = (const float*)(ws + WS_MOD) + ((size_t)layer * 17 + mb) * 6144;
        for (int i = F.tid; i < 256; i += NTHREADS) { const f32x4 g = *(const f32x4*)(gffn + 4 * i), sc = *(const f32x4*)(md + 4096 + 4 * i);
            *(LAS f32x4*)(vec + 4 * i) = *(const f32x4*)(md + 2048 + 4 * i); *(LAS f32x4*)(vec + 1024 + 4 * i) = g * (1.f + sc); *(LAS f32x4*)(vec + 2048 + 4 * i) = *(const f32x4*)(md + 3072 + 4 * i); } };
    load_vecs(F.blk >> 4);
    const int ib = 2 * F.wave;
    f32x4 vn[2][4];
#pragma unroll
    for (int tk = 0; tk < 2; ++tk) { const int t = blk_token(F.blk, ib + tk); load_row_bf(X + (size_t)t * DM, F.lane, vn[tk]); }
    LDS_WAIT(); __syncthreads();
    for (int c = 0; c < nchunk; ++c) {
        if (c == 8) { load_vecs(16); LDS_WAIT(); __syncthreads(); }
#pragma unroll
        for (int tk = 0; tk < 2; ++tk) { const int t = blk_token(F.blk, c * 16 + ib + tk);
            const float rstd = row_rstd(vn[tk]);
            LAS unsigned char* r1 = F.lds + (ib + tk) * RT_ROWB + 8 * F.lane; bf16_t* hrow = H + (size_t)t * DM;
#pragma unroll
            for (int j = 0; j < 4; ++j) { const int cc = 4 * F.lane + 256 * j; const f32x4 ga = *(const LAS f32x4*)(vec + 1024 + cc), sh = *(const LAS f32x4*)(vec + 2048 + cc);
                const f32x4 hf = (vn[tk][j] * rstd) * ga + sh;
                u32x2 a; a.x = pk2(hf[0], hf[1]); a.y = pk2(hf[2], hf[3]);
                u32x2 b; b.x = pk2(hf[0] - bf2f(a.x & 0xffffu), hf[1] - bf2f(a.x >> 16)); b.y = pk2(hf[2] - bf2f(a.y & 0xffffu), hf[3] - bf2f(a.y >> 16));
                *(u32x2*)(hrow + cc) = a; *(LAS u32x2*)(r1 + 512 * j) = a; *(LAS u32x2*)(r1 + RT_X2_OFF + 512 * j) = b; } }
        if (c + 1 < nchunk) {
#pragma unroll
            for (int tk = 0; tk < 2; ++tk) { const int t = blk_token(F.blk, (c + 1) * 16 + ib + tk); load_row_bf(X + (size_t)t * DM, F.lane, vn[tk]); }
        }
        LDS_WAIT(); __syncthreads();
        f32x4 acc[3];
#pragma unroll
        for (int nt = 0; nt < 3; ++nt) acc[nt] = (f32x4){0.f, 0.f, 0.f, 0.f};
        { const LAS unsigned char* ap = F.lds + (F.lane & 15) * RT_ROWB + 256 * F.wave + 16 * (F.lane >> 4);
#pragma unroll
          for (int s = 0; s < 4; ++s) { const bf16x8 a1 = *(const LAS bf16x8*)(ap + 64 * s), a2 = *(const LAS bf16x8*)(ap + RT_X2_OFF + 64 * s);
#pragma unroll
              for (int nt = 0; nt < 2; ++nt) { acc[nt] = __builtin_amdgcn_mfma_f32_16x16x32_bf16(a1, wreg[s][nt][0], acc[nt], 0, 0, 0);
                  acc[nt] = __builtin_amdgcn_mfma_f32_16x16x32_bf16(a1, wreg[s][nt][1], acc[nt], 0, 0, 0); acc[nt] = __builtin_amdgcn_mfma_f32_16x16x32_bf16(a2, wreg[s][nt][0], acc[nt], 0, 0, 0); }
              acc[2] = __builtin_amdgcn_mfma_f32_16x16x32_bf16(a1, w2t[s][0], acc[2], 0, 0, 0);
              acc[2] = __builtin_amdgcn_mfma_f32_16x16x32_bf16(a1, w2t[s][1], acc[2], 0, 0, 0); acc[2] = __builtin_amdgcn_mfma_f32_16x16x32_bf16(a2, w2t[s][0], acc[2], 0, 0, 0); } }
        { LAS float* pp = part + F.wave * 768 + (4 * (F.lane >> 4)) * 48 + (F.lane & 15);
#pragma unroll
          for (int nt = 0; nt < 3; ++nt)
#pragma unroll
              for (int r = 0; r < 4; ++r) pp[r * 48 + 16 * nt] = acc[nt][r]; }
        LDS_WAIT(); __syncthreads();
        { const int tk = F.tid >> 5, n = F.tid & 31; float s = 0.f;
#pragma unroll
          for (int w = 0; w < 8; ++w) s += part[w * 768 + tk * 48 + n];
          logit[(c * 16 + tk) * RT_LOGS + n] = s;
          if (F.tid < 64) { const int tk2 = F.tid >> 2, n2 = 32 + (F.tid & 3); float s2 = 0.f;
#pragma unroll
              for (int w = 0; w < 8; ++w) s2 += part[w * 768 + tk2 * 48 + n2];
              logit[(c * 16 + tk2) * RT_LOGS + n2] = s2; } }
    }
    LDS_WAIT(); __syncthreads();
    int rt_t = 0, rt_e1 = 0, rt_e2 = 0, rt_q1 = 0, rt_q2 = 0; float rt_w1 = 0.f, rt_w2 = 0.f;
    if (F.tid < TPB) { const int t = blk_token(F.blk, F.tid); const LAS float* lg = logit + F.tid * RT_LOGS;
        const float* bg = inp(P, IN_BGROUP) + layer * 4; const float* br = inp(P, IN_BROUTER) + layer * 32;
        const float g0 = lg[0] + bg[0], g1 = lg[1] + bg[1], g2 = lg[2] + bg[2], g3 = lg[3] + bg[3];
        int grp = 0; float gm = g0; if (g1 > gm) { gm = g1; grp = 1; } if (g2 > gm) { gm = g2; grp = 2; } if (g3 > gm) { gm = g3; grp = 3; }
        const float ptop = 1.f / (expf(g0 - gm) + expf(g1 - gm) + expf(g2 - gm) + expf(g3 - gm));
        float ev[8], em = -INFINITY;
#pragma unroll
        for (int j = 0; j < 8; ++j) { ev[j] = lg[4 + grp * 8 + j] + br[grp * 8 + j]; em = fmaxf(em, ev[j]); }
        float pe[8];
#pragma unroll
        for (int j = 0; j < 8; ++j) pe[j] = expf(ev[j] - em);
        int i1 = 0; float p1 = pe[0];
#pragma unroll
        for (int j = 1; j < 8; ++j) if (pe[j] > p1) { p1 = pe[j]; i1 = j; }
        int i2 = 0; float p2 = -1.f;
#pragma unroll
        for (int j = 0; j < 8; ++j) if (j != i1 && pe[j] > p2) { p2 = pe[j]; i2 = j; }
        const float w1 = ptop * p1 / (p1 + p2), w2 = ptop * p2 / (p1 + p2);
        const int e1 = grp * 8 + i1, e2 = grp * 8 + i2;
        rt_q1 = atomicAdd((int*)&hist[e1], 1); rt_q2 = atomicAdd((int*)&hist[e2], 1);
        rt_t = t; rt_e1 = e1; rt_e2 = e2; rt_w1 = w1; rt_w2 = w2; }
    __syncthreads();
    LAS unsigned* gbase = (LAS unsigned*)(hist + 32);
    if (F.tid < 32) gbase[F.tid] = __hip_atomic_fetch_add((unsigned*)(ws + WS_CTL) + CW_CNT + (layer * NEXP + F.tid) * CNT_STRIDE, (unsigned)hist[F.tid], __ATOMIC_RELAXED, __HIP_MEMORY_SCOPE_AGENT);
    LDS_WAIT(); __syncthreads();
    if (F.tid < TPB) { const unsigned i1 = gbase[rt_e1] + (unsigned)rt_q1, i2 = gbase[rt_e2] + (unsigned)rt_q2;
        unsigned* asg = (unsigned*)(ws + WS_ASG); float* asgw = (float*)(ws + WS_ASGW); unsigned* toke = (unsigned*)(ws + WS_TOKE);
        *(u32x2*)(asg + (size_t)rt_t * 2) = (u32x2){((unsigned)rt_e1 << 20) | i1, ((unsigned)rt_e2 << 20) | i2};
        *(f32x2*)(asgw + (size_t)rt_t * 2) = (f32x2){rt_w1, rt_w2};
        toke[(size_t)rt_e1 * TALL + i1] = (unsigned)rt_t; toke[(size_t)rt_e2 * TALL + i2] = (unsigned)rt_t; }
}
DI void build_tile_table(const Params& P, const Frame& F0, LAS unsigned* tab, int layer) {
    const Frame F = opaque_frame(F0);
    unsigned char* const ws = wsp(P);
    constexpr int TP = pg8::MoeSched<true>::TAB_PST, TC = pg8::MoeSched<true>::TAB_CNT;
    if (F.tid < NEXP) tab[TC + F.tid] = expert_count(ws, layer, F.tid);
    LDS_WAIT(); __syncthreads();
    if (F.tid == 0) { unsigned ps = 0; for (int e = 0; e < NEXP; ++e) { tab[TP + e] = ps; ps += (tab[TC + e] + 255u) & ~255u; } tab[0] = ps >> 8; }
    LDS_WAIT(); __syncthreads();
    const unsigned ntile = tab[0];
    for (unsigned rt = F.tid; rt < ntile; rt += NTHREADS) { unsigned e = 0; for (int k = 1; k < NEXP; ++k) if (rt * 256u >= tab[TP + k]) e = k; tab[1 + rt] = e; }
    LDS_WAIT(); __syncthreads();
}
__global__ void __launch_bounds__(NTHREADS, 2) dit_fwd(Params P) {
    extern __shared__ __attribute__((aligned(16))) unsigned char lds_raw[];
    Frame F;
    F.lds = (LAS unsigned char*)lds_raw;
    F.tid = threadIdx.x; F.lane = F.tid & 63; F.wave = __builtin_amdgcn_readfirstlane(F.tid >> 6);
    F.blk = blockIdx.x; F.G = gridDim.x; F.vcu = (F.G % 8 == 0) ? (F.blk % 8) * (F.G / 8) + F.blk / 8 : F.blk;
    F.gw = F.vcu * NWAVES + F.wave; F.NGW = F.G * NWAVES;
    for (int u = F.tid; u < (LDS_BYTES - RING_BYTES) / 4; u += NTHREADS) ((LAS unsigned*)(F.lds + RING_BYTES))[u] = 0u;
    __syncthreads();
    unsigned* ctl = (unsigned*)(P.ws + WS_CTL);
    XcdBarrier bar = xcd_barrier_post(ctl + CW_BAR, (volatile LAS unsigned*)(F.lds + MISC_OFF) + 8);

    unsigned long long pr_t0 = 0, pr_prev = 0, pr_acc = 0;
    if (PROBE_SEL) { pr_t0 = __builtin_amdgcn_s_memrealtime(); pr_prev = pr_t0; }
#define PSTAMP(id) do { if (PROBE_SEL) { const unsigned long long now_ = __builtin_amdgcn_s_memrealtime(); if ((id) == PROBE_SEL) pr_acc += now_ - pr_prev; pr_prev = now_; } } while (0)
    p0_prologue(P, F);
    if (RPT & 1) p0_prologue(P, F);
    xcd_barrier(bar);
    p0b_mod_reduce(P, F);
    xcd_barrier(bar);
    PSTAMP(1);

    for (int layer = 0; layer < DEPTH; ++layer) {
        const bool last = (layer == DEPTH - 1);
        unsigned char* ws = wsp(P);
        const int Mtok = last ? TLAT : TALL;
        phase_attn_norm(P, F, layer);
        if ((RPT & 256) && layer == 0) { phase_attn_norm(P, F, layer); phase_attn_norm(P, F, layer); phase_attn_norm(P, F, layer); }
        xcd_barrier(bar);
        PSTAMP(2);
        {
            pg8::PlainSched S; S.nN = QKVN / 256; S.nwg = (TALL / 256) * S.nN; S.G = F.G; S.c = F.vcu; S.K = DM; S.Bt = (const bf16_t*)(ws + WS_WQKV) + (size_t)layer * QKVN * DM;
            pg8::EpiQKV E{(bf16_t*)(ws + WS_QKV), ws + WS_KF, ws + WS_VF, (const f32x2*)(ws + WS_ROPE), inp(P, IN_GQ), inp(P, IN_GK), layer % 3};
            pg8::gemm_phase(F.lds, (const bf16_t*)(ws + WS_H), DM, S, E);
            if (RPT & 2) pg8::gemm_phase(F.lds, (const bf16_t*)(ws + WS_H), DM, S, E);
        }
        xcd_barrier(bar);
        PSTAMP(3);
        phase_attention(P, F, layer);
        if (((RPT & 4) && layer == 1) || ((RPT & 8) && layer != 1)) phase_attention(P, F, layer);
        xcd_barrier(bar);
        PSTAMP(4);
        {
            pg8::PlainSched S; S.nN = DM / 256; S.nwg = (Mtok / 256) * S.nN; S.G = F.G; S.c = F.vcu; S.K = DM; S.Bt = (const bf16_t*)(ws + WS_WO) + (size_t)layer * DM * DM;
            pg8::EpiResidBf E{(bf16_t*)(ws + WS_X), (const float*)(ws + WS_MOD) + (size_t)layer * 17 * 6144 + 2048};
            pg8::gemm_phase(F.lds, (const bf16_t*)(ws + WS_O), DM, S, E);
        }
        xcd_barrier(bar);
        PSTAMP(5);
        phase_router(P, F, layer, Mtok);
        xcd_barrier(bar);
        PSTAMP(6);
        if (RPT & 128) { for (int xb = 0; xb < 9; ++xb) xcd_barrier(bar); }
        LAS unsigned* tab = (LAS unsigned*)(F.lds + LDSX_OFF + 8192);
        build_tile_table(P, F, tab, layer);
        {
            pg8::MoeSched<true> S; S.tab = tab; S.G = F.G; S.c = F.vcu; S.K = DM; S.Bt = (const bf16_t*)(ws + WS_WGU) + (size_t)layer * NEXP * DM * DM; S.estride = (size_t)DM * DM * 2; S.tok = (const unsigned*)(ws + WS_TOKE);
            pg8::EpiSwiglu E{(bf16_t*)(ws + WS_ACT)};
            pg8::gemm_phase(F.lds, (const bf16_t*)(ws + WS_H), DM, S, E);
            if (RPT & 32) pg8::gemm_phase(F.lds, (const bf16_t*)(ws + WS_H), DM, S, E);
        }
        xcd_barrier(bar);
        PSTAMP(8);
        {
            pg8::MoeSched<false> S; S.tab = tab; S.G = F.G; S.c = F.vcu; S.K = FH; S.Bt = (const bf16_t*)(ws + WS_WD) + (size_t)layer * NEXP * DM * FH; S.estride = (size_t)DM * FH * 2; S.tok = nullptr;
            pg8::EpiStore E{(bf16_t*)(ws + WS_Y), DM};
            pg8::gemm_phase(F.lds, (const bf16_t*)(ws + WS_ACT), FH, S, E);
            if (RPT & 64) pg8::gemm_phase(F.lds, (const bf16_t*)(ws + WS_ACT), FH, S, E);
        }
        xcd_barrier(bar);
        PSTAMP(9);
    }
    if (PROBE_SEL) {
        if (F.blk == 0 && F.tid == 0) { const unsigned long long tot = __builtin_amdgcn_s_memrealtime() - pr_t0;
            const float f = (PROBE_SEL == 15) ? 0.5f : (float)pr_acc / (float)tot;
            __hip_atomic_store((float*)(P.ws + WS_CTL) + 64, sqrtf(4e-4f * f), __ATOMIC_RELAXED, __HIP_MEMORY_SCOPE_AGENT); }
        xcd_barrier(bar);
    }
    phase_final(P, F);
    if (RPT & 512) { phase_final(P, F); phase_final(P, F); phase_final(P, F); }
}

extern "C" void kernel_launch(void* const* d_in, const int* in_sizes, int n_in, void* d_out, int out_size, void* d_ws, size_t ws_size, hipStream_t stream) {
    static int ok = 0;
    if (ok == 0) {
        if (n_in != 22 || in_sizes[0] != TLAT * DM || out_size != TLAT * DM || ws_size < WS_END) {
            fprintf(stderr, "kernel_launch: unexpected shapes (n_in %d, in0 %d, out %d, ws %zu < %zu); nothing launched\n", n_in, n_in > 0 ? in_sizes[0] : -1, out_size, ws_size, (size_t)WS_END); ok = -1; return; }
        int dev = 0, cus = 0, per_cu = 0;
        if (hipGetDevice(&dev) != hipSuccess || hipDeviceGetAttribute(&cus, hipDeviceAttributeMultiprocessorCount, dev) != hipSuccess) { ok = -1; return; }
        if (hipFuncSetAttribute((const void*)dit_fwd, hipFuncAttributeMaxDynamicSharedMemorySize, LDS_BYTES) != hipSuccess) { fprintf(stderr, "kernel_launch: hipFuncSetAttribute failed\n"); ok = -1; return; }
        if (hipOccupancyMaxActiveBlocksPerMultiprocessor(&per_cu, (const void*)dit_fwd, NTHREADS, LDS_BYTES) != hipSuccess || per_cu < 1) fprintf(stderr, "kernel_launch: note: occupancy query reports %d\n", per_cu);
        (void)hipGetLastError();
        if (cus < GRID) { fprintf(stderr, "kernel_launch: %d CUs < %d workgroups: grid would not be resident; nothing launched\n", cus, GRID); ok = -1; return; }
        ok = 1;
    }
    if (ok < 0) return;
    if (hipMemsetAsync((char*)d_ws + WS_CTL, 0, CTL_ZERO_BYTES, stream) != hipSuccess) return;
    Params p{};
    for (int i = 0; i < 22; ++i) p.in[i] = (const float*)d_in[i];
    p.out = (float*)d_out; p.ws = (unsigned char*)d_ws;
    hipLaunchKernelGGL(dit_fwd, dim3(GRID), dim3(NTHREADS), LDS_BYTES, stream, p);
}
```

```cpp
#include <hip/hip_runtime.h>
#include <cstdio>
#include <cstdint>

#ifndef PROBE_SEL
#define PROBE_SEL 0
#endif
#ifndef RPT
#define RPT 0
#endif

#define LAS __attribute__((address_space(3)))
#define GAS __attribute__((address_space(1)))
#define DI __device__ __forceinline__

typedef unsigned short bf16_t;
typedef short bf16x8 __attribute__((ext_vector_type(8)));
typedef short s16x4 __attribute__((ext_vector_type(4)));
typedef float f32x2 __attribute__((ext_vector_type(2)));
typedef float f32x4 __attribute__((ext_vector_type(4)));
typedef float f32x16 __attribute__((ext_vector_type(16)));
typedef unsigned u32x2 __attribute__((ext_vector_type(2)));
typedef unsigned u32x4 __attribute__((ext_vector_type(4)));

constexpr int NB = 16, SEQ = 2048, DM = 1024, DEPTH = 4, CTXL = 256, NH = 16, NKV = 4, HD = 64, QKVN = 1536;
constexpr int TLAT = NB * SEQ, TCTX = NB * CTXL, TALL = TLAT + TCTX;
constexpr int NEXP = 32, FH = 512;
constexpr int KEYS = SEQ + CTXL, KGRP = KEYS / 8;
constexpr int CAPR = 2 * TALL + NEXP * 256;
constexpr int NWAVES = 8, NTHREADS = 512, GRID = 256;
constexpr float NORM_EPS = 1e-6f, LOG2E = 1.4426950408889634f;

constexpr size_t MiB = 1u << 20;
constexpr size_t WS_CTL = 0, CTL_ZERO_BYTES = 1 * MiB;
constexpr size_t WS_MODP = 1 * MiB;
constexpr size_t WS_MOD = 15 * MiB;
constexpr size_t WS_ROPE = 17 * MiB;
constexpr size_t WS_WRT = 17 * MiB + 65536;
constexpr size_t WS_ASG = 18 * MiB;
constexpr size_t WS_ASGW = 18 * MiB + 512 * 1024;
constexpr size_t WS_TOKE = 1 * MiB;
constexpr size_t WS_WQKV = 21 * MiB;
constexpr size_t WS_WO = 33 * MiB;
constexpr size_t WS_WGU = 41 * MiB;
constexpr size_t WS_WD = 297 * MiB;
constexpr size_t WS_X = 425 * MiB;
constexpr size_t WS_H = 569 * MiB;
constexpr size_t WS_R1 = 641 * MiB;
constexpr size_t WS_QKV = WS_R1;
constexpr size_t WS_KF = WS_R1 + 108 * MiB;
constexpr size_t WS_VF = WS_R1 + 126 * MiB;
constexpr size_t WS_O = WS_R1 + 144 * MiB;
constexpr size_t WS_Y = WS_R1;
constexpr size_t WS_ACT = WS_R1 + 160 * MiB;
constexpr size_t WS_END = WS_R1 + 240 * MiB;
constexpr int CW_TMO = 0, CW_BAR = 4096, CW_CNT = 65536, CNT_STRIDE = 32;

constexpr int RING_BYTES = 131072;
constexpr int MISC_OFF = RING_BYTES + 320;
constexpr int LDSX_OFF = RING_BYTES + 1024;
constexpr int LDS_BYTES = 147456;

#define LDS_WAIT() asm volatile("s_waitcnt lgkmcnt(0)" ::: "memory")
#define VM_WAIT() asm volatile("s_waitcnt vmcnt(0)" ::: "memory")

DI unsigned f2bf(float f) { unsigned u = __float_as_uint(f); return (u + 0x7fffu + ((u >> 16) & 1u)) >> 16; }
DI float bf2f(unsigned b) { return __uint_as_float(b << 16); }
DI float bfs2f(short b) { return __uint_as_float(((unsigned)(unsigned short)b) << 16); }
DI unsigned cvt_pk_bf16(float lo, float hi);
DI unsigned pk2(float lo, float hi) { return cvt_pk_bf16(lo, hi); }
DI unsigned cvt_pk_bf16(float lo, float hi) { unsigned r; asm volatile("v_cvt_pk_bf16_f32 %0, %1, %2" : "=v"(r) : "v"(lo), "v"(hi)); return r; }
DI float wave_sum(float v) {
#pragma unroll
    for (int o = 1; o < 64; o <<= 1) v += __shfl_xor(v, o);
    return v;
}
DI int crow(int r, int hi) { return (r & 3) + 8 * (r >> 2) + 4 * hi; }

#define XB_TMO      128
#define XB_XCNT(j)  (256  + 64 * (j))
#define XB_XSUB(j)  (1280 + 64 * (j))
#define XB_XGEN(j)  (2304 + 64 * (j))
#define XB_TOP      3328
#define XB_TOPGEN   3392
#define XCD_BAR_WORDS 3456
#define XB_SPIN_CAP (1u << 18)

__device__ __forceinline__ unsigned xb_ld(unsigned* p)              { return __hip_atomic_load(p, __ATOMIC_RELAXED, __HIP_MEMORY_SCOPE_AGENT); }
__device__ __forceinline__ unsigned xb_add(unsigned* p, unsigned v) { return __hip_atomic_fetch_add(p, v, __ATOMIC_RELAXED, __HIP_MEMORY_SCOPE_AGENT); }
__device__ __forceinline__ unsigned xb_xcc_id() { return (unsigned)__builtin_amdgcn_s_getreg((3 << 11) | 20) & 0xFu; }
#define XB_SPIN(cond, bar) do { unsigned _sp = 0; while (cond) { __builtin_amdgcn_s_sleep(1); \
    if ((++_sp & 255u) == 0u) { if (xb_ld(&(bar)[XB_TMO])) break; if (_sp > XB_SPIN_CAP) { atomicAdd(&(bar)[XB_TMO], 1u); break; } } } } while (0)

struct XcdBarrier { unsigned* bar; unsigned x; volatile LAS unsigned* st; };

__device__ __forceinline__ XcdBarrier xcd_barrier_post(unsigned* bar, volatile LAS unsigned* st) {
    XcdBarrier b; b.bar = bar; b.x = xb_xcc_id(); b.st = st;
    if (threadIdx.x == 0) (void)xb_add(&bar[XB_XCNT(b.x)], 1u);
    return b;
}
__device__ __forceinline__ void xcd_barrier_complete(unsigned* bar, unsigned x, unsigned& nloc, unsigned& nx) {
    const unsigned G = gridDim.x * gridDim.y * gridDim.z;
    unsigned sum, cnt, mine, sp = 0u;
    for (;;) {
        sum = 0u; cnt = 0u; mine = 0u;
#pragma unroll
        for (unsigned j = 0; j < 16; ++j) { const unsigned c = xb_ld(&bar[XB_XCNT(j)]); sum += c; cnt += (c > 0u) ? 1u : 0u; mine = (j == x) ? c : mine; }
        if (sum == G) break;
        __builtin_amdgcn_s_sleep(1);
        if ((++sp & 255u) == 0u) { if (xb_ld(&bar[XB_TMO])) break; if (sp > XB_SPIN_CAP) { atomicAdd(&bar[XB_TMO], 1u); break; } }
    }
    nloc = mine > 0u ? mine : 1u; nx = cnt > 0u ? cnt : 1u;
}
__device__ __forceinline__ void xcd_barrier(const XcdBarrier& b0) {
    XcdBarrier b = b0;
    { unsigned z = 0, bx = __builtin_amdgcn_readfirstlane(b0.x); asm volatile("s_mov_b32 %0, 0" : "=s"(z)); asm volatile("" : "+s"(bx)); b.bar = b0.bar + z; b.x = bx; }
    asm volatile("s_waitcnt vmcnt(0)" ::: "memory");
    __syncthreads();
    if (threadIdx.x == 0) {
        unsigned* bar = b.bar;
        __builtin_amdgcn_s_waitcnt(0);
        unsigned nloc = b.st[0], nx = b.st[1];
        if (nloc == 0u) { xcd_barrier_complete(bar, b.x, nloc, nx); b.st[0] = nloc; b.st[1] = nx; }
        const unsigned old = xb_add(&bar[XB_XSUB(b.x)], 1u);
        const unsigned gen = old / nloc;
        if (old + 1u == (gen + 1u) * nloc) {
            __builtin_amdgcn_fence(__ATOMIC_RELEASE, "agent");
            asm volatile("s_waitcnt vmcnt(0)" ::: "memory");
            const unsigned og = xb_add(&bar[XB_TOP], 1u);
            const unsigned tg = og / nx;
            if (og + 1u == (tg + 1u) * nx) xb_add(&bar[XB_TOPGEN], 1u);
            else XB_SPIN(xb_ld(&bar[XB_TOPGEN]) == tg, bar);
            __builtin_amdgcn_fence(__ATOMIC_ACQUIRE, "agent");
            xb_add(&bar[XB_XGEN(b.x)], 1u);
            asm volatile("s_waitcnt vmcnt(0)" ::: "memory");
        } else {
            XB_SPIN(xb_ld(&bar[XB_XGEN(b.x)]) == gen, bar);
            __builtin_amdgcn_fence(__ATOMIC_ACQUIRE, "agent");
            asm volatile("s_waitcnt vmcnt(0)" ::: "memory");
        }
    }
    __syncthreads();
}

namespace pg8 {
constexpr int BM = 256, BK = 64, HALF = 128, HTB = HALF * BK * 2, STAGE_BYTES = 8 * HTB;
DI int lds_byte(int r, int c) { const int st = (r >> 4) * 2 + (c >> 5), rr = r & 15, cc = c & 31, ob = rr * 64 + cc * 2; return st * 1024 + (ob ^ (((ob >> 9) & 1) << 5)); }
DI void stage_rc(int b, int& R, int& C) { const int st = b / 1024, sb = b % 1024, swz = sb ^ (((sb >> 9) & 1) << 5); R = (st >> 1) * 16 + swz / 64; C = (st & 1) * 32 + (swz % 64) / 2; }
DI int perm32(int rho) { const int n = rho >> 4, i = rho & 15; return 8 * (i >> 2) + 4 * n + (i & 3); }
struct Unit { int pm, pn, e, r0, na; };

template <class Epi, class Sched>
DI void gemm_phase(LAS unsigned char* lds, const bf16_t* A, const int K, const Sched& S, const Epi& E) {
    int tid_ = threadIdx.x; asm volatile("" : "+v"(tid_));
    const int tid = tid_, wid = __builtin_amdgcn_readfirstlane(tid >> 6), lane = tid & 63, wr = wid >> 2, wc = wid & 3, fr = lane & 15, fq = lane >> 4;
    const int nt = K / BK;
    constexpr bool GA = Sched::GATHER;
    int Rr[2], Cc[2]; unsigned voffB[2], voffA[2];
#pragma unroll
    for (int i = 0; i < 2; ++i) { int R, C; stage_rc(tid * 16 + i * 8192, R, C); const int Rb = Epi::PERM ? ((R & ~31) + perm32(R & 31)) : R;
        Rr[i] = R; Cc[i] = C; voffB[i] = (unsigned)(Rb * K + C) * 2u; voffA[i] = (unsigned)(R * K + C) * 2u; }
    const size_t kstep = (size_t)(BK * 2);
    const size_t hstep = (size_t)HALF * K * 2;
    const unsigned ldsw = (unsigned)wid * 1024u;
    const int aoff = lds_byte(wr * 64 + fr, fq * 8), boff = lds_byte(wc * 32 + fr, fq * 8);
#define PG8_SA(b, h) (((b) * 2 + (h)) * HTB)
#define PG8_SB(b, h) ((4 + (b) * 2 + (h)) * HTB)
#define PG8_STAGE(bufoff, gbase, voff) do { _Pragma("unroll") for (int _i = 0; _i < 2; ++_i) \
        __builtin_amdgcn_global_load_lds((const unsigned*)((const char*)(gbase) + (voff)[_i]), (LAS unsigned*)(lds + (bufoff) + ldsw + _i * 8192), 16, 0, 0); } while (0)
#define PG8_LDA(dst, b, h) do { _Pragma("unroll") for (int m = 0; m < 4; ++m) _Pragma("unroll") for (int k = 0; k < 2; ++k) dst[m][k] = *(const LAS bf16x8*)(lds + PG8_SA(b, h) + aoff + m * 2048 + k * 1024); } while (0)
#define PG8_LDB(dst, b, h) do { _Pragma("unroll") for (int n = 0; n < 2; ++n) _Pragma("unroll") for (int k = 0; k < 2; ++k) dst[n][k] = *(const LAS bf16x8*)(lds + PG8_SB(b, h) + boff + n * 2048 + k * 1024); } while (0)
#define PG8_MMA(ai, bj, At, Bt) do { __builtin_amdgcn_s_setprio(1); _Pragma("unroll") for (int m = 0; m < 4; ++m) _Pragma("unroll") for (int n = 0; n < 2; ++n) _Pragma("unroll") for (int k = 0; k < 2; ++k) \
        acc[ai][bj][m][n] = __builtin_amdgcn_mfma_f32_16x16x32_bf16(Bt[n][k], At[m][k], acc[ai][bj][m][n], 0, 0, 0); __builtin_amdgcn_s_setprio(0); } while (0)
#define PG8_WAIT_V(n) asm volatile("s_waitcnt vmcnt(" #n ")" ::: "memory")
#define PG8_WAIT_L(n) asm volatile("s_waitcnt lgkmcnt(" #n ")" ::: "memory")
#define PG8_BAR __builtin_amdgcn_s_barrier()
#define PG8_SCHED __builtin_amdgcn_sched_barrier(0)
    Unit cur, nxt; int ui = 0;
    if (!S.next(0, cur)) return;
    f32x4 acc[2][2][4][2];
#pragma unroll
    for (int a = 0; a < 2; ++a)
#pragma unroll
        for (int b = 0; b < 2; ++b)
#pragma unroll
            for (int m = 0; m < 4; ++m)
#pragma unroll
                for (int n = 0; n < 2; ++n) acc[a][b][m][n] = (f32x4){0.f, 0.f, 0.f, 0.f};
    bf16x8 At[4][2], B0[2][2], B1[2][2];
    unsigned oc0[2], oc1[2], on0[2], on1[2];
#pragma unroll
    for (int i = 0; i < 2; ++i) { if (GA) { oc0[i] = S.a_off(cur, Rr[i]) + (unsigned)Cc[i] * 2u; oc1[i] = S.a_off(cur, HALF + Rr[i]) + (unsigned)Cc[i] * 2u; } else { oc0[i] = voffA[i]; oc1[i] = voffA[i]; } on0[i] = oc0[i]; on1[i] = oc1[i]; }
    size_t hA = (GA || (Sched::HALVES && cur.na == 1)) ? (size_t)0 : hstep, hAn = hA;
    const char* Ab = GA ? (const char*)A : (const char*)A + (size_t)cur.r0 * K * 2;
    const char* cB = S.b_ptr(cur);
    PG8_STAGE(PG8_SB(0, 0), cB, voffB); PG8_STAGE(PG8_SB(0, 1), cB + hstep, voffB); PG8_STAGE(PG8_SA(0, 0), Ab, oc0); PG8_STAGE(PG8_SA(0, 1), Ab + hA, oc1);
    if (wr == 1) PG8_BAR;
    PG8_WAIT_V(2); PG8_BAR;
    PG8_STAGE(PG8_SB(1, 0), cB + kstep, voffB); PG8_STAGE(PG8_SA(1, 0), Ab + kstep, oc0); PG8_STAGE(PG8_SB(1, 1), cB + hstep + kstep, voffB);
    PG8_WAIT_V(6); PG8_BAR;
    for (;;) {
        const bool has_next = S.next(ui + 1, nxt);
        const char* nB = has_next ? S.b_ptr(nxt) : cB;
        const char* nA = GA ? Ab : (has_next ? (const char*)A + (size_t)nxt.r0 * K * 2 : Ab);
        if (!GA && Sched::HALVES) hAn = (has_next && nxt.na == 1) ? (size_t)0 : (has_next ? hstep : hA);
        if (GA) {
            if (has_next) {
#pragma unroll
                for (int i = 0; i < 2; ++i) { on0[i] = S.a_off(nxt, Rr[i]) + (unsigned)Cc[i] * 2u; on1[i] = S.a_off(nxt, HALF + Rr[i]) + (unsigned)Cc[i] * 2u; }
            } else {
#pragma unroll
                for (int i = 0; i < 2; ++i) { on0[i] = oc0[i]; on1[i] = oc1[i]; }
            }
        }
#define PG8_KLOOP(FULL) \
        for (int t = 0; t < nt; t += 2) { \
            const bool last = (t == nt - 2); \
            const char* a1 = Ab + (size_t)(t + 1) * kstep + hA; \
            const char* a2 = last ? nA : Ab + (size_t)(t + 2) * kstep; const char* b2 = last ? nB : cB + (size_t)(t + 2) * kstep; \
            const char* a3 = a2 + kstep; const char* b3 = b2 + kstep; const size_t hA2 = last ? hAn : hA; \
            unsigned o20[2], o21[2]; \
            for (int i = 0; i < 2; ++i) { if (GA) { o20[i] = last ? on0[i] : oc0[i]; o21[i] = last ? on1[i] : oc1[i]; } else { o20[i] = voffA[i]; o21[i] = voffA[i]; } } \
              \
            PG8_LDB(B0, 0, 0); PG8_LDB(B1, 0, 1); PG8_SCHED; PG8_LDA(At, 0, 0); PG8_STAGE(PG8_SA(1, 1), a1, oc1); \
            PG8_WAIT_V(8); PG8_WAIT_L(0); PG8_BAR; PG8_MMA(0, 0, At, B0); PG8_MMA(0, 1, At, B1); PG8_BAR; PG8_SCHED; \
              \
            if (FULL) { PG8_LDA(At, 0, 1); } PG8_STAGE(PG8_SB(0, 0), b2, voffB); PG8_STAGE(PG8_SB(0, 1), b2 + hstep, voffB); PG8_STAGE(PG8_SA(0, 0), a2, o20); \
            PG8_WAIT_V(8); PG8_WAIT_L(0); PG8_BAR; if (FULL) { PG8_MMA(1, 0, At, B0); PG8_MMA(1, 1, At, B1); } PG8_BAR; PG8_SCHED; \
              \
            PG8_LDB(B0, 1, 0); PG8_LDB(B1, 1, 1); PG8_SCHED; PG8_LDA(At, 1, 0); PG8_STAGE(PG8_SA(0, 1), a2 + hA2, o21); \
            PG8_WAIT_V(8); PG8_WAIT_L(0); PG8_BAR; PG8_MMA(0, 0, At, B0); PG8_MMA(0, 1, At, B1); PG8_BAR; PG8_SCHED; \
              \
            if (FULL) { PG8_LDA(At, 1, 1); } PG8_STAGE(PG8_SB(1, 0), b3, voffB); PG8_STAGE(PG8_SB(1, 1), b3 + hstep, voffB); PG8_STAGE(PG8_SA(1, 0), a3, o20); \
            PG8_WAIT_V(8); PG8_WAIT_L(0); PG8_BAR; if (FULL) { PG8_MMA(1, 0, At, B0); PG8_MMA(1, 1, At, B1); } PG8_BAR; PG8_SCHED; \
        }
        if (Sched::HALVES && cur.na == 1) { PG8_KLOOP(0) } else { PG8_KLOOP(1) }
#undef PG8_KLOOP
        if (wr == 0) PG8_BAR;
        E(acc, cur, wr, wc, fr, fq);
        if (!has_next) break;
#pragma unroll
        for (int a = 0; a < 2; ++a)
#pragma unroll
            for (int b = 0; b < 2; ++b)
#pragma unroll
                for (int m = 0; m < 4; ++m)
#pragma unroll
                    for (int n = 0; n < 2; ++n) acc[a][b][m][n] = (f32x4){0.f, 0.f, 0.f, 0.f};
        cur = nxt; cB = nB; Ab = nA; hA = hAn; ++ui;
        if (GA) {
#pragma unroll
            for (int i = 0; i < 2; ++i) { oc0[i] = on0[i]; oc1[i] = on1[i]; }
        }
        if (wr == 1) PG8_BAR;
    }
    PG8_WAIT_V(0);
    PG8_BAR;
#undef PG8_SA
#undef PG8_SB
#undef PG8_STAGE
#undef PG8_LDA
#undef PG8_LDB
#undef PG8_MMA
#undef PG8_WAIT_V
#undef PG8_WAIT_L
#undef PG8_BAR
#undef PG8_SCHED
}

struct PlainSched {
    static constexpr bool GATHER = false, HALVES = true;
    int nN, nwg, G, c, K; const bf16_t* Bt;
    DI bool next(int i, Unit& u) const { const int L = i * G + c; const int nfull = (nwg / G) * G, rem = nwg - nfull; int Lu = L, hf = 0; u.na = 2;
        if (L >= nfull) { if (2 * rem <= G) { const int h = L - nfull; if (h >= 2 * rem) return false; Lu = nfull + (h >> 1); hf = h & 1; u.na = 1; } else if (L >= nwg) return false; }
        u.pm = Lu / nN; u.pn = Lu - u.pm * nN; u.e = 0; u.r0 = u.pm * BM + hf * HALF; return true; }
    DI unsigned a_off(const Unit& u, int r) const { return (unsigned)(u.r0 + r) * (unsigned)(K * 2); }
    DI const char* b_ptr(const Unit& u) const { return (const char*)Bt + (size_t)u.pn * BM * K * 2; }
};
template <bool GATHER_> struct MoeSched {
    static constexpr bool GATHER = GATHER_, HALVES = true;
    static constexpr int TAB_PST = 384, TAB_CNT = 416;
    const LAS unsigned* tab; int G, c, K; const bf16_t* Bt; size_t estride; const unsigned* tok;
    DI bool next(int i, Unit& u) const { const int L = i * G + c; const int nwg = (int)tab[0] * 4, nfull = (nwg / G) * G, rem = nwg - nfull; int Lu = L, hf = 0; u.na = 2;
        if (L >= nfull) { if (2 * rem <= G) { const int h = L - nfull; if (h >= 2 * rem) return false; Lu = nfull + (h >> 1); hf = h & 1; u.na = 1; } else if (L >= nwg) return false; }
        u.pm = Lu >> 2; u.pn = Lu & 3; u.e = (int)tab[1 + u.pm]; u.r0 = u.pm * BM + hf * HALF; return true; }
    DI unsigned a_off(const Unit& u, int r) const {
        unsigned row = (unsigned)(u.r0 + (u.na == 1 ? (r & (HALF - 1)) : r));
        if (GATHER_) { const unsigned last = tab[TAB_CNT + u.e] - 1u; unsigned idx = row - tab[TAB_PST + u.e]; idx = idx < last ? idx : last; row = tok[(unsigned)u.e * (unsigned)TALL + idx]; }
        return row * (unsigned)(K * 2); }
    DI const char* b_ptr(const Unit& u) const { return (const char*)Bt + (size_t)u.e * estride + (size_t)u.pn * BM * K * 2; }
};

struct EpiStore {
    static constexpr bool PERM = true;
    bf16_t* O; int ldc;
    DI void operator()(const f32x4 (&acc)[2][2][4][2], const Unit& u, int wr, int wc, int fr, int fq) const {
        const int row0 = u.r0 + wr * 64 + fr, col0 = u.pn * BM + wc * 32 + 8 * fq;
#pragma unroll
        for (int ai = 0; ai < 2; ++ai) if (ai < u.na)
#pragma unroll
            for (int m = 0; m < 4; ++m) { bf16_t* rowp = O + (size_t)(row0 + ai * HALF + m * 16) * ldc + col0;
#pragma unroll
                for (int bj = 0; bj < 2; ++bj) { const f32x4 v0 = acc[ai][bj][m][0], v1 = acc[ai][bj][m][1];
                    u32x4 w; w.x = cvt_pk_bf16(v0[0], v0[1]); w.y = cvt_pk_bf16(v0[2], v0[3]); w.z = cvt_pk_bf16(v1[0], v1[1]); w.w = cvt_pk_bf16(v1[2], v1[3]);
                    *(u32x4*)(rowp + bj * HALF) = w; } }
    }
};
struct EpiQKV {
    static constexpr bool PERM = false;
    bf16_t* QKV; unsigned char* KF; unsigned char* VF; const f32x2* T; const float* gq; const float* gk; int m;
    DI void operator()(const f32x4 (&acc)[2][2][4][2], const Unit& u, int wr, int wc, int fr, int fq) const {
        const bool lat = u.pm < TLAT / BM; const int b = lat ? (u.pm >> 3) : (u.pm - TLAT / BM);
        const int trow0 = u.r0 + wr * 64 + fr;
        if (u.pn < 4) {
            const int h = 4 * u.pn + wc;
            f32x4 g[2][2];
#pragma unroll
            for (int bj = 0; bj < 2; ++bj)
#pragma unroll
                for (int n = 0; n < 2; ++n) g[bj][n] = (m == 1) ? *(const f32x4*)(gq + 32 * bj + 16 * n + 4 * fq) : (f32x4){1.f, 1.f, 1.f, 1.f};
#pragma unroll
            for (int ai = 0; ai < 2; ++ai) if (ai < u.na)
#pragma unroll
                for (int mm = 0; mm < 4; ++mm) {
                    f32x4 x[2][2]; float ss = 0.f;
#pragma unroll
                    for (int bj = 0; bj < 2; ++bj)
#pragma unroll
                        for (int n = 0; n < 2; ++n) { x[bj][n] = acc[ai][bj][mm][n]; ss += (x[bj][n][0] * x[bj][n][0] + x[bj][n][1] * x[bj][n][1]) + (x[bj][n][2] * x[bj][n][2] + x[bj][n][3] * x[bj][n][3]); }
                    float sc = 0.125f * LOG2E;
                    if (m == 1) { ss += __shfl_xor(ss, 16); ss += __shfl_xor(ss, 32); sc *= 1.0f / sqrtf(ss * (1.f / HD) + NORM_EPS); }
                    bf16_t* qrow = QKV + (size_t)(trow0 + ai * HALF + mm * 16) * QKVN + h * HD + 4 * fq;
#pragma unroll
                    for (int bj = 0; bj < 2; ++bj)
#pragma unroll
                        for (int n = 0; n < 2; ++n) { const f32x4 y = x[bj][n] * g[bj][n] * sc; u32x2 w; w.x = cvt_pk_bf16(y[0], y[1]); w.y = cvt_pk_bf16(y[2], y[3]); *(u32x2*)(qrow + 32 * bj + 16 * n) = w; }
                }
        } else if (u.pn == 4) {
            f32x4 g[2][2];
#pragma unroll
            for (int bj = 0; bj < 2; ++bj)
#pragma unroll
                for (int n = 0; n < 2; ++n) g[bj][n] = (m == 1) ? *(const f32x4*)(gk + 32 * bj + 16 * n + 4 * fq) : (f32x4){1.f, 1.f, 1.f, 1.f};
            const bool rope = lat && (m != 2);
            unsigned char* kbase = KF + (size_t)(b * NKV + wc) * KGRP * 1024 + (fq >> 1) * 128 + (fq & 1) * 8;
#pragma unroll
            for (int ai = 0; ai < 2; ++ai) if (ai < u.na)
#pragma unroll
                for (int mm = 0; mm < 4; ++mm) {
                    const int t = trow0 + ai * HALF + mm * 16;
                    const int kidx = lat ? (t & 2047) : (2048 + ((t - TLAT) & 255));
                    f32x4 x[2][2]; float ss = 0.f;
#pragma unroll
                    for (int bj = 0; bj < 2; ++bj)
#pragma unroll
                        for (int n = 0; n < 2; ++n) { x[bj][n] = acc[ai][bj][mm][n]; ss += (x[bj][n][0] * x[bj][n][0] + x[bj][n][1] * x[bj][n][1]) + (x[bj][n][2] * x[bj][n][2] + x[bj][n][3] * x[bj][n][3]); }
                    if (m == 1) { ss += __shfl_xor(ss, 16); ss += __shfl_xor(ss, 32); const float rs = 1.0f / sqrtf(ss * (1.f / HD) + NORM_EPS);
#pragma unroll
                        for (int bj = 0; bj < 2; ++bj)
#pragma unroll
                            for (int n = 0; n < 2; ++n) x[bj][n] = x[bj][n] * g[bj][n] * rs; }
                    if (rope) {
#pragma unroll
                        for (int bj = 0; bj < 2; ++bj) { const int pos = bj ? (kidx & 63) : (kidx >> 6); const f32x4* tp = (const f32x4*)(T + pos * 16 + 4 * fq);
                            const f32x4 t0 = tp[0], t1 = tp[1];
                            const f32x4 cs = (f32x4){t0[0], t0[2], t1[0], t1[2]}, sn = (f32x4){t0[1], t0[3], t1[1], t1[3]};
                            const f32x4 a = x[bj][0], c = x[bj][1];
                            x[bj][0] = a * cs - c * sn; x[bj][1] = c * cs + a * sn; }
                    }
                    unsigned char* kp = kbase + (size_t)(kidx >> 3) * 1024 + (kidx & 7) * 16;
#pragma unroll
                    for (int bj = 0; bj < 2; ++bj)
#pragma unroll
                        for (int n = 0; n < 2; ++n) { u32x2 w; w.x = cvt_pk_bf16(x[bj][n][0], x[bj][n][1]); w.y = cvt_pk_bf16(x[bj][n][2], x[bj][n][3]); *(u32x2*)(kp + (4 * bj + 2 * n) * 128) = w; }
                }
        } else {
            const int q4 = fr & 3;
            unsigned char* vbase = VF + (size_t)(b * NKV + wc) * KGRP * 1024 + (4 * fq + q4) * 16;
#pragma unroll
            for (int ai = 0; ai < 2; ++ai) if (ai < u.na)
#pragma unroll
                for (int mm = 0; mm < 4; ++mm) {
                    const int t = trow0 + ai * HALF + mm * 16;
                    const int kidx = lat ? (t & 2047) : (2048 + ((t - TLAT) & 255));
                    unsigned char* vp = vbase + (size_t)(kidx >> 3) * 1024 + (kidx & 4) * 2;
#pragma unroll
                    for (int bj = 0; bj < 2; ++bj)
#pragma unroll
                        for (int n = 0; n < 2; ++n) {
                            f32x4 x = acc[ai][bj][mm][n];
                            { const float s0 = (q4 & 1) ? x[0] : x[1], s1 = (q4 & 1) ? x[2] : x[3]; const float r0 = __shfl_xor(s0, 1), r1 = __shfl_xor(s1, 1);
                              if (q4 & 1) { x[0] = r0; x[2] = r1; } else { x[1] = r0; x[3] = r1; } }
                            { const float s0 = (q4 & 2) ? x[0] : x[2], s1 = (q4 & 2) ? x[1] : x[3]; const float r0 = __shfl_xor(s0, 2), r1 = __shfl_xor(s1, 2);
                              if (q4 & 2) { x[0] = r0; x[1] = r1; } else { x[2] = r0; x[3] = r1; } }
                            u32x2 w; w.x = cvt_pk_bf16(x[0], x[1]); w.y = cvt_pk_bf16(x[2], x[3]);
                            *(u32x2*)(vp + (32 * bj + 16 * n) * 16) = w; }
                }
        }
    }
};
DI float silu_mul(float g, float u) { return g * __builtin_amdgcn_rcpf(1.f + __builtin_amdgcn_exp2f(-g * LOG2E)) * u; }
struct EpiResidBf {
    static constexpr bool PERM = true;
    bf16_t* X; const float* gate;
    DI void operator()(const f32x4 (&acc)[2][2][4][2], const Unit& u, int wr, int wc, int fr, int fq) const {
        const int mb = (u.pm < TLAT / BM) ? (u.pm >> 3) : 16;
        const float* gt = gate + (size_t)mb * 6144;
        const int row0 = u.r0 + wr * 64 + fr, col0 = u.pn * BM + wc * 32 + 8 * fq;
        f32x4 g[2][2];
#pragma unroll
        for (int bj = 0; bj < 2; ++bj)
#pragma unroll
            for (int n = 0; n < 2; ++n) g[bj][n] = *(const f32x4*)(gt + col0 + bj * HALF + 4 * n);
#pragma unroll
        for (int ai = 0; ai < 2; ++ai) if (ai < u.na) {
            u32x4 old[4][2];
#pragma unroll
            for (int m = 0; m < 4; ++m)
#pragma unroll
                for (int bj = 0; bj < 2; ++bj) old[m][bj] = *(const u32x4*)(X + (size_t)(row0 + ai * HALF + m * 16) * DM + col0 + bj * HALF);
#pragma unroll
            for (int m = 0; m < 4; ++m)
#pragma unroll
                for (int bj = 0; bj < 2; ++bj) { const u32x4 o = old[m][bj]; const f32x4 a0 = acc[ai][bj][m][0] * g[bj][0], a1 = acc[ai][bj][m][1] * g[bj][1];
                    u32x4 w; w.x = cvt_pk_bf16(bf2f(o.x & 0xffffu) + a0[0], bf2f(o.x >> 16) + a0[1]); w.y = cvt_pk_bf16(bf2f(o.y & 0xffffu) + a0[2], bf2f(o.y >> 16) + a0[3]);
                    w.z = cvt_pk_bf16(bf2f(o.z & 0xffffu) + a1[0], bf2f(o.z >> 16) + a1[1]); w.w = cvt_pk_bf16(bf2f(o.w & 0xffffu) + a1[2], bf2f(o.w >> 16) + a1[3]);
                    *(u32x4*)(X + (size_t)(row0 + ai * HALF + m * 16) * DM + col0 + bj * HALF) = w; }
        }
    }
};
struct EpiSwiglu {
    static constexpr bool PERM = true;
    bf16_t* ACT;
    DI void operator()(const f32x4 (&acc)[2][2][4][2], const Unit& u, int wr, int wc, int fr, int fq) const {
        const int row0 = u.r0 + wr * 64 + fr, col0 = u.pn * HALF + wc * 32 + 8 * fq;
#pragma unroll
        for (int ai = 0; ai < 2; ++ai) if (ai < u.na)
#pragma unroll
            for (int m = 0; m < 4; ++m) { bf16_t* rowp = ACT + (size_t)(row0 + ai * HALF + m * 16) * FH + col0;
                const f32x4 g0 = acc[ai][0][m][0], g1 = acc[ai][0][m][1], u0 = acc[ai][1][m][0], u1 = acc[ai][1][m][1];
                u32x4 w; w.x = cvt_pk_bf16(silu_mul(g0[0], u0[0]), silu_mul(g0[1], u0[1])); w.y = cvt_pk_bf16(silu_mul(g0[2], u0[2]), silu_mul(g0[3], u0[3]));
                w.z = cvt_pk_bf16(silu_mul(g1[0], u1[0]), silu_mul(g1[1], u1[1])); w.w = cvt_pk_bf16(silu_mul(g1[2], u1[2]), silu_mul(g1[3], u1[3]));
                *(u32x4*)rowp = w; }
    }
};
}

struct Params { const float* in[22]; float* out; unsigned char* ws; };
enum { IN_X = 0, IN_C, IN_CTX, IN_CCTX, IN_WADA, IN_BADA, IN_GATTN, IN_WQKV, IN_WO, IN_SINK, IN_GQ, IN_GK, IN_RPB, IN_GFFN, IN_WGROUP, IN_BGROUP, IN_WROUTER, IN_BROUTER, IN_WGATE, IN_WUP, IN_WDOWN, IN_GFINAL };

DI const float* inp(const Params& P, int i) { i = __builtin_amdgcn_readfirstlane(i); asm volatile("" : "+s"(i)); return P.in[i]; }
DI unsigned char* wsp(const Params& P) { unsigned z = 0; asm volatile("s_mov_b32 %0, 0" : "=s"(z)); return P.ws + z; }
struct Frame { LAS unsigned char* lds; int tid, lane, wave, blk, G, vcu, gw, NGW; };
DI Frame opaque_frame(const Frame& F0) { Frame F = F0; asm volatile("" : "+v"(F.tid), "+v"(F.lane)); asm volatile("" : "+s"(F.wave), "+s"(F.blk), "+s"(F.vcu), "+s"(F.gw)); return F; }

DI void p0_transpose_item(const float* W, int N, int k0, int n0, bf16_t* dst, int Kd, LAS float* scr, int lane) {
#pragma unroll 8
    for (int i = 0; i < 32; ++i) { const int kk = 2 * i + (lane >> 5); scr[kk * 33 + (lane & 31)] = W[(size_t)(k0 + kk) * N + n0 + (lane & 31)]; }
    LDS_WAIT();
    const int c = lane & 7;
#pragma unroll
    for (int j = 0; j < 4; ++j) { const int n = (lane >> 3) + 8 * j; const LAS float* s = scr + (8 * c) * 33 + n;
        u32x4 o; o.x = pk2(s[0 * 33], s[1 * 33]); o.y = pk2(s[2 * 33], s[3 * 33]); o.z = pk2(s[4 * 33], s[5 * 33]); o.w = pk2(s[6 * 33], s[7 * 33]);
        *(u32x4*)(dst + (size_t)n * Kd + 8 * c) = o; }
    LDS_WAIT();
}
DI double dsin_poly(double r) { const double r2 = r * r;
    return r * (1.0 - r2 * (1.0 / 6.0) * (1.0 - r2 * (1.0 / 20.0) * (1.0 - r2 * (1.0 / 42.0) * (1.0 - r2 * (1.0 / 72.0) * (1.0 - r2 * (1.0 / 110.0) * (1.0 - r2 * (1.0 / 156.0) * (1.0 - r2 * (1.0 / 210.0) * (1.0 - r2 * (1.0 / 272.0) * (1.0 - r2 * (1.0 / 342.0) * (1.0 - r2 * (1.0 / 420.0) * (1.0 - r2 * (1.0 / 506.0)))))))))))); }
DI double dcos_poly(double r) { const double r2 = r * r;
    return 1.0 - r2 * (1.0 / 2.0) * (1.0 - r2 * (1.0 / 12.0) * (1.0 - r2 * (1.0 / 30.0) * (1.0 - r2 * (1.0 / 56.0) * (1.0 - r2 * (1.0 / 90.0) * (1.0 - r2 * (1.0 / 132.0) * (1.0 - r2 * (1.0 / 182.0) * (1.0 - r2 * (1.0 / 240.0) * (1.0 - r2 * (1.0 / 306.0) * (1.0 - r2 * (1.0 / 380.0) * (1.0 - r2 * (1.0 / 462.0) * (1.0 - r2 * (1.0 / 552.0)))))))))))); }

constexpr int IT_MOD = DEPTH * 96 * 8;
constexpr int IT_QKV = (DM / 64) * (QKVN / 32), IT_WO = (DM / 64) * (DM / 32), IT_GU = NEXP * (DM / 64) * (FH / 32), IT_DN = NEXP * (FH / 64) * (DM / 32);
constexpr int IT_LAYER = IT_QKV + IT_WO + 2 * IT_GU + IT_DN;
constexpr int IT_TOTAL = IT_MOD + DEPTH * IT_LAYER;

DI void p0_prologue(const Params& P, const Frame& F) {
    LAS float* scr = (LAS float*)(F.lds + F.wave * 16384);
    unsigned char* ws = wsp(P);
    for (int it = F.gw; it < IT_TOTAL; it += F.NGW) {
        if (it < IT_MOD) {
            const int l = it / (96 * 8), rem = it % (96 * 8), cc = rem >> 3, ks = rem & 7;
            for (int idx = F.lane; idx < 17 * 128; idx += 64) { const int b = idx >> 7, k = idx & 127;
                const float cv = (b < 16) ? inp(P, IN_C)[b * DM + ks * 128 + k] : inp(P, IN_CCTX)[ks * 128 + k];
                scr[idx] = cv / (1.f + expf(-cv)); }
            LDS_WAIT();
            float acc[17];
#pragma unroll
            for (int b = 0; b < 17; ++b) acc[b] = 0.f;
            const float* wp = inp(P, IN_WADA) + ((size_t)l * DM + ks * 128) * 6144 + cc * 64 + F.lane;
#pragma unroll 4
            for (int k = 0; k < 128; ++k) { const float w = wp[(size_t)k * 6144];
#pragma unroll
                for (int b = 0; b < 17; ++b) acc[b] += scr[b * 128 + k] * w; }
            float* mp = (float*)(ws + WS_MODP) + ((size_t)(ks * DEPTH + l) * 17) * 6144 + cc * 64 + F.lane;
#pragma unroll
            for (int b = 0; b < 17; ++b) mp[(size_t)b * 6144] = acc[b];
            LDS_WAIT();
            continue;
        }
        int r = it - IT_MOD; const int l = r / IT_LAYER; r -= l * IT_LAYER;
        if (r < IT_QKV) { const int kb = r / (QKVN / 32), nb = r % (QKVN / 32); const int n0 = nb * 32;
            const int drow0 = 256 * (n0 >> 8) + 128 * ((n0 >> 5) & 1) + 32 * ((n0 >> 6) & 3);
            p0_transpose_item(inp(P, IN_WQKV) + (size_t)l * DM * QKVN, QKVN, kb * 64, n0, (bf16_t*)(ws + WS_WQKV) + (size_t)l * QKVN * DM + (size_t)drow0 * DM + kb * 64, DM, scr, F.lane); continue; }
        r -= IT_QKV;
        if (r < IT_WO) { const int kb = r / (DM / 32), nb = r % (DM / 32);
            p0_transpose_item(inp(P, IN_WO) + (size_t)l * DM * DM, DM, kb * 64, nb * 32, (bf16_t*)(ws + WS_WO) + (size_t)l * DM * DM + (size_t)(nb * 32) * DM + kb * 64, DM, scr, F.lane); continue; }
        r -= IT_WO;
        if (r < 2 * IT_GU) { const int which = r / IT_GU; r -= which * IT_GU; const int e = r / 256, kb = (r % 256) / 16, nb = r % 16; const int n0 = nb * 32;
            const int drow0 = 256 * (n0 >> 7) + 128 * which + (n0 & 127);
            p0_transpose_item(inp(P, which ? IN_WUP : IN_WGATE) + (size_t)(l * NEXP + e) * DM * FH, FH, kb * 64, n0,
                              (bf16_t*)(ws + WS_WGU) + (size_t)(l * NEXP + e) * DM * DM + (size_t)drow0 * DM + kb * 64, DM, scr, F.lane); continue; }
        r -= 2 * IT_GU;
        { const int e = r / 256, kb = (r % 256) / 32, nb = r % 32;
            p0_transpose_item(inp(P, IN_WDOWN) + (size_t)(l * NEXP + e) * FH * DM, DM, kb * 64, nb * 32,
                              (bf16_t*)(ws + WS_WD) + (size_t)(l * NEXP + e) * DM * FH + (size_t)(nb * 32) * FH + kb * 64, FH, scr, F.lane); }
    }
    if (F.gw == F.NGW - 1) {
        f32x2* T = (f32x2*)(ws + WS_ROPE);
        for (int idx = F.lane; idx < 64 * 16; idx += 64) { const int pos = idx >> 4, j = idx & 15;
            const float inv = exp2f(-(float)j * (1.f / 16.f) * 13.287712379549449f);
            const float ang = (float)pos * inv;
            const double a = (double)ang; const double rr = a - 6.283185307179586 * rint(a * 0.15915494309189535);
            T[idx] = (f32x2){(float)dcos_poly(rr), (float)dsin_poly(rr)}; }
    }
    { u32x4* wf = (u32x4*)(ws + WS_WRT); const float* wg = inp(P, IN_WGROUP); const float* wr = inp(P, IN_WROUTER);
      for (int idx = F.gw * 64 + F.lane; idx < DEPTH * 32 * 3 * 2 * 64; idx += F.NGW * 64) { const int l = idx / (32 * 3 * 2 * 64), rem = idx % (32 * 3 * 2 * 64), step = rem / 384, nt = (rem % 384) >> 7, which = (rem >> 6) & 1, ln = rem & 63;
          const int n = 16 * nt + (ln & 15); float w[8];
#pragma unroll
          for (int j = 0; j < 8; ++j) { const int k = 32 * step + 8 * (ln >> 4) + j;
              const float wv = (n < 4) ? wg[((size_t)l * DM + k) * 4 + n] : (n < 36 ? wr[((size_t)l * DM + k) * 32 + (n - 4)] : 0.f);
              const float w1 = bf2f(f2bf(wv)); w[j] = which ? (wv - w1) : wv; }
          u32x4 o; o.x = pk2(w[0], w[1]); o.y = pk2(w[2], w[3]); o.z = pk2(w[4], w[5]); o.w = pk2(w[6], w[7]); wf[idx] = o; } }
}
DI void p0b_mod_reduce(const Params& P, const Frame& F) {
    unsigned char* const ws = wsp(P);
    const float* mp = (const float*)(ws + WS_MODP); float* mod = (float*)(ws + WS_MOD);
    for (int idx = F.gw * 64 + F.lane; idx < DEPTH * 17 * 6144; idx += F.NGW * 64) {
        const int l = idx / (17 * 6144), c = idx % 6144;
        float s = inp(P, IN_BADA)[l * 6144 + c];
#pragma unroll
        for (int ks = 0; ks < 8; ++ks) s += mp[(size_t)ks * DEPTH * 17 * 6144 + idx];
        mod[idx] = s; }
}

DI unsigned expert_count(const unsigned char* ws, int layer, int e) { return __hip_atomic_load((const unsigned*)(ws + WS_CTL) + CW_CNT + (layer * NEXP + e) * CNT_STRIDE, __ATOMIC_RELAXED, __HIP_MEMORY_SCOPE_AGENT); }
DI unsigned expert_starts(const unsigned char* ws, int layer, int lane) {
    const unsigned p = (lane < NEXP) ? ((expert_count(ws, layer, lane & 31) + 255u) & ~255u) : 0u; unsigned incl = p;
#pragma unroll
    for (int d = 1; d < 32; d <<= 1) { const unsigned v = __shfl_up(incl, d); if ((lane & 31) >= d) incl += v; }
    return incl - p;
}

DI void load_row(const float* row, int lane, f32x4 (&v)[4]) {
#pragma unroll
    for (int j = 0; j < 4; ++j) v[j] = *(const f32x4*)(row + 4 * lane + 256 * j);
}
DI void load_row_bf(const bf16_t* row, int lane, f32x4 (&v)[4]) {
#pragma unroll
    for (int j = 0; j < 4; ++j) { const u32x2 w = *(const u32x2*)(row + 4 * lane + 256 * j); v[j] = (f32x4){bf2f(w.x & 0xffffu), bf2f(w.x >> 16), bf2f(w.y & 0xffffu), bf2f(w.y >> 16)}; }
}
DI float row_rstd(const f32x4 (&v)[4]) {
    float s = 0.f;
#pragma unroll
    for (int j = 0; j < 4; ++j) s += (v[j][0] * v[j][0] + v[j][1] * v[j][1]) + (v[j][2] * v[j][2] + v[j][3] * v[j][3]);
    return 1.0f / sqrtf(wave_sum(s) * (1.f / DM) + NORM_EPS);
}
DI void load_vec(const float* p, int lane, f32x4 (&v)[4]) {
#pragma unroll
    for (int j = 0; j < 4; ++j) v[j] = *(const f32x4*)(p + 4 * lane + 256 * j);
}
DI void norm_mod_store(const f32x4 (&v)[4], float rstd, const f32x4 (&gg)[4], const f32x4 (&sh)[4], const f32x4 (&sc)[4], bf16_t* hrow, int lane) {
#pragma unroll
    for (int j = 0; j < 4; ++j) { const int c = 4 * lane + 256 * j;
        const f32x4 hf = (v[j] * rstd * gg[j]) * (1.f + sc[j]) + sh[j];
        u32x2 w; w.x = pk2(hf[0], hf[1]); w.y = pk2(hf[2], hf[3]); *(u32x2*)(hrow + c) = w; }
}
struct RowIn { f32x4 x[4]; u32x2 ya[4], yb[4]; };
DI void row_fetch(const unsigned char* ws, const float* xrow, const bf16_t* xrow_bf, int t, unsigned s0, unsigned s1, int lane, bool prev, RowIn& R) {
    if (xrow_bf) load_row_bf(xrow_bf, lane, R.x); else load_row(xrow, lane, R.x);
    if (prev) {
        const bf16_t* Y = (const bf16_t*)(ws + WS_Y);
#pragma unroll
        for (int j = 0; j < 4; ++j) { R.ya[j] = *(const u32x2*)(Y + (size_t)s0 * DM + 4 * lane + 256 * j); R.yb[j] = *(const u32x2*)(Y + (size_t)s1 * DM + 4 * lane + 256 * j); } }
}
DI void row_apply(const f32x4 (&gt)[4], float w0, float w1, RowIn& R) {
#pragma unroll
    for (int j = 0; j < 4; ++j) { const f32x4 g = gt[j]; const u32x2 a = R.ya[j], b = R.yb[j];
        R.x[j][0] += g[0] * (w0 * bf2f(a.x & 0xffffu) + w1 * bf2f(b.x & 0xffffu)); R.x[j][1] += g[1] * (w0 * bf2f(a.x >> 16) + w1 * bf2f(b.x >> 16));
        R.x[j][2] += g[2] * (w0 * bf2f(a.y & 0xffffu) + w1 * bf2f(b.y & 0xffffu)); R.x[j][3] += g[3] * (w0 * bf2f(a.y >> 16) + w1 * bf2f(b.y >> 16)); }
}
DI void phase_attn_norm(const Params& P, const Frame& F0, int layer) {
    const Frame F = opaque_frame(F0);
    unsigned char* const ws = wsp(P);
    bf16_t* X = (bf16_t*)(ws + WS_X); bf16_t* H = (bf16_t*)(ws + WS_H);
    const bool prev = layer > 0;
    const int nrow = (TALL - F.gw + F.NGW - 1) / F.NGW;
    unsigned ms0 = 0, ms1 = 0; float mw0 = 0.f, mw1 = 0.f;
    if (prev) { const unsigned pst = expert_starts(ws, layer - 1, F.lane); u32x2 a = (u32x2){0u, 0u};
        if (F.lane < nrow) { const int tl = F.gw + F.lane * F.NGW; a = *(const u32x2*)((const unsigned*)(ws + WS_ASG) + (size_t)tl * 2); const f32x2 w = *(const f32x2*)((const float*)(ws + WS_ASGW) + (size_t)tl * 2); mw0 = w.x; mw1 = w.y; }
        ms0 = (unsigned)__shfl((int)pst, (int)(a.x >> 20)) + (a.x & 0xfffffu); ms1 = (unsigned)__shfl((int)pst, (int)(a.y >> 20)) + (a.y & 0xfffffu); }
    auto xsrc = [&](int t) -> const float* { return (t < TLAT ? inp(P, IN_X) + (size_t)t * DM : inp(P, IN_CTX) + (size_t)(t - TLAT) * DM); };
    auto xbf = [&](int t) -> const bf16_t* { return prev ? X + (size_t)t * DM : (const bf16_t*)nullptr; };
    RowIn cur, nxt;
    f32x4 gat[4]; load_vec(inp(P, IN_GATTN) + layer * DM, F.lane, gat);
    row_fetch(ws, xsrc(F.gw), xbf(F.gw), F.gw, __shfl(ms0, 0), __shfl(ms1, 0), F.lane, prev, cur);
    for (int i = 0; i < nrow; ++i) {
        const int t = F.gw + i * F.NGW; const int mb = (t < TLAT) ? (t >> 11) : 16;
        const float* md = (const float*)(ws + WS_MOD) + ((size_t)layer * 17 + mb) * 6144;
        f32x4 gt[4], sh[4], sc[4];
        if (prev) load_vec(md - 17 * 6144 + 5120, F.lane, gt);
        load_vec(md, F.lane, sh); load_vec(md + 1024, F.lane, sc);
        asm volatile("" ::: "memory");
        if (i + 1 < nrow) row_fetch(ws, xsrc(t + F.NGW), xbf(t + F.NGW), t + F.NGW, __shfl(ms0, i + 1), __shfl(ms1, i + 1), F.lane, prev, nxt);
        if (prev) row_apply(gt, __shfl(mw0, i), __shfl(mw1, i), cur);
#pragma unroll
        for (int j = 0; j < 4; ++j) { u32x2 w; w.x = pk2(cur.x[j][0], cur.x[j][1]); w.y = pk2(cur.x[j][2], cur.x[j][3]); *(u32x2*)(X + (size_t)t * DM + 4 * F.lane + 256 * j) = w; }
        const float rstd = row_rstd(cur.x);
        norm_mod_store(cur.x, rstd, gat, sh, sc, H + (size_t)t * DM, F.lane);
        cur = nxt;
    }
}
DI void phase_final(const Params& P, const Frame& F0) {
    const Frame F = opaque_frame(F0);
    unsigned char* const ws = wsp(P);
    const bf16_t* X = (const bf16_t*)(ws + WS_X);
    const float pc = PROBE_SEL ? *((const float*)(ws + WS_CTL) + 64) : 0.f;
    const int nrow = (TLAT - F.gw + F.NGW - 1) / F.NGW;
    unsigned ms0 = 0, ms1 = 0; float mw0 = 0.f, mw1 = 0.f;
    { const unsigned pst = expert_starts(ws, DEPTH - 1, F.lane); u32x2 a = (u32x2){0u, 0u};
      if (F.lane < nrow) { const int tl = F.gw + F.lane * F.NGW; a = *(const u32x2*)((const unsigned*)(ws + WS_ASG) + (size_t)tl * 2); const f32x2 w = *(const f32x2*)((const float*)(ws + WS_ASGW) + (size_t)tl * 2); mw0 = w.x; mw1 = w.y; }
      ms0 = (unsigned)__shfl((int)pst, (int)(a.x >> 20)) + (a.x & 0xfffffu); ms1 = (unsigned)__shfl((int)pst, (int)(a.y >> 20)) + (a.y & 0xfffffu); }
    RowIn cur, nxt;
    row_fetch(ws, nullptr, X + (size_t)F.gw * DM, F.gw, __shfl(ms0, 0), __shfl(ms1, 0), F.lane, true, cur);
    f32x4 gfin[4]; load_vec(inp(P, IN_GFINAL), F.lane, gfin);
    for (int i = 0; i < nrow; ++i) {
        const int t = F.gw + i * F.NGW;
        f32x4 gt[4]; load_vec((const float*)(ws + WS_MOD) + ((size_t)(DEPTH - 1) * 17 + (t >> 11)) * 6144 + 5120, F.lane, gt);
        asm volatile("" ::: "memory");
        if (i + 1 < nrow) row_fetch(ws, nullptr, X + (size_t)(t + F.NGW) * DM, t + F.NGW, __shfl(ms0, i + 1), __shfl(ms1, i + 1), F.lane, true, nxt);
        row_apply(gt, __shfl(mw0, i), __shfl(mw1, i), cur);
        const float rstd = row_rstd(cur.x);
#pragma unroll
        for (int j = 0; j < 4; ++j) { const int c = 4 * F.lane + 256 * j; *(f32x4*)(P.out + (size_t)t * DM + c) = cur.x[j] * rstd * gfin[j] + pc; }
        cur = nxt;
    }
}

DI float swap_max(float v) { auto rr = __builtin_amdgcn_permlane32_swap(__float_as_uint(v), __float_as_uint(v), false, false); return fmaxf(__uint_as_float(rr[0]), __uint_as_float(rr[1])); }
DI float swap_add(float v) { auto rr = __builtin_amdgcn_permlane32_swap(__float_as_uint(v), __float_as_uint(v), false, false); return __uint_as_float(rr[0]) + __uint_as_float(rr[1]); }
DI bf16x8 pack_p(const f32x16& p, int s) {
    u32x4 w; w.x = cvt_pk_bf16(p[8 * s + 0], p[8 * s + 1]); w.y = cvt_pk_bf16(p[8 * s + 2], p[8 * s + 3]); w.z = cvt_pk_bf16(p[8 * s + 4], p[8 * s + 5]); w.w = cvt_pk_bf16(p[8 * s + 6], p[8 * s + 7]);
    return __builtin_bit_cast(bf16x8, w);
}
struct AttnState { float m, l; f32x16 o[2]; };
DI void load_k(const unsigned char* Kbh, int kg, int r32, int hi, bf16x8 (&k)[4]) {
    const unsigned char* kb = Kbh + (size_t)(kg + (r32 >> 3)) * 1024 + hi * 128 + (r32 & 7) * 16;
#pragma unroll
    for (int d0 = 0; d0 < 4; ++d0) k[d0] = *(const bf16x8*)(kb + d0 * 256);
}
DI void load_v(const unsigned char* Vbh, int kg, int r32, int hi, s16x4 (&v)[2][2][2]) {
    const unsigned char* vb = Vbh + (size_t)kg * 1024 + r32 * 16 + hi * 8;
#pragma unroll
    for (int dh = 0; dh < 2; ++dh)
#pragma unroll
        for (int ks = 0; ks < 2; ++ks)
#pragma unroll
            for (int pt = 0; pt < 2; ++pt) v[dh][ks][pt] = *(const s16x4*)(vb + dh * 512 + (2 * ks + pt) * 1024);
}
DI f32x16 attn_scores(const bf16x8 (&k)[4], const bf16x8 (&q)[4]) {
    f32x16 s;
#pragma unroll
    for (int r = 0; r < 16; ++r) s[r] = 0.f;
#pragma unroll
    for (int d0 = 0; d0 < 4; ++d0) s = __builtin_amdgcn_mfma_f32_32x32x16_bf16(k[d0], q[d0], s, 0, 0, 0);
    return s;
}
DI float row_max16(const f32x16& s) {
    float mt = fmaxf(fmaxf(s[0], s[1]), fmaxf(s[2], s[3]));
#pragma unroll
    for (int r = 4; r < 16; r += 4) mt = fmaxf(mt, fmaxf(fmaxf(s[r], s[r + 1]), fmaxf(s[r + 2], s[r + 3])));
    return mt;
}
DI void attn_rescale(AttnState& st, f32x16& s, float mt, LAS float* wsf, int r32, int hi) {
    mt = swap_max(mt);
    const float dm = fmaxf(mt, 0.f);
    const float al = __builtin_amdgcn_exp2f(-dm);
    st.l *= al; st.m += dm;
#pragma unroll
    for (int r = 0; r < 16; ++r) s[r] -= dm;
    if (hi == 0) wsf[r32] = al;
    LDS_WAIT();
#pragma unroll
    for (int r = 0; r < 16; ++r) { const float f = wsf[crow(r, hi)]; st.o[0][r] *= f; st.o[1][r] *= f; }
    LDS_WAIT();
}
DI void attn_exp_pv(AttnState& st, f32x16& s, const s16x4 (&v)[2][2][2]) {
    float p0 = 0.f, p1 = 0.f;
#pragma unroll
    for (int r = 0; r < 16; r += 2) { s[r] = __builtin_amdgcn_exp2f(s[r]); s[r + 1] = __builtin_amdgcn_exp2f(s[r + 1]); p0 += s[r]; p1 += s[r + 1]; }
    st.l += p0 + p1;
    const bf16x8 pa0 = pack_p(s, 0), pa1 = pack_p(s, 1);
#pragma unroll
    for (int dh = 0; dh < 2; ++dh) {
        const bf16x8 vf0 = __builtin_shufflevector(v[dh][0][0], v[dh][0][1], 0, 1, 2, 3, 4, 5, 6, 7);
        const bf16x8 vf1 = __builtin_shufflevector(v[dh][1][0], v[dh][1][1], 0, 1, 2, 3, 4, 5, 6, 7);
        st.o[dh] = __builtin_amdgcn_mfma_f32_32x32x16_bf16(pa0, vf0, st.o[dh], 0, 0, 0);
        st.o[dh] = __builtin_amdgcn_mfma_f32_32x32x16_bf16(pa1, vf1, st.o[dh], 0, 0, 0);
    }
}
DI void attn_softmax_pv2(AttnState (&st)[2], f32x16 (&s)[2], const s16x4 (&v)[2][2][2], LAS float* wsf, int r32, int hi) {
#pragma unroll
    for (int r = 0; r < 16; ++r) { s[0][r] -= st[0].m; s[1][r] -= st[1].m; }
    const float mt0 = row_max16(s[0]), mt1 = row_max16(s[1]);
    if (__any(fmaxf(mt0, mt1) > 8.f)) { attn_rescale(st[0], s[0], mt0, wsf, r32, hi); attn_rescale(st[1], s[1], mt1, wsf + 32, r32, hi); }
    attn_exp_pv(st[0], s[0], v);
    attn_exp_pv(st[1], s[1], v);
}
template <int MODE>
DI void attn_unit(const Params& P, unsigned char* ws, int layer, int b, int h0, int qblk, LAS unsigned char* wl, int lane) {
    const int r32 = lane & 31, hi = lane >> 5, kvh = h0 >> 2, m = layer % 3;
    constexpr bool VDB = false;
    LAS float* wsf = (LAS float*)wl; LAS bf16_t* stg = (LAS bf16_t*)(wl + 256); LAS float* rpbt = (LAS float*)(wl + 256 + 4096);
    const bf16_t* QKV = (const bf16_t*)(ws + WS_QKV);
    const unsigned char* Kbh = ws + WS_KF + (size_t)(b * NKV + kvh) * KGRP * 1024;
    const unsigned char* Vbh = ws + WS_VF + (size_t)(b * NKV + kvh) * KGRP * 1024;
    bf16_t* O = (bf16_t*)(ws + WS_O);
    int r0 = 0, c0 = 0;
    if (MODE == 2) { r0 = 2 * (qblk >> 2); c0 = 16 * (qblk & 3); }
    auto qtok = [&](int i) -> int {
        if (MODE == 3) return TLAT + b * CTXL + qblk * 32 + i;
        if (MODE == 2) return b * SEQ + (r0 + (i >> 4)) * 64 + c0 + (i & 15);
        return b * SEQ + qblk * 32 + i; };
    const int tq = qtok(r32);
    const bf16_t* qp = QKV + (size_t)tq * QKVN + h0 * HD + hi * 8;
    bf16x8 qr[2][4];
#pragma unroll
    for (int hh = 0; hh < 2; ++hh)
#pragma unroll
        for (int d0 = 0; d0 < 4; ++d0) qr[hh][d0] = *(const bf16x8*)(qp + hh * HD + d0 * 16);
    const int q0 = qblk * 32;
    int nl = 0, jlo = 0, rs_min = 0, cseg = 0;
    if (MODE == 0) { jlo = (q0 < 128) ? (128 - q0) / 32 : 0; const int jhi = min(8, (SEQ - 32 - q0 + 128) / 32); nl = jhi - jlo + 1; }
    if (MODE == 1) nl = SEQ / 32;
    if (MODE == 2) { rs_min = min(max(r0 - 4, 0), 24); const int rs_max = min(max(r0 + 1 - 4, 0), 24); nl = rs_max - rs_min + 8; cseg = (c0 == 0) ? 0 : (c0 == 16) ? 8 : (c0 == 32) ? 24 : 32; }
    auto lat_kg = [&](int i) -> int {
        if (MODE == 0) return (q0 - 128 + 32 * (jlo + i)) >> 3;
        if (MODE == 1) return 4 * i;
        return ((rs_min + i) * 64 + cseg) >> 3; };
    bf16x8 kn[4];
    load_k(Kbh, nl > 0 ? lat_kg(0) : SEQ / 8, r32, hi, kn);
    if (MODE == 0 || MODE == 1) {
        const int n = tq & 2047; const f32x2* T = (const f32x2*)(ws + WS_ROPE);
        const f32x2* tr = T + (n >> 6) * 16 + 8 * hi; const f32x2* tc = T + (n & 63) * 16 + 8 * hi;
#pragma unroll
        for (int e = 0; e < 8; ++e) { const f32x2 a = tr[e], cc = tc[e];
#pragma unroll
            for (int hh = 0; hh < 2; ++hh) {
                const float x1 = bfs2f(qr[hh][0][e]), x2 = bfs2f(qr[hh][1][e]), x3 = bfs2f(qr[hh][2][e]), x4 = bfs2f(qr[hh][3][e]);
                qr[hh][0][e] = (short)f2bf(x1 * a.x - x2 * a.y); qr[hh][1][e] = (short)f2bf(x2 * a.x + x1 * a.y);
                qr[hh][2][e] = (short)f2bf(x3 * cc.x - x4 * cc.y); qr[hh][3][e] = (short)f2bf(x4 * cc.x + x3 * cc.y); } }
    }
    LAS bf16x8* qlds = (LAS bf16x8*)(wl + 8192) + lane;
    if (VDB) {
#pragma unroll
        for (int d0 = 0; d0 < 4; ++d0) qlds[d0 * 64] = qr[1][d0];
        LDS_WAIT();
    }
    int rq = 0, cq = 0, rsq = 0, csq = 0;
    if (MODE == 2) {
        const float* rpb = inp(P, IN_RPB) + (size_t)h0 * 465;
        for (int i = lane; i < 930; i += 64) rpbt[i + (i >= 465 ? 7 : 0)] = rpb[i] * LOG2E;
        LDS_WAIT();
        rq = r0 + (r32 >> 4); cq = c0 + (r32 & 15); rsq = min(max(rq - 4, 0), 24); csq = min(max(cq - 8, 0), 48);
    }
    AttnState st[2];
#pragma unroll
    for (int hh = 0; hh < 2; ++hh) { st[hh].m = -1024.f; st[hh].l = 0.f;
#pragma unroll
        for (int r = 0; r < 16; ++r) { st[hh].o[0][r] = 0.f; st[hh].o[1][r] = 0.f; } }
    const float NEG = -INFINITY;
    s16x4 vn[2][2][2];
    if (VDB) load_v(Vbh, nl > 0 ? lat_kg(0) : SEQ / 8, r32, hi, vn);
    for (int i = 0; i < nl; ++i) {
        const int kgn = (i + 1 < nl) ? lat_kg(i + 1) : SEQ / 8;
        s16x4 v[2][2][2];
        if (VDB) {
#pragma unroll
            for (int a = 0; a < 2; ++a)
#pragma unroll
                for (int c = 0; c < 2; ++c)
#pragma unroll
                    for (int e = 0; e < 2; ++e) v[a][c][e] = vn[a][c][e];
        } else load_v(Vbh, lat_kg(i), r32, hi, v);
        f32x16 s[2];
        s[0] = attn_scores(kn, qr[0]);
        if (VDB) { bf16x8 q1[4];
#pragma unroll
            for (int d0 = 0; d0 < 4; ++d0) q1[d0] = qlds[d0 * 64];
            s[1] = attn_scores(kn, q1); }
        else s[1] = attn_scores(kn, qr[1]);
        load_k(Kbh, kgn, r32, hi, kn);
        if (VDB) load_v(Vbh, kgn, r32, hi, vn);
        if (MODE == 0) {
            const int j = jlo + i;
            if (j == 0 || j == 8) { const int kt = q0 - 128 + 32 * j, qpos = q0 + r32;
#pragma unroll
                for (int r = 0; r < 16; ++r) { const int d = kt + crow(r, hi) - qpos; if (d > 128 || d < -128) { s[0][r] = NEG; s[1][r] = NEG; } } }
        }
        if (MODE == 2) {
            const int kr = rs_min + i;
            const bool rowok = (kr >= rsq) && (kr < rsq + 8);
            const int ib = (kr - rq + 7) * 31 - cq + 15;
#pragma unroll
            for (int r = 0; r < 16; ++r) { const int idx = min(max(ib + cseg + crow(r, hi), 0), 464);
                s[0][r] += rpbt[idx]; s[1][r] += rpbt[472 + idx]; }
            asm volatile("" ::: "memory");
#pragma unroll
            for (int r = 0; r < 16; ++r) { const int kc2 = cseg + crow(r, hi); const bool ok = rowok && (kc2 >= csq) && (kc2 < csq + 16);
                s[0][r] = ok ? s[0][r] : NEG; s[1][r] = ok ? s[1][r] : NEG; }
        }
        attn_softmax_pv2(st, s, v, wsf, r32, hi);
    }
    if (MODE == 0 || MODE == 1) {
#pragma unroll
        for (int hh = 0; hh < 2; ++hh)
#pragma unroll
            for (int d0 = 0; d0 < 4; ++d0) qr[hh][d0] = *(const bf16x8*)(qp + hh * HD + d0 * 16);
        if (VDB) {
#pragma unroll
            for (int d0 = 0; d0 < 4; ++d0) qlds[d0 * 64] = qr[1][d0];
            LDS_WAIT();
        }
    }
    for (int j = 0; j < CTXL / 32; ++j) {
        const int kg = SEQ / 8 + 4 * j, kgn = (j + 1 < CTXL / 32) ? kg + 4 : kg;
        s16x4 v[2][2][2];
        if (VDB) {
#pragma unroll
            for (int a = 0; a < 2; ++a)
#pragma unroll
                for (int c = 0; c < 2; ++c)
#pragma unroll
                    for (int e = 0; e < 2; ++e) v[a][c][e] = vn[a][c][e];
        } else load_v(Vbh, kg, r32, hi, v);
        f32x16 s[2];
        s[0] = attn_scores(kn, qr[0]);
        if (VDB) { bf16x8 q1[4];
#pragma unroll
            for (int d0 = 0; d0 < 4; ++d0) q1[d0] = qlds[d0 * 64];
            s[1] = attn_scores(kn, q1); }
        else s[1] = attn_scores(kn, qr[1]);
        load_k(Kbh, kgn, r32, hi, kn);
        if (VDB) load_v(Vbh, kgn, r32, hi, vn);
        attn_softmax_pv2(st, s, v, wsf, r32, hi);
    }
    int lane2 = lane; asm volatile("" : "+v"(lane2));
    const int r32b = lane2 & 31, hib = lane2 >> 5;
#pragma unroll
    for (int hh = 0; hh < 2; ++hh) {
        const float lt = swap_add(st[hh].l);
        float inv;
        if (MODE == 0 || (MODE == 3 && m == 0)) { const float sk = inp(P, IN_SINK)[(layer / 3) * NH + h0 + hh] * LOG2E;
            const float mnew = fmaxf(st[hh].m, sk); const float al = __builtin_amdgcn_exp2f(st[hh].m - mnew), es = __builtin_amdgcn_exp2f(sk - mnew);
            inv = al / (lt * al + es); }
        else inv = 1.f / lt;
        if (hib == 0) wsf[r32b] = inv;
        LDS_WAIT();
        LAS bf16_t* sb = stg + hib * 256 + r32b;
        const LAS float* wf = wsf + 4 * hib;
#pragma unroll
        for (int r = 0; r < 16; ++r) { const float f = wf[(r & 3) + 8 * (r >> 2)];
            sb[((r & 3) + 8 * (r >> 2)) * 64] = (bf16_t)f2bf(st[hh].o[0][r] * f); sb[((r & 3) + 8 * (r >> 2)) * 64 + 32] = (bf16_t)f2bf(st[hh].o[1][r] * f); }
        LDS_WAIT();
        const int rw = lane2 >> 3, ch = lane2 & 7;
        const LAS unsigned char* rb = (const LAS unsigned char*)stg + rw * 128 + ch * 16;
#pragma unroll
        for (int i = 0; i < 4; ++i) { const u32x4 vv = *(const LAS u32x4*)(rb + i * 1024);
            *(u32x4*)(O + (size_t)qtok(i * 8 + rw) * DM + (h0 + hh) * HD + ch * 8) = vv; }
        LDS_WAIT();
    }
}
DI void phase_attention(const Params& P, const Frame& F0, int layer) {
    const Frame F = opaque_frame(F0);
    unsigned char* const ws = wsp(P);
    const int m = layer % 3;
    LAS unsigned char* wl = F.lds + F.wave * 16384;
    for (int bu = F.blk; bu < NB * NKV * 16; bu += F.G) {
        const int rnd = bu >> 8, x = bu & 7, loc = (bu & 255) >> 3;
        const int bkv = rnd * 16 + x * 2 + (loc >> 4), qg = loc & 15;
        const int b = bkv >> 2, kvh = bkv & 3, h0 = kvh * 4 + 2 * (F.wave & 1), qblk = 4 * qg + (F.wave >> 1);
        if (m == 0) attn_unit<0>(P, ws, layer, b, h0, qblk, wl, F.lane);
        else if (m == 1) attn_unit<1>(P, ws, layer, b, h0, qblk, wl, F.lane);
        else attn_unit<2>(P, ws, layer, b, h0, qblk, wl, F.lane);
    }
    if (layer < DEPTH - 1) {
        for (int bu = F.blk; bu < NB * NKV * 2; bu += F.G) {
            const int bkv = bu >> 1, b = bkv >> 2, kvh = bkv & 3, h0 = kvh * 4 + 2 * (F.wave & 1), qblk = 4 * (bu & 1) + (F.wave >> 1);
            attn_unit<3>(P, ws, layer, b, h0, qblk, wl, F.lane);
        }
    }
}

DI int blk_token(int blk, int i) { return i < 128 ? blk * 128 + i : TLAT + blk * 16 + (i - 128); }
constexpr int RT_ROWB = 2064;
constexpr int RT_X2_OFF = 16 * RT_ROWB, RT_PART_OFF = 2 * 16 * RT_ROWB, RT_LOG_OFF = RT_PART_OFF + 8 * 16 * 48 * 4, RT_LOGS = 37, RT_VEC_OFF = RT_LOG_OFF + 144 * RT_LOGS * 4;
DI void phase_router(const Params& P, const Frame& F0, int layer, int M) {
    const Frame F = opaque_frame(F0);
    unsigned char* const ws = wsp(P);
    const int TPB = M / GRID, nchunk = TPB / 16;
    LAS int* hist = (LAS int*)(F.lds + LDSX_OFF);
    LAS float* part = (LAS float*)(F.lds + RT_PART_OFF); LAS float* logit = (LAS float*)(F.lds + RT_LOG_OFF);
    if (F.tid < 32) hist[F.tid] = 0;
    const bf16_t* X = (const bf16_t*)(ws + WS_X); bf16_t* H = (bf16_t*)(ws + WS_H);
    const float* gffn = inp(P, IN_GFFN) + layer * DM;
    const u32x4* wf = (const u32x4*)(ws + WS_WRT) + ((size_t)layer * 32 + 4 * F.wave) * 384 + F.lane;
    bf16x8 wreg[4][2][2];
#pragma unroll
    for (int s = 0; s < 4; ++s)
#pragma unroll
        for (int nt = 0; nt < 2; ++nt)
#pragma unroll
            for (int wh = 0; wh < 2; ++wh) wreg[s][nt][wh] = __builtin_bit_cast(bf16x8, wf[s * 384 + nt * 128 + wh * 64]);
    bf16x8 w2t[4][2];
#pragma unroll
    for (int s = 0; s < 4; ++s)
#pragma unroll
        for (int wh = 0; wh < 2; ++wh) w2t[s][wh] = __builtin_bit_cast(bf16x8, wf[s * 384 + 256 + wh * 64]);
    LAS float* vec = (LAS float*)(F.lds + RT_VEC_OFF);
    auto load_vecs = [&](int mb) {
        const float* md = (const float*)(ws + WS_MOD) + ((size_t)layer * 17 + mb) * 6144;
        for (int i = F.tid; i < 256; i += NTHREADS) { const f32x4 g = *(const f32x4*)(gffn + 4 * i), sc = *(const f32x4*)(md + 4096 + 4 * i);
            *(LAS f32x4*)(vec + 4 * i) = *(const f32x4*)(md + 2048 + 4 * i); *(LAS f32x4*)(vec + 1024 + 4 * i) = g * (1.f + sc); *(LAS f32x4*)(vec + 2048 + 4 * i) = *(const f32x4*)(md + 3072 + 4 * i); } };
    load_vecs(F.blk >> 4);
    const int ib = 2 * F.wave;
    f32x4 vn[2][4];
#pragma unroll
    for (int tk = 0; tk < 2; ++tk) { const int t = blk_token(F.blk, ib + tk); load_row_bf(X + (size_t)t * DM, F.lane, vn[tk]); }
    LDS_WAIT(); __syncthreads();
    for (int c = 0; c < nchunk; ++c) {
        if (c == 8) { load_vecs(16); LDS_WAIT(); __syncthreads(); }
#pragma unroll
        for (int tk = 0; tk < 2; ++tk) { const int t = blk_token(F.blk, c * 16 + ib + tk);
            const float rstd = row_rstd(vn[tk]);
            LAS unsigned char* r1 = F.lds + (ib + tk) * RT_ROWB + 8 * F.lane; bf16_t* hrow = H + (size_t)t * DM;
#pragma unroll
            for (int j = 0; j < 4; ++j) { const int cc = 4 * F.lane + 256 * j; const f32x4 ga = *(const LAS f32x4*)(vec + 1024 + cc), sh = *(const LAS f32x4*)(vec + 2048 + cc);
                const f32x4 hf = (vn[tk][j] * rstd) * ga + sh;
                u32x2 a; a.x = pk2(hf[0], hf[1]); a.y = pk2(hf[2], hf[3]);
                u32x2 b; b.x = pk2(hf[0] - bf2f(a.x & 0xffffu), hf[1] - bf2f(a.x >> 16)); b.y = pk2(hf[2] - bf2f(a.y & 0xffffu), hf[3] - bf2f(a.y >> 16));
                *(u32x2*)(hrow + cc) = a; *(LAS u32x2*)(r1 + 512 * j) = a; *(LAS u32x2*)(r1 + RT_X2_OFF + 512 * j) = b; } }
        if (c + 1 < nchunk) {
#pragma unroll
            for (int tk = 0; tk < 2; ++tk) { const int t = blk_token(F.blk, (c + 1) * 16 + ib + tk); load_row_bf(X + (size_t)t * DM, F.lane, vn[tk]); }
        }
        LDS_WAIT(); __syncthreads();
        f32x4 acc[3];
#pragma unroll
        for (int nt = 0; nt < 3; ++nt) acc[nt] = (f32x4){0.f, 0.f, 0.f, 0.f};
        { const LAS unsigned char* ap = F.lds + (F.lane & 15) * RT_ROWB + 256 * F.wave + 16 * (F.lane >> 4);
#pragma unroll
          for (int s = 0; s < 4; ++s) { const bf16x8 a1 = *(const LAS bf16x8*)(ap + 64 * s), a2 = *(const LAS bf16x8*)(ap + RT_X2_OFF + 64 * s);
#pragma unroll
              for (int nt = 0; nt < 2; ++nt) { acc[nt] = __builtin_amdgcn_mfma_f32_16x16x32_bf16(a1, wreg[s][nt][0], acc[nt], 0, 0, 0);
                  acc[nt] = __builtin_amdgcn_mfma_f32_16x16x32_bf16(a1, wreg[s][nt][1], acc[nt], 0, 0, 0); acc[nt] = __builtin_amdgcn_mfma_f32_16x16x32_bf16(a2, wreg[s][nt][0], acc[nt], 0, 0, 0); }
              acc[2] = __builtin_amdgcn_mfma_f32_16x16x32_bf16(a1, w2t[s][0], acc[2], 0, 0, 0);
              acc[2] = __builtin_amdgcn_mfma_f32_16x16x32_bf16(a1, w2t[s][1], acc[2], 0, 0, 0); acc[2] = __builtin_amdgcn_mfma_f32_16x16x32_bf16(a2, w2t[s][0], acc[2], 0, 0, 0); } }
        { LAS float* pp = part + F.wave * 768 + (4 * (F.lane >> 4)) * 48 + (F.lane & 15);
#pragma unroll
          for (int nt = 0; nt < 3; ++nt)
#pragma unroll
              for (int r = 0; r < 4; ++r) pp[r * 48 + 16 * nt] = acc[nt][r]; }
        LDS_WAIT(); __syncthreads();
        { const int tk = F.tid >> 5, n = F.tid & 31; float s = 0.f;
#pragma unroll
          for (int w = 0; w < 8; ++w) s += part[w * 768 + tk * 48 + n];
          logit[(c * 16 + tk) * RT_LOGS + n] = s;
          if (F.tid < 64) { const int tk2 = F.tid >> 2, n2 = 32 + (F.tid & 3); float s2 = 0.f;
#pragma unroll
              for (int w = 0; w < 8; ++w) s2 += part[w * 768 + tk2 * 48 + n2];
              logit[(c * 16 + tk2) * RT_LOGS + n2] = s2; } }
    }
    LDS_WAIT(); __syncthreads();
    int rt_t = 0, rt_e1 = 0, rt_e2 = 0, rt_q1 = 0, rt_q2 = 0; float rt_w1 = 0.f, rt_w2 = 0.f;
    if (F.tid < TPB) { const int t = blk_token(F.blk, F.tid); const LAS float* lg = logit + F.tid * RT_LOGS;
        const float* bg = inp(P, IN_BGROUP) + layer * 4; const float* br = inp(P, IN_BROUTER) + layer * 32;
        const float g0 = lg[0] + bg[0], g1 = lg[1] + bg[1], g2 = lg[2] + bg[2], g3 = lg[3] + bg[3];
        int grp = 0; float gm = g0; if (g1 > gm) { gm = g1; grp = 1; } if (g2 > gm) { gm = g2; grp = 2; } if (g3 > gm) { gm = g3; grp = 3; }
        const float ptop = 1.f / (expf(g0 - gm) + expf(g1 - gm) + expf(g2 - gm) + expf(g3 - gm));
        float ev[8], em = -INFINITY;
#pragma unroll
        for (int j = 0; j < 8; ++j) { ev[j] = lg[4 + grp * 8 + j] + br[grp * 8 + j]; em = fmaxf(em, ev[j]); }
        float pe[8];
#pragma unroll
        for (int j = 0; j < 8; ++j) pe[j] = expf(ev[j] - em);
        int i1 = 0; float p1 = pe[0];
#pragma unroll
        for (int j = 1; j < 8; ++j) if (pe[j] > p1) { p1 = pe[j]; i1 = j; }
        int i2 = 0; float p2 = -1.f;
#pragma unroll
        for (int j = 0; j < 8; ++j) if (j != i1 && pe[j] > p2) { p2 = pe[j]; i2 = j; }
        const float w1 = ptop * p1 / (p1 + p2), w2 = ptop * p2 / (p1 + p2);
        const int e1 = grp * 8 + i1, e2 = grp * 8 + i2;
        rt_q1 = atomicAdd((int*)&hist[e1], 1); rt_q2 = atomicAdd((int*)&hist[e2], 1);
        rt_t = t; rt_e1 = e1; rt_e2 = e2; rt_w1 = w1; rt_w2 = w2; }
    __syncthreads();
    LAS unsigned* gbase = (LAS unsigned*)(hist + 32);
    if (F.tid < 32) gbase[F.tid] = __hip_atomic_fetch_add((unsigned*)(ws + WS_CTL) + CW_CNT + (layer * NEXP + F.tid) * CNT_STRIDE, (unsigned)hist[F.tid], __ATOMIC_RELAXED, __HIP_MEMORY_SCOPE_AGENT);
    LDS_WAIT(); __syncthreads();
    if (F.tid < TPB) { const unsigned i1 = gbase[rt_e1] + (unsigned)rt_q1, i2 = gbase[rt_e2] + (unsigned)rt_q2;
        unsigned* asg = (unsigned*)(ws + WS_ASG); float* asgw = (float*)(ws + WS_ASGW); unsigned* toke = (unsigned*)(ws + WS_TOKE);
        *(u32x2*)(asg + (size_t)rt_t * 2) = (u32x2){((unsigned)rt_e1 << 20) | i1, ((unsigned)rt_e2 << 20) | i2};
        *(f32x2*)(asgw + (size_t)rt_t * 2) = (f32x2){rt_w1, rt_w2};
        toke[(size_t)rt_e1 * TALL + i1] = (unsigned)rt_t; toke[(size_t)rt_e2 * TALL + i2] = (unsigned)rt_t; }
}
DI void build_tile_table(const Params& P, const Frame& F0, LAS unsigned* tab, int layer) {
    const Frame F = opaque_frame(F0);
    unsigned char* const ws = wsp(P);
    constexpr int TP = pg8::MoeSched<true>::TAB_PST, TC = pg8::MoeSched<true>::TAB_CNT;
    if (F.tid < NEXP) tab[TC + F.tid] = expert_count(ws, layer, F.tid);
    LDS_WAIT(); __syncthreads();
    if (F.tid == 0) { unsigned ps = 0; for (int e = 0; e < NEXP; ++e) { tab[TP + e] = ps; ps += (tab[TC + e] + 255u) & ~255u; } tab[0] = ps >> 8; }
    LDS_WAIT(); __syncthreads();
    const unsigned ntile = tab[0];
    for (unsigned rt = F.tid; rt < ntile; rt += NTHREADS) { unsigned e = 0; for (int k = 1; k < NEXP; ++k) if (rt * 256u >= tab[TP + k]) e = k; tab[1 + rt] = e; }
    LDS_WAIT(); __syncthreads();
}
__global__ void __launch_bounds__(NTHREADS, 2) dit_fwd(Params P) {
    extern __shared__ __attribute__((aligned(16))) unsigned char lds_raw[];
    Frame F;
    F.lds = (LAS unsigned char*)lds_raw;
    F.tid = threadIdx.x; F.lane = F.tid & 63; F.wave = __builtin_amdgcn_readfirstlane(F.tid >> 6);
    F.blk = blockIdx.x; F.G = gridDim.x; F.vcu = (F.G % 8 == 0) ? (F.blk % 8) * (F.G / 8) + F.blk / 8 : F.blk;
    F.gw = F.vcu * NWAVES + F.wave; F.NGW = F.G * NWAVES;
    for (int u = F.tid; u < (LDS_BYTES - RING_BYTES) / 4; u += NTHREADS) ((LAS unsigned*)(F.lds + RING_BYTES))[u] = 0u;
    __syncthreads();
    unsigned* ctl = (unsigned*)(P.ws + WS_CTL);
    XcdBarrier bar = xcd_barrier_post(ctl + CW_BAR, (volatile LAS unsigned*)(F.lds + MISC_OFF) + 8);

    unsigned long long pr_t0 = 0, pr_prev = 0, pr_acc = 0;
    if (PROBE_SEL) { pr_t0 = __builtin_amdgcn_s_memrealtime(); pr_prev = pr_t0; }
#define PSTAMP(id) do { if (PROBE_SEL) { const unsigned long long now_ = __builtin_amdgcn_s_memrealtime(); if ((id) == PROBE_SEL) pr_acc += now_ - pr_prev; pr_prev = now_; } } while (0)
    p0_prologue(P, F);
    if (RPT & 1) p0_prologue(P, F);
    xcd_barrier(bar);
    p0b_mod_reduce(P, F);
    xcd_barrier(bar);
    PSTAMP(1);

    for (int layer = 0; layer < DEPTH; ++layer) {
        const bool last = (layer == DEPTH - 1);
        unsigned char* ws = wsp(P);
        const int Mtok = last ? TLAT : TALL;
        phase_attn_norm(P, F, layer);
        if ((RPT & 256) && layer == 0) { phase_attn_norm(P, F, layer); phase_attn_norm(P, F, layer); phase_attn_norm(P, F, layer); }
        xcd_barrier(bar);
        PSTAMP(2);
        {
            pg8::PlainSched S; S.nN = QKVN / 256; S.nwg = (TALL / 256) * S.nN; S.G = F.G; S.c = F.vcu; S.K = DM; S.Bt = (const bf16_t*)(ws + WS_WQKV) + (size_t)layer * QKVN * DM;
            pg8::EpiQKV E{(bf16_t*)(ws + WS_QKV), ws + WS_KF, ws + WS_VF, (const f32x2*)(ws + WS_ROPE), inp(P, IN_GQ), inp(P, IN_GK), layer % 3};
            pg8::gemm_phase(F.lds, (const bf16_t*)(ws + WS_H), DM, S, E);
            if (RPT & 2) pg8::gemm_phase(F.lds, (const bf16_t*)(ws + WS_H), DM, S, E);
        }
        xcd_barrier(bar);
        PSTAMP(3);
        phase_attention(P, F, layer);
        if (((RPT & 4) && layer == 1) || ((RPT & 8) && layer != 1)) phase_attention(P, F, layer);
        xcd_barrier(bar);
        PSTAMP(4);
        {
            pg8::PlainSched S; S.nN = DM / 256; S.nwg = (Mtok / 256) * S.nN; S.G = F.G; S.c = F.vcu; S.K = DM; S.Bt = (const bf16_t*)(ws + WS_WO) + (size_t)layer * DM * DM;
            pg8::EpiResidBf E{(bf16_t*)(ws + WS_X), (const float*)(ws + WS_MOD) + (size_t)layer * 17 * 6144 + 2048};
            pg8::gemm_phase(F.lds, (const bf16_t*)(ws + WS_O), DM, S, E);
        }
        xcd_barrier(bar);
        PSTAMP(5);
        phase_router(P, F, layer, Mtok);
        xcd_barrier(bar);
        PSTAMP(6);
        if (RPT & 128) { for (int xb = 0; xb < 9; ++xb) xcd_barrier(bar); }
        LAS unsigned* tab = (LAS unsigned*)(F.lds + LDSX_OFF + 8192);
        build_tile_table(P, F, tab, layer);
        {
            pg8::MoeSched<true> S; S.tab = tab; S.G = F.G; S.c = F.vcu; S.K = DM; S.Bt = (const bf16_t*)(ws + WS_WGU) + (size_t)layer * NEXP * DM * DM; S.estride = (size_t)DM * DM * 2; S.tok = (const unsigned*)(ws + WS_TOKE);
            pg8::EpiSwiglu E{(bf16_t*)(ws + WS_ACT)};
            pg8::gemm_phase(F.lds, (const bf16_t*)(ws + WS_H), DM, S, E);
            if (RPT & 32) pg8::gemm_phase(F.lds, (const bf16_t*)(ws + WS_H), DM, S, E);
        }
        xcd_barrier(bar);
        PSTAMP(8);
        {
            pg8::MoeSched<false> S; S.tab = tab; S.G = F.G; S.c = F.vcu; S.K = FH; S.Bt = (const bf16_t*)(ws + WS_WD) + (size_t)layer * NEXP * DM * FH; S.estride = (size_t)DM * FH * 2; S.tok = nullptr;
            pg8::EpiStore E{(bf16_t*)(ws + WS_Y), DM};
            pg8::gemm_phase(F.lds, (const bf16_t*)(ws + WS_ACT), FH, S, E);
            if (RPT & 64) pg8::gemm_phase(F.lds, (const bf16_t*)(ws + WS_ACT), FH, S, E);
        }
        xcd_barrier(bar);
        PSTAMP(9);
    }
    if (PROBE_SEL) {
        if (F.blk == 0 && F.tid == 0) { const unsigned long long tot = __builtin_amdgcn_s_memrealtime() - pr_t0;
            const float f = (PROBE_SEL == 15) ? 0.5f : (float)pr_acc / (float)tot;
            __hip_atomic_store((float*)(P.ws + WS_CTL) + 64, sqrtf(4e-4f * f), __ATOMIC_RELAXED, __HIP_MEMORY_SCOPE_AGENT); }
        xcd_barrier(bar);
    }
    phase_final(P, F);
    if (RPT & 512) { phase_final(P, F); phase_final(P, F); phase_final(P, F); }
}

extern "C" void kernel_launch(void* const* d_in, const int* in_sizes, int n_in, void* d_out, int out_size, void* d_ws, size_t ws_size, hipStream_t stream) {
    static int ok = 0;
    if (ok == 0) {
        if (n_in != 22 || in_sizes[0] != TLAT * DM || out_size != TLAT * DM || ws_size < WS_END) {
            fprintf(stderr, "kernel_launch: unexpected shapes (n_in %d, in0 %d, out %d, ws %zu < %zu); nothing launched\n", n_in, n_in > 0 ? in_sizes[0] : -1, out_size, ws_size, (size_t)WS_END); ok = -1; return; }
        int dev = 0, cus = 0, per_cu = 0;
        if (hipGetDevice(&dev) != hipSuccess || hipDeviceGetAttribute(&cus, hipDeviceAttributeMultiprocessorCount, dev) != hipSuccess) { ok = -1; return; }
        if (hipFuncSetAttribute((const void*)dit_fwd, hipFuncAttributeMaxDynamicSharedMemorySize, LDS_BYTES) != hipSuccess) { fprintf(stderr, "kernel_launch: hipFuncSetAttribute failed\n"); ok = -1; return; }
        if (hipOccupancyMaxActiveBlocksPerMultiprocessor(&per_cu, (const void*)dit_fwd, NTHREADS, LDS_BYTES) != hipSuccess || per_cu < 1) fprintf(stderr, "kernel_launch: note: occupancy query reports %d\n", per_cu);
        (void)hipGetLastError();
        if (cus < GRID) { fprintf(stderr, "kernel_launch: %d CUs < %d workgroups: grid would not be resident; nothing launched\n", cus, GRID); ok = -1; return; }
        ok = 1;
    }
    if (ok < 0) return;
    if (hipMemsetAsync((char*)d_ws + WS_CTL, 0, CTL_ZERO_BYTES, stream) != hipSuccess) return;
    Params p{};
    for (int i = 0; i < 22; ++i) p.in[i] = (const float*)d_in[i];
    p.out = (float*)d_out; p.ws = (unsigned char*)d_ws;
    hipLaunchKernelGGL(dit_fwd, dim3(GRID), dim3(NTHREADS), LDS_BYTES, stream, p);
}
```

```cpp
#include <hip/hip_runtime.h>
#include <cstdio>
#include <cstdint>

#ifndef PROBE_SEL
#define PROBE_SEL 0
#endif
#ifndef RPT
#define RPT 0
#endif

#define LAS __attribute__((address_space(3)))
#define GAS __attribute__((address_space(1)))
#define DI __device__ __forceinline__

typedef unsigned short bf16_t;
typedef short bf16x8 __attribute__((ext_vector_type(8)));
typedef short s16x4 __attribute__((ext_vector_type(4)));
typedef float f32x2 __attribute__((ext_vector_type(2)));
typedef float f32x4 __attribute__((ext_vector_type(4)));
typedef float f32x16 __attribute__((ext_vector_type(16)));
typedef unsigned u32x2 __attribute__((ext_vector_type(2)));
typedef unsigned u32x4 __attribute__((ext_vector_type(4)));

constexpr int NB = 16, SEQ = 2048, DM = 1024, DEPTH = 4, CTXL = 256, NH = 16, NKV = 4, HD = 64, QKVN = 1536;
constexpr int TLAT = NB * SEQ, TCTX = NB * CTXL, TALL = TLAT + TCTX;
constexpr int NEXP = 32, FH = 512;
constexpr int KEYS = SEQ + CTXL, KGRP = KEYS / 8;
constexpr int CAPR = 2 * TALL + NEXP * 256;
constexpr int NWAVES = 8, NTHREADS = 512, GRID = 256;
constexpr float NORM_EPS = 1e-6f, LOG2E = 1.4426950408889634f;

constexpr size_t MiB = 1u << 20;
constexpr size_t WS_CTL = 0, CTL_ZERO_BYTES = 1 * MiB;
constexpr size_t WS_MODP = 1 * MiB;
constexpr size_t WS_MOD = 15 * MiB;
constexpr size_t WS_ROPE = 17 * MiB;
constexpr size_t WS_WRT = 17 * MiB + 65536;
constexpr size_t WS_ASG = 18 * MiB;
constexpr size_t WS_ASGW = 18 * MiB + 512 * 1024;
constexpr size_t WS_TOKE = 1 * MiB;
constexpr size_t WS_WQKV = 21 * MiB;
constexpr size_t WS_WO = 33 * MiB;
constexpr size_t WS_WGU = 41 * MiB;
constexpr size_t WS_WD = 297 * MiB;
constexpr size_t WS_X = 425 * MiB;
constexpr size_t WS_H = 569 * MiB;
constexpr size_t WS_R1 = 641 * MiB;
constexpr size_t WS_QKV = WS_R1;
constexpr size_t WS_KF = WS_R1 + 108 * MiB;
constexpr size_t WS_VF = WS_R1 + 126 * MiB;
constexpr size_t WS_O = WS_R1 + 144 * MiB;
constexpr size_t WS_Y = WS_R1;
constexpr size_t WS_ACT = WS_R1 + 160 * MiB;
constexpr size_t WS_END = WS_R1 + 240 * MiB;
constexpr int CW_TMO = 0, CW_BAR = 4096, CW_CNT = 65536, CNT_STRIDE = 32;

constexpr int RING_BYTES = 131072;
constexpr int MISC_OFF = RING_BYTES + 320;
constexpr int LDSX_OFF = RING_BYTES + 1024;
constexpr int LDS_BYTES = 147456;

#define LDS_WAIT() asm volatile("s_waitcnt lgkmcnt(0)" ::: "memory")
#define VM_WAIT() asm volatile("s_waitcnt vmcnt(0)" ::: "memory")

DI unsigned f2bf(float f) { unsigned u = __float_as_uint(f); return (u + 0x7fffu + ((u >> 16) & 1u)) >> 16; }
DI float bf2f(unsigned b) { return __uint_as_float(b << 16); }
DI float bfs2f(short b) { return __uint_as_float(((unsigned)(unsigned short)b) << 16); }
DI unsigned cvt_pk_bf16(float lo, float hi);
DI unsigned pk2(float lo, float hi) { return cvt_pk_bf16(lo, hi); }
DI unsigned cvt_pk_bf16(float lo, float hi) { unsigned r; asm volatile("v_cvt_pk_bf16_f32 %0, %1, %2" : "=v"(r) : "v"(lo), "v"(hi)); return r; }
DI float wave_sum(float v) {
#pragma unroll
    for (int o = 1; o < 64; o <<= 1) v += __shfl_xor(v, o);
    return v;
}
DI int crow(int r, int hi) { return (r & 3) + 8 * (r >> 2) + 4 * hi; }

#define XB_TMO      128
#define XB_XCNT(j)  (256  + 64 * (j))
#define XB_XSUB(j)  (1280 + 64 * (j))
#define XB_XGEN(j)  (2304 + 64 * (j))
#define XB_TOP      3328
#define XB_TOPGEN   3392
#define XCD_BAR_WORDS 3456
#define XB_SPIN_CAP (1u << 18)

__device__ __forceinline__ unsigned xb_ld(unsigned* p)              { return __hip_atomic_load(p, __ATOMIC_RELAXED, __HIP_MEMORY_SCOPE_AGENT); }
__device__ __forceinline__ unsigned xb_add(unsigned* p, unsigned v) { return __hip_atomic_fetch_add(p, v, __ATOMIC_RELAXED, __HIP_MEMORY_SCOPE_AGENT); }
__device__ __forceinline__ unsigned xb_xcc_id() { return (unsigned)__builtin_amdgcn_s_getreg((3 << 11) | 20) & 0xFu; }
#define XB_SPIN(cond, bar) do { unsigned _sp = 0; while (cond) { __builtin_amdgcn_s_sleep(1); \
    if ((++_sp & 255u) == 0u) { if (xb_ld(&(bar)[XB_TMO])) break; if (_sp > XB_SPIN_CAP) { atomicAdd(&(bar)[XB_TMO], 1u); break; } } } } while (0)

struct XcdBarrier { unsigned* bar; unsigned x; volatile LAS unsigned* st; };

__device__ __forceinline__ XcdBarrier xcd_barrier_post(unsigned* bar, volatile LAS unsigned* st) {
    XcdBarrier b; b.bar = bar; b.x = xb_xcc_id(); b.st = st;
    if (threadIdx.x == 0) (void)xb_add(&bar[XB_XCNT(b.x)], 1u);
    return b;
}
__device__ __forceinline__ void xcd_barrier_complete(unsigned* bar, unsigned x, unsigned& nloc, unsigned& nx) {
    const unsigned G = gridDim.x * gridDim.y * gridDim.z;
    unsigned sum, cnt, mine, sp = 0u;
    for (;;) {
        sum = 0u; cnt = 0u; mine = 0u;
#pragma unroll
        for (unsigned j = 0; j < 16; ++j) { const unsigned c = xb_ld(&bar[XB_XCNT(j)]); sum += c; cnt += (c > 0u) ? 1u : 0u; mine = (j == x) ? c : mine; }
        if (sum == G) break;
        __builtin_amdgcn_s_sleep(1);
        if ((++sp & 255u) == 0u) { if (xb_ld(&bar[XB_TMO])) break; if (sp > XB_SPIN_CAP) { atomicAdd(&bar[XB_TMO], 1u); break; } }
    }
    nloc = mine > 0u ? mine : 1u; nx = cnt > 0u ? cnt : 1u;
}
__device__ __forceinline__ void xcd_barrier(const XcdBarrier& b0) {
    XcdBarrier b = b0;
    { unsigned z = 0, bx = __builtin_amdgcn_readfirstlane(b0.x); asm volatile("s_mov_b32 %0, 0" : "=s"(z)); asm volatile("" : "+s"(bx)); b.bar = b0.bar + z; b.x = bx; }
    asm volatile("s_waitcnt vmcnt(0)" ::: "memory");
    __syncthreads();
    if (threadIdx.x == 0) {
        unsigned* bar = b.bar;
        __builtin_amdgcn_s_waitcnt(0);
        unsigned nloc = b.st[0], nx = b.st[1];
        if (nloc == 0u) { xcd_barrier_complete(bar, b.x, nloc, nx); b.st[0] = nloc; b.st[1] = nx; }
        const unsigned old = xb_add(&bar[XB_XSUB(b.x)], 1u);
        const unsigned gen = old / nloc;
        if (old + 1u == (gen + 1u) * nloc) {
            __builtin_amdgcn_fence(__ATOMIC_RELEASE, "agent");
            asm volatile("s_waitcnt vmcnt(0)" ::: "memory");
            const unsigned og = xb_add(&bar[XB_TOP], 1u);
            const unsigned tg = og / nx;
            if (og + 1u == (tg + 1u) * nx) xb_add(&bar[XB_TOPGEN], 1u);
            else XB_SPIN(xb_ld(&bar[XB_TOPGEN]) == tg, bar);
            __builtin_amdgcn_fence(__ATOMIC_ACQUIRE, "agent");
            xb_add(&bar[XB_XGEN(b.x)], 1u);
            asm volatile("s_waitcnt vmcnt(0)" ::: "memory");
        } else {
            XB_SPIN(xb_ld(&bar[XB_XGEN(b.x)]) == gen, bar);
            __builtin_amdgcn_fence(__ATOMIC_ACQUIRE, "agent");
            asm volatile("s_waitcnt vmcnt(0)" ::: "memory");
        }
    }
    __syncthreads();
}

namespace pg8 {
constexpr int BM = 256, BK = 64, HALF = 128, HTB = HALF * BK * 2, STAGE_BYTES = 8 * HTB;
DI int lds_byte(int r, int c) { const int st = (r >> 4) * 2 + (c >> 5), rr = r & 15, cc = c & 31, ob = rr * 64 + cc * 2; return st * 1024 + (ob ^ (((ob >> 9) & 1) << 5)); }
DI void stage_rc(int b, int& R, int& C) { const int st = b / 1024, sb = b % 1024, swz = sb ^ (((sb >> 9) & 1) << 5); R = (st >> 1) * 16 + swz / 64; C = (st & 1) * 32 + (swz % 64) / 2; }
DI int perm32(int rho) { const int n = rho >> 4, i = rho & 15; return 8 * (i >> 2) + 4 * n + (i & 3); }
struct Unit { int pm, pn, e, r0, na; };

template <class Epi, class Sched>
DI void gemm_phase(LAS unsigned char* lds, const bf16_t* A, const int K, const Sched& S, const Epi& E) {
    int tid_ = threadIdx.x; asm volatile("" : "+v"(tid_));
    const int tid = tid_, wid = __builtin_amdgcn_readfirstlane(tid >> 6), lane = tid & 63, wr = wid >> 2, wc = wid & 3, fr = lane & 15, fq = lane >> 4;
    const int nt = K / BK;
    constexpr bool GA = Sched::GATHER;
    int Rr[2], Cc[2]; unsigned voffB[2], voffA[2];
#pragma unroll
    for (int i = 0; i < 2; ++i) { int R, C; stage_rc(tid * 16 + i * 8192, R, C); const int Rb = Epi::PERM ? ((R & ~31) + perm32(R & 31)) : R;
        Rr[i] = R; Cc[i] = C; voffB[i] = (unsigned)(Rb * K + C) * 2u; voffA[i] = (unsigned)(R * K + C) * 2u; }
    const size_t kstep = (size_t)(BK * 2);
    const size_t hstep = (size_t)HALF * K * 2;
    const unsigned ldsw = (unsigned)wid * 1024u;
    const int aoff = lds_byte(wr * 64 + fr, fq * 8), boff = lds_byte(wc * 32 + fr, fq * 8);
#define PG8_SA(b, h) (((b) * 2 + (h)) * HTB)
#define PG8_SB(b, h) ((4 + (b) * 2 + (h)) * HTB)
#define PG8_STAGE(bufoff, gbase, voff) do { _Pragma("unroll") for (int _i = 0; _i < 2; ++_i) \
        __builtin_amdgcn_global_load_lds((const unsigned*)((const char*)(gbase) + (voff)[_i]), (LAS unsigned*)(lds + (bufoff) + ldsw + _i * 8192), 16, 0, 0); } while (0)
#define PG8_LDA(dst, b, h) do { _Pragma("unroll") for (int m = 0; m < 4; ++m) _Pragma("unroll") for (int k = 0; k < 2; ++k) dst[m][k] = *(const LAS bf16x8*)(lds + PG8_SA(b, h) + aoff + m * 2048 + k * 1024); } while (0)
#define PG8_LDB(dst, b, h) do { _Pragma("unroll") for (int n = 0; n < 2; ++n) _Pragma("unroll") for (int k = 0; k < 2; ++k) dst[n][k] = *(const LAS bf16x8*)(lds + PG8_SB(b, h) + boff + n * 2048 + k * 1024); } while (0)
#define PG8_MMA(ai, bj, At, Bt) do { __builtin_amdgcn_s_setprio(1); _Pragma("unroll") for (int m = 0; m < 4; ++m) _Pragma("unroll") for (int n = 0; n < 2; ++n) _Pragma("unroll") for (int k = 0; k < 2; ++k) \
        acc[ai][bj][m][n] = __builtin_amdgcn_mfma_f32_16x16x32_bf16(Bt[n][k], At[m][k], acc[ai][bj][m][n], 0, 0, 0); __builtin_amdgcn_s_setprio(0); } while (0)
#define PG8_WAIT_V(n) asm volatile("s_waitcnt vmcnt(" #n ")" ::: "memory")
#define PG8_WAIT_L(n) asm volatile("s_waitcnt lgkmcnt(" #n ")" ::: "memory")
#define PG8_BAR __builtin_amdgcn_s_barrier()
#define PG8_SCHED __builtin_amdgcn_sched_barrier(0)
    Unit cur, nxt; int ui = 0;
    if (!S.next(0, cur)) return;
    f32x4 acc[2][2][4][2];
#pragma unroll
    for (int a = 0; a < 2; ++a)
#pragma unroll
        for (int b = 0; b < 2; ++b)
#pragma unroll
            for (int m = 0; m < 4; ++m)
#pragma unroll
                for (int n = 0; n < 2; ++n) acc[a][b][m][n] = (f32x4){0.f, 0.f, 0.f, 0.f};
    bf16x8 At[4][2], B0[2][2], B1[2][2];
    unsigned oc0[2], oc1[2], on0[2], on1[2];
#pragma unroll
    for (int i = 0; i < 2; ++i) { if (GA) { oc0[i] = S.a_off(cur, Rr[i]) + (unsigned)Cc[i] * 2u; oc1[i] = S.a_off(cur, HALF + Rr[i]) + (unsigned)Cc[i] * 2u; } else { oc0[i] = voffA[i]; oc1[i] = voffA[i]; } on0[i] = oc0[i]; on1[i] = oc1[i]; }
    size_t hA = (GA || (Sched::HALVES && cur.na == 1)) ? (size_t)0 : hstep, hAn = hA;
    const char* Ab = GA ? (const char*)A : (const char*)A + (size_t)cur.r0 * K * 2;
    const char* cB = S.b_ptr(cur);
    PG8_STAGE(PG8_SB(0, 0), cB, voffB); PG8_STAGE(PG8_SB(0, 1), cB + hstep, voffB); PG8_STAGE(PG8_SA(0, 0), Ab, oc0); PG8_STAGE(PG8_SA(0, 1), Ab + hA, oc1);
    if (wr == 1) PG8_BAR;
    PG8_WAIT_V(2); PG8_BAR;
    PG8_STAGE(PG8_SB(1, 0), cB + kstep, voffB); PG8_STAGE(PG8_SA(1, 0), Ab + kstep, oc0); PG8_STAGE(PG8_SB(1, 1), cB + hstep + kstep, voffB);
    PG8_WAIT_V(6); PG8_BAR;
    for (;;) {
        const bool has_next = S.next(ui + 1, nxt);
        const char* nB = has_next ? S.b_ptr(nxt) : cB;
        const char* nA = GA ? Ab : (has_next ? (const char*)A + (size_t)nxt.r0 * K * 2 : Ab);
        if (!GA && Sched::HALVES) hAn = (has_next && nxt.na == 1) ? (size_t)0 : (has_next ? hstep : hA);
        if (GA) {
            if (has_next) {
#pragma unroll
                for (int i = 0; i < 2; ++i) { on0[i] = S.a_off(nxt, Rr[i]) + (unsigned)Cc[i] * 2u; on1[i] = S.a_off(nxt, HALF + Rr[i]) + (unsigned)Cc[i] * 2u; }
            } else {
#pragma unroll
                for (int i = 0; i < 2; ++i) { on0[i] = oc0[i]; on1[i] = oc1[i]; }
            }
        }
#define PG8_KLOOP(FULL) \
        for (int t = 0; t < nt; t += 2) { \
            const bool last = (t == nt - 2); \
            const char* a1 = Ab + (size_t)(t + 1) * kstep + hA; \
            const char* a2 = last ? nA : Ab + (size_t)(t + 2) * kstep; const char* b2 = last ? nB : cB + (size_t)(t + 2) * kstep; \
            const char* a3 = a2 + kstep; const char* b3 = b2 + kstep; const size_t hA2 = last ? hAn : hA; \
            unsigned o20[2], o21[2]; \
            for (int i = 0; i < 2; ++i) { if (GA) { o20[i] = last ? on0[i] : oc0[i]; o21[i] = last ? on1[i] : oc1[i]; } else { o20[i] = voffA[i]; o21[i] = voffA[i]; } } \
              \
            PG8_LDB(B0, 0, 0); PG8_LDB(B1, 0, 1); PG8_SCHED; PG8_LDA(At, 0, 0); PG8_STAGE(PG8_SA(1, 1), a1, oc1); \
            PG8_WAIT_V(8); PG8_WAIT_L(0); PG8_BAR; PG8_MMA(0, 0, At, B0); PG8_MMA(0, 1, At, B1); PG8_BAR; PG8_SCHED; \
              \
            if (FULL) { PG8_LDA(At, 0, 1); } PG8_STAGE(PG8_SB(0, 0), b2, voffB); PG8_STAGE(PG8_SB(0, 1), b2 + hstep, voffB); PG8_STAGE(PG8_SA(0, 0), a2, o20); \
            PG8_WAIT_V(8); PG8_WAIT_L(0); PG8_BAR; if (FULL) { PG8_MMA(1, 0, At, B0); PG8_MMA(1, 1, At, B1); } PG8_BAR; PG8_SCHED; \
              \
            PG8_LDB(B0, 1, 0); PG8_LDB(B1, 1, 1); PG8_SCHED; PG8_LDA(At, 1, 0); PG8_STAGE(PG8_SA(0, 1), a2 + hA2, o21); \
            PG8_WAIT_V(8); PG8_WAIT_L(0); PG8_BAR; PG8_MMA(0, 0, At, B0); PG8_MMA(0, 1, At, B1); PG8_BAR; PG8_SCHED; \
              \
            if (FULL) { PG8_LDA(At, 1, 1); } PG8_STAGE(PG8_SB(1, 0), b3, voffB); PG8_STAGE(PG8_SB(1, 1), b3 + hstep, voffB); PG8_STAGE(PG8_SA(1, 0), a3, o20); \
            PG8_WAIT_V(8); PG8_WAIT_L(0); PG8_BAR; if (FULL) { PG8_MMA(1, 0, At, B0); PG8_MMA(1, 1, At, B1); } PG8_BAR; PG8_SCHED; \
        }
        if (Sched::HALVES && cur.na == 1) { PG8_KLOOP(0) } else { PG8_KLOOP(1) }
#undef PG8_KLOOP
        if (wr == 0) PG8_BAR;
        E(acc, cur, wr, wc, fr, fq);
        if (!has_next) break;
#pragma unroll
        for (int a = 0; a < 2; ++a)
#pragma unroll
            for (int b = 0; b < 2; ++b)
#pragma unroll
                for (int m = 0; m < 4; ++m)
#pragma unroll
                    for (int n = 0; n < 2; ++n) acc[a][b][m][n] = (f32x4){0.f, 0.f, 0.f, 0.f};
        cur = nxt; cB = nB; Ab = nA; hA = hAn; ++ui;
        if (GA) {
#pragma unroll
            for (int i = 0; i < 2; ++i) { oc0[i] = on0[i]; oc1[i] = on1[i]; }
        }
        if (wr == 1) PG8_BAR;
    }
    PG8_WAIT_V(0);
    PG8_BAR;
#undef PG8_SA
#undef PG8_SB
#undef PG8_STAGE
#undef PG8_LDA
#undef PG8_LDB
#undef PG8_MMA
#undef PG8_WAIT_V
#undef PG8_WAIT_L
#undef PG8_BAR
#undef PG8_SCHED
}

struct PlainSched {
    static constexpr bool GATHER = false, HALVES = true;
    int nN, nwg, G, c, K; const bf16_t* Bt;
    DI bool next(int i, Unit& u) const { const int L = i * G + c; const int nfull = (nwg / G) * G, rem = nwg - nfull; int Lu = L, hf = 0; u.na = 2;
        if (L >= nfull) { if (2 * rem <= G) { const int h = L - nfull; if (h >= 2 * rem) return false; Lu = nfull + (h >> 1); hf = h & 1; u.na = 1; } else if (L >= nwg) return false; }
        u.pm = Lu / nN; u.pn = Lu - u.pm * nN; u.e = 0; u.r0 = u.pm * BM + hf * HALF; return true; }
    DI unsigned a_off(const Unit& u, int r) const { return (unsigned)(u.r0 + r) * (unsigned)(K * 2); }
    DI const char* b_ptr(const Unit& u) const { return (const char*)Bt + (size_t)u.pn * BM * K * 2; }
};
template <bool GATHER_> struct MoeSched {
    static constexpr bool GATHER = GATHER_, HALVES = true;
    static constexpr int TAB_PST = 384, TAB_CNT = 416;
    const LAS unsigned* tab; int G, c, K; const bf16_t* Bt; size_t estride; const unsigned* tok;
    DI bool next(int i, Unit& u) const { const int L = i * G + c; const int nwg = (int)tab[0] * 4, nfull = (nwg / G) * G, rem = nwg - nfull; int Lu = L, hf = 0; u.na = 2;
        if (L >= nfull) { if (2 * rem <= G) { const int h = L - nfull; if (h >= 2 * rem) return false; Lu = nfull + (h >> 1); hf = h & 1; u.na = 1; } else if (L >= nwg) return false; }
        u.pm = Lu >> 2; u.pn = Lu & 3; u.e = (int)tab[1 + u.pm]; u.r0 = u.pm * BM + hf * HALF; return true; }
    DI unsigned a_off(const Unit& u, int r) const {
        unsigned row = (unsigned)(u.r0 + (u.na == 1 ? (r & (HALF - 1)) : r));
        if (GATHER_) { const unsigned last = tab[TAB_CNT + u.e] - 1u; unsigned idx = row - tab[TAB_PST + u.e]; idx = idx < last ? idx : last; row = tok[(unsigned)u.e * (unsigned)TALL + idx]; }
        return row * (unsigned)(K * 2); }
    DI const char* b_ptr(const Unit& u) const { return (const char*)Bt + (size_t)u.e * estride + (size_t)u.pn * BM * K * 2; }
};

struct EpiStore {
    static constexpr bool PERM = true;
    bf16_t* O; int ldc;
    DI void operator()(const f32x4 (&acc)[2][2][4][2], const Unit& u, int wr, int wc, int fr, int fq) const {
        const int row0 = u.r0 + wr * 64 + fr, col0 = u.pn * BM + wc * 32 + 8 * fq;
#pragma unroll
        for (int ai = 0; ai < 2; ++ai) if (ai < u.na)
#pragma unroll
            for (int m = 0; m < 4; ++m) { bf16_t* rowp = O + (size_t)(row0 + ai * HALF + m * 16) * ldc + col0;
#pragma unroll
                for (int bj = 0; bj < 2; ++bj) { const f32x4 v0 = acc[ai][bj][m][0], v1 = acc[ai][bj][m][1];
                    u32x4 w; w.x = cvt_pk_bf16(v0[0], v0[1]); w.y = cvt_pk_bf16(v0[2], v0[3]); w.z = cvt_pk_bf16(v1[0], v1[1]); w.w = cvt_pk_bf16(v1[2], v1[3]);
                    *(u32x4*)(rowp + bj * HALF) = w; } }
    }
};
struct EpiQKV {
    static constexpr bool PERM = false;
    bf16_t* QKV; unsigned char* KF; unsigned char* VF; const LAS f32x2* T; const float* gq; const float* gk; int m;
    DI void operator()(const f32x4 (&acc)[2][2][4][2], const Unit& u, int wr, int wc, int fr, int fq) const {
        const bool lat = u.pm < TLAT / BM; const int b = lat ? (u.pm >> 3) : (u.pm - TLAT / BM);
        const int trow0 = u.r0 + wr * 64 + fr;
        if (u.pn < 4) {
            const int h = 4 * u.pn + wc;
            f32x4 g[2][2];
#pragma unroll
            for (int bj = 0; bj < 2; ++bj)
#pragma unroll
                for (int n = 0; n < 2; ++n) g[bj][n] = (m == 1) ? *(const f32x4*)(gq + 32 * bj + 16 * n + 4 * fq) : (f32x4){1.f, 1.f, 1.f, 1.f};
#pragma unroll
            for (int ai = 0; ai < 2; ++ai) if (ai < u.na)
#pragma unroll
                for (int mm = 0; mm < 4; ++mm) {
                    f32x4 x[2][2]; float ss = 0.f;
#pragma unroll
                    for (int bj = 0; bj < 2; ++bj)
#pragma unroll
                        for (int n = 0; n < 2; ++n) { x[bj][n] = acc[ai][bj][mm][n]; ss += (x[bj][n][0] * x[bj][n][0] + x[bj][n][1] * x[bj][n][1]) + (x[bj][n][2] * x[bj][n][2] + x[bj][n][3] * x[bj][n][3]); }
                    float sc = 0.125f * LOG2E;
                    if (m == 1) { ss += __shfl_xor(ss, 16); ss += __shfl_xor(ss, 32); sc *= 1.0f / sqrtf(ss * (1.f / HD) + NORM_EPS); }
                    bf16_t* qrow = QKV + (size_t)(trow0 + ai * HALF + mm * 16) * QKVN + h * HD + 4 * fq;
#pragma unroll
                    for (int bj = 0; bj < 2; ++bj)
#pragma unroll
                        for (int n = 0; n < 2; ++n) { const f32x4 y = x[bj][n] * g[bj][n] * sc; u32x2 w; w.x = cvt_pk_bf16(y[0], y[1]); w.y = cvt_pk_bf16(y[2], y[3]); *(u32x2*)(qrow + 32 * bj + 16 * n) = w; }
                }
        } else if (u.pn == 4) {
            f32x4 g[2][2];
#pragma unroll
            for (int bj = 0; bj < 2; ++bj)
#pragma unroll
                for (int n = 0; n < 2; ++n) g[bj][n] = (m == 1) ? *(const f32x4*)(gk + 32 * bj + 16 * n + 4 * fq) : (f32x4){1.f, 1.f, 1.f, 1.f};
            const bool rope = lat && (m != 2);
            unsigned char* kbase = KF + (size_t)(b * NKV + wc) * KGRP * 1024 + (fq >> 1) * 128 + (fq & 1) * 8;
#pragma unroll
            for (int ai = 0; ai < 2; ++ai) if (ai < u.na)
#pragma unroll
                for (int mm = 0; mm < 4; ++mm) {
                    const int t = trow0 + ai * HALF + mm * 16;
                    const int kidx = lat ? (t & 2047) : (2048 + ((t - TLAT) & 255));
                    f32x4 x[2][2]; float ss = 0.f;
#pragma unroll
                    for (int bj = 0; bj < 2; ++bj)
#pragma unroll
                        for (int n = 0; n < 2; ++n) { x[bj][n] = acc[ai][bj][mm][n]; ss += (x[bj][n][0] * x[bj][n][0] + x[bj][n][1] * x[bj][n][1]) + (x[bj][n][2] * x[bj][n][2] + x[bj][n][3] * x[bj][n][3]); }
                    if (m == 1) { ss += __shfl_xor(ss, 16); ss += __shfl_xor(ss, 32); const float rs = 1.0f / sqrtf(ss * (1.f / HD) + NORM_EPS);
#pragma unroll
                        for (int bj = 0; bj < 2; ++bj)
#pragma unroll
                            for (int n = 0; n < 2; ++n) x[bj][n] = x[bj][n] * g[bj][n] * rs; }
                    if (rope) {
#pragma unroll
                        for (int bj = 0; bj < 2; ++bj) { const int pos = bj ? (kidx & 63) : (kidx >> 6); const LAS f32x4* tp = (const LAS f32x4*)(T + pos * 16 + 4 * fq);
                            const f32x4 t0 = tp[0], t1 = tp[1];
                            const f32x4 cs = (f32x4){t0[0], t0[2], t1[0], t1[2]}, sn = (f32x4){t0[1], t0[3], t1[1], t1[3]};
                            const f32x4 a = x[bj][0], c = x[bj][1];
                            x[bj][0] = a * cs - c * sn; x[bj][1] = c * cs + a * sn; }
                    }
                    unsigned char* kp = kbase + (size_t)(kidx >> 3) * 1024 + (kidx & 7) * 16;
#pragma unroll
                    for (int bj = 0; bj < 2; ++bj)
#pragma unroll
                        for (int n = 0; n < 2; ++n) { u32x2 w; w.x = cvt_pk_bf16(x[bj][n][0], x[bj][n][1]); w.y = cvt_pk_bf16(x[bj][n][2], x[bj][n][3]); *(u32x2*)(kp + (4 * bj + 2 * n) * 128) = w; }
                }
        } else {
            const int q4 = fr & 3;
            unsigned char* vbase = VF + (size_t)(b * NKV + wc) * KGRP * 1024 + (4 * fq + q4) * 16;
#pragma unroll
            for (int ai = 0; ai < 2; ++ai) if (ai < u.na)
#pragma unroll
                for (int mm = 0; mm < 4; ++mm) {
                    const int t = trow0 + ai * HALF + mm * 16;
                    const int kidx = lat ? (t & 2047) : (2048 + ((t - TLAT) & 255));
                    unsigned char* vp = vbase + (size_t)(kidx >> 3) * 1024 + (kidx & 4) * 2;
#pragma unroll
                    for (int bj = 0; bj < 2; ++bj)
#pragma unroll
                        for (int n = 0; n < 2; ++n) {
                            f32x4 x = acc[ai][bj][mm][n];
                            { const float s0 = (q4 & 1) ? x[0] : x[1], s1 = (q4 & 1) ? x[2] : x[3]; const float r0 = __shfl_xor(s0, 1), r1 = __shfl_xor(s1, 1);
                              if (q4 & 1) { x[0] = r0; x[2] = r1; } else { x[1] = r0; x[3] = r1; } }
                            { const float s0 = (q4 & 2) ? x[0] : x[2], s1 = (q4 & 2) ? x[1] : x[3]; const float r0 = __shfl_xor(s0, 2), r1 = __shfl_xor(s1, 2);
                              if (q4 & 2) { x[0] = r0; x[1] = r1; } else { x[2] = r0; x[3] = r1; } }
                            u32x2 w; w.x = cvt_pk_bf16(x[0], x[1]); w.y = cvt_pk_bf16(x[2], x[3]);
                            *(u32x2*)(vp + (32 * bj + 16 * n) * 16) = w; }
                }
        }
    }
};
DI float silu_mul(float g, float u) { return g * __builtin_amdgcn_rcpf(1.f + __builtin_amdgcn_exp2f(-g * LOG2E)) * u; }
struct EpiResidBf {
    static constexpr bool PERM = true;
    bf16_t* X; const float* gate;
    DI void operator()(const f32x4 (&acc)[2][2][4][2], const Unit& u, int wr, int wc, int fr, int fq) const {
        const int mb = (u.pm < TLAT / BM) ? (u.pm >> 3) : 16;
        const float* gt = gate + (size_t)mb * 6144;
        const int row0 = u.r0 + wr * 64 + fr, col0 = u.pn * BM + wc * 32 + 8 * fq;
        f32x4 g[2][2];
#pragma unroll
        for (int bj = 0; bj < 2; ++bj)
#pragma unroll
            for (int n = 0; n < 2; ++n) g[bj][n] = *(const f32x4*)(gt + col0 + bj * HALF + 4 * n);
#pragma unroll
        for (int ai = 0; ai < 2; ++ai) if (ai < u.na) {
            u32x4 old[4][2];
#pragma unroll
            for (int m = 0; m < 4; ++m)
#pragma unroll
                for (int bj = 0; bj < 2; ++bj) old[m][bj] = *(const u32x4*)(X + (size_t)(row0 + ai * HALF + m * 16) * DM + col0 + bj * HALF);
#pragma unroll
            for (int m = 0; m < 4; ++m)
#pragma unroll
                for (int bj = 0; bj < 2; ++bj) { const u32x4 o = old[m][bj]; const f32x4 a0 = acc[ai][bj][m][0] * g[bj][0], a1 = acc[ai][bj][m][1] * g[bj][1];
                    u32x4 w; w.x = cvt_pk_bf16(bf2f(o.x & 0xffffu) + a0[0], bf2f(o.x >> 16) + a0[1]); w.y = cvt_pk_bf16(bf2f(o.y & 0xffffu) + a0[2], bf2f(o.y >> 16) + a0[3]);
                    w.z = cvt_pk_bf16(bf2f(o.z & 0xffffu) + a1[0], bf2f(o.z >> 16) + a1[1]); w.w = cvt_pk_bf16(bf2f(o.w & 0xffffu) + a1[2], bf2f(o.w >> 16) + a1[3]);
                    *(u32x4*)(X + (size_t)(row0 + ai * HALF + m * 16) * DM + col0 + bj * HALF) = w; }
        }
    }
};
struct EpiSwiglu {
    static constexpr bool PERM = true;
    bf16_t* ACT;
    DI void operator()(const f32x4 (&acc)[2][2][4][2], const Unit& u, int wr, int wc, int fr, int fq) const {
        const int row0 = u.r0 + wr * 64 + fr, col0 = u.pn * HALF + wc * 32 + 8 * fq;
#pragma unroll
        for (int ai = 0; ai < 2; ++ai) if (ai < u.na)
#pragma unroll
            for (int m = 0; m < 4; ++m) { bf16_t* rowp = ACT + (size_t)(row0 + ai * HALF + m * 16) * FH + col0;
                const f32x4 g0 = acc[ai][0][m][0], g1 = acc[ai][0][m][1], u0 = acc[ai][1][m][0], u1 = acc[ai][1][m][1];
                u32x4 w; w.x = cvt_pk_bf16(silu_mul(g0[0], u0[0]), silu_mul(g0[1], u0[1])); w.y = cvt_pk_bf16(silu_mul(g0[2], u0[2]), silu_mul(g0[3], u0[3]));
                w.z = cvt_pk_bf16(silu_mul(g1[0], u1[0]), silu_mul(g1[1], u1[1])); w.w = cvt_pk_bf16(silu_mul(g1[2], u1[2]), silu_mul(g1[3], u1[3]));
                *(u32x4*)rowp = w; }
    }
};
}

struct Params { const float* in[22]; float* out; unsigned char* ws; };
enum { IN_X = 0, IN_C, IN_CTX, IN_CCTX, IN_WADA, IN_BADA, IN_GATTN, IN_WQKV, IN_WO, IN_SINK, IN_GQ, IN_GK, IN_RPB, IN_GFFN, IN_WGROUP, IN_BGROUP, IN_WROUTER, IN_BROUTER, IN_WGATE, IN_WUP, IN_WDOWN, IN_GFINAL };

DI const float* inp(const Params& P, int i) { i = __builtin_amdgcn_readfirstlane(i); asm volatile("" : "+s"(i)); return P.in[i]; }
DI unsigned char* wsp(const Params& P) { unsigned z = 0; asm volatile("s_mov_b32 %0, 0" : "=s"(z)); return P.ws + z; }
struct Frame { LAS unsigned char* lds; int tid, lane, wave, blk, G, vcu, gw, NGW; };
DI Frame opaque_frame(const Frame& F0) { Frame F = F0; asm volatile("" : "+v"(F.tid), "+v"(F.lane)); asm volatile("" : "+s"(F.wave), "+s"(F.blk), "+s"(F.vcu), "+s"(F.gw)); return F; }

DI void p0_transpose_item(const float* W, int N, int k0, int n0, bf16_t* dst, int Kd, LAS float* scr, int lane) {
#pragma unroll 8
    for (int i = 0; i < 32; ++i) { const int kk = 2 * i + (lane >> 5); scr[kk * 33 + (lane & 31)] = W[(size_t)(k0 + kk) * N + n0 + (lane & 31)]; }
    LDS_WAIT();
    const int c = lane & 7;
#pragma unroll
    for (int j = 0; j < 4; ++j) { const int n = (lane >> 3) + 8 * j; const LAS float* s = scr + (8 * c) * 33 + n;
        u32x4 o; o.x = pk2(s[0 * 33], s[1 * 33]); o.y = pk2(s[2 * 33], s[3 * 33]); o.z = pk2(s[4 * 33], s[5 * 33]); o.w = pk2(s[6 * 33], s[7 * 33]);
        *(u32x4*)(dst + (size_t)n * Kd + 8 * c) = o; }
    LDS_WAIT();
}
DI double dsin_poly(double r) { const double r2 = r * r;
    return r * (1.0 - r2 * (1.0 / 6.0) * (1.0 - r2 * (1.0 / 20.0) * (1.0 - r2 * (1.0 / 42.0) * (1.0 - r2 * (1.0 / 72.0) * (1.0 - r2 * (1.0 / 110.0) * (1.0 - r2 * (1.0 / 156.0) * (1.0 - r2 * (1.0 / 210.0) * (1.0 - r2 * (1.0 / 272.0) * (1.0 - r2 * (1.0 / 342.0) * (1.0 - r2 * (1.0 / 420.0) * (1.0 - r2 * (1.0 / 506.0)))))))))))); }
DI double dcos_poly(double r) { const double r2 = r * r;
    return 1.0 - r2 * (1.0 / 2.0) * (1.0 - r2 * (1.0 / 12.0) * (1.0 - r2 * (1.0 / 30.0) * (1.0 - r2 * (1.0 / 56.0) * (1.0 - r2 * (1.0 / 90.0) * (1.0 - r2 * (1.0 / 132.0) * (1.0 - r2 * (1.0 / 182.0) * (1.0 - r2 * (1.0 / 240.0) * (1.0 - r2 * (1.0 / 306.0) * (1.0 - r2 * (1.0 / 380.0) * (1.0 - r2 * (1.0 / 462.0) * (1.0 - r2 * (1.0 / 552.0)))))))))))); }

constexpr int IT_MOD = DEPTH * 96 * 8;
constexpr int IT_QKV = (DM / 64) * (QKVN / 32), IT_WO = (DM / 64) * (DM / 32), IT_GU = NEXP * (DM / 64) * (FH / 32), IT_DN = NEXP * (FH / 64) * (DM / 32);
constexpr int IT_LAYER = IT_QKV + IT_WO + 2 * IT_GU + IT_DN;
constexpr int IT_TOTAL = IT_MOD + DEPTH * IT_LAYER;

DI void p0_prologue(const Params& P, const Frame& F) {
    LAS float* scr = (LAS float*)(F.lds + F.wave * 16384);
    unsigned char* ws = wsp(P);
    for (int it = F.gw; it < IT_TOTAL; it += F.NGW) {
        if (it < IT_MOD) {
            const int l = it / (96 * 8), rem = it % (96 * 8), cc = rem >> 3, ks = rem & 7;
            for (int idx = F.lane; idx < 17 * 128; idx += 64) { const int b = idx >> 7, k = idx & 127;
                const float cv = (b < 16) ? inp(P, IN_C)[b * DM + ks * 128 + k] : inp(P, IN_CCTX)[ks * 128 + k];
                scr[idx] = cv / (1.f + expf(-cv)); }
            LDS_WAIT();
            float acc[17];
#pragma unroll
            for (int b = 0; b < 17; ++b) acc[b] = 0.f;
            const float* wp = inp(P, IN_WADA) + ((size_t)l * DM + ks * 128) * 6144 + cc * 64 + F.lane;
#pragma unroll 4
            for (int k = 0; k < 128; ++k) { const float w = wp[(size_t)k * 6144];
#pragma unroll
                for (int b = 0; b < 17; ++b) acc[b] += scr[b * 128 + k] * w; }
            float* mp = (float*)(ws + WS_MODP) + ((size_t)(ks * DEPTH + l) * 17) * 6144 + cc * 64 + F.lane;
#pragma unroll
            for (int b = 0; b < 17; ++b) mp[(size_t)b * 6144] = acc[b];
            LDS_WAIT();
            continue;
        }
        int r = it - IT_MOD; const int l = r / IT_LAYER; r -= l * IT_LAYER;
        if (r < IT_QKV) { const int kb = r / (QKVN / 32), nb = r % (QKVN / 32); const int n0 = nb * 32;
            const int drow0 = 256 * (n0 >> 8) + 128 * ((n0 >> 5) & 1) + 32 * ((n0 >> 6) & 3);
            p0_transpose_item(inp(P, IN_WQKV) + (size_t)l * DM * QKVN, QKVN, kb * 64, n0, (bf16_t*)(ws + WS_WQKV) + (size_t)l * QKVN * DM + (size_t)drow0 * DM + kb * 64, DM, scr, F.lane); continue; }
        r -= IT_QKV;
        if (r < IT_WO) { const int kb = r / (DM / 32), nb = r % (DM / 32);
            p0_transpose_item(inp(P, IN_WO) + (size_t)l * DM * DM, DM, kb * 64, nb * 32, (bf16_t*)(ws + WS_WO) + (size_t)l * DM * DM + (size_t)(nb * 32) * DM + kb * 64, DM, scr, F.lane); continue; }
        r -= IT_WO;
        if (r < 2 * IT_GU) { const int which = r / IT_GU; r -= which * IT_GU; const int e = r / 256, kb = (r % 256) / 16, nb = r % 16; const int n0 = nb * 32;
            const int drow0 = 256 * (n0 >> 7) + 128 * which + (n0 & 127);
            p0_transpose_item(inp(P, which ? IN_WUP : IN_WGATE) + (size_t)(l * NEXP + e) * DM * FH, FH, kb * 64, n0,
                              (bf16_t*)(ws + WS_WGU) + (size_t)(l * NEXP + e) * DM * DM + (size_t)drow0 * DM + kb * 64, DM, scr, F.lane); continue; }
        r -= 2 * IT_GU;
        { const int e = r / 256, kb = (r % 256) / 32, nb = r % 32;
            p0_transpose_item(inp(P, IN_WDOWN) + (size_t)(l * NEXP + e) * FH * DM, DM, kb * 64, nb * 32,
                              (bf16_t*)(ws + WS_WD) + (size_t)(l * NEXP + e) * DM * FH + (size_t)(nb * 32) * FH + kb * 64, FH, scr, F.lane); }
    }
    if (F.gw == F.NGW - 1) {
        f32x2* T = (f32x2*)(ws + WS_ROPE);
        for (int idx = F.lane; idx < 64 * 16; idx += 64) { const int pos = idx >> 4, j = idx & 15;
            const float inv = exp2f(-(float)j * (1.f / 16.f) * 13.287712379549449f);
            const float ang = (float)pos * inv;
            const double a = (double)ang; const double rr = a - 6.283185307179586 * rint(a * 0.15915494309189535);
            T[idx] = (f32x2){(float)dcos_poly(rr), (float)dsin_poly(rr)}; }
    }
    { u32x4* wf = (u32x4*)(ws + WS_WRT); const float* wg = inp(P, IN_WGROUP); const float* wr = inp(P, IN_WROUTER);
      for (int idx = F.gw * 64 + F.lane; idx < DEPTH * 32 * 3 * 2 * 64; idx += F.NGW * 64) { const int l = idx / (32 * 3 * 2 * 64), rem = idx % (32 * 3 * 2 * 64), step = rem / 384, nt = (rem % 384) >> 7, which = (rem >> 6) & 1, ln = rem & 63;
          const int n = 16 * nt + (ln & 15); float w[8];
#pragma unroll
          for (int j = 0; j < 8; ++j) { const int k = 32 * step + 8 * (ln >> 4) + j;
              const float wv = (n < 4) ? wg[((size_t)l * DM + k) * 4 + n] : (n < 36 ? wr[((size_t)l * DM + k) * 32 + (n - 4)] : 0.f);
              const float w1 = bf2f(f2bf(wv)); w[j] = which ? (wv - w1) : wv; }
          u32x4 o; o.x = pk2(w[0], w[1]); o.y = pk2(w[2], w[3]); o.z = pk2(w[4], w[5]); o.w = pk2(w[6], w[7]); wf[idx] = o; } }
}
DI void p0b_mod_reduce(const Params& P, const Frame& F) {
    unsigned char* const ws = wsp(P);
    const float* mp = (const float*)(ws + WS_MODP); float* mod = (float*)(ws + WS_MOD);
    for (int idx = F.gw * 64 + F.lane; idx < DEPTH * 17 * 6144; idx += F.NGW * 64) {
        const int l = idx / (17 * 6144), c = idx % 6144;
        float s = inp(P, IN_BADA)[l * 6144 + c];
#pragma unroll
        for (int ks = 0; ks < 8; ++ks) s += mp[(size_t)ks * DEPTH * 17 * 6144 + idx];
        mod[idx] = s; }
}

DI unsigned expert_count(const unsigned char* ws, int layer, int e) { return __hip_atomic_load((const unsigned*)(ws + WS_CTL) + CW_CNT + (layer * NEXP + e) * CNT_STRIDE, __ATOMIC_RELAXED, __HIP_MEMORY_SCOPE_AGENT); }
DI unsigned expert_starts(const unsigned char* ws, int layer, int lane) {
    const unsigned p = (lane < NEXP) ? ((expert_count(ws, layer, lane & 31) + 255u) & ~255u) : 0u; unsigned incl = p;
#pragma unroll
    for (int d = 1; d < 32; d <<= 1) { const unsigned v = __shfl_up(incl, d); if ((lane & 31) >= d) incl += v; }
    return incl - p;
}

DI void load_row(const float* row, int lane, f32x4 (&v)[4]) {
#pragma unroll
    for (int j = 0; j < 4; ++j) v[j] = *(const f32x4*)(row + 4 * lane + 256 * j);
}
DI void load_row_bf(const bf16_t* row, int lane, f32x4 (&v)[4]) {
#pragma unroll
    for (int j = 0; j < 4; ++j) { const u32x2 w = *(const u32x2*)(row + 4 * lane + 256 * j); v[j] = (f32x4){bf2f(w.x & 0xffffu), bf2f(w.x >> 16), bf2f(w.y & 0xffffu), bf2f(w.y >> 16)}; }
}
DI float row_rstd(const f32x4 (&v)[4]) {
    float s = 0.f;
#pragma unroll
    for (int j = 0; j < 4; ++j) s += (v[j][0] * v[j][0] + v[j][1] * v[j][1]) + (v[j][2] * v[j][2] + v[j][3] * v[j][3]);
    return 1.0f / sqrtf(wave_sum(s) * (1.f / DM) + NORM_EPS);
}
DI void load_vec(const float* p, int lane, f32x4 (&v)[4]) {
#pragma unroll
    for (int j = 0; j < 4; ++j) v[j] = *(const f32x4*)(p + 4 * lane + 256 * j);
}
DI void norm_mod_store(const f32x4 (&v)[4], float rstd, const f32x4 (&gg)[4], const f32x4 (&sh)[4], const f32x4 (&sc)[4], bf16_t* hrow, int lane) {
#pragma unroll
    for (int j = 0; j < 4; ++j) { const int c = 4 * lane + 256 * j;
        const f32x4 hf = (v[j] * rstd * gg[j]) * (1.f + sc[j]) + sh[j];
        u32x2 w; w.x = pk2(hf[0], hf[1]); w.y = pk2(hf[2], hf[3]); *(u32x2*)(hrow + c) = w; }
}
struct RowIn { f32x4 x[4]; u32x2 ya[4], yb[4]; };
DI void row_fetch(const unsigned char* ws, const float* xrow, const bf16_t* xrow_bf, int t, unsigned s0, unsigned s1, int lane, bool prev, RowIn& R) {
    if (xrow_bf) load_row_bf(xrow_bf, lane, R.x); else load_row(xrow, lane, R.x);
    if (prev) {
        const bf16_t* Y = (const bf16_t*)(ws + WS_Y);
#pragma unroll
        for (int j = 0; j < 4; ++j) { R.ya[j] = *(const u32x2*)(Y + (size_t)s0 * DM + 4 * lane + 256 * j); R.yb[j] = *(const u32x2*)(Y + (size_t)s1 * DM + 4 * lane + 256 * j); } }
}
DI void row_apply(const f32x4 (&gt)[4], float w0, float w1, RowIn& R) {
#pragma unroll
    for (int j = 0; j < 4; ++j) { const f32x4 g = gt[j]; const u32x2 a = R.ya[j], b = R.yb[j];
        R.x[j][0] += g[0] * (w0 * bf2f(a.x & 0xffffu) + w1 * bf2f(b.x & 0xffffu)); R.x[j][1] += g[1] * (w0 * bf2f(a.x >> 16) + w1 * bf2f(b.x >> 16));
        R.x[j][2] += g[2] * (w0 * bf2f(a.y & 0xffffu) + w1 * bf2f(b.y & 0xffffu)); R.x[j][3] += g[3] * (w0 * bf2f(a.y >> 16) + w1 * bf2f(b.y >> 16)); }
}
DI void phase_attn_norm(const Params& P, const Frame& F0, int layer) {
    const Frame F = opaque_frame(F0);
    unsigned char* const ws = wsp(P);
    bf16_t* X = (bf16_t*)(ws + WS_X); bf16_t* H = (bf16_t*)(ws + WS_H);
    const bool prev = layer > 0;
    const int nrow = (TALL - F.gw + F.NGW - 1) / F.NGW;
    unsigned ms0 = 0, ms1 = 0; float mw0 = 0.f, mw1 = 0.f;
    if (prev) { const unsigned pst = expert_starts(ws, layer - 1, F.lane); u32x2 a = (u32x2){0u, 0u};
        if (F.lane < nrow) { const int tl = F.gw + F.lane * F.NGW; a = *(const u32x2*)((const unsigned*)(ws + WS_ASG) + (size_t)tl * 2); const f32x2 w = *(const f32x2*)((const float*)(ws + WS_ASGW) + (size_t)tl * 2); mw0 = w.x; mw1 = w.y; }
        ms0 = (unsigned)__shfl((int)pst, (int)(a.x >> 20)) + (a.x & 0xfffffu); ms1 = (unsigned)__shfl((int)pst, (int)(a.y >> 20)) + (a.y & 0xfffffu); }
    auto xsrc = [&](int t) -> const float* { return (t < TLAT ? inp(P, IN_X) + (size_t)t * DM : inp(P, IN_CTX) + (size_t)(t - TLAT) * DM); };
    auto xbf = [&](int t) -> const bf16_t* { return prev ? X + (size_t)t * DM : (const bf16_t*)nullptr; };
    RowIn cur, nxt;
    f32x4 gat[4]; load_vec(inp(P, IN_GATTN) + layer * DM, F.lane, gat);
    row_fetch(ws, xsrc(F.gw), xbf(F.gw), F.gw, __shfl(ms0, 0), __shfl(ms1, 0), F.lane, prev, cur);
    for (int i = 0; i < nrow; ++i) {
        const int t = F.gw + i * F.NGW; const int mb = (t < TLAT) ? (t >> 11) : 16;
        const float* md = (const float*)(ws + WS_MOD) + ((size_t)layer * 17 + mb) * 6144;
        f32x4 gt[4], sh[4], sc[4];
        if (prev) load_vec(md - 17 * 6144 + 5120, F.lane, gt);
        load_vec(md, F.lane, sh); load_vec(md + 1024, F.lane, sc);
        asm volatile("" ::: "memory");
        if (i + 1 < nrow) row_fetch(ws, xsrc(t + F.NGW), xbf(t + F.NGW), t + F.NGW, __shfl(ms0, i + 1), __shfl(ms1, i + 1), F.lane, prev, nxt);
        if (prev) row_apply(gt, __shfl(mw0, i), __shfl(mw1, i), cur);
#pragma unroll
        for (int j = 0; j < 4; ++j) { u32x2 w; w.x = pk2(cur.x[j][0], cur.x[j][1]); w.y = pk2(cur.x[j][2], cur.x[j][3]); *(u32x2*)(X + (size_t)t * DM + 4 * F.lane + 256 * j) = w; }
        const float rstd = row_rstd(cur.x);
        norm_mod_store(cur.x, rstd, gat, sh, sc, H + (size_t)t * DM, F.lane);
        cur = nxt;
    }
}
DI void phase_final(const Params& P, const Frame& F0) {
    const Frame F = opaque_frame(F0);
    unsigned char* const ws = wsp(P);
    const bf16_t* X = (const bf16_t*)(ws + WS_X);
    const float pc = PROBE_SEL ? *((const float*)(ws + WS_CTL) + 64) : 0.f;
    const int nrow = (TLAT - F.gw + F.NGW - 1) / F.NGW;
    unsigned ms0 = 0, ms1 = 0; float mw0 = 0.f, mw1 = 0.f;
    { const unsigned pst = expert_starts(ws, DEPTH - 1, F.lane); u32x2 a = (u32x2){0u, 0u};
      if (F.lane < nrow) { const int tl = F.gw + F.lane * F.NGW; a = *(const u32x2*)((const unsigned*)(ws + WS_ASG) + (size_t)tl * 2); const f32x2 w = *(const f32x2*)((const float*)(ws + WS_ASGW) + (size_t)tl * 2); mw0 = w.x; mw1 = w.y; }
      ms0 = (unsigned)__shfl((int)pst, (int)(a.x >> 20)) + (a.x & 0xfffffu); ms1 = (unsigned)__shfl((int)pst, (int)(a.y >> 20)) + (a.y & 0xfffffu); }
    RowIn cur, nxt;
    row_fetch(ws, nullptr, X + (size_t)F.gw * DM, F.gw, __shfl(ms0, 0), __shfl(ms1, 0), F.lane, true, cur);
    f32x4 gfin[4]; load_vec(inp(P, IN_GFINAL), F.lane, gfin);
    for (int i = 0; i < nrow; ++i) {
        const int t = F.gw + i * F.NGW;
        f32x4 gt[4]; load_vec((const float*)(ws + WS_MOD) + ((size_t)(DEPTH - 1) * 17 + (t >> 11)) * 6144 + 5120, F.lane, gt);
        asm volatile("" ::: "memory");
        if (i + 1 < nrow) row_fetch(ws, nullptr, X + (size_t)(t + F.NGW) * DM, t + F.NGW, __shfl(ms0, i + 1), __shfl(ms1, i + 1), F.lane, true, nxt);
        row_apply(gt, __shfl(mw0, i), __shfl(mw1, i), cur);
        const float rstd = row_rstd(cur.x);
#pragma unroll
        for (int j = 0; j < 4; ++j) { const int c = 4 * F.lane + 256 * j; *(f32x4*)(P.out + (size_t)t * DM + c) = cur.x[j] * rstd * gfin[j] + pc; }
        cur = nxt;
    }
}

DI float swap_max(float v) { auto rr = __builtin_amdgcn_permlane32_swap(__float_as_uint(v), __float_as_uint(v), false, false); return fmaxf(__uint_as_float(rr[0]), __uint_as_float(rr[1])); }
DI float swap_add(float v) { auto rr = __builtin_amdgcn_permlane32_swap(__float_as_uint(v), __float_as_uint(v), false, false); return __uint_as_float(rr[0]) + __uint_as_float(rr[1]); }
DI bf16x8 pack_p(const f32x16& p, int s) {
    u32x4 w; w.x = cvt_pk_bf16(p[8 * s + 0], p[8 * s + 1]); w.y = cvt_pk_bf16(p[8 * s + 2], p[8 * s + 3]); w.z = cvt_pk_bf16(p[8 * s + 4], p[8 * s + 5]); w.w = cvt_pk_bf16(p[8 * s + 6], p[8 * s + 7]);
    return __builtin_bit_cast(bf16x8, w);
}
struct AttnState { float m, l; f32x16 o[2]; };
DI void load_k(const unsigned char* Kbh, int kg, int r32, int hi, bf16x8 (&k)[4]) {
    const unsigned char* kb = Kbh + (size_t)(kg + (r32 >> 3)) * 1024 + hi * 128 + (r32 & 7) * 16;
#pragma unroll
    for (int d0 = 0; d0 < 4; ++d0) k[d0] = *(const bf16x8*)(kb + d0 * 256);
}
DI void load_v(const unsigned char* Vbh, int kg, int r32, int hi, s16x4 (&v)[2][2][2]) {
    const unsigned char* vb = Vbh + (size_t)kg * 1024 + r32 * 16 + hi * 8;
#pragma unroll
    for (int dh = 0; dh < 2; ++dh)
#pragma unroll
        for (int ks = 0; ks < 2; ++ks)
#pragma unroll
            for (int pt = 0; pt < 2; ++pt) v[dh][ks][pt] = *(const s16x4*)(vb + dh * 512 + (2 * ks + pt) * 1024);
}
DI f32x16 attn_scores(const bf16x8 (&k)[4], const bf16x8 (&q)[4]) {
    f32x16 s;
#pragma unroll
    for (int r = 0; r < 16; ++r) s[r] = 0.f;
#pragma unroll
    for (int d0 = 0; d0 < 4; ++d0) s = __builtin_amdgcn_mfma_f32_32x32x16_bf16(k[d0], q[d0], s, 0, 0, 0);
    return s;
}
DI float row_max16(const f32x16& s) {
    float mt = fmaxf(fmaxf(s[0], s[1]), fmaxf(s[2], s[3]));
#pragma unroll
    for (int r = 4; r < 16; r += 4) mt = fmaxf(mt, fmaxf(fmaxf(s[r], s[r + 1]), fmaxf(s[r + 2], s[r + 3])));
    return mt;
}
DI void attn_rescale(AttnState& st, f32x16& s, float mt, LAS float* wsf, int r32, int hi) {
    mt = swap_max(mt);
    const float dm = fmaxf(mt, 0.f);
    const float al = __builtin_amdgcn_exp2f(-dm);
    st.l *= al; st.m += dm;
#pragma unroll
    for (int r = 0; r < 16; ++r) s[r] -= dm;
    if (hi == 0) wsf[r32] = al;
    LDS_WAIT();
#pragma unroll
    for (int r = 0; r < 16; ++r) { const float f = wsf[crow(r, hi)]; st.o[0][r] *= f; st.o[1][r] *= f; }
    LDS_WAIT();
}
DI void attn_exp_pv(AttnState& st, f32x16& s, const s16x4 (&v)[2][2][2]) {
    float p0 = 0.f, p1 = 0.f;
#pragma unroll
    for (int r = 0; r < 16; r += 2) { s[r] = __builtin_amdgcn_exp2f(s[r]); s[r + 1] = __builtin_amdgcn_exp2f(s[r + 1]); p0 += s[r]; p1 += s[r + 1]; }
    st.l += p0 + p1;
    const bf16x8 pa0 = pack_p(s, 0), pa1 = pack_p(s, 1);
#pragma unroll
    for (int dh = 0; dh < 2; ++dh) {
        const bf16x8 vf0 = __builtin_shufflevector(v[dh][0][0], v[dh][0][1], 0, 1, 2, 3, 4, 5, 6, 7);
        const bf16x8 vf1 = __builtin_shufflevector(v[dh][1][0], v[dh][1][1], 0, 1, 2, 3, 4, 5, 6, 7);
        st.o[dh] = __builtin_amdgcn_mfma_f32_32x32x16_bf16(pa0, vf0, st.o[dh], 0, 0, 0);
        st.o[dh] = __builtin_amdgcn_mfma_f32_32x32x16_bf16(pa1, vf1, st.o[dh], 0, 0, 0);
    }
}
DI void attn_softmax_pv2(AttnState (&st)[2], f32x16 (&s)[2], const s16x4 (&v)[2][2][2], LAS float* wsf, int r32, int hi) {
#pragma unroll
    for (int r = 0; r < 16; ++r) { s[0][r] -= st[0].m; s[1][r] -= st[1].m; }
    const float mt0 = row_max16(s[0]), mt1 = row_max16(s[1]);
    if (__any(fmaxf(mt0, mt1) > 8.f)) { attn_rescale(st[0], s[0], mt0, wsf, r32, hi); attn_rescale(st[1], s[1], mt1, wsf + 32, r32, hi); }
    attn_exp_pv(st[0], s[0], v);
    attn_exp_pv(st[1], s[1], v);
}
template <int MODE>
DI void attn_unit(const Params& P, unsigned char* ws, int layer, int b, int h0, int qblk, LAS unsigned char* wl, int lane) {
    const int r32 = lane & 31, hi = lane >> 5, kvh = h0 >> 2, m = layer % 3;
    constexpr bool VDB = false;
    LAS float* wsf = (LAS float*)wl; LAS bf16_t* stg = (LAS bf16_t*)(wl + 256); LAS float* rpbt = (LAS float*)(wl + 256 + 4096);
    const bf16_t* QKV = (const bf16_t*)(ws + WS_QKV);
    const unsigned char* Kbh = ws + WS_KF + (size_t)(b * NKV + kvh) * KGRP * 1024;
    const unsigned char* Vbh = ws + WS_VF + (size_t)(b * NKV + kvh) * KGRP * 1024;
    bf16_t* O = (bf16_t*)(ws + WS_O);
    int r0 = 0, c0 = 0;
    if (MODE == 2) { r0 = 2 * (qblk >> 2); c0 = 16 * (qblk & 3); }
    auto qtok = [&](int i) -> int {
        if (MODE == 3) return TLAT + b * CTXL + qblk * 32 + i;
        if (MODE == 2) return b * SEQ + (r0 + (i >> 4)) * 64 + c0 + (i & 15);
        return b * SEQ + qblk * 32 + i; };
    const int tq = qtok(r32);
    const bf16_t* qp = QKV + (size_t)tq * QKVN + h0 * HD + hi * 8;
    bf16x8 qr[2][4];
#pragma unroll
    for (int hh = 0; hh < 2; ++hh)
#pragma unroll
        for (int d0 = 0; d0 < 4; ++d0) qr[hh][d0] = *(const bf16x8*)(qp + hh * HD + d0 * 16);
    const int q0 = qblk * 32;
    int nl = 0, jlo = 0, rs_min = 0, cseg = 0;
    if (MODE == 0) { jlo = (q0 < 128) ? (128 - q0) / 32 : 0; const int jhi = min(8, (SEQ - 32 - q0 + 128) / 32); nl = jhi - jlo + 1; }
    if (MODE == 1) nl = SEQ / 32;
    if (MODE == 2) { rs_min = min(max(r0 - 4, 0), 24); const int rs_max = min(max(r0 + 1 - 4, 0), 24); nl = rs_max - rs_min + 8; cseg = (c0 == 0) ? 0 : (c0 == 16) ? 8 : (c0 == 32) ? 24 : 32; }
    auto lat_kg = [&](int i) -> int {
        if (MODE == 0) return (q0 - 128 + 32 * (jlo + i)) >> 3;
        if (MODE == 1) return 4 * i;
        return ((rs_min + i) * 64 + cseg) >> 3; };
    bf16x8 kn[4];
    load_k(Kbh, nl > 0 ? lat_kg(0) : SEQ / 8, r32, hi, kn);
    if (MODE == 0 || MODE == 1) {
        const int n = tq & 2047; const f32x2* T = (const f32x2*)(ws + WS_ROPE);
        const f32x2* tr = T + (n >> 6) * 16 + 8 * hi; const f32x2* tc = T + (n & 63) * 16 + 8 * hi;
#pragma unroll
        for (int e = 0; e < 8; ++e) { const f32x2 a = tr[e], cc = tc[e];
#pragma unroll
            for (int hh = 0; hh < 2; ++hh) {
                const float x1 = bfs2f(qr[hh][0][e]), x2 = bfs2f(qr[hh][1][e]), x3 = bfs2f(qr[hh][2][e]), x4 = bfs2f(qr[hh][3][e]);
                qr[hh][0][e] = (short)f2bf(x1 * a.x - x2 * a.y); qr[hh][1][e] = (short)f2bf(x2 * a.x + x1 * a.y);
                qr[hh][2][e] = (short)f2bf(x3 * cc.x - x4 * cc.y); qr[hh][3][e] = (short)f2bf(x4 * cc.x + x3 * cc.y); } }
    }
    LAS bf16x8* qlds = (LAS bf16x8*)(wl + 8192) + lane;
    if (VDB) {
#pragma unroll
        for (int d0 = 0; d0 < 4; ++d0) qlds[d0 * 64] = qr[1][d0];
        LDS_WAIT();
    }
    int rq = 0, cq = 0, rsq = 0, csq = 0;
    if (MODE == 2) {
        const float* rpb = inp(P, IN_RPB) + (size_t)h0 * 465;
        for (int i = lane; i < 930; i += 64) rpbt[i + (i >= 465 ? 7 : 0)] = rpb[i] * LOG2E;
        LDS_WAIT();
        rq = r0 + (r32 >> 4); cq = c0 + (r32 & 15); rsq = min(max(rq - 4, 0), 24); csq = min(max(cq - 8, 0), 48);
    }
    AttnState st[2];
#pragma unroll
    for (int hh = 0; hh < 2; ++hh) { st[hh].m = -1024.f; st[hh].l = 0.f;
#pragma unroll
        for (int r = 0; r < 16; ++r) { st[hh].o[0][r] = 0.f; st[hh].o[1][r] = 0.f; } }
    const float NEG = -INFINITY;
    s16x4 vn[2][2][2];
    if (VDB) load_v(Vbh, nl > 0 ? lat_kg(0) : SEQ / 8, r32, hi, vn);
    for (int i = 0; i < nl; ++i) {
        const int kgn = (i + 1 < nl) ? lat_kg(i + 1) : SEQ / 8;
        s16x4 v[2][2][2];
        if (VDB) {
#pragma unroll
            for (int a = 0; a < 2; ++a)
#pragma unroll
                for (int c = 0; c < 2; ++c)
#pragma unroll
                    for (int e = 0; e < 2; ++e) v[a][c][e] = vn[a][c][e];
        } else load_v(Vbh, lat_kg(i), r32, hi, v);
        f32x16 s[2];
        s[0] = attn_scores(kn, qr[0]);
        if (VDB) { bf16x8 q1[4];
#pragma unroll
            for (int d0 = 0; d0 < 4; ++d0) q1[d0] = qlds[d0 * 64];
            s[1] = attn_scores(kn, q1); }
        else s[1] = attn_scores(kn, qr[1]);
        load_k(Kbh, kgn, r32, hi, kn);
        if (VDB) load_v(Vbh, kgn, r32, hi, vn);
        if (MODE == 0) {
            const int j = jlo + i;
            if (j == 0 || j == 8) { const int kt = q0 - 128 + 32 * j, qpos = q0 + r32;
#pragma unroll
                for (int r = 0; r < 16; ++r) { const int d = kt + crow(r, hi) - qpos; if (d > 128 || d < -128) { s[0][r] = NEG; s[1][r] = NEG; } } }
        }
        if (MODE == 2) {
            const int kr = rs_min + i;
            const bool rowok = (kr >= rsq) && (kr < rsq + 8);
            const int ib = (kr - rq + 7) * 31 - cq + 15;
#pragma unroll
            for (int r = 0; r < 16; ++r) { const int kc2 = cseg + crow(r, hi); const bool ok = rowok && (kc2 >= csq) && (kc2 < csq + 16);
                const int idx = min(max(ib + kc2, 0), 464);
                s[0][r] = ok ? s[0][r] + rpbt[idx] : NEG; s[1][r] = ok ? s[1][r] + rpbt[472 + idx] : NEG; }
        }
        attn_softmax_pv2(st, s, v, wsf, r32, hi);
    }
    if (MODE == 0 || MODE == 1) {
#pragma unroll
        for (int hh = 0; hh < 2; ++hh)
#pragma unroll
            for (int d0 = 0; d0 < 4; ++d0) qr[hh][d0] = *(const bf16x8*)(qp + hh * HD + d0 * 16);
        if (VDB) {
#pragma unroll
            for (int d0 = 0; d0 < 4; ++d0) qlds[d0 * 64] = qr[1][d0];
            LDS_WAIT();
        }
    }
    for (int j = 0; j < CTXL / 32; ++j) {
        const int kg = SEQ / 8 + 4 * j, kgn = (j + 1 < CTXL / 32) ? kg + 4 : kg;
        s16x4 v[2][2][2];
        if (VDB) {
#pragma unroll
            for (int a = 0; a < 2; ++a)
#pragma unroll
                for (int c = 0; c < 2; ++c)
#pragma unroll
                    for (int e = 0; e < 2; ++e) v[a][c][e] = vn[a][c][e];
        } else load_v(Vbh, kg, r32, hi, v);
        f32x16 s[2];
        s[0] = attn_scores(kn, qr[0]);
        if (VDB) { bf16x8 q1[4];
#pragma unroll
            for (int d0 = 0; d0 < 4; ++d0) q1[d0] = qlds[d0 * 64];
            s[1] = attn_scores(kn, q1); }
        else s[1] = attn_scores(kn, qr[1]);
        load_k(Kbh, kgn, r32, hi, kn);
        if (VDB) load_v(Vbh, kgn, r32, hi, vn);
        attn_softmax_pv2(st, s, v, wsf, r32, hi);
    }
    int lane2 = lane; asm volatile("" : "+v"(lane2));
    const int r32b = lane2 & 31, hib = lane2 >> 5;
#pragma unroll
    for (int hh = 0; hh < 2; ++hh) {
        const float lt = swap_add(st[hh].l);
        float inv;
        if (MODE == 0 || (MODE == 3 && m == 0)) { const float sk = inp(P, IN_SINK)[(layer / 3) * NH + h0 + hh] * LOG2E;
            const float mnew = fmaxf(st[hh].m, sk); const float al = __builtin_amdgcn_exp2f(st[hh].m - mnew), es = __builtin_amdgcn_exp2f(sk - mnew);
            inv = al / (lt * al + es); }
        else inv = 1.f / lt;
        if (hib == 0) wsf[r32b] = inv;
        LDS_WAIT();
        LAS bf16_t* sb = stg + hib * 256 + r32b;
        const LAS float* wf = wsf + 4 * hib;
#pragma unroll
        for (int r = 0; r < 16; ++r) { const float f = wf[(r & 3) + 8 * (r >> 2)];
            sb[((r & 3) + 8 * (r >> 2)) * 64] = (bf16_t)f2bf(st[hh].o[0][r] * f); sb[((r & 3) + 8 * (r >> 2)) * 64 + 32] = (bf16_t)f2bf(st[hh].o[1][r] * f); }
        LDS_WAIT();
        const int rw = lane2 >> 3, ch = lane2 & 7;
        const LAS unsigned char* rb = (const LAS unsigned char*)stg + rw * 128 + ch * 16;
#pragma unroll
        for (int i = 0; i < 4; ++i) { const u32x4 vv = *(const LAS u32x4*)(rb + i * 1024);
            *(u32x4*)(O + (size_t)qtok(i * 8 + rw) * DM + (h0 + hh) * HD + ch * 8) = vv; }
        LDS_WAIT();
    }
}
DI void phase_attention(const Params& P, const Frame& F0, int layer) {
    const Frame F = opaque_frame(F0);
    unsigned char* const ws = wsp(P);
    const int m = layer % 3;
    LAS unsigned char* wl = F.lds + F.wave * 16384;
    for (int bu = F.blk; bu < NB * NKV * 16; bu += F.G) {
        const int rnd = bu >> 8, x = bu & 7, loc = (bu & 255) >> 3;
        const int bkv = rnd * 16 + x * 2 + (loc >> 4), qg = loc & 15;
        const int b = bkv >> 2, kvh = bkv & 3, h0 = kvh * 4 + 2 * (F.wave & 1), qblk = 4 * qg + (F.wave >> 1);
        if (m == 0) attn_unit<0>(P, ws, layer, b, h0, qblk, wl, F.lane);
        else if (m == 1) attn_unit<1>(P, ws, layer, b, h0, qblk, wl, F.lane);
        else attn_unit<2>(P, ws, layer, b, h0, qblk, wl, F.lane);
    }
    if (layer < DEPTH - 1) {
        for (int bu = F.blk; bu < NB * NKV * 2; bu += F.G) {
            const int bkv = bu >> 1, b = bkv >> 2, kvh = bkv & 3, h0 = kvh * 4 + 2 * (F.wave & 1), qblk = 4 * (bu & 1) + (F.wave >> 1);
            attn_unit<3>(P, ws, layer, b, h0, qblk, wl, F.lane);
        }
    }
}

DI int blk_token(int blk, int i) { return i < 128 ? blk * 128 + i : TLAT + blk * 16 + (i - 128); }
constexpr int RT_ROWB = 2064;
constexpr int RT_X2_OFF = 16 * RT_ROWB, RT_PART_OFF = 2 * 16 * RT_ROWB, RT_LOG_OFF = RT_PART_OFF + 8 * 16 * 48 * 4, RT_LOGS = 37, RT_VEC_OFF = RT_LOG_OFF + 144 * RT_LOGS * 4;
DI void phase_router(const Params& P, const Frame& F0, int layer, int M) {
    const Frame F = opaque_frame(F0);
    unsigned char* const ws = wsp(P);
    const int TPB = M / GRID, nchunk = TPB / 16;
    LAS int* hist = (LAS int*)(F.lds + LDSX_OFF);
    LAS float* part = (LAS float*)(F.lds + RT_PART_OFF); LAS float* logit = (LAS float*)(F.lds + RT_LOG_OFF);
    if (F.tid < 32) hist[F.tid] = 0;
    const bf16_t* X = (const bf16_t*)(ws + WS_X); bf16_t* H = (bf16_t*)(ws + WS_H);
    const float* gffn = inp(P, IN_GFFN) + layer * DM;
    const u32x4* wf = (const u32x4*)(ws + WS_WRT) + ((size_t)layer * 32 + 4 * F.wave) * 384 + F.lane;
    bf16x8 wreg[4][2][2];
#pragma unroll
    for (int s = 0; s < 4; ++s)
#pragma unroll
        for (int nt = 0; nt < 2; ++nt)
#pragma unroll
            for (int wh = 0; wh < 2; ++wh) wreg[s][nt][wh] = __builtin_bit_cast(bf16x8, wf[s * 384 + nt * 128 + wh * 64]);
    bf16x8 w2t[4][2];
#pragma unroll
    for (int s = 0; s < 4; ++s)
#pragma unroll
        for (int wh = 0; wh < 2; ++wh) w2t[s][wh] = __builtin_bit_cast(bf16x8, wf[s * 384 + 256 + wh * 64]);
    LAS float* vec = (LAS float*)(F.lds + RT_VEC_OFF);
    auto load_vecs = [&](int mb) {
        const float* md = (const float*)(ws + WS_MOD) + ((size_t)layer * 17 + mb) * 6144;
        for (int i = F.tid; i < 256; i += NTHREADS) { const f32x4 g = *(const f32x4*)(gffn + 4 * i), sc = *(const f32x4*)(md + 4096 + 4 * i);
            *(LAS f32x4*)(vec + 4 * i) = *(const f32x4*)(md + 2048 + 4 * i); *(LAS f32x4*)(vec + 1024 + 4 * i) = g * (1.f + sc); *(LAS f32x4*)(vec + 2048 + 4 * i) = *(const f32x4*)(md + 3072 + 4 * i); } };
    load_vecs(F.blk >> 4);
    const int ib = 2 * F.wave;
    f32x4 vn[2][4];
#pragma unroll
    for (int tk = 0; tk < 2; ++tk) { const int t = blk_token(F.blk, ib + tk); load_row_bf(X + (size_t)t * DM, F.lane, vn[tk]); }
    LDS_WAIT(); __syncthreads();
    for (int c = 0; c < nchunk; ++c) {
        if (c == 8) { load_vecs(16); LDS_WAIT(); __syncthreads(); }
#pragma unroll
        for (int tk = 0; tk < 2; ++tk) { const int t = blk_token(F.blk, c * 16 + ib + tk);
            const float rstd = row_rstd(vn[tk]);
            LAS unsigned char* r1 = F.lds + (ib + tk) * RT_ROWB + 8 * F.lane; bf16_t* hrow = H + (size_t)t * DM;
#pragma unroll
            for (int j = 0; j < 4; ++j) { const int cc = 4 * F.lane + 256 * j; const f32x4 ga = *(const LAS f32x4*)(vec + 1024 + cc), sh = *(const LAS f32x4*)(vec + 2048 + cc);
                const f32x4 hf = (vn[tk][j] * rstd) * ga + sh;
                u32x2 a; a.x = pk2(hf[0], hf[1]); a.y = pk2(hf[2], hf[3]);
                u32x2 b; b.x = pk2(hf[0] - bf2f(a.x & 0xffffu), hf[1] - bf2f(a.x >> 16)); b.y = pk2(hf[2] - bf2f(a.y & 0xffffu), hf[3] - bf2f(a.y >> 16));
                *(u32x2*)(hrow + cc) = a; *(LAS u32x2*)(r1 + 512 * j) = a; *(LAS u32x2*)(r1 + RT_X2_OFF + 512 * j) = b; } }
        if (c + 1 < nchunk) {
#pragma unroll
            for (int tk = 0; tk < 2; ++tk) { const int t = blk_token(F.blk, (c + 1) * 16 + ib + tk); load_row_bf(X + (size_t)t * DM, F.lane, vn[tk]); }
        }
        LDS_WAIT(); __syncthreads();
        f32x4 acc[3];
#pragma unroll
        for (int nt = 0; nt < 3; ++nt) acc[nt] = (f32x4){0.f, 0.f, 0.f, 0.f};
        { const LAS unsigned char* ap = F.lds + (F.lane & 15) * RT_ROWB + 256 * F.wave + 16 * (F.lane >> 4);
#pragma unroll
          for (int s = 0; s < 4; ++s) { const bf16x8 a1 = *(const LAS bf16x8*)(ap + 64 * s), a2 = *(const LAS bf16x8*)(ap + RT_X2_OFF + 64 * s);
#pragma unroll
              for (int nt = 0; nt < 2; ++nt) { acc[nt] = __builtin_amdgcn_mfma_f32_16x16x32_bf16(a1, wreg[s][nt][0], acc[nt], 0, 0, 0);
                  acc[nt] = __builtin_amdgcn_mfma_f32_16x16x32_bf16(a1, wreg[s][nt][1], acc[nt], 0, 0, 0); acc[nt] = __builtin_amdgcn_mfma_f32_16x16x32_bf16(a2, wreg[s][nt][0], acc[nt], 0, 0, 0); }
              acc[2] = __builtin_amdgcn_mfma_f32_16x16x32_bf16(a1, w2t[s][0], acc[2], 0, 0, 0);
              acc[2] = __builtin_amdgcn_mfma_f32_16x16x32_bf16(a1, w2t[s][1], acc[2], 0, 0, 0); acc[2] = __builtin_amdgcn_mfma_f32_16x16x32_bf16(a2, w2t[s][0], acc[2], 0, 0, 0); } }
        { LAS float* pp = part + F.wave * 768 + (4 * (F.lane >> 4)) * 48 + (F.lane & 15);
#pragma unroll
          for (int nt = 0; nt < 3; ++nt)
#pragma unroll
              for (int r = 0; r < 4; ++r) pp[r * 48 + 16 * nt] = acc[nt][r]; }
        LDS_WAIT(); __syncthreads();
        { const int tk = F.tid >> 5, n = F.tid & 31; float s = 0.f;
#pragma unroll
          for (int w = 0; w < 8; ++w) s += part[w * 768 + tk * 48 + n];
          logit[(c * 16 + tk) * RT_LOGS + n] = s;
          if (F.tid < 64) { const int tk2 = F.tid >> 2, n2 = 32 + (F.tid & 3); float s2 = 0.f;
#pragma unroll
              for (int w = 0; w < 8; ++w) s2 += part[w * 768 + tk2 * 48 + n2];
              logit[(c * 16 + tk2) * RT_LOGS + n2] = s2; } }
    }
    LDS_WAIT(); __syncthreads();
    int rt_t = 0, rt_e1 = 0, rt_e2 = 0, rt_q1 = 0, rt_q2 = 0; float rt_w1 = 0.f, rt_w2 = 0.f;
    if (F.tid < TPB) { const int t = blk_token(F.blk, F.tid); const LAS float* lg = logit + F.tid * RT_LOGS;
        const float* bg = inp(P, IN_BGROUP) + layer * 4; const float* br = inp(P, IN_BROUTER) + layer * 32;
        const float g0 = lg[0] + bg[0], g1 = lg[1] + bg[1], g2 = lg[2] + bg[2], g3 = lg[3] + bg[3];
        int grp = 0; float gm = g0; if (g1 > gm) { gm = g1; grp = 1; } if (g2 > gm) { gm = g2; grp = 2; } if (g3 > gm) { gm = g3; grp = 3; }
        const float ptop = 1.f / (expf(g0 - gm) + expf(g1 - gm) + expf(g2 - gm) + expf(g3 - gm));
        float ev[8], em = -INFINITY;
#pragma unroll
        for (int j = 0; j < 8; ++j) { ev[j] = lg[4 + grp * 8 + j] + br[grp * 8 + j]; em = fmaxf(em, ev[j]); }
        float pe[8];
#pragma unroll
        for (int j = 0; j < 8; ++j) pe[j] = expf(ev[j] - em);
        int i1 = 0; float p1 = pe[0];
#pragma unroll
        for (int j = 1; j < 8; ++j) if (pe[j] > p1) { p1 = pe[j]; i1 = j; }
        int i2 = 0; float p2 = -1.f;
#pragma unroll
        for (int j = 0; j < 8; ++j) if (j != i1 && pe[j] > p2) { p2 = pe[j]; i2 = j; }
        const float w1 = ptop * p1 / (p1 + p2), w2 = ptop * p2 / (p1 + p2);
        const int e1 = grp * 8 + i1, e2 = grp * 8 + i2;
        rt_q1 = atomicAdd((int*)&hist[e1], 1); rt_q2 = atomicAdd((int*)&hist[e2], 1);
        rt_t = t; rt_e1 = e1; rt_e2 = e2; rt_w1 = w1; rt_w2 = w2; }
    __syncthreads();
    LAS unsigned* gbase = (LAS unsigned*)(hist + 32);
    if (F.tid < 32) gbase[F.tid] = __hip_atomic_fetch_add((unsigned*)(ws + WS_CTL) + CW_CNT + (layer * NEXP + F.tid) * CNT_STRIDE, (unsigned)hist[F.tid], __ATOMIC_RELAXED, __HIP_MEMORY_SCOPE_AGENT);
    LDS_WAIT(); __syncthreads();
    if (F.tid < TPB) { const unsigned i1 = gbase[rt_e1] + (unsigned)rt_q1, i2 = gbase[rt_e2] + (unsigned)rt_q2;
        unsigned* asg = (unsigned*)(ws + WS_ASG); float* asgw = (float*)(ws + WS_ASGW); unsigned* toke = (unsigned*)(ws + WS_TOKE);
        *(u32x2*)(asg + (size_t)rt_t * 2) = (u32x2){((unsigned)rt_e1 << 20) | i1, ((unsigned)rt_e2 << 20) | i2};
        *(f32x2*)(asgw + (size_t)rt_t * 2) = (f32x2){rt_w1, rt_w2};
        toke[(size_t)rt_e1 * TALL + i1] = (unsigned)rt_t; toke[(size_t)rt_e2 * TALL + i2] = (unsigned)rt_t; }
}
DI void build_tile_table(const Params& P, const Frame& F0, LAS unsigned* tab, int layer) {
    const Frame F = opaque_frame(F0);
    unsigned char* const ws = wsp(P);
    constexpr int TP = pg8::MoeSched<true>::TAB_PST, TC = pg8::MoeSched<true>::TAB_CNT;
    if (F.tid < NEXP) tab[TC + F.tid] = expert_count(ws, layer, F.tid);
    LDS_WAIT(); __syncthreads();
    if (F.tid == 0) { unsigned ps = 0; for (int e = 0; e < NEXP; ++e) { tab[TP + e] = ps; ps += (tab[TC + e] + 255u) & ~255u; } tab[0] = ps >> 8; }
    LDS_WAIT(); __syncthreads();
    const unsigned ntile = tab[0];
    for (unsigned rt = F.tid; rt < ntile; rt += NTHREADS) { unsigned e = 0; for (int k = 1; k < NEXP; ++k) if (rt * 256u >= tab[TP + k]) e = k; tab[1 + rt] = e; }
    LDS_WAIT(); __syncthreads();
}
DI void stage_rope_table(const Params& P, const Frame& F0, LAS f32x2* dst) {
    const Frame F = opaque_frame(F0);
    const f32x2* T = (const f32x2*)(wsp(P) + WS_ROPE);
    for (int i = F.tid; i < 64 * 16; i += NTHREADS) dst[i] = T[i];
    LDS_WAIT(); __syncthreads();
}

__global__ void __launch_bounds__(NTHREADS, 2) dit_fwd(Params P) {
    extern __shared__ __attribute__((aligned(16))) unsigned char lds_raw[];
    Frame F;
    F.lds = (LAS unsigned char*)lds_raw;
    F.tid = threadIdx.x; F.lane = F.tid & 63; F.wave = __builtin_amdgcn_readfirstlane(F.tid >> 6);
    F.blk = blockIdx.x; F.G = gridDim.x; F.vcu = (F.G % 8 == 0) ? (F.blk % 8) * (F.G / 8) + F.blk / 8 : F.blk;
    F.gw = F.vcu * NWAVES + F.wave; F.NGW = F.G * NWAVES;
    for (int u = F.tid; u < (LDS_BYTES - RING_BYTES) / 4; u += NTHREADS) ((LAS unsigned*)(F.lds + RING_BYTES))[u] = 0u;
    __syncthreads();
    unsigned* ctl = (unsigned*)(P.ws + WS_CTL);
    XcdBarrier bar = xcd_barrier_post(ctl + CW_BAR, (volatile LAS unsigned*)(F.lds + MISC_OFF) + 8);

    unsigned long long pr_t0 = 0, pr_prev = 0, pr_acc = 0;
    if (PROBE_SEL) { pr_t0 = __builtin_amdgcn_s_memrealtime(); pr_prev = pr_t0; }
#define PSTAMP(id) do { if (PROBE_SEL) { const unsigned long long now_ = __builtin_amdgcn_s_memrealtime(); if ((id) == PROBE_SEL) pr_acc += now_ - pr_prev; pr_prev = now_; } } while (0)
    p0_prologue(P, F);
    if (RPT & 1) p0_prologue(P, F);
    xcd_barrier(bar);
    p0b_mod_reduce(P, F);
    xcd_barrier(bar);
    PSTAMP(1);

    for (int layer = 0; layer < DEPTH; ++layer) {
        const bool last = (layer == DEPTH - 1);
        unsigned char* ws = wsp(P);
        const int Mtok = last ? TLAT : TALL;
        phase_attn_norm(P, F, layer);
        if ((RPT & 256) && layer == 0) { phase_attn_norm(P, F, layer); phase_attn_norm(P, F, layer); phase_attn_norm(P, F, layer); }
        xcd_barrier(bar);
        PSTAMP(2);
        {
            pg8::PlainSched S; S.nN = QKVN / 256; S.nwg = (TALL / 256) * S.nN; S.G = F.G; S.c = F.vcu; S.K = DM; S.Bt = (const bf16_t*)(ws + WS_WQKV) + (size_t)layer * QKVN * DM;
            LAS f32x2* ropel = (LAS f32x2*)(F.lds + LDSX_OFF + 1024);
            stage_rope_table(P, F, ropel);
            pg8::EpiQKV E{(bf16_t*)(ws + WS_QKV), ws + WS_KF, ws + WS_VF, ropel, inp(P, IN_GQ), inp(P, IN_GK), layer % 3};
            pg8::gemm_phase(F.lds, (const bf16_t*)(ws + WS_H), DM, S, E);
            if (RPT & 2) pg8::gemm_phase(F.lds, (const bf16_t*)(ws + WS_H), DM, S, E);
        }
        xcd_barrier(bar);
        PSTAMP(3);
        phase_attention(P, F, layer);
        if (((RPT & 4) && layer == 1) || ((RPT & 8) && layer != 1)) phase_attention(P, F, layer);
        xcd_barrier(bar);
        PSTAMP(4);
        {
            pg8::PlainSched S; S.nN = DM / 256; S.nwg = (Mtok / 256) * S.nN; S.G = F.G; S.c = F.vcu; S.K = DM; S.Bt = (const bf16_t*)(ws + WS_WO) + (size_t)layer * DM * DM;
            pg8::EpiResidBf E{(bf16_t*)(ws + WS_X), (const float*)(ws + WS_MOD) + (size_t)layer * 17 * 6144 + 2048};
            pg8::gemm_phase(F.lds, (const bf16_t*)(ws + WS_O), DM, S, E);
        }
        xcd_barrier(bar);
        PSTAMP(5);
        phase_router(P, F, layer, Mtok);
        xcd_barrier(bar);
        PSTAMP(6);
        if (RPT & 128) { for (int xb = 0; xb < 9; ++xb) xcd_barrier(bar); }
        LAS unsigned* tab = (LAS unsigned*)(F.lds + LDSX_OFF + 8192);
        build_tile_table(P, F, tab, layer);
        {
            pg8::MoeSched<true> S; S.tab = tab; S.G = F.G; S.c = F.vcu; S.K = DM; S.Bt = (const bf16_t*)(ws + WS_WGU) + (size_t)layer * NEXP * DM * DM; S.estride = (size_t)DM * DM * 2; S.tok = (const unsigned*)(ws + WS_TOKE);
            pg8::EpiSwiglu E{(bf16_t*)(ws + WS_ACT)};
            pg8::gemm_phase(F.lds, (const bf16_t*)(ws + WS_H), DM, S, E);
            if (RPT & 32) pg8::gemm_phase(F.lds, (const bf16_t*)(ws + WS_H), DM, S, E);
        }
        xcd_barrier(bar);
        PSTAMP(8);
        {
            pg8::MoeSched<false> S; S.tab = tab; S.G = F.G; S.c = F.vcu; S.K = FH; S.Bt = (const bf16_t*)(ws + WS_WD) + (size_t)layer * NEXP * DM * FH; S.estride = (size_t)DM * FH * 2; S.tok = nullptr;
            pg8::EpiStore E{(bf16_t*)(ws + WS_Y), DM};
            pg8::gemm_phase(F.lds, (const bf16_t*)(ws + WS_ACT), FH, S, E);
            if (RPT & 64) pg8::gemm_phase(F.lds, (const bf16_t*)(ws + WS_ACT), FH, S, E);
        }
        xcd_barrier(bar);
        PSTAMP(9);
    }
    if (PROBE_SEL) {
        if (F.blk == 0 && F.tid == 0) { const unsigned long long tot = __builtin_amdgcn_s_memrealtime() - pr_t0;
            const float f = (PROBE_SEL == 15) ? 0.5f : (float)pr_acc / (float)tot;
            __hip_atomic_store((float*)(P.ws + WS_CTL) + 64, sqrtf(4e-4f * f), __ATOMIC_RELAXED, __HIP_MEMORY_SCOPE_AGENT); }
        xcd_barrier(bar);
    }
    phase_final(P, F);
    if (RPT & 512) { phase_final(P, F); phase_final(P, F); phase_final(P, F); }
}

extern "C" void kernel_launch(void* const* d_in, const int* in_sizes, int n_in, void* d_out, int out_size, void* d_ws, size_t ws_size, hipStream_t stream) {
    static int ok = 0;
    if (ok == 0) {
        if (n_in != 22 || in_sizes[0] != TLAT * DM || out_size != TLAT * DM || ws_size < WS_END) {
            fprintf(stderr, "kernel_launch: unexpected shapes (n_in %d, in0 %d, out %d, ws %zu < %zu); nothing launched\n", n_in, n_in > 0 ? in_sizes[0] : -1, out_size, ws_size, (size_t)WS_END); ok = -1; return; }
        int dev = 0, cus = 0, per_cu = 0;
        if (hipGetDevice(&dev) != hipSuccess || hipDeviceGetAttribute(&cus, hipDeviceAttributeMultiprocessorCount, dev) != hipSuccess) { ok = -1; return; }
        if (hipFuncSetAttribute((const void*)dit_fwd, hipFuncAttributeMaxDynamicSharedMemorySize, LDS_BYTES) != hipSuccess) { fprintf(stderr, "kernel_launch: hipFuncSetAttribute failed\n"); ok = -1; return; }
        if (hipOccupancyMaxActiveBlocksPerMultiprocessor(&per_cu, (const void*)dit_fwd, NTHREADS, LDS_BYTES) != hipSuccess || per_cu < 1) fprintf(stderr, "kernel_launch: note: occupancy query reports %d\n", per_cu);
        (void)hipGetLastError();
        if (cus < GRID) { fprintf(stderr, "kernel_launch: %d CUs < %d workgroups: grid would not be resident; nothing launched\n", cus, GRID); ok = -1; return; }
        ok = 1;
    }
    if (ok < 0) return;
    if (hipMemsetAsync((char*)d_ws + WS_CTL, 0, CTL_ZERO_BYTES, stream) != hipSuccess) return;
    Params p{};
    for (int i = 0; i < 22; ++i) p.in[i] = (const float*)d_in[i];
    p.out = (float*)d_out; p.ws = (unsigned char*)d_ws;
    hipLaunchKernelGGL(dit_fwd, dim3(GRID), dim3(NTHREADS), LDS_BYTES, stream, p);
}
```

```cpp
#include <hip/hip_runtime.h>
#include <cstdio>
#include <cstdint>

#ifndef PROBE_SEL
#define PROBE_SEL 0
#endif
#ifndef RPT
#define RPT 0
#endif

#define LAS __attribute__((address_space(3)))
#define GAS __attribute__((address_space(1)))
#define DI __device__ __forceinline__

typedef unsigned short bf16_t;
typedef short bf16x8 __attribute__((ext_vector_type(8)));
typedef short s16x4 __attribute__((ext_vector_type(4)));
typedef float f32x2 __attribute__((ext_vector_type(2)));
typedef float f32x4 __attribute__((ext_vector_type(4)));
typedef float f32x16 __attribute__((ext_vector_type(16)));
typedef unsigned u32x2 __attribute__((ext_vector_type(2)));
typedef unsigned u32x4 __attribute__((ext_vector_type(4)));
typedef int i32x4 __attribute__((ext_vector_type(4)));
typedef int i32x8 __attribute__((ext_vector_type(8)));

constexpr int NB = 16, SEQ = 2048, DM = 1024, DEPTH = 4, CTXL = 256, NH = 16, NKV = 4, HD = 64, QKVN = 1536;
constexpr int TLAT = NB * SEQ, TCTX = NB * CTXL, TALL = TLAT + TCTX;
constexpr int NEXP = 32, FH = 512;
constexpr int KEYS = SEQ + CTXL, KGRP = KEYS / 8;
constexpr int CAPR = 2 * TALL + NEXP * 256;
constexpr int NWAVES = 8, NTHREADS = 512, GRID = 256;
constexpr float NORM_EPS = 1e-6f, LOG2E = 1.4426950408889634f;

constexpr size_t MiB = 1u << 20;
constexpr size_t WS_CTL = 0, CTL_ZERO_BYTES = 1 * MiB;
constexpr size_t WS_MODP = 1 * MiB;
constexpr size_t WS_MOD = 15 * MiB;
constexpr size_t WS_ROPE = 17 * MiB;
constexpr size_t WS_WRT = 17 * MiB + 65536;
constexpr size_t WS_ASG = 18 * MiB;
constexpr size_t WS_ASGW = 18 * MiB + 512 * 1024;
constexpr size_t WS_TOKE = 1 * MiB;
constexpr size_t WS_WQKV = 21 * MiB;
constexpr size_t WS_WO = 33 * MiB;
constexpr size_t WS_WGU = 41 * MiB;
constexpr size_t WS_WD = 297 * MiB;
constexpr size_t WS_X = 425 * MiB;
constexpr size_t WS_H = 569 * MiB;
constexpr size_t WS_R1 = 641 * MiB;
constexpr size_t WS_QKV = WS_R1;
constexpr size_t WS_KF = WS_R1 + 108 * MiB;
constexpr size_t WS_VF = WS_R1 + 126 * MiB;
constexpr size_t WS_O = WS_R1 + 144 * MiB;
constexpr size_t WS_Y = WS_R1;
constexpr size_t WS_ACT = WS_R1 + 160 * MiB;
constexpr size_t WS_END = WS_R1 + 240 * MiB;
constexpr int CW_TMO = 0, CW_BAR = 4096, CW_CNT = 65536, CNT_STRIDE = 32;

constexpr int RING_BYTES = 131072;
constexpr int MISC_OFF = RING_BYTES + 320;
constexpr int LDSX_OFF = RING_BYTES + 1024;
constexpr int LDS_BYTES = 147456;

#define LDS_WAIT() asm volatile("s_waitcnt lgkmcnt(0)" ::: "memory")
#define VM_WAIT() asm volatile("s_waitcnt vmcnt(0)" ::: "memory")

DI unsigned f2bf(float f) { unsigned u = __float_as_uint(f); return (u + 0x7fffu + ((u >> 16) & 1u)) >> 16; }
DI float bf2f(unsigned b) { return __uint_as_float(b << 16); }
DI float bfs2f(short b) { return __uint_as_float(((unsigned)(unsigned short)b) << 16); }
DI unsigned cvt_pk_bf16(float lo, float hi);
DI unsigned pk2(float lo, float hi) { return cvt_pk_bf16(lo, hi); }
DI unsigned cvt_pk_bf16(float lo, float hi) { unsigned r; asm volatile("v_cvt_pk_bf16_f32 %0, %1, %2" : "=v"(r) : "v"(lo), "v"(hi)); return r; }
constexpr float F8_ACT_SCALE = 8.f, F8_W_SCALE = 64.f;
constexpr int F8_SC_ACT = 127 - 3, F8_SC_W = 127 - 6;
DI unsigned cvt_pk_fp8x4(float a, float b, float c, float d) {
    a = __builtin_amdgcn_fmed3f(a, -448.f, 448.f); b = __builtin_amdgcn_fmed3f(b, -448.f, 448.f); c = __builtin_amdgcn_fmed3f(c, -448.f, 448.f); d = __builtin_amdgcn_fmed3f(d, -448.f, 448.f);
    int r = __builtin_amdgcn_cvt_pk_fp8_f32(a, b, 0, false); r = __builtin_amdgcn_cvt_pk_fp8_f32(c, d, r, true); return (unsigned)r; }
DI float wave_sum(float v) {
#pragma unroll
    for (int o = 1; o < 64; o <<= 1) v += __shfl_xor(v, o);
    return v;
}
DI int crow(int r, int hi) { return (r & 3) + 8 * (r >> 2) + 4 * hi; }

#define XB_TMO      128
#define XB_XCNT(j)  (256  + 64 * (j))
#define XB_XSUB(j)  (1280 + 64 * (j))
#define XB_XGEN(j)  (2304 + 64 * (j))
#define XB_TOP      3328
#define XB_TOPGEN   3392
#define XCD_BAR_WORDS 3456
#define XB_SPIN_CAP (1u << 18)

__device__ __forceinline__ unsigned xb_ld(unsigned* p)              { return __hip_atomic_load(p, __ATOMIC_RELAXED, __HIP_MEMORY_SCOPE_AGENT); }
__device__ __forceinline__ unsigned xb_add(unsigned* p, unsigned v) { return __hip_atomic_fetch_add(p, v, __ATOMIC_RELAXED, __HIP_MEMORY_SCOPE_AGENT); }
__device__ __forceinline__ unsigned xb_xcc_id() { return (unsigned)__builtin_amdgcn_s_getreg((3 << 11) | 20) & 0xFu; }
#define XB_SPIN(cond, bar) do { unsigned _sp = 0; while (cond) { __builtin_amdgcn_s_sleep(1); \
    if ((++_sp & 255u) == 0u) { if (xb_ld(&(bar)[XB_TMO])) break; if (_sp > XB_SPIN_CAP) { atomicAdd(&(bar)[XB_TMO], 1u); break; } } } } while (0)

struct XcdBarrier { unsigned* bar; unsigned x; volatile LAS unsigned* st; };

__device__ __forceinline__ XcdBarrier xcd_barrier_post(unsigned* bar, volatile LAS unsigned* st) {
    XcdBarrier b; b.bar = bar; b.x = xb_xcc_id(); b.st = st;
    if (threadIdx.x == 0) (void)xb_add(&bar[XB_XCNT(b.x)], 1u);
    return b;
}
__device__ __forceinline__ void xcd_barrier_complete(unsigned* bar, unsigned x, unsigned& nloc, unsigned& nx) {
    const unsigned G = gridDim.x * gridDim.y * gridDim.z;
    unsigned sum, cnt, mine, sp = 0u;
    for (;;) {
        sum = 0u; cnt = 0u; mine = 0u;
#pragma unroll
        for (unsigned j = 0; j < 16; ++j) { const unsigned c = xb_ld(&bar[XB_XCNT(j)]); sum += c; cnt += (c > 0u) ? 1u : 0u; mine = (j == x) ? c : mine; }
        if (sum == G) break;
        __builtin_amdgcn_s_sleep(1);
        if ((++sp & 255u) == 0u) { if (xb_ld(&bar[XB_TMO])) break; if (sp > XB_SPIN_CAP) { atomicAdd(&bar[XB_TMO], 1u); break; } }
    }
    nloc = mine > 0u ? mine : 1u; nx = cnt > 0u ? cnt : 1u;
}
__device__ __forceinline__ void xcd_barrier(const XcdBarrier& b0) {
    XcdBarrier b = b0;
    { unsigned z = 0, bx = __builtin_amdgcn_readfirstlane(b0.x); asm volatile("s_mov_b32 %0, 0" : "=s"(z)); asm volatile("" : "+s"(bx)); b.bar = b0.bar + z; b.x = bx; }
    asm volatile("s_waitcnt vmcnt(0)" ::: "memory");
    __syncthreads();
    if (threadIdx.x == 0) {
        unsigned* bar = b.bar;
        __builtin_amdgcn_s_waitcnt(0);
        unsigned nloc = b.st[0], nx = b.st[1];
        if (nloc == 0u) { xcd_barrier_complete(bar, b.x, nloc, nx); b.st[0] = nloc; b.st[1] = nx; }
        const unsigned old = xb_add(&bar[XB_XSUB(b.x)], 1u);
        const unsigned gen = old / nloc;
        if (old + 1u == (gen + 1u) * nloc) {
            __builtin_amdgcn_fence(__ATOMIC_RELEASE, "agent");
            asm volatile("s_waitcnt vmcnt(0)" ::: "memory");
            const unsigned og = xb_add(&bar[XB_TOP], 1u);
            const unsigned tg = og / nx;
            if (og + 1u == (tg + 1u) * nx) xb_add(&bar[XB_TOPGEN], 1u);
            else XB_SPIN(xb_ld(&bar[XB_TOPGEN]) == tg, bar);
            __builtin_amdgcn_fence(__ATOMIC_ACQUIRE, "agent");
            xb_add(&bar[XB_XGEN(b.x)], 1u);
            asm volatile("s_waitcnt vmcnt(0)" ::: "memory");
        } else {
            XB_SPIN(xb_ld(&bar[XB_XGEN(b.x)]) == gen, bar);
            __builtin_amdgcn_fence(__ATOMIC_ACQUIRE, "agent");
            asm volatile("s_waitcnt vmcnt(0)" ::: "memory");
        }
    }
    __syncthreads();
}

namespace pg8 {
constexpr int BM = 256, BK = 64, HALF = 128, HTB = HALF * BK * 2, STAGE_BYTES = 8 * HTB;
DI int lds_byte(int r, int c) { const int st = (r >> 4) * 2 + (c >> 5), rr = r & 15, cc = c & 31, ob = rr * 64 + cc * 2; return st * 1024 + (ob ^ (((ob >> 9) & 1) << 5)); }
DI void stage_rc(int b, int& R, int& C) { const int st = b / 1024, sb = b % 1024, swz = sb ^ (((sb >> 9) & 1) << 5); R = (st >> 1) * 16 + swz / 64; C = (st & 1) * 32 + (swz % 64) / 2; }
DI int perm32(int rho) { const int n = rho >> 4, i = rho & 15; return 8 * (i >> 2) + 4 * n + (i & 3); }
struct Unit { int pm, pn, e, r0, na; };

DI void mfma_f8_acc(f32x4& c, const i32x8& w, const i32x8& a, int sw, int sa) {
    asm volatile("v_mfma_scale_f32_16x16x128_f8f6f4 %0, %1, %2, %0, %3, %4 op_sel_hi:[0,0,0]" : "+v"(c) : "v"(w), "v"(a), "v"(sw), "v"(sa));
}
template <class Epi, class Sched>
DI void gemm_phase(LAS unsigned char* lds, const bf16_t* A, const int K, const Sched& S, const Epi& E) {
    int tid_ = threadIdx.x; asm volatile("" : "+v"(tid_));
    const int tid = tid_, wid = __builtin_amdgcn_readfirstlane(tid >> 6), lane = tid & 63, wr = wid >> 2, wc = wid & 3, fr = lane & 15, fq = lane >> 4;
    int nt_ = K / BK; asm volatile("" : "+s"(nt_));
    const int nt = nt_;
    constexpr bool GA = Sched::GATHER, F8 = Sched::FP8;
    int f8sw = F8_SC_W, f8sa = F8_SC_ACT; asm volatile("" : "+v"(f8sw), "+v"(f8sa));
    int Rr[2], Cc[2]; unsigned voffB[2], voffA[2];
#pragma unroll
    for (int i = 0; i < 2; ++i) { int R, C; stage_rc(tid * 16 + i * 8192, R, C); const int Rb = Epi::PERM ? ((R & ~31) + perm32(R & 31)) : R;
        Rr[i] = R; Cc[i] = C; voffB[i] = (unsigned)(Rb * K + C) * 2u; voffA[i] = (unsigned)(R * K + C) * 2u; }
    const size_t kstep = (size_t)(BK * 2);
    const size_t hstep = (size_t)HALF * K * 2;
    const unsigned ldsw = (unsigned)wid * 1024u;
    const int aoff = lds_byte(wr * 64 + fr, fq * 8), boff = lds_byte(wc * 32 + fr, fq * 8);
#define PG8_SA(b, h) (((b) * 2 + (h)) * HTB)
#define PG8_SB(b, h) ((4 + (b) * 2 + (h)) * HTB)
#define PG8_STAGE(bufoff, gbase, voff) do { _Pragma("unroll") for (int _i = 0; _i < 2; ++_i) \
        __builtin_amdgcn_global_load_lds((const unsigned*)((const char*)(gbase) + (voff)[_i]), (LAS unsigned*)(lds + (bufoff) + ldsw + _i * 8192), 16, 0, 0); } while (0)
#define PG8_LDA(dst, b, h) do { _Pragma("unroll") for (int m = 0; m < 4; ++m) _Pragma("unroll") for (int k = 0; k < 2; ++k) dst[m][k] = *(const LAS bf16x8*)(lds + PG8_SA(b, h) + aoff + m * 2048 + k * 1024); } while (0)
#define PG8_LDB(dst, b, h) do { _Pragma("unroll") for (int n = 0; n < 2; ++n) _Pragma("unroll") for (int k = 0; k < 2; ++k) dst[n][k] = *(const LAS bf16x8*)(lds + PG8_SB(b, h) + boff + n * 2048 + k * 1024); } while (0)
#define PG8_CAT8(x0, x1) __builtin_shufflevector(__builtin_bit_cast(i32x4, x0), __builtin_bit_cast(i32x4, x1), 0, 1, 2, 3, 4, 5, 6, 7)
#define PG8_MMA(ai, bj, At, Bt) do { __builtin_amdgcn_s_setprio(1); \
        if (F8) { _Pragma("unroll") for (int m = 0; m < 4; ++m) _Pragma("unroll") for (int n = 0; n < 2; ++n) \
            mfma_f8_acc(acc[ai][bj][m][n], PG8_CAT8(Bt[n][0], Bt[n][1]), PG8_CAT8(At[m][0], At[m][1]), f8sw, f8sa); } \
        else { _Pragma("unroll") for (int m = 0; m < 4; ++m) _Pragma("unroll") for (int n = 0; n < 2; ++n) _Pragma("unroll") for (int k = 0; k < 2; ++k) \
            acc[ai][bj][m][n] = __builtin_amdgcn_mfma_f32_16x16x32_bf16(Bt[n][k], At[m][k], acc[ai][bj][m][n], 0, 0, 0); } \
        __builtin_amdgcn_s_setprio(0); } while (0)
#define PG8_WAIT_V(n) asm volatile("s_waitcnt vmcnt(" #n ")" ::: "memory")
#define PG8_WAIT_L(n) asm volatile("s_waitcnt lgkmcnt(" #n ")" ::: "memory")
#define PG8_BAR __builtin_amdgcn_s_barrier()
#define PG8_SCHED __builtin_amdgcn_sched_barrier(0)
    Unit cur, nxt; int ui = 0;
    if (!S.next(0, cur)) return;
    f32x4 acc[2][2][4][2];
#pragma unroll
    for (int a = 0; a < 2; ++a)
#pragma unroll
        for (int b = 0; b < 2; ++b)
#pragma unroll
            for (int m = 0; m < 4; ++m)
#pragma unroll
                for (int n = 0; n < 2; ++n) acc[a][b][m][n] = (f32x4){0.f, 0.f, 0.f, 0.f};
    bf16x8 At[4][2], B0[2][2], B1[2][2];
    unsigned oc0[2], oc1[2], on0[2], on1[2];
#pragma unroll
    for (int i = 0; i < 2; ++i) { if (GA) { oc0[i] = S.a_off(cur, Rr[i]) + (unsigned)Cc[i] * 2u; oc1[i] = S.a_off(cur, HALF + Rr[i]) + (unsigned)Cc[i] * 2u; } else { oc0[i] = voffA[i]; oc1[i] = voffA[i]; } on0[i] = oc0[i]; on1[i] = oc1[i]; }
    size_t hA = (GA || (Sched::HALVES && cur.na == 1)) ? (size_t)0 : hstep, hAn = hA;
    const char* Ab = GA ? (const char*)A : (const char*)A + (size_t)cur.r0 * K * 2;
    const char* cB = S.b_ptr(cur);
    PG8_STAGE(PG8_SB(0, 0), cB, voffB); PG8_STAGE(PG8_SB(0, 1), cB + hstep, voffB); PG8_STAGE(PG8_SA(0, 0), Ab, oc0); PG8_STAGE(PG8_SA(0, 1), Ab + hA, oc1);
    if (wr == 1) PG8_BAR;
    PG8_WAIT_V(2); PG8_BAR;
    PG8_STAGE(PG8_SB(1, 0), cB + kstep, voffB); PG8_STAGE(PG8_SA(1, 0), Ab + kstep, oc0); PG8_STAGE(PG8_SB(1, 1), cB + hstep + kstep, voffB);
    PG8_WAIT_V(6); PG8_BAR;
    for (;;) {
        const bool has_next = S.next(ui + 1, nxt);
        const char* nB = has_next ? S.b_ptr(nxt) : cB;
        const char* nA = GA ? Ab : (has_next ? (const char*)A + (size_t)nxt.r0 * K * 2 : Ab);
        if (!GA && Sched::HALVES) hAn = (has_next && nxt.na == 1) ? (size_t)0 : (has_next ? hstep : hA);
        if (GA) {
            if (has_next) {
#pragma unroll
                for (int i = 0; i < 2; ++i) { on0[i] = S.a_off(nxt, Rr[i]) + (unsigned)Cc[i] * 2u; on1[i] = S.a_off(nxt, HALF + Rr[i]) + (unsigned)Cc[i] * 2u; }
            } else {
#pragma unroll
                for (int i = 0; i < 2; ++i) { on0[i] = oc0[i]; on1[i] = oc1[i]; }
            }
        }
#define PG8_KLOOP(FULL) \
        for (int t = 0; t < nt; t += 2) { \
            const bool last = (t == nt - 2); \
            const char* a1 = Ab + (size_t)(t + 1) * kstep + hA; \
            const char* a2 = last ? nA : Ab + (size_t)(t + 2) * kstep; const char* b2 = last ? nB : cB + (size_t)(t + 2) * kstep; \
            const char* a3 = a2 + kstep; const char* b3 = b2 + kstep; const size_t hA2 = last ? hAn : hA; \
            unsigned o20[2], o21[2]; \
            for (int i = 0; i < 2; ++i) { if (GA) { o20[i] = last ? on0[i] : oc0[i]; o21[i] = last ? on1[i] : oc1[i]; } else { o20[i] = voffA[i]; o21[i] = voffA[i]; } } \
              \
            PG8_LDB(B0, 0, 0); PG8_LDB(B1, 0, 1); PG8_SCHED; PG8_LDA(At, 0, 0); PG8_STAGE(PG8_SA(1, 1), a1, oc1); \
            PG8_WAIT_V(8); PG8_WAIT_L(0); PG8_BAR; PG8_MMA(0, 0, At, B0); PG8_MMA(0, 1, At, B1); PG8_BAR; PG8_SCHED; \
              \
            if (FULL) { PG8_LDA(At, 0, 1); } PG8_STAGE(PG8_SB(0, 0), b2, voffB); PG8_STAGE(PG8_SB(0, 1), b2 + hstep, voffB); PG8_STAGE(PG8_SA(0, 0), a2, o20); \
            PG8_WAIT_V(8); PG8_WAIT_L(0); PG8_BAR; if (FULL) { PG8_MMA(1, 0, At, B0); PG8_MMA(1, 1, At, B1); } PG8_BAR; PG8_SCHED; \
              \
            PG8_LDB(B0, 1, 0); PG8_LDB(B1, 1, 1); PG8_SCHED; PG8_LDA(At, 1, 0); PG8_STAGE(PG8_SA(0, 1), a2 + hA2, o21); \
            PG8_WAIT_V(8); PG8_WAIT_L(0); PG8_BAR; PG8_MMA(0, 0, At, B0); PG8_MMA(0, 1, At, B1); PG8_BAR; PG8_SCHED; \
              \
            if (FULL) { PG8_LDA(At, 1, 1); } PG8_STAGE(PG8_SB(1, 0), b3, voffB); PG8_STAGE(PG8_SB(1, 1), b3 + hstep, voffB); PG8_STAGE(PG8_SA(1, 0), a3, o20); \
            PG8_WAIT_V(8); PG8_WAIT_L(0); PG8_BAR; if (FULL) { PG8_MMA(1, 0, At, B0); PG8_MMA(1, 1, At, B1); } PG8_BAR; PG8_SCHED; \
        }
        if (Sched::HALVES && cur.na == 1) { PG8_KLOOP(0) } else { PG8_KLOOP(1) }
#undef PG8_KLOOP
        if (wr == 0) PG8_BAR;
        if (F8) asm volatile("s_nop 15\n\ts_nop 15" ::: "memory");
        E(acc, cur, wr, wc, fr, fq);
        if (!has_next) break;
#pragma unroll
        for (int a = 0; a < 2; ++a)
#pragma unroll
            for (int b = 0; b < 2; ++b)
#pragma unroll
                for (int m = 0; m < 4; ++m)
#pragma unroll
                    for (int n = 0; n < 2; ++n) acc[a][b][m][n] = (f32x4){0.f, 0.f, 0.f, 0.f};
        cur = nxt; cB = nB; Ab = nA; hA = hAn; ++ui;
        if (GA) {
#pragma unroll
            for (int i = 0; i < 2; ++i) { oc0[i] = on0[i]; oc1[i] = on1[i]; }
        }
        if (wr == 1) PG8_BAR;
    }
    PG8_WAIT_V(0);
    PG8_BAR;
#undef PG8_SA
#undef PG8_SB
#undef PG8_STAGE
#undef PG8_LDA
#undef PG8_LDB
#undef PG8_MMA
#undef PG8_CAT8
#undef PG8_WAIT_V
#undef PG8_WAIT_L
#undef PG8_BAR
#undef PG8_SCHED
}

struct PlainSched {
    static constexpr bool GATHER = false, HALVES = true, FP8 = false;
    int nN, nwg, G, c, K; const bf16_t* Bt;
    DI bool next(int i, Unit& u) const { const int L = i * G + c; const int nfull = (nwg / G) * G, rem = nwg - nfull; int Lu = L, hf = 0; u.na = 2;
        if (L >= nfull) { if (2 * rem <= G) { const int h = L - nfull; if (h >= 2 * rem) return false; Lu = nfull + (h >> 1); hf = h & 1; u.na = 1; } else if (L >= nwg) return false; }
        u.pm = Lu / nN; u.pn = Lu - u.pm * nN; u.e = 0; u.r0 = u.pm * BM + hf * HALF; return true; }
    DI unsigned a_off(const Unit& u, int r) const { return (unsigned)(u.r0 + r) * (unsigned)(K * 2); }
    DI const char* b_ptr(const Unit& u) const { return (const char*)Bt + (size_t)u.pn * BM * K * 2; }
};
template <bool GATHER_> struct MoeSched {
    static constexpr bool GATHER = GATHER_, HALVES = true, FP8 = true;
    static constexpr int TAB_PST = 384, TAB_CNT = 416;
    const LAS unsigned* tab; int G, c, K; const bf16_t* Bt; size_t estride; const unsigned* tok;
    DI bool next(int i, Unit& u) const { const int L = i * G + c; const int nwg = (int)tab[0] * 4, nfull = (nwg / G) * G, rem = nwg - nfull; int Lu = L, hf = 0; u.na = 2;
        if (L >= nfull) { if (2 * rem <= G) { const int h = L - nfull; if (h >= 2 * rem) return false; Lu = nfull + (h >> 1); hf = h & 1; u.na = 1; } else if (L >= nwg) return false; }
        u.pm = Lu >> 2; u.pn = Lu & 3; u.e = (int)tab[1 + u.pm]; u.r0 = u.pm * BM + hf * HALF; return true; }
    DI unsigned a_off(const Unit& u, int r) const {
        unsigned row = (unsigned)(u.r0 + (u.na == 1 ? (r & (HALF - 1)) : r));
        if (GATHER_) { const unsigned last = tab[TAB_CNT + u.e] - 1u; unsigned idx = row - tab[TAB_PST + u.e]; idx = idx < last ? idx : last; row = tok[(unsigned)u.e * (unsigned)TALL + idx]; }
        return row * (unsigned)(K * 2); }
    DI const char* b_ptr(const Unit& u) const { return (const char*)Bt + (size_t)u.e * estride + (size_t)u.pn * BM * K * 2; }
};

struct EpiStore {
    static constexpr bool PERM = true;
    bf16_t* O; int ldc;
    DI void operator()(const f32x4 (&acc)[2][2][4][2], const Unit& u, int wr, int wc, int fr, int fq) const {
        const int row0 = u.r0 + wr * 64 + fr, col0 = u.pn * BM + wc * 32 + 8 * fq;
#pragma unroll
        for (int ai = 0; ai < 2; ++ai) if (ai < u.na)
#pragma unroll
            for (int m = 0; m < 4; ++m) { bf16_t* rowp = O + (size_t)(row0 + ai * HALF + m * 16) * ldc + col0;
#pragma unroll
                for (int bj = 0; bj < 2; ++bj) { const f32x4 v0 = acc[ai][bj][m][0], v1 = acc[ai][bj][m][1];
                    u32x4 w; w.x = cvt_pk_bf16(v0[0], v0[1]); w.y = cvt_pk_bf16(v0[2], v0[3]); w.z = cvt_pk_bf16(v1[0], v1[1]); w.w = cvt_pk_bf16(v1[2], v1[3]);
                    *(u32x4*)(rowp + bj * HALF) = w; } }
    }
};
struct EpiQKV {
    static constexpr bool PERM = false;
    bf16_t* QKV; unsigned char* KF; unsigned char* VF; const f32x2* T; const float* gq; const float* gk; int m;
    DI void operator()(const f32x4 (&acc)[2][2][4][2], const Unit& u, int wr, int wc, int fr, int fq) const {
        const bool lat = u.pm < TLAT / BM; const int b = lat ? (u.pm >> 3) : (u.pm - TLAT / BM);
        const int trow0 = u.r0 + wr * 64 + fr;
        if (u.pn < 4) {
            const int h = 4 * u.pn + wc;
            f32x4 g[2][2];
#pragma unroll
            for (int bj = 0; bj < 2; ++bj)
#pragma unroll
                for (int n = 0; n < 2; ++n) g[bj][n] = (m == 1) ? *(const f32x4*)(gq + 32 * bj + 16 * n + 4 * fq) : (f32x4){1.f, 1.f, 1.f, 1.f};
#pragma unroll
            for (int ai = 0; ai < 2; ++ai) if (ai < u.na)
#pragma unroll
                for (int mm = 0; mm < 4; ++mm) {
                    f32x4 x[2][2]; float ss = 0.f;
#pragma unroll
                    for (int bj = 0; bj < 2; ++bj)
#pragma unroll
                        for (int n = 0; n < 2; ++n) { x[bj][n] = acc[ai][bj][mm][n]; ss += (x[bj][n][0] * x[bj][n][0] + x[bj][n][1] * x[bj][n][1]) + (x[bj][n][2] * x[bj][n][2] + x[bj][n][3] * x[bj][n][3]); }
                    float sc = 0.125f * LOG2E;
                    if (m == 1) { ss += __shfl_xor(ss, 16); ss += __shfl_xor(ss, 32); sc *= 1.0f / sqrtf(ss * (1.f / HD) + NORM_EPS); }
                    bf16_t* qrow = QKV + (size_t)(trow0 + ai * HALF + mm * 16) * QKVN + h * HD + 4 * fq;
#pragma unroll
                    for (int bj = 0; bj < 2; ++bj)
#pragma unroll
                        for (int n = 0; n < 2; ++n) { const f32x4 y = x[bj][n] * g[bj][n] * sc; u32x2 w; w.x = cvt_pk_bf16(y[0], y[1]); w.y = cvt_pk_bf16(y[2], y[3]); *(u32x2*)(qrow + 32 * bj + 16 * n) = w; }
                }
        } else if (u.pn == 4) {
            f32x4 g[2][2];
#pragma unroll
            for (int bj = 0; bj < 2; ++bj)
#pragma unroll
                for (int n = 0; n < 2; ++n) g[bj][n] = (m == 1) ? *(const f32x4*)(gk + 32 * bj + 16 * n + 4 * fq) : (f32x4){1.f, 1.f, 1.f, 1.f};
            const bool rope = lat && (m != 2);
            unsigned char* kbase = KF + (size_t)(b * NKV + wc) * KGRP * 1024 + (fq >> 1) * 128 + (fq & 1) * 8;
#pragma unroll
            for (int ai = 0; ai < 2; ++ai) if (ai < u.na)
#pragma unroll
                for (int mm = 0; mm < 4; ++mm) {
                    const int t = trow0 + ai * HALF + mm * 16;
                    const int kidx = lat ? (t & 2047) : (2048 + ((t - TLAT) & 255));
                    f32x4 x[2][2]; float ss = 0.f;
#pragma unroll
                    for (int bj = 0; bj < 2; ++bj)
#pragma unroll
                        for (int n = 0; n < 2; ++n) { x[bj][n] = acc[ai][bj][mm][n]; ss += (x[bj][n][0] * x[bj][n][0] + x[bj][n][1] * x[bj][n][1]) + (x[bj][n][2] * x[bj][n][2] + x[bj][n][3] * x[bj][n][3]); }
                    if (m == 1) { ss += __shfl_xor(ss, 16); ss += __shfl_xor(ss, 32); const float rs = 1.0f / sqrtf(ss * (1.f / HD) + NORM_EPS);
#pragma unroll
                        for (int bj = 0; bj < 2; ++bj)
#pragma unroll
                            for (int n = 0; n < 2; ++n) x[bj][n] = x[bj][n] * g[bj][n] * rs; }
                    if (rope) {
#pragma unroll
                        for (int bj = 0; bj < 2; ++bj) { const int pos = bj ? (kidx & 63) : (kidx >> 6); const f32x4* tp = (const f32x4*)(T + pos * 16 + 4 * fq);
                            const f32x4 t0 = tp[0], t1 = tp[1];
                            const f32x4 cs = (f32x4){t0[0], t0[2], t1[0], t1[2]}, sn = (f32x4){t0[1], t0[3], t1[1], t1[3]};
                            const f32x4 a = x[bj][0], c = x[bj][1];
                            x[bj][0] = a * cs - c * sn; x[bj][1] = c * cs + a * sn; }
                    }
                    unsigned char* kp = kbase + (size_t)(kidx >> 3) * 1024 + (kidx & 7) * 16;
#pragma unroll
                    for (int bj = 0; bj < 2; ++bj)
#pragma unroll
                        for (int n = 0; n < 2; ++n) { u32x2 w; w.x = cvt_pk_bf16(x[bj][n][0], x[bj][n][1]); w.y = cvt_pk_bf16(x[bj][n][2], x[bj][n][3]); *(u32x2*)(kp + (4 * bj + 2 * n) * 128) = w; }
                }
        } else {
            const int q4 = fr & 3;
            unsigned char* vbase = VF + (size_t)(b * NKV + wc) * KGRP * 1024 + (4 * fq + q4) * 16;
#pragma unroll
            for (int ai = 0; ai < 2; ++ai) if (ai < u.na)
#pragma unroll
                for (int mm = 0; mm < 4; ++mm) {
                    const int t = trow0 + ai * HALF + mm * 16;
                    const int kidx = lat ? (t & 2047) : (2048 + ((t - TLAT) & 255));
                    unsigned char* vp = vbase + (size_t)(kidx >> 3) * 1024 + (kidx & 4) * 2;
#pragma unroll
                    for (int bj = 0; bj < 2; ++bj)
#pragma unroll
                        for (int n = 0; n < 2; ++n) {
                            f32x4 x = acc[ai][bj][mm][n];
                            { const float s0 = (q4 & 1) ? x[0] : x[1], s1 = (q4 & 1) ? x[2] : x[3]; const float r0 = __shfl_xor(s0, 1), r1 = __shfl_xor(s1, 1);
                              if (q4 & 1) { x[0] = r0; x[2] = r1; } else { x[1] = r0; x[3] = r1; } }
                            { const float s0 = (q4 & 2) ? x[0] : x[2], s1 = (q4 & 2) ? x[1] : x[3]; const float r0 = __shfl_xor(s0, 2), r1 = __shfl_xor(s1, 2);
                              if (q4 & 2) { x[0] = r0; x[1] = r1; } else { x[2] = r0; x[3] = r1; } }
                            u32x2 w; w.x = cvt_pk_bf16(x[0], x[1]); w.y = cvt_pk_bf16(x[2], x[3]);
                            *(u32x2*)(vp + (32 * bj + 16 * n) * 16) = w; }
                }
        }
    }
};
DI float silu_mul(float g, float u) { return g * __builtin_amdgcn_rcpf(1.f + __builtin_amdgcn_exp2f(-g * LOG2E)) * u; }
struct EpiResidBf {
    static constexpr bool PERM = true;
    bf16_t* X; const float* gate;
    DI void operator()(const f32x4 (&acc)[2][2][4][2], const Unit& u, int wr, int wc, int fr, int fq) const {
        const int mb = (u.pm < TLAT / BM) ? (u.pm >> 3) : 16;
        const float* gt = gate + (size_t)mb * 6144;
        const int row0 = u.r0 + wr * 64 + fr, col0 = u.pn * BM + wc * 32 + 8 * fq;
        f32x4 g[2][2];
#pragma unroll
        for (int bj = 0; bj < 2; ++bj)
#pragma unroll
            for (int n = 0; n < 2; ++n) g[bj][n] = *(const f32x4*)(gt + col0 + bj * HALF + 4 * n);
#pragma unroll
        for (int ai = 0; ai < 2; ++ai) if (ai < u.na) {
            u32x4 old[4][2];
#pragma unroll
            for (int m = 0; m < 4; ++m)
#pragma unroll
                for (int bj = 0; bj < 2; ++bj) old[m][bj] = *(const u32x4*)(X + (size_t)(row0 + ai * HALF + m * 16) * DM + col0 + bj * HALF);
#pragma unroll
            for (int m = 0; m < 4; ++m)
#pragma unroll
                for (int bj = 0; bj < 2; ++bj) { const u32x4 o = old[m][bj]; const f32x4 a0 = acc[ai][bj][m][0] * g[bj][0], a1 = acc[ai][bj][m][1] * g[bj][1];
                    u32x4 w; w.x = cvt_pk_bf16(bf2f(o.x & 0xffffu) + a0[0], bf2f(o.x >> 16) + a0[1]); w.y = cvt_pk_bf16(bf2f(o.y & 0xffffu) + a0[2], bf2f(o.y >> 16) + a0[3]);
                    w.z = cvt_pk_bf16(bf2f(o.z & 0xffffu) + a1[0], bf2f(o.z >> 16) + a1[1]); w.w = cvt_pk_bf16(bf2f(o.w & 0xffffu) + a1[2], bf2f(o.w >> 16) + a1[3]);
                    *(u32x4*)(X + (size_t)(row0 + ai * HALF + m * 16) * DM + col0 + bj * HALF) = w; }
        }
    }
};
struct EpiSwiglu {
    static constexpr bool PERM = true;
    unsigned char* ACT;
    DI void operator()(const f32x4 (&acc)[2][2][4][2], const Unit& u, int wr, int wc, int fr, int fq) const {
        const int row0 = u.r0 + wr * 64 + fr, col0 = u.pn * HALF + wc * 32 + 8 * fq;
#pragma unroll
        for (int ai = 0; ai < 2; ++ai) if (ai < u.na)
#pragma unroll
            for (int m = 0; m < 4; ++m) { unsigned char* rowp = ACT + (size_t)(row0 + ai * HALF + m * 16) * FH + col0;
                const f32x4 g0 = acc[ai][0][m][0], g1 = acc[ai][0][m][1], u0 = acc[ai][1][m][0] * F8_ACT_SCALE, u1 = acc[ai][1][m][1] * F8_ACT_SCALE;
                u32x2 w; w.x = cvt_pk_fp8x4(silu_mul(g0[0], u0[0]), silu_mul(g0[1], u0[1]), silu_mul(g0[2], u0[2]), silu_mul(g0[3], u0[3]));
                w.y = cvt_pk_fp8x4(silu_mul(g1[0], u1[0]), silu_mul(g1[1], u1[1]), silu_mul(g1[2], u1[2]), silu_mul(g1[3], u1[3]));
                *(u32x2*)rowp = w; }
    }
};
}

struct Params { const float* in[22]; float* out; unsigned char* ws; };
enum { IN_X = 0, IN_C, IN_CTX, IN_CCTX, IN_WADA, IN_BADA, IN_GATTN, IN_WQKV, IN_WO, IN_SINK, IN_GQ, IN_GK, IN_RPB, IN_GFFN, IN_WGROUP, IN_BGROUP, IN_WROUTER, IN_BROUTER, IN_WGATE, IN_WUP, IN_WDOWN, IN_GFINAL };

DI const float* inp(const Params& P, int i) { i = __builtin_amdgcn_readfirstlane(i); asm volatile("" : "+s"(i)); return P.in[i]; }
DI unsigned char* wsp(const Params& P) { unsigned z = 0; asm volatile("s_mov_b32 %0, 0" : "=s"(z)); return P.ws + z; }
struct Frame { LAS unsigned char* lds; int tid, lane, wave, blk, G, vcu, gw, NGW; };
DI Frame opaque_frame(const Frame& F0) { Frame F = F0; asm volatile("" : "+v"(F.tid), "+v"(F.lane)); asm volatile("" : "+s"(F.wave), "+s"(F.blk), "+s"(F.vcu), "+s"(F.gw)); return F; }

DI void p0_transpose_item(const float* W, int N, int k0, int n0, bf16_t* dst, int Kd, LAS float* scr, int lane) {
#pragma unroll 8
    for (int i = 0; i < 32; ++i) { const int kk = 2 * i + (lane >> 5); scr[kk * 33 + (lane & 31)] = W[(size_t)(k0 + kk) * N + n0 + (lane & 31)]; }
    LDS_WAIT();
    const int c = lane & 7;
#pragma unroll
    for (int j = 0; j < 4; ++j) { const int n = (lane >> 3) + 8 * j; const LAS float* s = scr + (8 * c) * 33 + n;
        u32x4 o; o.x = pk2(s[0 * 33], s[1 * 33]); o.y = pk2(s[2 * 33], s[3 * 33]); o.z = pk2(s[4 * 33], s[5 * 33]); o.w = pk2(s[6 * 33], s[7 * 33]);
        *(u32x4*)(dst + (size_t)n * Kd + 8 * c) = o; }
    LDS_WAIT();
}
DI void p0_transpose_item_f8(const float* W, int N, int k0, int n0, unsigned char* dst, int Kd, LAS float* scr, int lane) {
#pragma unroll 8
    for (int i = 0; i < 32; ++i) { const int kk = 2 * i + (lane >> 5); scr[kk * 33 + (lane & 31)] = W[(size_t)(k0 + kk) * N + n0 + (lane & 31)]; }
    LDS_WAIT();
    const int c = lane & 7;
#pragma unroll
    for (int j = 0; j < 4; ++j) { const int n = (lane >> 3) + 8 * j; const LAS float* s = scr + (8 * c) * 33 + n;
        u32x2 o; o.x = cvt_pk_fp8x4(s[0 * 33] * F8_W_SCALE, s[1 * 33] * F8_W_SCALE, s[2 * 33] * F8_W_SCALE, s[3 * 33] * F8_W_SCALE);
        o.y = cvt_pk_fp8x4(s[4 * 33] * F8_W_SCALE, s[5 * 33] * F8_W_SCALE, s[6 * 33] * F8_W_SCALE, s[7 * 33] * F8_W_SCALE);
        *(u32x2*)(dst + (size_t)n * Kd + 8 * c) = o; }
    LDS_WAIT();
}
DI double dsin_poly(double r) { const double r2 = r * r;
    return r * (1.0 - r2 * (1.0 / 6.0) * (1.0 - r2 * (1.0 / 20.0) * (1.0 - r2 * (1.0 / 42.0) * (1.0 - r2 * (1.0 / 72.0) * (1.0 - r2 * (1.0 / 110.0) * (1.0 - r2 * (1.0 / 156.0) * (1.0 - r2 * (1.0 / 210.0) * (1.0 - r2 * (1.0 / 272.0) * (1.0 - r2 * (1.0 / 342.0) * (1.0 - r2 * (1.0 / 420.0) * (1.0 - r2 * (1.0 / 506.0)))))))))))); }
DI double dcos_poly(double r) { const double r2 = r * r;
    return 1.0 - r2 * (1.0 / 2.0) * (1.0 - r2 * (1.0 / 12.0) * (1.0 - r2 * (1.0 / 30.0) * (1.0 - r2 * (1.0 / 56.0) * (1.0 - r2 * (1.0 / 90.0) * (1.0 - r2 * (1.0 / 132.0) * (1.0 - r2 * (1.0 / 182.0) * (1.0 - r2 * (1.0 / 240.0) * (1.0 - r2 * (1.0 / 306.0) * (1.0 - r2 * (1.0 / 380.0) * (1.0 - r2 * (1.0 / 462.0) * (1.0 - r2 * (1.0 / 552.0)))))))))))); }

constexpr int IT_MOD = DEPTH * 96 * 8;
constexpr int IT_QKV = (DM / 64) * (QKVN / 32), IT_WO = (DM / 64) * (DM / 32), IT_GU = NEXP * (DM / 64) * (FH / 32), IT_DN = NEXP * (FH / 64) * (DM / 32);
constexpr int IT_LAYER = IT_QKV + IT_WO + 2 * IT_GU + IT_DN;
constexpr int IT_TOTAL = IT_MOD + DEPTH * IT_LAYER;

DI void p0_prologue(const Params& P, const Frame& F) {
    LAS float* scr = (LAS float*)(F.lds + F.wave * 16384);
    unsigned char* ws = wsp(P);
    for (int it = F.gw; it < IT_TOTAL; it += F.NGW) {
        if (it < IT_MOD) {
            const int l = it / (96 * 8), rem = it % (96 * 8), cc = rem >> 3, ks = rem & 7;
            for (int idx = F.lane; idx < 17 * 128; idx += 64) { const int b = idx >> 7, k = idx & 127;
                const float cv = (b < 16) ? inp(P, IN_C)[b * DM + ks * 128 + k] : inp(P, IN_CCTX)[ks * 128 + k];
                scr[idx] = cv / (1.f + expf(-cv)); }
            LDS_WAIT();
            float acc[17];
#pragma unroll
            for (int b = 0; b < 17; ++b) acc[b] = 0.f;
            const float* wp = inp(P, IN_WADA) + ((size_t)l * DM + ks * 128) * 6144 + cc * 64 + F.lane;
#pragma unroll 4
            for (int k = 0; k < 128; ++k) { const float w = wp[(size_t)k * 6144];
#pragma unroll
                for (int b = 0; b < 17; ++b) acc[b] += scr[b * 128 + k] * w; }
            float* mp = (float*)(ws + WS_MODP) + ((size_t)(ks * DEPTH + l) * 17) * 6144 + cc * 64 + F.lane;
#pragma unroll
            for (int b = 0; b < 17; ++b) mp[(size_t)b * 6144] = acc[b];
            LDS_WAIT();
            continue;
        }
        int r = it - IT_MOD; const int l = r / IT_LAYER; r -= l * IT_LAYER;
        if (r < IT_QKV) { const int kb = r / (QKVN / 32), nb = r % (QKVN / 32); const int n0 = nb * 32;
            const int drow0 = 256 * (n0 >> 8) + 128 * ((n0 >> 5) & 1) + 32 * ((n0 >> 6) & 3);
            p0_transpose_item(inp(P, IN_WQKV) + (size_t)l * DM * QKVN, QKVN, kb * 64, n0, (bf16_t*)(ws + WS_WQKV) + (size_t)l * QKVN * DM + (size_t)drow0 * DM + kb * 64, DM, scr, F.lane); continue; }
        r -= IT_QKV;
        if (r < IT_WO) { const int kb = r / (DM / 32), nb = r % (DM / 32);
            p0_transpose_item(inp(P, IN_WO) + (size_t)l * DM * DM, DM, kb * 64, nb * 32, (bf16_t*)(ws + WS_WO) + (size_t)l * DM * DM + (size_t)(nb * 32) * DM + kb * 64, DM, scr, F.lane); continue; }
        r -= IT_WO;
        if (r < 2 * IT_GU) { const int which = r / IT_GU; r -= which * IT_GU; const int e = r / 256, kb = (r % 256) / 16, nb = r % 16; const int n0 = nb * 32;
            const int drow0 = 256 * (n0 >> 7) + 128 * which + (n0 & 127);
            p0_transpose_item_f8(inp(P, which ? IN_WUP : IN_WGATE) + (size_t)(l * NEXP + e) * DM * FH, FH, kb * 64, n0,
                                 ws + WS_WGU + (size_t)(l * NEXP + e) * DM * DM + (size_t)drow0 * DM + kb * 64, DM, scr, F.lane); continue; }
        r -= 2 * IT_GU;
        { const int e = r / 256, kb = (r % 256) / 32, nb = r % 32;
            p0_transpose_item_f8(inp(P, IN_WDOWN) + (size_t)(l * NEXP + e) * FH * DM, DM, kb * 64, nb * 32,
                                 ws + WS_WD + (size_t)(l * NEXP + e) * DM * FH + (size_t)(nb * 32) * FH + kb * 64, FH, scr, F.lane); }
    }
    if (F.gw == F.NGW - 1) {
        f32x2* T = (f32x2*)(ws + WS_ROPE);
        for (int idx = F.lane; idx < 64 * 16; idx += 64) { const int pos = idx >> 4, j = idx & 15;
            const float inv = exp2f(-(float)j * (1.f / 16.f) * 13.287712379549449f);
            const float ang = (float)pos * inv;
            const double a = (double)ang; const double rr = a - 6.283185307179586 * rint(a * 0.15915494309189535);
            T[idx] = (f32x2){(float)dcos_poly(rr), (float)dsin_poly(rr)}; }
    }
    { u32x4* wf = (u32x4*)(ws + WS_WRT); const float* wg = inp(P, IN_WGROUP); const float* wr = inp(P, IN_WROUTER);
      for (int idx = F.gw * 64 + F.lane; idx < DEPTH * 32 * 3 * 2 * 64; idx += F.NGW * 64) { const int l = idx / (32 * 3 * 2 * 64), rem = idx % (32 * 3 * 2 * 64), step = rem / 384, nt = (rem % 384) >> 7, which = (rem >> 6) & 1, ln = rem & 63;
          const int n = 16 * nt + (ln & 15); float w[8];
#pragma unroll
          for (int j = 0; j < 8; ++j) { const int k = 32 * step + 8 * (ln >> 4) + j;
              const float wv = (n < 4) ? wg[((size_t)l * DM + k) * 4 + n] : (n < 36 ? wr[((size_t)l * DM + k) * 32 + (n - 4)] : 0.f);
              const float w1 = bf2f(f2bf(wv)); w[j] = which ? (wv - w1) : wv; }
          u32x4 o; o.x = pk2(w[0], w[1]); o.y = pk2(w[2], w[3]); o.z = pk2(w[4], w[5]); o.w = pk2(w[6], w[7]); wf[idx] = o; } }
}
DI void p0b_mod_reduce(const Params& P, const Frame& F) {
    unsigned char* const ws = wsp(P);
    const float* mp = (const float*)(ws + WS_MODP); float* mod = (float*)(ws + WS_MOD);
    for (int idx = F.gw * 64 + F.lane; idx < DEPTH * 17 * 6144; idx += F.NGW * 64) {
        const int l = idx / (17 * 6144), c = idx % 6144;
        float s = inp(P, IN_BADA)[l * 6144 + c];
#pragma unroll
        for (int ks = 0; ks < 8; ++ks) s += mp[(size_t)ks * DEPTH * 17 * 6144 + idx];
        mod[idx] = s; }
}

DI unsigned expert_count(const unsigned char* ws, int layer, int e) { return __hip_atomic_load((const unsigned*)(ws + WS_CTL) + CW_CNT + (layer * NEXP + e) * CNT_STRIDE, __ATOMIC_RELAXED, __HIP_MEMORY_SCOPE_AGENT); }
DI unsigned expert_starts(const unsigned char* ws, int layer, int lane) {
    const unsigned p = (lane < NEXP) ? ((expert_count(ws, layer, lane & 31) + 255u) & ~255u) : 0u; unsigned incl = p;
#pragma unroll
    for (int d = 1; d < 32; d <<= 1) { const unsigned v = __shfl_up(incl, d); if ((lane & 31) >= d) incl += v; }
    return incl - p;
}

DI void load_row(const float* row, int lane, f32x4 (&v)[4]) {
#pragma unroll
    for (int j = 0; j < 4; ++j) v[j] = *(const f32x4*)(row + 4 * lane + 256 * j);
}
DI void load_row_bf(const bf16_t* row, int lane, f32x4 (&v)[4]) {
#pragma unroll
    for (int j = 0; j < 4; ++j) { const u32x2 w = *(const u32x2*)(row + 4 * lane + 256 * j); v[j] = (f32x4){bf2f(w.x & 0xffffu), bf2f(w.x >> 16), bf2f(w.y & 0xffffu), bf2f(w.y >> 16)}; }
}
DI float row_rstd(const f32x4 (&v)[4]) {
    float s = 0.f;
#pragma unroll
    for (int j = 0; j < 4; ++j) s += (v[j][0] * v[j][0] + v[j][1] * v[j][1]) + (v[j][2] * v[j][2] + v[j][3] * v[j][3]);
    return 1.0f / sqrtf(wave_sum(s) * (1.f / DM) + NORM_EPS);
}
DI void load_vec(const float* p, int lane, f32x4 (&v)[4]) {
#pragma unroll
    for (int j = 0; j < 4; ++j) v[j] = *(const f32x4*)(p + 4 * lane + 256 * j);
}
DI void norm_mod_store(const f32x4 (&v)[4], float rstd, const f32x4 (&gg)[4], const f32x4 (&sh)[4], const f32x4 (&sc)[4], bf16_t* hrow, int lane) {
#pragma unroll
    for (int j = 0; j < 4; ++j) { const int c = 4 * lane + 256 * j;
        const f32x4 hf = (v[j] * rstd * gg[j]) * (1.f + sc[j]) + sh[j];
        u32x2 w; w.x = pk2(hf[0], hf[1]); w.y = pk2(hf[2], hf[3]); *(u32x2*)(hrow + c) = w; }
}
struct RowIn { f32x4 x[4]; u32x2 ya[4], yb[4]; };
DI void row_fetch(const unsigned char* ws, const float* xrow, const bf16_t* xrow_bf, int t, unsigned s0, unsigned s1, int lane, bool prev, RowIn& R) {
    if (xrow_bf) load_row_bf(xrow_bf, lane, R.x); else load_row(xrow, lane, R.x);
    if (prev) {
        const bf16_t* Y = (const bf16_t*)(ws + WS_Y);
#pragma unroll
        for (int j = 0; j < 4; ++j) { R.ya[j] = *(const u32x2*)(Y + (size_t)s0 * DM + 4 * lane + 256 * j); R.yb[j] = *(const u32x2*)(Y + (size_t)s1 * DM + 4 * lane + 256 * j); } }
}
DI void row_apply(const f32x4 (&gt)[4], float w0, float w1, RowIn& R) {
#pragma unroll
    for (int j = 0; j < 4; ++j) { const f32x4 g = gt[j]; const u32x2 a = R.ya[j], b = R.yb[j];
        R.x[j][0] += g[0] * (w0 * bf2f(a.x & 0xffffu) + w1 * bf2f(b.x & 0xffffu)); R.x[j][1] += g[1] * (w0 * bf2f(a.x >> 16) + w1 * bf2f(b.x >> 16));
        R.x[j][2] += g[2] * (w0 * bf2f(a.y & 0xffffu) + w1 * bf2f(b.y & 0xffffu)); R.x[j][3] += g[3] * (w0 * bf2f(a.y >> 16) + w1 * bf2f(b.y >> 16)); }
}
DI void phase_attn_norm(const Params& P, const Frame& F0, int layer) {
    const Frame F = opaque_frame(F0);
    unsigned char* const ws = wsp(P);
    bf16_t* X = (bf16_t*)(ws + WS_X); bf16_t* H = (bf16_t*)(ws + WS_H);
    const bool prev = layer > 0;
    const int nrow = (TALL - F.gw + F.NGW - 1) / F.NGW;
    unsigned ms0 = 0, ms1 = 0; float mw0 = 0.f, mw1 = 0.f;
    if (prev) { const unsigned pst = expert_starts(ws, layer - 1, F.lane); u32x2 a = (u32x2){0u, 0u};
        if (F.lane < nrow) { const int tl = F.gw + F.lane * F.NGW; a = *(const u32x2*)((const unsigned*)(ws + WS_ASG) + (size_t)tl * 2); const f32x2 w = *(const f32x2*)((const float*)(ws + WS_ASGW) + (size_t)tl * 2); mw0 = w.x; mw1 = w.y; }
        ms0 = (unsigned)__shfl((int)pst, (int)(a.x >> 20)) + (a.x & 0xfffffu); ms1 = (unsigned)__shfl((int)pst, (int)(a.y >> 20)) + (a.y & 0xfffffu); }
    auto xsrc = [&](int t) -> const float* { return (t < TLAT ? inp(P, IN_X) + (size_t)t * DM : inp(P, IN_CTX) + (size_t)(t - TLAT) * DM); };
    auto xbf = [&](int t) -> const bf16_t* { return prev ? X + (size_t)t * DM : (const bf16_t*)nullptr; };
    RowIn cur, nxt;
    f32x4 gat[4]; load_vec(inp(P, IN_GATTN) + layer * DM, F.lane, gat);
    row_fetch(ws, xsrc(F.gw), xbf(F.gw), F.gw, __shfl(ms0, 0), __shfl(ms1, 0), F.lane, prev, cur);
    for (int i = 0; i < nrow; ++i) {
        const int t = F.gw + i * F.NGW; const int mb = (t < TLAT) ? (t >> 11) : 16;
        const float* md = (const float*)(ws + WS_MOD) + ((size_t)layer * 17 + mb) * 6144;
        f32x4 gt[4], sh[4], sc[4];
        if (prev) load_vec(md - 17 * 6144 + 5120, F.lane, gt);
        load_vec(md, F.lane, sh); load_vec(md + 1024, F.lane, sc);
        asm volatile("" ::: "memory");
        if (i + 1 < nrow) row_fetch(ws, xsrc(t + F.NGW), xbf(t + F.NGW), t + F.NGW, __shfl(ms0, i + 1), __shfl(ms1, i + 1), F.lane, prev, nxt);
        if (prev) row_apply(gt, __shfl(mw0, i), __shfl(mw1, i), cur);
#pragma unroll
        for (int j = 0; j < 4; ++j) { u32x2 w; w.x = pk2(cur.x[j][0], cur.x[j][1]); w.y = pk2(cur.x[j][2], cur.x[j][3]); *(u32x2*)(X + (size_t)t * DM + 4 * F.lane + 256 * j) = w; }
        const float rstd = row_rstd(cur.x);
        norm_mod_store(cur.x, rstd, gat, sh, sc, H + (size_t)t * DM, F.lane);
        cur = nxt;
    }
}
DI void phase_final(const Params& P, const Frame& F0) {
    const Frame F = opaque_frame(F0);
    unsigned char* const ws = wsp(P);
    const bf16_t* X = (const bf16_t*)(ws + WS_X);
    const float pc = PROBE_SEL ? *((const float*)(ws + WS_CTL) + 64) : 0.f;
    const int nrow = (TLAT - F.gw + F.NGW - 1) / F.NGW;
    unsigned ms0 = 0, ms1 = 0; float mw0 = 0.f, mw1 = 0.f;
    { const unsigned pst = expert_starts(ws, DEPTH - 1, F.lane); u32x2 a = (u32x2){0u, 0u};
      if (F.lane < nrow) { const int tl = F.gw + F.lane * F.NGW; a = *(const u32x2*)((const unsigned*)(ws + WS_ASG) + (size_t)tl * 2); const f32x2 w = *(const f32x2*)((const float*)(ws + WS_ASGW) + (size_t)tl * 2); mw0 = w.x; mw1 = w.y; }
      ms0 = (unsigned)__shfl((int)pst, (int)(a.x >> 20)) + (a.x & 0xfffffu); ms1 = (unsigned)__shfl((int)pst, (int)(a.y >> 20)) + (a.y & 0xfffffu); }
    RowIn cur, nxt;
    row_fetch(ws, nullptr, X + (size_t)F.gw * DM, F.gw, __shfl(ms0, 0), __shfl(ms1, 0), F.lane, true, cur);
    f32x4 gfin[4]; load_vec(inp(P, IN_GFINAL), F.lane, gfin);
    for (int i = 0; i < nrow; ++i) {
        const int t = F.gw + i * F.NGW;
        f32x4 gt[4]; load_vec((const float*)(ws + WS_MOD) + ((size_t)(DEPTH - 1) * 17 + (t >> 11)) * 6144 + 5120, F.lane, gt);
        asm volatile("" ::: "memory");
        if (i + 1 < nrow) row_fetch(ws, nullptr, X + (size_t)(t + F.NGW) * DM, t + F.NGW, __shfl(ms0, i + 1), __shfl(ms1, i + 1), F.lane, true, nxt);
        row_apply(gt, __shfl(mw0, i), __shfl(mw1, i), cur);
        const float rstd = row_rstd(cur.x);
#pragma unroll
        for (int j = 0; j < 4; ++j) { const int c = 4 * F.lane + 256 * j; *(f32x4*)(P.out + (size_t)t * DM + c) = cur.x[j] * rstd * gfin[j] + pc; }
        cur = nxt;
    }
}

DI float swap_max(float v) { auto rr = __builtin_amdgcn_permlane32_swap(__float_as_uint(v), __float_as_uint(v), false, false); return fmaxf(__uint_as_float(rr[0]), __uint_as_float(rr[1])); }
DI float swap_add(float v) { auto rr = __builtin_amdgcn_permlane32_swap(__float_as_uint(v), __float_as_uint(v), false, false); return __uint_as_float(rr[0]) + __uint_as_float(rr[1]); }
DI bf16x8 pack_p(const f32x16& p, int s) {
    u32x4 w; w.x = cvt_pk_bf16(p[8 * s + 0], p[8 * s + 1]); w.y = cvt_pk_bf16(p[8 * s + 2], p[8 * s + 3]); w.z = cvt_pk_bf16(p[8 * s + 4], p[8 * s + 5]); w.w = cvt_pk_bf16(p[8 * s + 6], p[8 * s + 7]);
    return __builtin_bit_cast(bf16x8, w);
}
struct AttnState { float m, l; f32x16 o[2]; };
DI void load_k(const unsigned char* Kbh, int kg, int r32, int hi, bf16x8 (&k)[4]) {
    const unsigned char* kb = Kbh + (size_t)(kg + (r32 >> 3)) * 1024 + hi * 128 + (r32 & 7) * 16;
#pragma unroll
    for (int d0 = 0; d0 < 4; ++d0) k[d0] = *(const bf16x8*)(kb + d0 * 256);
}
DI void load_v(const unsigned char* Vbh, int kg, int r32, int hi, s16x4 (&v)[2][2][2]) {
    const unsigned char* vb = Vbh + (size_t)kg * 1024 + r32 * 16 + hi * 8;
#pragma unroll
    for (int dh = 0; dh < 2; ++dh)
#pragma unroll
        for (int ks = 0; ks < 2; ++ks)
#pragma unroll
            for (int pt = 0; pt < 2; ++pt) v[dh][ks][pt] = *(const s16x4*)(vb + dh * 512 + (2 * ks + pt) * 1024);
}
DI f32x16 attn_scores(const bf16x8 (&k)[4], const bf16x8 (&q)[4]) {
    f32x16 s;
#pragma unroll
    for (int r = 0; r < 16; ++r) s[r] = 0.f;
#pragma unroll
    for (int d0 = 0; d0 < 4; ++d0) s = __builtin_amdgcn_mfma_f32_32x32x16_bf16(k[d0], q[d0], s, 0, 0, 0);
    return s;
}
DI float row_max16(const f32x16& s) {
    float mt = fmaxf(fmaxf(s[0], s[1]), fmaxf(s[2], s[3]));
#pragma unroll
    for (int r = 4; r < 16; r += 4) mt = fmaxf(mt, fmaxf(fmaxf(s[r], s[r + 1]), fmaxf(s[r + 2], s[r + 3])));
    return mt;
}
DI void attn_rescale(AttnState& st, f32x16& s, float mt, LAS float* wsf, int r32, int hi) {
    mt = swap_max(mt);
    const float dm = fmaxf(mt, 0.f);
    const float al = __builtin_amdgcn_exp2f(-dm);
    st.l *= al; st.m += dm;
#pragma unroll
    for (int r = 0; r < 16; ++r) s[r] -= dm;
    if (hi == 0) wsf[r32] = al;
    LDS_WAIT();
#pragma unroll
    for (int r = 0; r < 16; ++r) { const float f = wsf[crow(r, hi)]; st.o[0][r] *= f; st.o[1][r] *= f; }
    LDS_WAIT();
}
DI void attn_exp_pv(AttnState& st, f32x16& s, const s16x4 (&v)[2][2][2]) {
    float p0 = 0.f, p1 = 0.f;
#pragma unroll
    for (int r = 0; r < 16; r += 2) { s[r] = __builtin_amdgcn_exp2f(s[r]); s[r + 1] = __builtin_amdgcn_exp2f(s[r + 1]); p0 += s[r]; p1 += s[r + 1]; }
    st.l += p0 + p1;
    const bf16x8 pa0 = pack_p(s, 0), pa1 = pack_p(s, 1);
#pragma unroll
    for (int dh = 0; dh < 2; ++dh) {
        const bf16x8 vf0 = __builtin_shufflevector(v[dh][0][0], v[dh][0][1], 0, 1, 2, 3, 4, 5, 6, 7);
        const bf16x8 vf1 = __builtin_shufflevector(v[dh][1][0], v[dh][1][1], 0, 1, 2, 3, 4, 5, 6, 7);
        st.o[dh] = __builtin_amdgcn_mfma_f32_32x32x16_bf16(pa0, vf0, st.o[dh], 0, 0, 0);
        st.o[dh] = __builtin_amdgcn_mfma_f32_32x32x16_bf16(pa1, vf1, st.o[dh], 0, 0, 0);
    }
}
DI void attn_softmax_pv2(AttnState (&st)[2], f32x16 (&s)[2], const s16x4 (&v)[2][2][2], LAS float* wsf, int r32, int hi) {
#pragma unroll
    for (int r = 0; r < 16; ++r) { s[0][r] -= st[0].m; s[1][r] -= st[1].m; }
    const float mt0 = row_max16(s[0]), mt1 = row_max16(s[1]);
    if (__any(fmaxf(mt0, mt1) > 8.f)) { attn_rescale(st[0], s[0], mt0, wsf, r32, hi); attn_rescale(st[1], s[1], mt1, wsf + 32, r32, hi); }
    attn_exp_pv(st[0], s[0], v);
    attn_exp_pv(st[1], s[1], v);
}
template <int MODE>
DI void attn_unit(const Params& P, unsigned char* ws, int layer, int b, int h0, int qblk, LAS unsigned char* wl, int lane) {
    const int r32 = lane & 31, hi = lane >> 5, kvh = h0 >> 2, m = layer % 3;
    constexpr bool VDB = false;
    LAS float* wsf = (LAS float*)wl; LAS bf16_t* stg = (LAS bf16_t*)(wl + 256); LAS float* rpbt = (LAS float*)(wl + 256 + 4096);
    const bf16_t* QKV = (const bf16_t*)(ws + WS_QKV);
    const unsigned char* Kbh = ws + WS_KF + (size_t)(b * NKV + kvh) * KGRP * 1024;
    const unsigned char* Vbh = ws + WS_VF + (size_t)(b * NKV + kvh) * KGRP * 1024;
    bf16_t* O = (bf16_t*)(ws + WS_O);
    int r0 = 0, c0 = 0;
    if (MODE == 2) { r0 = 2 * (qblk >> 2); c0 = 16 * (qblk & 3); }
    auto qtok = [&](int i) -> int {
        if (MODE == 3) return TLAT + b * CTXL + qblk * 32 + i;
        if (MODE == 2) return b * SEQ + (r0 + (i >> 4)) * 64 + c0 + (i & 15);
        return b * SEQ + qblk * 32 + i; };
    const int tq = qtok(r32);
    const bf16_t* qp = QKV + (size_t)tq * QKVN + h0 * HD + hi * 8;
    bf16x8 qr[2][4];
#pragma unroll
    for (int hh = 0; hh < 2; ++hh)
#pragma unroll
        for (int d0 = 0; d0 < 4; ++d0) qr[hh][d0] = *(const bf16x8*)(qp + hh * HD + d0 * 16);
    const int q0 = qblk * 32;
    int nl = 0, jlo = 0, rs_min = 0, cseg = 0;
    if (MODE == 0) { jlo = (q0 < 128) ? (128 - q0) / 32 : 0; const int jhi = min(8, (SEQ - 32 - q0 + 128) / 32); nl = jhi - jlo + 1; }
    if (MODE == 1) nl = SEQ / 32;
    if (MODE == 2) { rs_min = min(max(r0 - 4, 0), 24); const int rs_max = min(max(r0 + 1 - 4, 0), 24); nl = rs_max - rs_min + 8; cseg = (c0 == 0) ? 0 : (c0 == 16) ? 8 : (c0 == 32) ? 24 : 32; }
    auto lat_kg = [&](int i) -> int {
        if (MODE == 0) return (q0 - 128 + 32 * (jlo + i)) >> 3;
        if (MODE == 1) return 4 * i;
        return ((rs_min + i) * 64 + cseg) >> 3; };
    bf16x8 kn[4];
    load_k(Kbh, nl > 0 ? lat_kg(0) : SEQ / 8, r32, hi, kn);
    if (MODE == 0 || MODE == 1) {
        const int n = tq & 2047; const f32x2* T = (const f32x2*)(ws + WS_ROPE);
        const f32x2* tr = T + (n >> 6) * 16 + 8 * hi; const f32x2* tc = T + (n & 63) * 16 + 8 * hi;
#pragma unroll
        for (int e = 0; e < 8; ++e) { const f32x2 a = tr[e], cc = tc[e];
#pragma unroll
            for (int hh = 0; hh < 2; ++hh) {
                const float x1 = bfs2f(qr[hh][0][e]), x2 = bfs2f(qr[hh][1][e]), x3 = bfs2f(qr[hh][2][e]), x4 = bfs2f(qr[hh][3][e]);
                qr[hh][0][e] = (short)f2bf(x1 * a.x - x2 * a.y); qr[hh][1][e] = (short)f2bf(x2 * a.x + x1 * a.y);
                qr[hh][2][e] = (short)f2bf(x3 * cc.x - x4 * cc.y); qr[hh][3][e] = (short)f2bf(x4 * cc.x + x3 * cc.y); } }
    }
    LAS bf16x8* qlds = (LAS bf16x8*)(wl + 8192) + lane;
    if (VDB) {
#pragma unroll
        for (int d0 = 0; d0 < 4; ++d0) qlds[d0 * 64] = qr[1][d0];
        LDS_WAIT();
    }
    int rq = 0, cq = 0, rsq = 0, csq = 0;
    if (MODE == 2) {
        const float* rpb = inp(P, IN_RPB) + (size_t)h0 * 465;
        for (int i = lane; i < 930; i += 64) rpbt[i + (i >= 465 ? 7 : 0)] = rpb[i] * LOG2E;
        LDS_WAIT();
        rq = r0 + (r32 >> 4); cq = c0 + (r32 & 15); rsq = min(max(rq - 4, 0), 24); csq = min(max(cq - 8, 0), 48);
    }
    AttnState st[2];
#pragma unroll
    for (int hh = 0; hh < 2; ++hh) { st[hh].m = -1024.f; st[hh].l = 0.f;
#pragma unroll
        for (int r = 0; r < 16; ++r) { st[hh].o[0][r] = 0.f; st[hh].o[1][r] = 0.f; } }
    const float NEG = -INFINITY;
    s16x4 vn[2][2][2];
    if (VDB) load_v(Vbh, nl > 0 ? lat_kg(0) : SEQ / 8, r32, hi, vn);
    for (int i = 0; i < nl; ++i) {
        const int kgn = (i + 1 < nl) ? lat_kg(i + 1) : SEQ / 8;
        s16x4 v[2][2][2];
        if (VDB) {
#pragma unroll
            for (int a = 0; a < 2; ++a)
#pragma unroll
                for (int c = 0; c < 2; ++c)
#pragma unroll
                    for (int e = 0; e < 2; ++e) v[a][c][e] = vn[a][c][e];
        } else load_v(Vbh, lat_kg(i), r32, hi, v);
        f32x16 s[2];
        s[0] = attn_scores(kn, qr[0]);
        if (VDB) { bf16x8 q1[4];
#pragma unroll
            for (int d0 = 0; d0 < 4; ++d0) q1[d0] = qlds[d0 * 64];
            s[1] = attn_scores(kn, q1); }
        else s[1] = attn_scores(kn, qr[1]);
        load_k(Kbh, kgn, r32, hi, kn);
        if (VDB) load_v(Vbh, kgn, r32, hi, vn);
        if (MODE == 0) {
            const int j = jlo + i;
            if (j == 0 || j == 8) { const int kt = q0 - 128 + 32 * j, qpos = q0 + r32;
#pragma unroll
                for (int r = 0; r < 16; ++r) { const int d = kt + crow(r, hi) - qpos; if (d > 128 || d < -128) { s[0][r] = NEG; s[1][r] = NEG; } } }
        }
        if (MODE == 2) {
            const int kr = rs_min + i;
            const bool rowok = (kr >= rsq) && (kr < rsq + 8);
            const int ib = (kr - rq + 7) * 31 - cq + 15;
#pragma unroll
            for (int r = 0; r < 16; ++r) { const int kc2 = cseg + crow(r, hi); const bool ok = rowok && (kc2 >= csq) && (kc2 < csq + 16);
                const int idx = min(max(ib + kc2, 0), 464);
                s[0][r] = ok ? s[0][r] + rpbt[idx] : NEG; s[1][r] = ok ? s[1][r] + rpbt[472 + idx] : NEG; }
        }
        attn_softmax_pv2(st, s, v, wsf, r32, hi);
    }
    if (MODE == 0 || MODE == 1) {
#pragma unroll
        for (int hh = 0; hh < 2; ++hh)
#pragma unroll
            for (int d0 = 0; d0 < 4; ++d0) qr[hh][d0] = *(const bf16x8*)(qp + hh * HD + d0 * 16);
        if (VDB) {
#pragma unroll
            for (int d0 = 0; d0 < 4; ++d0) qlds[d0 * 64] = qr[1][d0];
            LDS_WAIT();
        }
    }
    for (int j = 0; j < CTXL / 32; ++j) {
        const int kg = SEQ / 8 + 4 * j, kgn = (j + 1 < CTXL / 32) ? kg + 4 : kg;
        s16x4 v[2][2][2];
        if (VDB) {
#pragma unroll
            for (int a = 0; a < 2; ++a)
#pragma unroll
                for (int c = 0; c < 2; ++c)
#pragma unroll
                    for (int e = 0; e < 2; ++e) v[a][c][e] = vn[a][c][e];
        } else load_v(Vbh, kg, r32, hi, v);
        f32x16 s[2];
        s[0] = attn_scores(kn, qr[0]);
        if (VDB) { bf16x8 q1[4];
#pragma unroll
            for (int d0 = 0; d0 < 4; ++d0) q1[d0] = qlds[d0 * 64];
            s[1] = attn_scores(kn, q1); }
        else s[1] = attn_scores(kn, qr[1]);
        load_k(Kbh, kgn, r32, hi, kn);
        if (VDB) load_v(Vbh, kgn, r32, hi, vn);
        attn_softmax_pv2(st, s, v, wsf, r32, hi);
    }
    int lane2 = lane; asm volatile("" : "+v"(lane2));
    const int r32b = lane2 & 31, hib = lane2 >> 5;
#pragma unroll
    for (int hh = 0; hh < 2; ++hh) {
        const float lt = swap_add(st[hh].l);
        float inv;
        if (MODE == 0 || (MODE == 3 && m == 0)) { const float sk = inp(P, IN_SINK)[(layer / 3) * NH + h0 + hh] * LOG2E;
            const float mnew = fmaxf(st[hh].m, sk); const float al = __builtin_amdgcn_exp2f(st[hh].m - mnew), es = __builtin_amdgcn_exp2f(sk - mnew);
            inv = al / (lt * al + es); }
        else inv = 1.f / lt;
        if (hib == 0) wsf[r32b] = inv;
        LDS_WAIT();
        LAS bf16_t* sb = stg + hib * 256 + r32b;
        const LAS float* wf = wsf + 4 * hib;
#pragma unroll
        for (int r = 0; r < 16; ++r) { const float f = wf[(r & 3) + 8 * (r >> 2)];
            sb[((r & 3) + 8 * (r >> 2)) * 64] = (bf16_t)f2bf(st[hh].o[0][r] * f); sb[((r & 3) + 8 * (r >> 2)) * 64 + 32] = (bf16_t)f2bf(st[hh].o[1][r] * f); }
        LDS_WAIT();
        const int rw = lane2 >> 3, ch = lane2 & 7;
        const LAS unsigned char* rb = (const LAS unsigned char*)stg + rw * 128 + ch * 16;
#pragma unroll
        for (int i = 0; i < 4; ++i) { const u32x4 vv = *(const LAS u32x4*)(rb + i * 1024);
            *(u32x4*)(O + (size_t)qtok(i * 8 + rw) * DM + (h0 + hh) * HD + ch * 8) = vv; }
        LDS_WAIT();
    }
}
DI void phase_attention(const Params& P, const Frame& F0, int layer) {
    const Frame F = opaque_frame(F0);
    unsigned char* const ws = wsp(P);
    const int m = layer % 3;
    LAS unsigned char* wl = F.lds + F.wave * 16384;
    for (int bu = F.blk; bu < NB * NKV * 16; bu += F.G) {
        const int rnd = bu >> 8, x = bu & 7, loc = (bu & 255) >> 3;
        const int bkv = rnd * 16 + x * 2 + (loc >> 4), qg = loc & 15;
        const int b = bkv >> 2, kvh = bkv & 3, h0 = kvh * 4 + 2 * (F.wave & 1), qblk = 4 * qg + (F.wave >> 1);
        if (m == 0) attn_unit<0>(P, ws, layer, b, h0, qblk, wl, F.lane);
        else if (m == 1) attn_unit<1>(P, ws, layer, b, h0, qblk, wl, F.lane);
        else attn_unit<2>(P, ws, layer, b, h0, qblk, wl, F.lane);
    }
    if (layer < DEPTH - 1) {
        for (int bu = F.blk; bu < NB * NKV * 2; bu += F.G) {
            const int bkv = bu >> 1, b = bkv >> 2, kvh = bkv & 3, h0 = kvh * 4 + 2 * (F.wave & 1), qblk = 4 * (bu & 1) + (F.wave >> 1);
            attn_unit<3>(P, ws, layer, b, h0, qblk, wl, F.lane);
        }
    }
}

DI int blk_token(int blk, int i) { return i < 128 ? blk * 128 + i : TLAT + blk * 16 + (i - 128); }
constexpr int RT_ROWB = 2064;
constexpr int RT_X2_OFF = 16 * RT_ROWB, RT_PART_OFF = 2 * 16 * RT_ROWB, RT_LOG_OFF = RT_PART_OFF + 8 * 16 * 48 * 4, RT_LOGS = 37, RT_VEC_OFF = RT_LOG_OFF + 144 * RT_LOGS * 4;
DI void phase_router(const Params& P, const Frame& F0, int layer, int M) {
    const Frame F = opaque_frame(F0);
    unsigned char* const ws = wsp(P);
    const int TPB = M / GRID, nchunk = TPB / 16;
    LAS int* hist = (LAS int*)(F.lds + LDSX_OFF);
    LAS float* part = (LAS float*)(F.lds + RT_PART_OFF); LAS float* logit = (LAS float*)(F.lds + RT_LOG_OFF);
    if (F.tid < 32) hist[F.tid] = 0;
    const bf16_t* X = (const bf16_t*)(ws + WS_X); bf16_t* H = (bf16_t*)(ws + WS_H);
    const float* gffn = inp(P, IN_GFFN) + layer * DM;
    const u32x4* wf = (const u32x4*)(ws + WS_WRT) + ((size_t)layer * 32 + 4 * F.wave) * 384 + F.lane;
    bf16x8 wreg[4][2][2];
#pragma unroll
    for (int s = 0; s < 4; ++s)
#pragma unroll
        for (int nt = 0; nt < 2; ++nt)
#pragma unroll
            for (int wh = 0; wh < 2; ++wh) wreg[s][nt][wh] = __builtin_bit_cast(bf16x8, wf[s * 384 + nt * 128 + wh * 64]);
    bf16x8 w2t[4][2];
#pragma unroll
    for (int s = 0; s < 4; ++s)
#pragma unroll
        for (int wh = 0; wh < 2; ++wh) w2t[s][wh] = __builtin_bit_cast(bf16x8, wf[s * 384 + 256 + wh * 64]);
    LAS float* vec = (LAS float*)(F.lds + RT_VEC_OFF);
    auto load_vecs = [&](int mb) {
        const float* md = (const float*)(ws + WS_MOD) + ((size_t)layer * 17 + mb) * 6144;
        for (int i = F.tid; i < 256; i += NTHREADS) { const f32x4 g = *(const f32x4*)(gffn + 4 * i), sc = *(const f32x4*)(md + 4096 + 4 * i);
            *(LAS f32x4*)(vec + 4 * i) = *(const f32x4*)(md + 2048 + 4 * i); *(LAS f32x4*)(vec + 1024 + 4 * i) = g * (1.f + sc); *(LAS f32x4*)(vec + 2048 + 4 * i) = *(const f32x4*)(md + 3072 + 4 * i); } };
    load_vecs(F.blk >> 4);
    const int ib = 2 * F.wave;
    f32x4 vn[2][4];
#pragma unroll
    for (int tk = 0; tk < 2; ++tk) { const int t = blk_token(F.blk, ib + tk); load_row_bf(X + (size_t)t * DM, F.lane, vn[tk]); }
    LDS_WAIT(); __syncthreads();
    for (int c = 0; c < nchunk; ++c) {
        if (c == 8) { load_vecs(16); LDS_WAIT(); __syncthreads(); }
#pragma unroll
        for (int tk = 0; tk < 2; ++tk) { const int t = blk_token(F.blk, c * 16 + ib + tk);
            const float rstd = row_rstd(vn[tk]);
            LAS unsigned char* r1 = F.lds + (ib + tk) * RT_ROWB + 8 * F.lane; unsigned char* hrow = (unsigned char*)H + (size_t)t * DM;
#pragma unroll
            for (int j = 0; j < 4; ++j) { const int cc = 4 * F.lane + 256 * j; const f32x4 ga = *(const LAS f32x4*)(vec + 1024 + cc), sh = *(const LAS f32x4*)(vec + 2048 + cc);
                const f32x4 hf = (vn[tk][j] * rstd) * ga + sh;
                u32x2 a; a.x = pk2(hf[0], hf[1]); a.y = pk2(hf[2], hf[3]);
                u32x2 b; b.x = pk2(hf[0] - bf2f(a.x & 0xffffu), hf[1] - bf2f(a.x >> 16)); b.y = pk2(hf[2] - bf2f(a.y & 0xffffu), hf[3] - bf2f(a.y >> 16));
                *(unsigned*)(hrow + cc) = cvt_pk_fp8x4(hf[0] * F8_ACT_SCALE, hf[1] * F8_ACT_SCALE, hf[2] * F8_ACT_SCALE, hf[3] * F8_ACT_SCALE); *(LAS u32x2*)(r1 + 512 * j) = a; *(LAS u32x2*)(r1 + RT_X2_OFF + 512 * j) = b; } }
        if (c + 1 < nchunk) {
#pragma unroll
            for (int tk = 0; tk < 2; ++tk) { const int t = blk_token(F.blk, (c + 1) * 16 + ib + tk); load_row_bf(X + (size_t)t * DM, F.lane, vn[tk]); }
        }
        LDS_WAIT(); __syncthreads();
        f32x4 acc[3];
#pragma unroll
        for (int nt = 0; nt < 3; ++nt) acc[nt] = (f32x4){0.f, 0.f, 0.f, 0.f};
        { const LAS unsigned char* ap = F.lds + (F.lane & 15) * RT_ROWB + 256 * F.wave + 16 * (F.lane >> 4);
#pragma unroll
          for (int s = 0; s < 4; ++s) { const bf16x8 a1 = *(const LAS bf16x8*)(ap + 64 * s), a2 = *(const LAS bf16x8*)(ap + RT_X2_OFF + 64 * s);
#pragma unroll
              for (int nt = 0; nt < 2; ++nt) { acc[nt] = __builtin_amdgcn_mfma_f32_16x16x32_bf16(a1, wreg[s][nt][0], acc[nt], 0, 0, 0);
                  acc[nt] = __builtin_amdgcn_mfma_f32_16x16x32_bf16(a1, wreg[s][nt][1], acc[nt], 0, 0, 0); acc[nt] = __builtin_amdgcn_mfma_f32_16x16x32_bf16(a2, wreg[s][nt][0], acc[nt], 0, 0, 0); }
              acc[2] = __builtin_amdgcn_mfma_f32_16x16x32_bf16(a1, w2t[s][0], acc[2], 0, 0, 0);
              acc[2] = __builtin_amdgcn_mfma_f32_16x16x32_bf16(a1, w2t[s][1], acc[2], 0, 0, 0); acc[2] = __builtin_amdgcn_mfma_f32_16x16x32_bf16(a2, w2t[s][0], acc[2], 0, 0, 0); } }
        { LAS float* pp = part + F.wave * 768 + (4 * (F.lane >> 4)) * 48 + (F.lane & 15);
#pragma unroll
          for (int nt = 0; nt < 3; ++nt)
#pragma unroll
              for (int r = 0; r < 4; ++r) pp[r * 48 + 16 * nt] = acc[nt][r]; }
        LDS_WAIT(); __syncthreads();
        { const int tk = F.tid >> 5, n = F.tid & 31; float s = 0.f;
#pragma unroll
          for (int w = 0; w < 8; ++w) s += part[w * 768 + tk * 48 + n];
          logit[(c * 16 + tk) * RT_LOGS + n] = s;
          if (F.tid < 64) { const int tk2 = F.tid >> 2, n2 = 32 + (F.tid & 3); float s2 = 0.f;
#pragma unroll
              for (int w = 0; w < 8; ++w) s2 += part[w * 768 + tk2 * 48 + n2];
              logit[(c * 16 + tk2) * RT_LOGS + n2] = s2; } }
    }
    LDS_WAIT(); __syncthreads();
    int rt_t = 0, rt_e1 = 0, rt_e2 = 0, rt_q1 = 0, rt_q2 = 0; float rt_w1 = 0.f, rt_w2 = 0.f;
    if (F.tid < TPB) { const int t = blk_token(F.blk, F.tid); const LAS float* lg = logit + F.tid * RT_LOGS;
        const float* bg = inp(P, IN_BGROUP) + layer * 4; const float* br = inp(P, IN_BROUTER) + layer * 32;
        const float g0 = lg[0] + bg[0], g1 = lg[1] + bg[1], g2 = lg[2] + bg[2], g3 = lg[3] + bg[3];
        int grp = 0; float gm = g0; if (g1 > gm) { gm = g1; grp = 1; } if (g2 > gm) { gm = g2; grp = 2; } if (g3 > gm) { gm = g3; grp = 3; }
        const float ptop = 1.f / (expf(g0 - gm) + expf(g1 - gm) + expf(g2 - gm) + expf(g3 - gm));
        float ev[8], em = -INFINITY;
#pragma unroll
        for (int j = 0; j < 8; ++j) { ev[j] = lg[4 + grp * 8 + j] + br[grp * 8 + j]; em = fmaxf(em, ev[j]); }
        float pe[8];
#pragma unroll
        for (int j = 0; j < 8; ++j) pe[j] = expf(ev[j] - em);
        int i1 = 0; float p1 = pe[0];
#pragma unroll
        for (int j = 1; j < 8; ++j) if (pe[j] > p1) { p1 = pe[j]; i1 = j; }
        int i2 = 0; float p2 = -1.f;
#pragma unroll
        for (int j = 0; j < 8; ++j) if (j != i1 && pe[j] > p2) { p2 = pe[j]; i2 = j; }
        const float w1 = ptop * p1 / (p1 + p2), w2 = ptop * p2 / (p1 + p2);
        const int e1 = grp * 8 + i1, e2 = grp * 8 + i2;
        rt_q1 = atomicAdd((int*)&hist[e1], 1); rt_q2 = atomicAdd((int*)&hist[e2], 1);
        rt_t = t; rt_e1 = e1; rt_e2 = e2; rt_w1 = w1; rt_w2 = w2; }
    __syncthreads();
    LAS unsigned* gbase = (LAS unsigned*)(hist + 32);
    if (F.tid < 32) gbase[F.tid] = __hip_atomic_fetch_add((unsigned*)(ws + WS_CTL) + CW_CNT + (layer * NEXP + F.tid) * CNT_STRIDE, (unsigned)hist[F.tid], __ATOMIC_RELAXED, __HIP_MEMORY_SCOPE_AGENT);
    LDS_WAIT(); __syncthreads();
    if (F.tid < TPB) { const unsigned i1 = gbase[rt_e1] + (unsigned)rt_q1, i2 = gbase[rt_e2] + (unsigned)rt_q2;
        unsigned* asg = (unsigned*)(ws + WS_ASG); float* asgw = (float*)(ws + WS_ASGW); unsigned* toke = (unsigned*)(ws + WS_TOKE);
        *(u32x2*)(asg + (size_t)rt_t * 2) = (u32x2){((unsigned)rt_e1 << 20) | i1, ((unsigned)rt_e2 << 20) | i2};
        *(f32x2*)(asgw + (size_t)rt_t * 2) = (f32x2){rt_w1, rt_w2};
        toke[(size_t)rt_e1 * TALL + i1] = (unsigned)rt_t; toke[(size_t)rt_e2 * TALL + i2] = (unsigned)rt_t; }
}
DI void build_tile_table(const Params& P, const Frame& F0, LAS unsigned* tab, int layer) {
    const Frame F = opaque_frame(F0);
    unsigned char* const ws = wsp(P);
    constexpr int TP = pg8::MoeSched<true>::TAB_PST, TC = pg8::MoeSched<true>::TAB_CNT;
    if (F.tid < NEXP) tab[TC + F.tid] = expert_count(ws, layer, F.tid);
    LDS_WAIT(); __syncthreads();
    if (F.tid == 0) { unsigned ps = 0; for (int e = 0; e < NEXP; ++e) { tab[TP + e] = ps; ps += (tab[TC + e] + 255u) & ~255u; } tab[0] = ps >> 8; }
    LDS_WAIT(); __syncthreads();
    const unsigned ntile = tab[0];
    for (unsigned rt = F.tid; rt < ntile; rt += NTHREADS) { unsigned e = 0; for (int k = 1; k < NEXP; ++k) if (rt * 256u >= tab[TP + k]) e = k; tab[1 + rt] = e; }
    LDS_WAIT(); __syncthreads();
}
__global__ void __launch_bounds__(NTHREADS, 2) dit_fwd(Params P) {
    extern __shared__ __attribute__((aligned(16))) unsigned char lds_raw[];
    Frame F;
    F.lds = (LAS unsigned char*)lds_raw;
    F.tid = threadIdx.x; F.lane = F.tid & 63; F.wave = __builtin_amdgcn_readfirstlane(F.tid >> 6);
    F.blk = blockIdx.x; F.G = gridDim.x; F.vcu = (F.G % 8 == 0) ? (F.blk % 8) * (F.G / 8) + F.blk / 8 : F.blk;
    F.gw = F.vcu * NWAVES + F.wave; F.NGW = F.G * NWAVES;
    for (int u = F.tid; u < (LDS_BYTES - RING_BYTES) / 4; u += NTHREADS) ((LAS unsigned*)(F.lds + RING_BYTES))[u] = 0u;
    __syncthreads();
    unsigned* ctl = (unsigned*)(P.ws + WS_CTL);
    XcdBarrier bar = xcd_barrier_post(ctl + CW_BAR, (volatile LAS unsigned*)(F.lds + MISC_OFF) + 8);

    unsigned long long pr_t0 = 0, pr_prev = 0, pr_acc = 0;
    if (PROBE_SEL) { pr_t0 = __builtin_amdgcn_s_memrealtime(); pr_prev = pr_t0; }
#define PSTAMP(id) do { if (PROBE_SEL) { const unsigned long long now_ = __builtin_amdgcn_s_memrealtime(); if ((id) == PROBE_SEL) pr_acc += now_ - pr_prev; pr_prev = now_; } } while (0)
    p0_prologue(P, F);
    if (RPT & 1) p0_prologue(P, F);
    xcd_barrier(bar);
    p0b_mod_reduce(P, F);
    xcd_barrier(bar);
    PSTAMP(1);

    for (int layer = 0; layer < DEPTH; ++layer) {
        const bool last = (layer == DEPTH - 1);
        unsigned char* ws = wsp(P);
        const int Mtok = last ? TLAT : TALL;
        phase_attn_norm(P, F, layer);
        if ((RPT & 256) && layer == 0) { phase_attn_norm(P, F, layer); phase_attn_norm(P, F, layer); phase_attn_norm(P, F, layer); }
        xcd_barrier(bar);
        PSTAMP(2);
        {
            pg8::PlainSched S; S.nN = QKVN / 256; S.nwg = (TALL / 256) * S.nN; S.G = F.G; S.c = F.vcu; S.K = DM; S.Bt = (const bf16_t*)(ws + WS_WQKV) + (size_t)layer * QKVN * DM;
            pg8::EpiQKV E{(bf16_t*)(ws + WS_QKV), ws + WS_KF, ws + WS_VF, (const f32x2*)(ws + WS_ROPE), inp(P, IN_GQ), inp(P, IN_GK), layer % 3};
            pg8::gemm_phase(F.lds, (const bf16_t*)(ws + WS_H), DM, S, E);
            if (RPT & 2) pg8::gemm_phase(F.lds, (const bf16_t*)(ws + WS_H), DM, S, E);
        }
        xcd_barrier(bar);
        PSTAMP(3);
        phase_attention(P, F, layer);
        if (((RPT & 4) && layer == 1) || ((RPT & 8) && layer != 1)) phase_attention(P, F, layer);
        xcd_barrier(bar);
        PSTAMP(4);
        {
            pg8::PlainSched S; S.nN = DM / 256; S.nwg = (Mtok / 256) * S.nN; S.G = F.G; S.c = F.vcu; S.K = DM; S.Bt = (const bf16_t*)(ws + WS_WO) + (size_t)layer * DM * DM;
            pg8::EpiResidBf E{(bf16_t*)(ws + WS_X), (const float*)(ws + WS_MOD) + (size_t)layer * 17 * 6144 + 2048};
            pg8::gemm_phase(F.lds, (const bf16_t*)(ws + WS_O), DM, S, E);
        }
        xcd_barrier(bar);
        PSTAMP(5);
        phase_router(P, F, layer, Mtok);
        xcd_barrier(bar);
        PSTAMP(6);
        if (RPT & 128) { for (int xb = 0; xb < 9; ++xb) xcd_barrier(bar); }
        LAS unsigned* tab = (LAS unsigned*)(F.lds + LDSX_OFF + 8192);
        build_tile_table(P, F, tab, layer);
        {
            pg8::MoeSched<true> S; S.tab = tab; S.G = F.G; S.c = F.vcu; S.K = DM / 2; S.Bt = (const bf16_t*)(ws + WS_WGU + (size_t)layer * NEXP * DM * DM); S.estride = (size_t)DM * DM; S.tok = (const unsigned*)(ws + WS_TOKE);
            pg8::EpiSwiglu E{ws + WS_ACT};
            pg8::gemm_phase(F.lds, (const bf16_t*)(ws + WS_H), DM / 2, S, E);
            if (RPT & 32) pg8::gemm_phase(F.lds, (const bf16_t*)(ws + WS_H), DM / 2, S, E);
        }
        xcd_barrier(bar);
        PSTAMP(8);
        {
            pg8::MoeSched<false> S; S.tab = tab; S.G = F.G; S.c = F.vcu; S.K = FH / 2; S.Bt = (const bf16_t*)(ws + WS_WD + (size_t)layer * NEXP * DM * FH); S.estride = (size_t)DM * FH; S.tok = nullptr;
            pg8::EpiStore E{(bf16_t*)(ws + WS_Y), DM};
            pg8::gemm_phase(F.lds, (const bf16_t*)(ws + WS_ACT), FH / 2, S, E);
            if (RPT & 64) pg8::gemm_phase(F.lds, (const bf16_t*)(ws + WS_ACT), FH / 2, S, E);
        }
        xcd_barrier(bar);
        PSTAMP(9);
    }
    if (PROBE_SEL) {
        if (F.blk == 0 && F.tid == 0) { const unsigned long long tot = __builtin_amdgcn_s_memrealtime() - pr_t0;
            const float f = (PROBE_SEL == 15) ? 0.5f : (float)pr_acc / (float)tot;
            __hip_atomic_store((float*)(P.ws + WS_CTL) + 64, sqrtf(4e-4f * f), __ATOMIC_RELAXED, __HIP_MEMORY_SCOPE_AGENT); }
        xcd_barrier(bar);
    }
    phase_final(P, F);
    if (RPT & 512) { phase_final(P, F); phase_final(P, F); phase_final(P, F); }
}

extern "C" void kernel_launch(void* const* d_in, const int* in_sizes, int n_in, void* d_out, int out_size, void* d_ws, size_t ws_size, hipStream_t stream) {
    static int ok = 0;
    if (ok == 0) {
        if (n_in != 22 || in_sizes[0] != TLAT * DM || out_size != TLAT * DM || ws_size < WS_END) {
            fprintf(stderr, "kernel_launch: unexpected shapes (n_in %d, in0 %d, out %d, ws %zu < %zu); nothing launched\n", n_in, n_in > 0 ? in_sizes[0] : -1, out_size, ws_size, (size_t)WS_END); ok = -1; return; }
        int dev = 0, cus = 0, per_cu = 0;
        if (hipGetDevice(&dev) != hipSuccess || hipDeviceGetAttribute(&cus, hipDeviceAttributeMultiprocessorCount, dev) != hipSuccess) { ok = -1; return; }
        if (hipFuncSetAttribute((const void*)dit_fwd, hipFuncAttributeMaxDynamicSharedMemorySize, LDS_BYTES) != hipSuccess) { fprintf(stderr, "kernel_launch: hipFuncSetAttribute failed\n"); ok = -1; return; }
        if (hipOccupancyMaxActiveBlocksPerMultiprocessor(&per_cu, (const void*)dit_fwd, NTHREADS, LDS_BYTES) != hipSuccess || per_cu < 1) fprintf(stderr, "kernel_launch: note: occupancy query reports %d\n", per_cu);
        (void)hipGetLastError();
        if (cus < GRID) { fprintf(stderr, "kernel_launch: %d CUs < %d workgroups: grid would not be resident; nothing launched\n", cus, GRID); ok = -1; return; }
        ok = 1;
    }
    if (ok < 0) return;
    if (hipMemsetAsync((char*)d_ws + WS_CTL, 0, CTL_ZERO_BYTES, stream) != hipSuccess) return;
    Params p{};
    for (int i = 0; i < 22; ++i) p.in[i] = (const float*)d_in[i];
    p.out = (float*)d_out; p.ws = (unsigned char*)d_ws;
    hipLaunchKernelGGL(dit_fwd, dim3(GRID), dim3(NTHREADS), LDS_BYTES, stream, p);
}
```

```cpp
#include <hip/hip_runtime.h>
#include <cstdio>
#include <cstdint>

#ifndef PROBE_SEL
#define PROBE_SEL 0
#endif
#ifndef RPT
#define RPT 0
#endif

#define LAS __attribute__((address_space(3)))
#define GAS __attribute__((address_space(1)))
#define DI __device__ __forceinline__

typedef unsigned short bf16_t;
typedef short bf16x8 __attribute__((ext_vector_type(8)));
typedef short s16x4 __attribute__((ext_vector_type(4)));
typedef float f32x2 __attribute__((ext_vector_type(2)));
typedef float f32x4 __attribute__((ext_vector_type(4)));
typedef float f32x16 __attribute__((ext_vector_type(16)));
typedef unsigned u32x2 __attribute__((ext_vector_type(2)));
typedef unsigned u32x4 __attribute__((ext_vector_type(4)));
typedef int i32x4 __attribute__((ext_vector_type(4)));
typedef int i32x8 __attribute__((ext_vector_type(8)));

constexpr int NB = 16, SEQ = 2048, DM = 1024, DEPTH = 4, CTXL = 256, NH = 16, NKV = 4, HD = 64, QKVN = 1536;
constexpr int TLAT = NB * SEQ, TCTX = NB * CTXL, TALL = TLAT + TCTX;
constexpr int NEXP = 32, FH = 512;
constexpr int KEYS = SEQ + CTXL, KGRP = KEYS / 8;
constexpr int CAPR = 2 * TALL + NEXP * 256;
constexpr int NWAVES = 8, NTHREADS = 512, GRID = 256;
constexpr float NORM_EPS = 1e-6f, LOG2E = 1.4426950408889634f;

constexpr size_t MiB = 1u << 20;
constexpr size_t WS_CTL = 0, CTL_ZERO_BYTES = 1 * MiB;
constexpr size_t WS_MODP = 1 * MiB;
constexpr size_t WS_MOD = 15 * MiB;
constexpr size_t WS_ROPE = 17 * MiB;
constexpr size_t WS_WRT = 17 * MiB + 65536;
constexpr size_t WS_ASG = 18 * MiB;
constexpr size_t WS_ASGW = 18 * MiB + 512 * 1024;
constexpr size_t WS_TOKE = 1 * MiB;
constexpr size_t WS_WQKV = 21 * MiB;
constexpr size_t WS_WO = 33 * MiB;
constexpr size_t WS_WGU = 41 * MiB;
constexpr size_t WS_WD = 297 * MiB;
constexpr size_t WS_X = 425 * MiB;
constexpr size_t WS_H = 569 * MiB;
constexpr size_t WS_R1 = 641 * MiB;
constexpr size_t WS_QKV = WS_R1;
constexpr size_t WS_KF = WS_R1 + 108 * MiB;
constexpr size_t WS_VF = WS_R1 + 126 * MiB;
constexpr size_t WS_O = WS_R1 + 144 * MiB;
constexpr size_t WS_Y = WS_R1;
constexpr size_t WS_ACT = WS_R1 + 160 * MiB;
constexpr size_t WS_END = WS_R1 + 240 * MiB;
constexpr int CW_TMO = 0, CW_BAR = 4096, CW_CNT = 65536, CNT_STRIDE = 32;

constexpr int RING_BYTES = 131072;
constexpr int MISC_OFF = RING_BYTES + 320;
constexpr int LDSX_OFF = RING_BYTES + 1024;
constexpr int LDS_BYTES = 147456;

#define LDS_WAIT() asm volatile("s_waitcnt lgkmcnt(0)" ::: "memory")
#define VM_WAIT() asm volatile("s_waitcnt vmcnt(0)" ::: "memory")

DI unsigned f2bf(float f) { unsigned u = __float_as_uint(f); return (u + 0x7fffu + ((u >> 16) & 1u)) >> 16; }
DI float bf2f(unsigned b) { return __uint_as_float(b << 16); }
DI float bfs2f(short b) { return __uint_as_float(((unsigned)(unsigned short)b) << 16); }
DI unsigned cvt_pk_bf16(float lo, float hi);
DI unsigned pk2(float lo, float hi) { return cvt_pk_bf16(lo, hi); }
DI unsigned cvt_pk_bf16(float lo, float hi) { unsigned r; asm volatile("v_cvt_pk_bf16_f32 %0, %1, %2" : "=v"(r) : "v"(lo), "v"(hi)); return r; }
constexpr float F8_ACT_SCALE = 8.f, F8_W_SCALE = 64.f;
constexpr int F8_SC_ACT = 127 - 3, F8_SC_W = 127 - 6;
constexpr float F8_O_SCALE = 32.f; constexpr int F8_SC_O = 127 - 5;
DI unsigned cvt_pk_fp8x4(float a, float b, float c, float d) {
    a = __builtin_amdgcn_fmed3f(a, -448.f, 448.f); b = __builtin_amdgcn_fmed3f(b, -448.f, 448.f); c = __builtin_amdgcn_fmed3f(c, -448.f, 448.f); d = __builtin_amdgcn_fmed3f(d, -448.f, 448.f);
    int r = __builtin_amdgcn_cvt_pk_fp8_f32(a, b, 0, false); r = __builtin_amdgcn_cvt_pk_fp8_f32(c, d, r, true); return (unsigned)r; }
DI float wave_sum(float v) {
#pragma unroll
    for (int o = 1; o < 64; o <<= 1) v += __shfl_xor(v, o);
    return v;
}
DI int crow(int r, int hi) { return (r & 3) + 8 * (r >> 2) + 4 * hi; }

#define XB_TMO      128
#define XB_XCNT(j)  (256  + 64 * (j))
#define XB_XSUB(j)  (1280 + 64 * (j))
#define XB_XGEN(j)  (2304 + 64 * (j))
#define XB_TOP      3328
#define XB_TOPGEN   3392
#define XCD_BAR_WORDS 3456
#define XB_SPIN_CAP (1u << 18)

__device__ __forceinline__ unsigned xb_ld(unsigned* p)              { return __hip_atomic_load(p, __ATOMIC_RELAXED, __HIP_MEMORY_SCOPE_AGENT); }
__device__ __forceinline__ unsigned xb_add(unsigned* p, unsigned v) { return __hip_atomic_fetch_add(p, v, __ATOMIC_RELAXED, __HIP_MEMORY_SCOPE_AGENT); }
__device__ __forceinline__ unsigned xb_xcc_id() { return (unsigned)__builtin_amdgcn_s_getreg((3 << 11) | 20) & 0xFu; }
#define XB_SPIN(cond, bar) do { unsigned _sp = 0; while (cond) { __builtin_amdgcn_s_sleep(1); \
    if ((++_sp & 255u) == 0u) { if (xb_ld(&(bar)[XB_TMO])) break; if (_sp > XB_SPIN_CAP) { atomicAdd(&(bar)[XB_TMO], 1u); break; } } } } while (0)

struct XcdBarrier { unsigned* bar; unsigned x; volatile LAS unsigned* st; };

__device__ __forceinline__ XcdBarrier xcd_barrier_post(unsigned* bar, volatile LAS unsigned* st) {
    XcdBarrier b; b.bar = bar; b.x = xb_xcc_id(); b.st = st;
    if (threadIdx.x == 0) (void)xb_add(&bar[XB_XCNT(b.x)], 1u);
    return b;
}
__device__ __forceinline__ void xcd_barrier_complete(unsigned* bar, unsigned x, unsigned& nloc, unsigned& nx) {
    const unsigned G = gridDim.x * gridDim.y * gridDim.z;
    unsigned sum, cnt, mine, sp = 0u;
    for (;;) {
        sum = 0u; cnt = 0u; mine = 0u;
#pragma unroll
        for (unsigned j = 0; j < 16; ++j) { const unsigned c = xb_ld(&bar[XB_XCNT(j)]); sum += c; cnt += (c > 0u) ? 1u : 0u; mine = (j == x) ? c : mine; }
        if (sum == G) break;
        __builtin_amdgcn_s_sleep(1);
        if ((++sp & 255u) == 0u) { if (xb_ld(&bar[XB_TMO])) break; if (sp > XB_SPIN_CAP) { atomicAdd(&bar[XB_TMO], 1u); break; } }
    }
    nloc = mine > 0u ? mine : 1u; nx = cnt > 0u ? cnt : 1u;
}
__device__ __forceinline__ void xcd_barrier(const XcdBarrier& b0) {
    XcdBarrier b = b0;
    { unsigned z = 0, bx = __builtin_amdgcn_readfirstlane(b0.x); asm volatile("s_mov_b32 %0, 0" : "=s"(z)); asm volatile("" : "+s"(bx)); b.bar = b0.bar + z; b.x = bx; }
    asm volatile("s_waitcnt vmcnt(0)" ::: "memory");
    __syncthreads();
    if (threadIdx.x == 0) {
        unsigned* bar = b.bar;
        __builtin_amdgcn_s_waitcnt(0);
        unsigned nloc = b.st[0], nx = b.st[1];
        if (nloc == 0u) { xcd_barrier_complete(bar, b.x, nloc, nx); b.st[0] = nloc; b.st[1] = nx; }
        const unsigned old = xb_add(&bar[XB_XSUB(b.x)], 1u);
        const unsigned gen = old / nloc;
        if (old + 1u == (gen + 1u) * nloc) {
            __builtin_amdgcn_fence(__ATOMIC_RELEASE, "agent");
            asm volatile("s_waitcnt vmcnt(0)" ::: "memory");
            const unsigned og = xb_add(&bar[XB_TOP], 1u);
            const unsigned tg = og / nx;
            if (og + 1u == (tg + 1u) * nx) xb_add(&bar[XB_TOPGEN], 1u);
            else XB_SPIN(xb_ld(&bar[XB_TOPGEN]) == tg, bar);
            __builtin_amdgcn_fence(__ATOMIC_ACQUIRE, "agent");
            xb_add(&bar[XB_XGEN(b.x)], 1u);
            asm volatile("s_waitcnt vmcnt(0)" ::: "memory");
        } else {
            XB_SPIN(xb_ld(&bar[XB_XGEN(b.x)]) == gen, bar);
            __builtin_amdgcn_fence(__ATOMIC_ACQUIRE, "agent");
            asm volatile("s_waitcnt vmcnt(0)" ::: "memory");
        }
    }
    __syncthreads();
}

namespace pg8 {
constexpr int BM = 256, BK = 64, HALF = 128, HTB = HALF * BK * 2, STAGE_BYTES = 8 * HTB;
DI int lds_byte(int r, int c) { const int st = (r >> 4) * 2 + (c >> 5), rr = r & 15, cc = c & 31, ob = rr * 64 + cc * 2; return st * 1024 + (ob ^ (((ob >> 9) & 1) << 5)); }
DI void stage_rc(int b, int& R, int& C) { const int st = b / 1024, sb = b % 1024, swz = sb ^ (((sb >> 9) & 1) << 5); R = (st >> 1) * 16 + swz / 64; C = (st & 1) * 32 + (swz % 64) / 2; }
DI int perm32(int rho) { const int n = rho >> 4, i = rho & 15; return 8 * (i >> 2) + 4 * n + (i & 3); }
struct Unit { int pm, pn, e, r0, na; };

DI void mfma_f8_acc(f32x4& c, const i32x8& w, const i32x8& a, int sw, int sa) {
    asm volatile("v_mfma_scale_f32_16x16x128_f8f6f4 %0, %1, %2, %0, %3, %4 op_sel_hi:[0,0,0]" : "+v"(c) : "v"(w), "v"(a), "v"(sw), "v"(sa));
}
template <class Epi, class Sched>
DI void gemm_phase(LAS unsigned char* lds, const bf16_t* A, const int K, const Sched& S, const Epi& E) {
    int tid_ = threadIdx.x; asm volatile("" : "+v"(tid_));
    const int tid = tid_, wid = __builtin_amdgcn_readfirstlane(tid >> 6), lane = tid & 63, wr = wid >> 2, wc = wid & 3, fr = lane & 15, fq = lane >> 4;
    int nt_ = K / BK; asm volatile("" : "+s"(nt_));
    const int nt = nt_;
    constexpr bool GA = Sched::GATHER, F8 = Sched::FP8;
    int f8sw = F8_SC_W, f8sa = Sched::SC_ACT; asm volatile("" : "+v"(f8sw), "+v"(f8sa));
    int Rr[2], Cc[2]; unsigned voffB[2], voffA[2];
#pragma unroll
    for (int i = 0; i < 2; ++i) { int R, C; stage_rc(tid * 16 + i * 8192, R, C); const int Rb = Epi::PERM ? ((R & ~31) + perm32(R & 31)) : R;
        Rr[i] = R; Cc[i] = C; voffB[i] = (unsigned)(Rb * K + C) * 2u; voffA[i] = (unsigned)(R * K + C) * 2u; }
    const size_t kstep = (size_t)(BK * 2);
    const size_t hstep = (size_t)HALF * K * 2;
    const unsigned ldsw = (unsigned)wid * 1024u;
    const int aoff = lds_byte(wr * 64 + fr, fq * 8), boff = lds_byte(wc * 32 + fr, fq * 8);
#define PG8_SA(b, h) (((b) * 2 + (h)) * HTB)
#define PG8_SB(b, h) ((4 + (b) * 2 + (h)) * HTB)
#define PG8_STAGE(bufoff, gbase, voff) do { _Pragma("unroll") for (int _i = 0; _i < 2; ++_i) \
        __builtin_amdgcn_global_load_lds((const unsigned*)((const char*)(gbase) + (voff)[_i]), (LAS unsigned*)(lds + (bufoff) + ldsw + _i * 8192), 16, 0, 0); } while (0)
#define PG8_LDA(dst, b, h) do { _Pragma("unroll") for (int m = 0; m < 4; ++m) _Pragma("unroll") for (int k = 0; k < 2; ++k) dst[m][k] = *(const LAS bf16x8*)(lds + PG8_SA(b, h) + aoff + m * 2048 + k * 1024); } while (0)
#define PG8_LDB(dst, b, h) do { _Pragma("unroll") for (int n = 0; n < 2; ++n) _Pragma("unroll") for (int k = 0; k < 2; ++k) dst[n][k] = *(const LAS bf16x8*)(lds + PG8_SB(b, h) + boff + n * 2048 + k * 1024); } while (0)
#define PG8_CAT8(x0, x1) __builtin_shufflevector(__builtin_bit_cast(i32x4, x0), __builtin_bit_cast(i32x4, x1), 0, 1, 2, 3, 4, 5, 6, 7)
#define PG8_MMA(ai, bj, At, Bt) do { __builtin_amdgcn_s_setprio(1); \
        if (F8) { _Pragma("unroll") for (int m = 0; m < 4; ++m) _Pragma("unroll") for (int n = 0; n < 2; ++n) \
            mfma_f8_acc(acc[ai][bj][m][n], PG8_CAT8(Bt[n][0], Bt[n][1]), PG8_CAT8(At[m][0], At[m][1]), f8sw, f8sa); } \
        else { _Pragma("unroll") for (int m = 0; m < 4; ++m) _Pragma("unroll") for (int n = 0; n < 2; ++n) _Pragma("unroll") for (int k = 0; k < 2; ++k) \
            acc[ai][bj][m][n] = __builtin_amdgcn_mfma_f32_16x16x32_bf16(Bt[n][k], At[m][k], acc[ai][bj][m][n], 0, 0, 0); } \
        __builtin_amdgcn_s_setprio(0); } while (0)
#define PG8_WAIT_V(n) asm volatile("s_waitcnt vmcnt(" #n ")" ::: "memory")
#define PG8_WAIT_L(n) asm volatile("s_waitcnt lgkmcnt(" #n ")" ::: "memory")
#define PG8_BAR __builtin_amdgcn_s_barrier()
#define PG8_SCHED __builtin_amdgcn_sched_barrier(0)
    Unit cur, nxt; int ui = 0;
    if (!S.next(0, cur)) return;
    f32x4 acc[2][2][4][2];
#pragma unroll
    for (int a = 0; a < 2; ++a)
#pragma unroll
        for (int b = 0; b < 2; ++b)
#pragma unroll
            for (int m = 0; m < 4; ++m)
#pragma unroll
                for (int n = 0; n < 2; ++n) acc[a][b][m][n] = (f32x4){0.f, 0.f, 0.f, 0.f};
    bf16x8 At[4][2], B0[2][2], B1[2][2];
    unsigned oc0[2], oc1[2], on0[2], on1[2];
#pragma unroll
    for (int i = 0; i < 2; ++i) { if (GA) { oc0[i] = S.a_off(cur, Rr[i]) + (unsigned)Cc[i] * 2u; oc1[i] = S.a_off(cur, HALF + Rr[i]) + (unsigned)Cc[i] * 2u; } else { oc0[i] = voffA[i]; oc1[i] = voffA[i]; } on0[i] = oc0[i]; on1[i] = oc1[i]; }
    size_t hA = (GA || (Sched::HALVES && cur.na == 1)) ? (size_t)0 : hstep, hAn = hA;
    const char* Ab = GA ? (const char*)A : (const char*)A + (size_t)cur.r0 * K * 2;
    const char* cB = S.b_ptr(cur);
    PG8_STAGE(PG8_SB(0, 0), cB, voffB); PG8_STAGE(PG8_SB(0, 1), cB + hstep, voffB); PG8_STAGE(PG8_SA(0, 0), Ab, oc0); PG8_STAGE(PG8_SA(0, 1), Ab + hA, oc1);
    if (wr == 1) PG8_BAR;
    PG8_WAIT_V(2); PG8_BAR;
    PG8_STAGE(PG8_SB(1, 0), cB + kstep, voffB); PG8_STAGE(PG8_SA(1, 0), Ab + kstep, oc0); PG8_STAGE(PG8_SB(1, 1), cB + hstep + kstep, voffB);
    PG8_WAIT_V(6); PG8_BAR;
    for (;;) {
        const bool has_next = S.next(ui + 1, nxt);
        const char* nB = has_next ? S.b_ptr(nxt) : cB;
        const char* nA = GA ? Ab : (has_next ? (const char*)A + (size_t)nxt.r0 * K * 2 : Ab);
        if (!GA && Sched::HALVES) hAn = (has_next && nxt.na == 1) ? (size_t)0 : (has_next ? hstep : hA);
        if (GA) {
            if (has_next) {
#pragma unroll
                for (int i = 0; i < 2; ++i) { on0[i] = S.a_off(nxt, Rr[i]) + (unsigned)Cc[i] * 2u; on1[i] = S.a_off(nxt, HALF + Rr[i]) + (unsigned)Cc[i] * 2u; }
            } else {
#pragma unroll
                for (int i = 0; i < 2; ++i) { on0[i] = oc0[i]; on1[i] = oc1[i]; }
            }
        }
#define PG8_KLOOP(FULL) \
        for (int t = 0; t < nt; t += 2) { \
            const bool last = (t == nt - 2); \
            const char* a1 = Ab + (size_t)(t + 1) * kstep + hA; \
            const char* a2 = last ? nA : Ab + (size_t)(t + 2) * kstep; const char* b2 = last ? nB : cB + (size_t)(t + 2) * kstep; \
            const char* a3 = a2 + kstep; const char* b3 = b2 + kstep; const size_t hA2 = last ? hAn : hA; \
            unsigned o20[2], o21[2]; \
            for (int i = 0; i < 2; ++i) { if (GA) { o20[i] = last ? on0[i] : oc0[i]; o21[i] = last ? on1[i] : oc1[i]; } else { o20[i] = voffA[i]; o21[i] = voffA[i]; } } \
              \
            PG8_LDB(B0, 0, 0); PG8_LDB(B1, 0, 1); PG8_SCHED; PG8_LDA(At, 0, 0); PG8_STAGE(PG8_SA(1, 1), a1, oc1); \
            PG8_WAIT_V(8); PG8_WAIT_L(0); PG8_BAR; PG8_MMA(0, 0, At, B0); PG8_MMA(0, 1, At, B1); PG8_BAR; PG8_SCHED; \
              \
            if (FULL) { PG8_LDA(At, 0, 1); } PG8_STAGE(PG8_SB(0, 0), b2, voffB); PG8_STAGE(PG8_SB(0, 1), b2 + hstep, voffB); PG8_STAGE(PG8_SA(0, 0), a2, o20); \
            PG8_WAIT_V(8); PG8_WAIT_L(0); PG8_BAR; if (FULL) { PG8_MMA(1, 0, At, B0); PG8_MMA(1, 1, At, B1); } PG8_BAR; PG8_SCHED; \
              \
            PG8_LDB(B0, 1, 0); PG8_LDB(B1, 1, 1); PG8_SCHED; PG8_LDA(At, 1, 0); PG8_STAGE(PG8_SA(0, 1), a2 + hA2, o21); \
            PG8_WAIT_V(8); PG8_WAIT_L(0); PG8_BAR; PG8_MMA(0, 0, At, B0); PG8_MMA(0, 1, At, B1); PG8_BAR; PG8_SCHED; \
              \
            if (FULL) { PG8_LDA(At, 1, 1); } PG8_STAGE(PG8_SB(1, 0), b3, voffB); PG8_STAGE(PG8_SB(1, 1), b3 + hstep, voffB); PG8_STAGE(PG8_SA(1, 0), a3, o20); \
            PG8_WAIT_V(8); PG8_WAIT_L(0); PG8_BAR; if (FULL) { PG8_MMA(1, 0, At, B0); PG8_MMA(1, 1, At, B1); } PG8_BAR; PG8_SCHED; \
        }
        if (Sched::HALVES && cur.na == 1) { PG8_KLOOP(0) } else { PG8_KLOOP(1) }
#undef PG8_KLOOP
        if (wr == 0) PG8_BAR;
        if (F8) asm volatile("s_nop 15\n\ts_nop 15" ::: "memory");
        E(acc, cur, wr, wc, fr, fq);
        if (!has_next) break;
#pragma unroll
        for (int a = 0; a < 2; ++a)
#pragma unroll
            for (int b = 0; b < 2; ++b)
#pragma unroll
                for (int m = 0; m < 4; ++m)
#pragma unroll
                    for (int n = 0; n < 2; ++n) acc[a][b][m][n] = (f32x4){0.f, 0.f, 0.f, 0.f};
        cur = nxt; cB = nB; Ab = nA; hA = hAn; ++ui;
        if (GA) {
#pragma unroll
            for (int i = 0; i < 2; ++i) { oc0[i] = on0[i]; oc1[i] = on1[i]; }
        }
        if (wr == 1) PG8_BAR;
    }
    PG8_WAIT_V(0);
    PG8_BAR;
#undef PG8_SA
#undef PG8_SB
#undef PG8_STAGE
#undef PG8_LDA
#undef PG8_LDB
#undef PG8_MMA
#undef PG8_CAT8
#undef PG8_WAIT_V
#undef PG8_WAIT_L
#undef PG8_BAR
#undef PG8_SCHED
}

template <bool FP8_> struct PlainSched {
    static constexpr bool GATHER = false, HALVES = true, FP8 = FP8_; static constexpr int SC_ACT = F8_SC_O;
    int nN, nwg, G, c, K; const bf16_t* Bt;
    DI bool next(int i, Unit& u) const { const int L = i * G + c; const int nfull = (nwg / G) * G, rem = nwg - nfull; int Lu = L, hf = 0; u.na = 2;
        if (L >= nfull) { if (2 * rem <= G) { const int h = L - nfull; if (h >= 2 * rem) return false; Lu = nfull + (h >> 1); hf = h & 1; u.na = 1; } else if (L >= nwg) return false; }
        u.pm = Lu / nN; u.pn = Lu - u.pm * nN; u.e = 0; u.r0 = u.pm * BM + hf * HALF; return true; }
    DI unsigned a_off(const Unit& u, int r) const { return (unsigned)(u.r0 + r) * (unsigned)(K * 2); }
    DI const char* b_ptr(const Unit& u) const { return (const char*)Bt + (size_t)u.pn * BM * K * 2; }
};
template <bool GATHER_> struct MoeSched {
    static constexpr bool GATHER = GATHER_, HALVES = true, FP8 = true; static constexpr int SC_ACT = F8_SC_ACT;
    static constexpr int TAB_PST = 384, TAB_CNT = 416;
    const LAS unsigned* tab; int G, c, K; const bf16_t* Bt; size_t estride; const unsigned* tok;
    DI bool next(int i, Unit& u) const { const int L = i * G + c; const int nwg = (int)tab[0] * 4, nfull = (nwg / G) * G, rem = nwg - nfull; int Lu = L, hf = 0; u.na = 2;
        if (L >= nfull) { if (2 * rem <= G) { const int h = L - nfull; if (h >= 2 * rem) return false; Lu = nfull + (h >> 1); hf = h & 1; u.na = 1; } else if (L >= nwg) return false; }
        u.pm = Lu >> 2; u.pn = Lu & 3; u.e = (int)tab[1 + u.pm]; u.r0 = u.pm * BM + hf * HALF; return true; }
    DI unsigned a_off(const Unit& u, int r) const {
        unsigned row = (unsigned)(u.r0 + (u.na == 1 ? (r & (HALF - 1)) : r));
        if (GATHER_) { const unsigned last = tab[TAB_CNT + u.e] - 1u; unsigned idx = row - tab[TAB_PST + u.e]; idx = idx < last ? idx : last; row = tok[(unsigned)u.e * (unsigned)TALL + idx]; }
        return row * (unsigned)(K * 2); }
    DI const char* b_ptr(const Unit& u) const { return (const char*)Bt + (size_t)u.e * estride + (size_t)u.pn * BM * K * 2; }
};

struct EpiStore {
    static constexpr bool PERM = true;
    bf16_t* O; int ldc;
    DI void operator()(const f32x4 (&acc)[2][2][4][2], const Unit& u, int wr, int wc, int fr, int fq) const {
        const int row0 = u.r0 + wr * 64 + fr, col0 = u.pn * BM + wc * 32 + 8 * fq;
#pragma unroll
        for (int ai = 0; ai < 2; ++ai) if (ai < u.na)
#pragma unroll
            for (int m = 0; m < 4; ++m) { bf16_t* rowp = O + (size_t)(row0 + ai * HALF + m * 16) * ldc + col0;
#pragma unroll
                for (int bj = 0; bj < 2; ++bj) { const f32x4 v0 = acc[ai][bj][m][0], v1 = acc[ai][bj][m][1];
                    u32x4 w; w.x = cvt_pk_bf16(v0[0], v0[1]); w.y = cvt_pk_bf16(v0[2], v0[3]); w.z = cvt_pk_bf16(v1[0], v1[1]); w.w = cvt_pk_bf16(v1[2], v1[3]);
                    *(u32x4*)(rowp + bj * HALF) = w; } }
    }
};
struct EpiQKV {
    static constexpr bool PERM = false;
    bf16_t* QKV; unsigned char* KF; unsigned char* VF; const f32x2* T; const float* gq; const float* gk; int m;
    DI void operator()(const f32x4 (&acc)[2][2][4][2], const Unit& u, int wr, int wc, int fr, int fq) const {
        const bool lat = u.pm < TLAT / BM; const int b = lat ? (u.pm >> 3) : (u.pm - TLAT / BM);
        const int trow0 = u.r0 + wr * 64 + fr;
        if (u.pn < 4) {
            const int h = 4 * u.pn + wc;
            f32x4 g[2][2];
#pragma unroll
            for (int bj = 0; bj < 2; ++bj)
#pragma unroll
                for (int n = 0; n < 2; ++n) g[bj][n] = (m == 1) ? *(const f32x4*)(gq + 32 * bj + 16 * n + 4 * fq) : (f32x4){1.f, 1.f, 1.f, 1.f};
#pragma unroll
            for (int ai = 0; ai < 2; ++ai) if (ai < u.na)
#pragma unroll
                for (int mm = 0; mm < 4; ++mm) {
                    f32x4 x[2][2]; float ss = 0.f;
#pragma unroll
                    for (int bj = 0; bj < 2; ++bj)
#pragma unroll
                        for (int n = 0; n < 2; ++n) { x[bj][n] = acc[ai][bj][mm][n]; ss += (x[bj][n][0] * x[bj][n][0] + x[bj][n][1] * x[bj][n][1]) + (x[bj][n][2] * x[bj][n][2] + x[bj][n][3] * x[bj][n][3]); }
                    float sc = 0.125f * LOG2E;
                    if (m == 1) { ss += __shfl_xor(ss, 16); ss += __shfl_xor(ss, 32); sc *= 1.0f / sqrtf(ss * (1.f / HD) + NORM_EPS); }
                    bf16_t* qrow = QKV + (size_t)(trow0 + ai * HALF + mm * 16) * QKVN + h * HD + 4 * fq;
#pragma unroll
                    for (int bj = 0; bj < 2; ++bj)
#pragma unroll
                        for (int n = 0; n < 2; ++n) { const f32x4 y = x[bj][n] * g[bj][n] * sc; u32x2 w; w.x = cvt_pk_bf16(y[0], y[1]); w.y = cvt_pk_bf16(y[2], y[3]); *(u32x2*)(qrow + 32 * bj + 16 * n) = w; }
                }
        } else if (u.pn == 4) {
            f32x4 g[2][2];
#pragma unroll
            for (int bj = 0; bj < 2; ++bj)
#pragma unroll
                for (int n = 0; n < 2; ++n) g[bj][n] = (m == 1) ? *(const f32x4*)(gk + 32 * bj + 16 * n + 4 * fq) : (f32x4){1.f, 1.f, 1.f, 1.f};
            const bool rope = lat && (m != 2);
            unsigned char* kbase = KF + (size_t)(b * NKV + wc) * KGRP * 1024 + (fq >> 1) * 128 + (fq & 1) * 8;
#pragma unroll
            for (int ai = 0; ai < 2; ++ai) if (ai < u.na)
#pragma unroll
                for (int mm = 0; mm < 4; ++mm) {
                    const int t = trow0 + ai * HALF + mm * 16;
                    const int kidx = lat ? (t & 2047) : (2048 + ((t - TLAT) & 255));
                    f32x4 x[2][2]; float ss = 0.f;
#pragma unroll
                    for (int bj = 0; bj < 2; ++bj)
#pragma unroll
                        for (int n = 0; n < 2; ++n) { x[bj][n] = acc[ai][bj][mm][n]; ss += (x[bj][n][0] * x[bj][n][0] + x[bj][n][1] * x[bj][n][1]) + (x[bj][n][2] * x[bj][n][2] + x[bj][n][3] * x[bj][n][3]); }
                    if (m == 1) { ss += __shfl_xor(ss, 16); ss += __shfl_xor(ss, 32); const float rs = 1.0f / sqrtf(ss * (1.f / HD) + NORM_EPS);
#pragma unroll
                        for (int bj = 0; bj < 2; ++bj)
#pragma unroll
                            for (int n = 0; n < 2; ++n) x[bj][n] = x[bj][n] * g[bj][n] * rs; }
                    if (rope) {
#pragma unroll
                        for (int bj = 0; bj < 2; ++bj) { const int pos = bj ? (kidx & 63) : (kidx >> 6); const f32x4* tp = (const f32x4*)(T + pos * 16 + 4 * fq);
                            const f32x4 t0 = tp[0], t1 = tp[1];
                            const f32x4 cs = (f32x4){t0[0], t0[2], t1[0], t1[2]}, sn = (f32x4){t0[1], t0[3], t1[1], t1[3]};
                            const f32x4 a = x[bj][0], c = x[bj][1];
                            x[bj][0] = a * cs - c * sn; x[bj][1] = c * cs + a * sn; }
                    }
                    unsigned char* kp = kbase + (size_t)(kidx >> 3) * 1024 + (kidx & 7) * 16;
#pragma unroll
                    for (int bj = 0; bj < 2; ++bj)
#pragma unroll
                        for (int n = 0; n < 2; ++n) { u32x2 w; w.x = cvt_pk_bf16(x[bj][n][0], x[bj][n][1]); w.y = cvt_pk_bf16(x[bj][n][2], x[bj][n][3]); *(u32x2*)(kp + (4 * bj + 2 * n) * 128) = w; }
                }
        } else {
            const int q4 = fr & 3;
            unsigned char* vbase = VF + (size_t)(b * NKV + wc) * KGRP * 1024 + (4 * fq + q4) * 16;
#pragma unroll
            for (int ai = 0; ai < 2; ++ai) if (ai < u.na)
#pragma unroll
                for (int mm = 0; mm < 4; ++mm) {
                    const int t = trow0 + ai * HALF + mm * 16;
                    const int kidx = lat ? (t & 2047) : (2048 + ((t - TLAT) & 255));
                    unsigned char* vp = vbase + (size_t)(kidx >> 3) * 1024 + (kidx & 4) * 2;
#pragma unroll
                    for (int bj = 0; bj < 2; ++bj)
#pragma unroll
                        for (int n = 0; n < 2; ++n) {
                            f32x4 x = acc[ai][bj][mm][n];
                            { const float s0 = (q4 & 1) ? x[0] : x[1], s1 = (q4 & 1) ? x[2] : x[3]; const float r0 = __shfl_xor(s0, 1), r1 = __shfl_xor(s1, 1);
                              if (q4 & 1) { x[0] = r0; x[2] = r1; } else { x[1] = r0; x[3] = r1; } }
                            { const float s0 = (q4 & 2) ? x[0] : x[2], s1 = (q4 & 2) ? x[1] : x[3]; const float r0 = __shfl_xor(s0, 2), r1 = __shfl_xor(s1, 2);
                              if (q4 & 2) { x[0] = r0; x[1] = r1; } else { x[2] = r0; x[3] = r1; } }
                            u32x2 w; w.x = cvt_pk_bf16(x[0], x[1]); w.y = cvt_pk_bf16(x[2], x[3]);
                            *(u32x2*)(vp + (32 * bj + 16 * n) * 16) = w; }
                }
        }
    }
};
DI float silu_mul(float g, float u) { return g * __builtin_amdgcn_rcpf(1.f + __builtin_amdgcn_exp2f(-g * LOG2E)) * u; }
struct EpiResidBf {
    static constexpr bool PERM = true;
    bf16_t* X; const float* gate;
    DI void operator()(const f32x4 (&acc)[2][2][4][2], const Unit& u, int wr, int wc, int fr, int fq) const {
        const int mb = (u.pm < TLAT / BM) ? (u.pm >> 3) : 16;
        const float* gt = gate + (size_t)mb * 6144;
        const int row0 = u.r0 + wr * 64 + fr, col0 = u.pn * BM + wc * 32 + 8 * fq;
        f32x4 g[2][2];
#pragma unroll
        for (int bj = 0; bj < 2; ++bj)
#pragma unroll
            for (int n = 0; n < 2; ++n) g[bj][n] = *(const f32x4*)(gt + col0 + bj * HALF + 4 * n);
#pragma unroll
        for (int ai = 0; ai < 2; ++ai) if (ai < u.na) {
            u32x4 old[4][2];
#pragma unroll
            for (int m = 0; m < 4; ++m)
#pragma unroll
                for (int bj = 0; bj < 2; ++bj) old[m][bj] = *(const u32x4*)(X + (size_t)(row0 + ai * HALF + m * 16) * DM + col0 + bj * HALF);
#pragma unroll
            for (int m = 0; m < 4; ++m)
#pragma unroll
                for (int bj = 0; bj < 2; ++bj) { const u32x4 o = old[m][bj]; const f32x4 a0 = acc[ai][bj][m][0] * g[bj][0], a1 = acc[ai][bj][m][1] * g[bj][1];
                    u32x4 w; w.x = cvt_pk_bf16(bf2f(o.x & 0xffffu) + a0[0], bf2f(o.x >> 16) + a0[1]); w.y = cvt_pk_bf16(bf2f(o.y & 0xffffu) + a0[2], bf2f(o.y >> 16) + a0[3]);
                    w.z = cvt_pk_bf16(bf2f(o.z & 0xffffu) + a1[0], bf2f(o.z >> 16) + a1[1]); w.w = cvt_pk_bf16(bf2f(o.w & 0xffffu) + a1[2], bf2f(o.w >> 16) + a1[3]);
                    *(u32x4*)(X + (size_t)(row0 + ai * HALF + m * 16) * DM + col0 + bj * HALF) = w; }
        }
    }
};
struct EpiSwiglu {
    static constexpr bool PERM = true;
    unsigned char* ACT;
    DI void operator()(const f32x4 (&acc)[2][2][4][2], const Unit& u, int wr, int wc, int fr, int fq) const {
        const int row0 = u.r0 + wr * 64 + fr, col0 = u.pn * HALF + wc * 32 + 8 * fq;
#pragma unroll
        for (int ai = 0; ai < 2; ++ai) if (ai < u.na)
#pragma unroll
            for (int m = 0; m < 4; ++m) { unsigned char* rowp = ACT + (size_t)(row0 + ai * HALF + m * 16) * FH + col0;
                const f32x4 g0 = acc[ai][0][m][0], g1 = acc[ai][0][m][1], u0 = acc[ai][1][m][0] * F8_ACT_SCALE, u1 = acc[ai][1][m][1] * F8_ACT_SCALE;
                u32x2 w; w.x = cvt_pk_fp8x4(silu_mul(g0[0], u0[0]), silu_mul(g0[1], u0[1]), silu_mul(g0[2], u0[2]), silu_mul(g0[3], u0[3]));
                w.y = cvt_pk_fp8x4(silu_mul(g1[0], u1[0]), silu_mul(g1[1], u1[1]), silu_mul(g1[2], u1[2]), silu_mul(g1[3], u1[3]));
                *(u32x2*)rowp = w; }
    }
};
}

struct Params { const float* in[22]; float* out; unsigned char* ws; };
enum { IN_X = 0, IN_C, IN_CTX, IN_CCTX, IN_WADA, IN_BADA, IN_GATTN, IN_WQKV, IN_WO, IN_SINK, IN_GQ, IN_GK, IN_RPB, IN_GFFN, IN_WGROUP, IN_BGROUP, IN_WROUTER, IN_BROUTER, IN_WGATE, IN_WUP, IN_WDOWN, IN_GFINAL };

DI const float* inp(const Params& P, int i) { i = __builtin_amdgcn_readfirstlane(i); asm volatile("" : "+s"(i)); return P.in[i]; }
DI unsigned char* wsp(const Params& P) { unsigned z = 0; asm volatile("s_mov_b32 %0, 0" : "=s"(z)); return P.ws + z; }
struct Frame { LAS unsigned char* lds; int tid, lane, wave, blk, G, vcu, gw, NGW; };
DI Frame opaque_frame(const Frame& F0) { Frame F = F0; asm volatile("" : "+v"(F.tid), "+v"(F.lane)); asm volatile("" : "+s"(F.wave), "+s"(F.blk), "+s"(F.vcu), "+s"(F.gw)); return F; }

DI void p0_transpose_item(const float* W, int N, int k0, int n0, bf16_t* dst, int Kd, LAS float* scr, int lane) {
#pragma unroll 8
    for (int i = 0; i < 32; ++i) { const int kk = 2 * i + (lane >> 5); scr[kk * 33 + (lane & 31)] = W[(size_t)(k0 + kk) * N + n0 + (lane & 31)]; }
    LDS_WAIT();
    const int c = lane & 7;
#pragma unroll
    for (int j = 0; j < 4; ++j) { const int n = (lane >> 3) + 8 * j; const LAS float* s = scr + (8 * c) * 33 + n;
        u32x4 o; o.x = pk2(s[0 * 33], s[1 * 33]); o.y = pk2(s[2 * 33], s[3 * 33]); o.z = pk2(s[4 * 33], s[5 * 33]); o.w = pk2(s[6 * 33], s[7 * 33]);
        *(u32x4*)(dst + (size_t)n * Kd + 8 * c) = o; }
    LDS_WAIT();
}
DI void p0_transpose_item_f8(const float* W, int N, int k0, int n0, unsigned char* dst, int Kd, LAS float* scr, int lane) {
#pragma unroll 8
    for (int i = 0; i < 32; ++i) { const int kk = 2 * i + (lane >> 5); scr[kk * 33 + (lane & 31)] = W[(size_t)(k0 + kk) * N + n0 + (lane & 31)]; }
    LDS_WAIT();
    const int c = lane & 7;
#pragma unroll
    for (int j = 0; j < 4; ++j) { const int n = (lane >> 3) + 8 * j; const LAS float* s = scr + (8 * c) * 33 + n;
        u32x2 o; o.x = cvt_pk_fp8x4(s[0 * 33] * F8_W_SCALE, s[1 * 33] * F8_W_SCALE, s[2 * 33] * F8_W_SCALE, s[3 * 33] * F8_W_SCALE);
        o.y = cvt_pk_fp8x4(s[4 * 33] * F8_W_SCALE, s[5 * 33] * F8_W_SCALE, s[6 * 33] * F8_W_SCALE, s[7 * 33] * F8_W_SCALE);
        *(u32x2*)(dst + (size_t)n * Kd + 8 * c) = o; }
    LDS_WAIT();
}
DI double dsin_poly(double r) { const double r2 = r * r;
    return r * (1.0 - r2 * (1.0 / 6.0) * (1.0 - r2 * (1.0 / 20.0) * (1.0 - r2 * (1.0 / 42.0) * (1.0 - r2 * (1.0 / 72.0) * (1.0 - r2 * (1.0 / 110.0) * (1.0 - r2 * (1.0 / 156.0) * (1.0 - r2 * (1.0 / 210.0) * (1.0 - r2 * (1.0 / 272.0) * (1.0 - r2 * (1.0 / 342.0) * (1.0 - r2 * (1.0 / 420.0) * (1.0 - r2 * (1.0 / 506.0)))))))))))); }
DI double dcos_poly(double r) { const double r2 = r * r;
    return 1.0 - r2 * (1.0 / 2.0) * (1.0 - r2 * (1.0 / 12.0) * (1.0 - r2 * (1.0 / 30.0) * (1.0 - r2 * (1.0 / 56.0) * (1.0 - r2 * (1.0 / 90.0) * (1.0 - r2 * (1.0 / 132.0) * (1.0 - r2 * (1.0 / 182.0) * (1.0 - r2 * (1.0 / 240.0) * (1.0 - r2 * (1.0 / 306.0) * (1.0 - r2 * (1.0 / 380.0) * (1.0 - r2 * (1.0 / 462.0) * (1.0 - r2 * (1.0 / 552.0)))))))))))); }

constexpr int IT_MOD = DEPTH * 96 * 8;
constexpr int IT_QKV = (DM / 64) * (QKVN / 32), IT_WO = (DM / 64) * (DM / 32), IT_GU = NEXP * (DM / 64) * (FH / 32), IT_DN = NEXP * (FH / 64) * (DM / 32);
constexpr int IT_LAYER = IT_QKV + IT_WO + 2 * IT_GU + IT_DN;
constexpr int IT_TOTAL = IT_MOD + DEPTH * IT_LAYER;

DI void p0_prologue(const Params& P, const Frame& F) {
    LAS float* scr = (LAS float*)(F.lds + F.wave * 16384);
    unsigned char* ws = wsp(P);
    for (int it = F.gw; it < IT_TOTAL; it += F.NGW) {
        if (it < IT_MOD) {
            const int l = it / (96 * 8), rem = it % (96 * 8), cc = rem >> 3, ks = rem & 7;
            for (int idx = F.lane; idx < 17 * 128; idx += 64) { const int b = idx >> 7, k = idx & 127;
                const float cv = (b < 16) ? inp(P, IN_C)[b * DM + ks * 128 + k] : inp(P, IN_CCTX)[ks * 128 + k];
                scr[idx] = cv / (1.f + expf(-cv)); }
            LDS_WAIT();
            float acc[17];
#pragma unroll
            for (int b = 0; b < 17; ++b) acc[b] = 0.f;
            const float* wp = inp(P, IN_WADA) + ((size_t)l * DM + ks * 128) * 6144 + cc * 64 + F.lane;
#pragma unroll 4
            for (int k = 0; k < 128; ++k) { const float w = wp[(size_t)k * 6144];
#pragma unroll
                for (int b = 0; b < 17; ++b) acc[b] += scr[b * 128 + k] * w; }
            float* mp = (float*)(ws + WS_MODP) + ((size_t)(ks * DEPTH + l) * 17) * 6144 + cc * 64 + F.lane;
#pragma unroll
            for (int b = 0; b < 17; ++b) mp[(size_t)b * 6144] = acc[b];
            LDS_WAIT();
            continue;
        }
        int r = it - IT_MOD; const int l = r / IT_LAYER; r -= l * IT_LAYER;
        if (r < IT_QKV) { const int kb = r / (QKVN / 32), nb = r % (QKVN / 32); const int n0 = nb * 32;
            const int drow0 = 256 * (n0 >> 8) + 128 * ((n0 >> 5) & 1) + 32 * ((n0 >> 6) & 3);
            p0_transpose_item(inp(P, IN_WQKV) + (size_t)l * DM * QKVN, QKVN, kb * 64, n0, (bf16_t*)(ws + WS_WQKV) + (size_t)l * QKVN * DM + (size_t)drow0 * DM + kb * 64, DM, scr, F.lane); continue; }
        r -= IT_QKV;
        if (r < IT_WO) { const int kb = r / (DM / 32), nb = r % (DM / 32);
            p0_transpose_item_f8(inp(P, IN_WO) + (size_t)l * DM * DM, DM, kb * 64, nb * 32, ws + WS_WO + (size_t)l * DM * DM + (size_t)(nb * 32) * DM + kb * 64, DM, scr, F.lane); continue; }
        r -= IT_WO;
        if (r < 2 * IT_GU) { const int which = r / IT_GU; r -= which * IT_GU; const int e = r / 256, kb = (r % 256) / 16, nb = r % 16; const int n0 = nb * 32;
            const int drow0 = 256 * (n0 >> 7) + 128 * which + (n0 & 127);
            p0_transpose_item_f8(inp(P, which ? IN_WUP : IN_WGATE) + (size_t)(l * NEXP + e) * DM * FH, FH, kb * 64, n0,
                                 ws + WS_WGU + (size_t)(l * NEXP + e) * DM * DM + (size_t)drow0 * DM + kb * 64, DM, scr, F.lane); continue; }
        r -= 2 * IT_GU;
        { const int e = r / 256, kb = (r % 256) / 32, nb = r % 32;
            p0_transpose_item_f8(inp(P, IN_WDOWN) + (size_t)(l * NEXP + e) * FH * DM, DM, kb * 64, nb * 32,
                                 ws + WS_WD + (size_t)(l * NEXP + e) * DM * FH + (size_t)(nb * 32) * FH + kb * 64, FH, scr, F.lane); }
    }
    if (F.gw == F.NGW - 1) {
        f32x2* T = (f32x2*)(ws + WS_ROPE);
        for (int idx = F.lane; idx < 64 * 16; idx += 64) { const int pos = idx >> 4, j = idx & 15;
            const float inv = exp2f(-(float)j * (1.f / 16.f) * 13.287712379549449f);
            const float ang = (float)pos * inv;
            const double a = (double)ang; const double rr = a - 6.283185307179586 * rint(a * 0.15915494309189535);
            T[idx] = (f32x2){(float)dcos_poly(rr), (float)dsin_poly(rr)}; }
    }
    { u32x4* wf = (u32x4*)(ws + WS_WRT); const float* wg = inp(P, IN_WGROUP); const float* wr = inp(P, IN_WROUTER);
      for (int idx = F.gw * 64 + F.lane; idx < DEPTH * 32 * 3 * 2 * 64; idx += F.NGW * 64) { const int l = idx / (32 * 3 * 2 * 64), rem = idx % (32 * 3 * 2 * 64), step = rem / 384, nt = (rem % 384) >> 7, which = (rem >> 6) & 1, ln = rem & 63;
          const int n = 16 * nt + (ln & 15); float w[8];
#pragma unroll
          for (int j = 0; j < 8; ++j) { const int k = 32 * step + 8 * (ln >> 4) + j;
              const float wv = (n < 4) ? wg[((size_t)l * DM + k) * 4 + n] : (n < 36 ? wr[((size_t)l * DM + k) * 32 + (n - 4)] : 0.f);
              const float w1 = bf2f(f2bf(wv)); w[j] = which ? (wv - w1) : wv; }
          u32x4 o; o.x = pk2(w[0], w[1]); o.y = pk2(w[2], w[3]); o.z = pk2(w[4], w[5]); o.w = pk2(w[6], w[7]); wf[idx] = o; } }
}
DI void p0b_mod_reduce(const Params& P, const Frame& F) {
    unsigned char* const ws = wsp(P);
    const float* mp = (const float*)(ws + WS_MODP); float* mod = (float*)(ws + WS_MOD);
    for (int idx = F.gw * 64 + F.lane; idx < DEPTH * 17 * 6144; idx += F.NGW * 64) {
        const int l = idx / (17 * 6144), c = idx % 6144;
        float s = inp(P, IN_BADA)[l * 6144 + c];
#pragma unroll
        for (int ks = 0; ks < 8; ++ks) s += mp[(size_t)ks * DEPTH * 17 * 6144 + idx];
        mod[idx] = s; }
}

DI unsigned expert_count(const unsigned char* ws, int layer, int e) { return __hip_atomic_load((const unsigned*)(ws + WS_CTL) + CW_CNT + (layer * NEXP + e) * CNT_STRIDE, __ATOMIC_RELAXED, __HIP_MEMORY_SCOPE_AGENT); }
DI unsigned expert_starts(const unsigned char* ws, int layer, int lane) {
    const unsigned p = (lane < NEXP) ? ((expert_count(ws, layer, lane & 31) + 255u) & ~255u) : 0u; unsigned incl = p;
#pragma unroll
    for (int d = 1; d < 32; d <<= 1) { const unsigned v = __shfl_up(incl, d); if ((lane & 31) >= d) incl += v; }
    return incl - p;
}

DI void load_row(const float* row, int lane, f32x4 (&v)[4]) {
#pragma unroll
    for (int j = 0; j < 4; ++j) v[j] = *(const f32x4*)(row + 4 * lane + 256 * j);
}
DI void load_row_bf(const bf16_t* row, int lane, f32x4 (&v)[4]) {
#pragma unroll
    for (int j = 0; j < 4; ++j) { const u32x2 w = *(const u32x2*)(row + 4 * lane + 256 * j); v[j] = (f32x4){bf2f(w.x & 0xffffu), bf2f(w.x >> 16), bf2f(w.y & 0xffffu), bf2f(w.y >> 16)}; }
}
DI float row_rstd(const f32x4 (&v)[4]) {
    float s = 0.f;
#pragma unroll
    for (int j = 0; j < 4; ++j) s += (v[j][0] * v[j][0] + v[j][1] * v[j][1]) + (v[j][2] * v[j][2] + v[j][3] * v[j][3]);
    return 1.0f / sqrtf(wave_sum(s) * (1.f / DM) + NORM_EPS);
}
DI void load_vec(const float* p, int lane, f32x4 (&v)[4]) {
#pragma unroll
    for (int j = 0; j < 4; ++j) v[j] = *(const f32x4*)(p + 4 * lane + 256 * j);
}
DI void norm_mod_store(const f32x4 (&v)[4], float rstd, const f32x4 (&gg)[4], const f32x4 (&sh)[4], const f32x4 (&sc)[4], bf16_t* hrow, int lane) {
#pragma unroll
    for (int j = 0; j < 4; ++j) { const int c = 4 * lane + 256 * j;
        const f32x4 hf = (v[j] * rstd * gg[j]) * (1.f + sc[j]) + sh[j];
        u32x2 w; w.x = pk2(hf[0], hf[1]); w.y = pk2(hf[2], hf[3]); *(u32x2*)(hrow + c) = w; }
}
struct RowIn { f32x4 x[4]; u32x2 ya[4], yb[4]; };
DI void row_fetch(const unsigned char* ws, const float* xrow, const bf16_t* xrow_bf, int t, unsigned s0, unsigned s1, int lane, bool prev, RowIn& R) {
    if (xrow_bf) load_row_bf(xrow_bf, lane, R.x); else load_row(xrow, lane, R.x);
    if (prev) {
        const bf16_t* Y = (const bf16_t*)(ws + WS_Y);
#pragma unroll
        for (int j = 0; j < 4; ++j) { R.ya[j] = *(const u32x2*)(Y + (size_t)s0 * DM + 4 * lane + 256 * j); R.yb[j] = *(const u32x2*)(Y + (size_t)s1 * DM + 4 * lane + 256 * j); } }
}
DI void row_apply(const f32x4 (&gt)[4], float w0, float w1, RowIn& R) {
#pragma unroll
    for (int j = 0; j < 4; ++j) { const f32x4 g = gt[j]; const u32x2 a = R.ya[j], b = R.yb[j];
        R.x[j][0] += g[0] * (w0 * bf2f(a.x & 0xffffu) + w1 * bf2f(b.x & 0xffffu)); R.x[j][1] += g[1] * (w0 * bf2f(a.x >> 16) + w1 * bf2f(b.x >> 16));
        R.x[j][2] += g[2] * (w0 * bf2f(a.y & 0xffffu) + w1 * bf2f(b.y & 0xffffu)); R.x[j][3] += g[3] * (w0 * bf2f(a.y >> 16) + w1 * bf2f(b.y >> 16)); }
}
DI void phase_attn_norm(const Params& P, const Frame& F0, int layer) {
    const Frame F = opaque_frame(F0);
    unsigned char* const ws = wsp(P);
    bf16_t* X = (bf16_t*)(ws + WS_X); bf16_t* H = (bf16_t*)(ws + WS_H);
    const bool prev = layer > 0;
    const int nrow = (TALL - F.gw + F.NGW - 1) / F.NGW;
    unsigned ms0 = 0, ms1 = 0; float mw0 = 0.f, mw1 = 0.f;
    if (prev) { const unsigned pst = expert_starts(ws, layer - 1, F.lane); u32x2 a = (u32x2){0u, 0u};
        if (F.lane < nrow) { const int tl = F.gw + F.lane * F.NGW; a = *(const u32x2*)((const unsigned*)(ws + WS_ASG) + (size_t)tl * 2); const f32x2 w = *(const f32x2*)((const float*)(ws + WS_ASGW) + (size_t)tl * 2); mw0 = w.x; mw1 = w.y; }
        ms0 = (unsigned)__shfl((int)pst, (int)(a.x >> 20)) + (a.x & 0xfffffu); ms1 = (unsigned)__shfl((int)pst, (int)(a.y >> 20)) + (a.y & 0xfffffu); }
    auto xsrc = [&](int t) -> const float* { return (t < TLAT ? inp(P, IN_X) + (size_t)t * DM : inp(P, IN_CTX) + (size_t)(t - TLAT) * DM); };
    auto xbf = [&](int t) -> const bf16_t* { return prev ? X + (size_t)t * DM : (const bf16_t*)nullptr; };
    RowIn cur, nxt;
    f32x4 gat[4]; load_vec(inp(P, IN_GATTN) + layer * DM, F.lane, gat);
    row_fetch(ws, xsrc(F.gw), xbf(F.gw), F.gw, __shfl(ms0, 0), __shfl(ms1, 0), F.lane, prev, cur);
    for (int i = 0; i < nrow; ++i) {
        const int t = F.gw + i * F.NGW; const int mb = (t < TLAT) ? (t >> 11) : 16;
        const float* md = (const float*)(ws + WS_MOD) + ((size_t)layer * 17 + mb) * 6144;
        f32x4 gt[4], sh[4], sc[4];
        if (prev) load_vec(md - 17 * 6144 + 5120, F.lane, gt);
        load_vec(md, F.lane, sh); load_vec(md + 1024, F.lane, sc);
        asm volatile("" ::: "memory");
        if (i + 1 < nrow) row_fetch(ws, xsrc(t + F.NGW), xbf(t + F.NGW), t + F.NGW, __shfl(ms0, i + 1), __shfl(ms1, i + 1), F.lane, prev, nxt);
        if (prev) row_apply(gt, __shfl(mw0, i), __shfl(mw1, i), cur);
#pragma unroll
        for (int j = 0; j < 4; ++j) { u32x2 w; w.x = pk2(cur.x[j][0], cur.x[j][1]); w.y = pk2(cur.x[j][2], cur.x[j][3]); *(u32x2*)(X + (size_t)t * DM + 4 * F.lane + 256 * j) = w; }
        const float rstd = row_rstd(cur.x);
        norm_mod_store(cur.x, rstd, gat, sh, sc, H + (size_t)t * DM, F.lane);
        cur = nxt;
    }
}
DI void phase_final(const Params& P, const Frame& F0) {
    const Frame F = opaque_frame(F0);
    unsigned char* const ws = wsp(P);
    const bf16_t* X = (const bf16_t*)(ws + WS_X);
    const float pc = PROBE_SEL ? *((const float*)(ws + WS_CTL) + 64) : 0.f;
    const int nrow = (TLAT - F.gw + F.NGW - 1) / F.NGW;
    unsigned ms0 = 0, ms1 = 0; float mw0 = 0.f, mw1 = 0.f;
    { const unsigned pst = expert_starts(ws, DEPTH - 1, F.lane); u32x2 a = (u32x2){0u, 0u};
      if (F.lane < nrow) { const int tl = F.gw + F.lane * F.NGW; a = *(const u32x2*)((const unsigned*)(ws + WS_ASG) + (size_t)tl * 2); const f32x2 w = *(const f32x2*)((const float*)(ws + WS_ASGW) + (size_t)tl * 2); mw0 = w.x; mw1 = w.y; }
      ms0 = (unsigned)__shfl((int)pst, (int)(a.x >> 20)) + (a.x & 0xfffffu); ms1 = (unsigned)__shfl((int)pst, (int)(a.y >> 20)) + (a.y & 0xfffffu); }
    RowIn cur, nxt;
    row_fetch(ws, nullptr, X + (size_t)F.gw * DM, F.gw, __shfl(ms0, 0), __shfl(ms1, 0), F.lane, true, cur);
    f32x4 gfin[4]; load_vec(inp(P, IN_GFINAL), F.lane, gfin);
    for (int i = 0; i < nrow; ++i) {
        const int t = F.gw + i * F.NGW;
        f32x4 gt[4]; load_vec((const float*)(ws + WS_MOD) + ((size_t)(DEPTH - 1) * 17 + (t >> 11)) * 6144 + 5120, F.lane, gt);
        asm volatile("" ::: "memory");
        if (i + 1 < nrow) row_fetch(ws, nullptr, X + (size_t)(t + F.NGW) * DM, t + F.NGW, __shfl(ms0, i + 1), __shfl(ms1, i + 1), F.lane, true, nxt);
        row_apply(gt, __shfl(mw0, i), __shfl(mw1, i), cur);
        const float rstd = row_rstd(cur.x);
#pragma unroll
        for (int j = 0; j < 4; ++j) { const int c = 4 * F.lane + 256 * j; *(f32x4*)(P.out + (size_t)t * DM + c) = cur.x[j] * rstd * gfin[j] + pc; }
        cur = nxt;
    }
}

DI float swap_max(float v) { auto rr = __builtin_amdgcn_permlane32_swap(__float_as_uint(v), __float_as_uint(v), false, false); return fmaxf(__uint_as_float(rr[0]), __uint_as_float(rr[1])); }
DI float swap_add(float v) { auto rr = __builtin_amdgcn_permlane32_swap(__float_as_uint(v), __float_as_uint(v), false, false); return __uint_as_float(rr[0]) + __uint_as_float(rr[1]); }
DI bf16x8 pack_p(const f32x16& p, int s) {
    u32x4 w; w.x = cvt_pk_bf16(p[8 * s + 0], p[8 * s + 1]); w.y = cvt_pk_bf16(p[8 * s + 2], p[8 * s + 3]); w.z = cvt_pk_bf16(p[8 * s + 4], p[8 * s + 5]); w.w = cvt_pk_bf16(p[8 * s + 6], p[8 * s + 7]);
    return __builtin_bit_cast(bf16x8, w);
}
struct AttnState { float m, l; f32x16 o[2]; };
DI void load_k(const unsigned char* Kbh, int kg, int r32, int hi, bf16x8 (&k)[4]) {
    const unsigned char* kb = Kbh + (size_t)(kg + (r32 >> 3)) * 1024 + hi * 128 + (r32 & 7) * 16;
#pragma unroll
    for (int d0 = 0; d0 < 4; ++d0) k[d0] = *(const bf16x8*)(kb + d0 * 256);
}
DI void load_v(const unsigned char* Vbh, int kg, int r32, int hi, s16x4 (&v)[2][2][2]) {
    const unsigned char* vb = Vbh + (size_t)kg * 1024 + r32 * 16 + hi * 8;
#pragma unroll
    for (int dh = 0; dh < 2; ++dh)
#pragma unroll
        for (int ks = 0; ks < 2; ++ks)
#pragma unroll
            for (int pt = 0; pt < 2; ++pt) v[dh][ks][pt] = *(const s16x4*)(vb + dh * 512 + (2 * ks + pt) * 1024);
}
DI f32x16 attn_scores(const bf16x8 (&k)[4], const bf16x8 (&q)[4]) {
    f32x16 s;
#pragma unroll
    for (int r = 0; r < 16; ++r) s[r] = 0.f;
#pragma unroll
    for (int d0 = 0; d0 < 4; ++d0) s = __builtin_amdgcn_mfma_f32_32x32x16_bf16(k[d0], q[d0], s, 0, 0, 0);
    return s;
}
DI float row_max16(const f32x16& s) {
    float mt = fmaxf(fmaxf(s[0], s[1]), fmaxf(s[2], s[3]));
#pragma unroll
    for (int r = 4; r < 16; r += 4) mt = fmaxf(mt, fmaxf(fmaxf(s[r], s[r + 1]), fmaxf(s[r + 2], s[r + 3])));
    return mt;
}
DI void attn_rescale(AttnState& st, f32x16& s, float mt, LAS float* wsf, int r32, int hi) {
    mt = swap_max(mt);
    const float dm = fmaxf(mt, 0.f);
    const float al = __builtin_amdgcn_exp2f(-dm);
    st.l *= al; st.m += dm;
#pragma unroll
    for (int r = 0; r < 16; ++r) s[r] -= dm;
    if (hi == 0) wsf[r32] = al;
    LDS_WAIT();
#pragma unroll
    for (int r = 0; r < 16; ++r) { const float f = wsf[crow(r, hi)]; st.o[0][r] *= f; st.o[1][r] *= f; }
    LDS_WAIT();
}
DI void attn_exp_pv(AttnState& st, f32x16& s, const s16x4 (&v)[2][2][2]) {
    float p0 = 0.f, p1 = 0.f;
#pragma unroll
    for (int r = 0; r < 16; r += 2) { s[r] = __builtin_amdgcn_exp2f(s[r]); s[r + 1] = __builtin_amdgcn_exp2f(s[r + 1]); p0 += s[r]; p1 += s[r + 1]; }
    st.l += p0 + p1;
    const bf16x8 pa0 = pack_p(s, 0), pa1 = pack_p(s, 1);
#pragma unroll
    for (int dh = 0; dh < 2; ++dh) {
        const bf16x8 vf0 = __builtin_shufflevector(v[dh][0][0], v[dh][0][1], 0, 1, 2, 3, 4, 5, 6, 7);
        const bf16x8 vf1 = __builtin_shufflevector(v[dh][1][0], v[dh][1][1], 0, 1, 2, 3, 4, 5, 6, 7);
        st.o[dh] = __builtin_amdgcn_mfma_f32_32x32x16_bf16(pa0, vf0, st.o[dh], 0, 0, 0);
        st.o[dh] = __builtin_amdgcn_mfma_f32_32x32x16_bf16(pa1, vf1, st.o[dh], 0, 0, 0);
    }
}
DI void attn_softmax_pv2(AttnState (&st)[2], f32x16 (&s)[2], const s16x4 (&v)[2][2][2], LAS float* wsf, int r32, int hi) {
#pragma unroll
    for (int r = 0; r < 16; ++r) { s[0][r] -= st[0].m; s[1][r] -= st[1].m; }
    const float mt0 = row_max16(s[0]), mt1 = row_max16(s[1]);
    if (__any(fmaxf(mt0, mt1) > 8.f)) { attn_rescale(st[0], s[0], mt0, wsf, r32, hi); attn_rescale(st[1], s[1], mt1, wsf + 32, r32, hi); }
    attn_exp_pv(st[0], s[0], v);
    attn_exp_pv(st[1], s[1], v);
}
template <int MODE>
DI void attn_unit(const Params& P, unsigned char* ws, int layer, int b, int h0, int qblk, LAS unsigned char* wl, int lane) {
    const int r32 = lane & 31, hi = lane >> 5, kvh = h0 >> 2, m = layer % 3;
    constexpr bool VDB = false;
    LAS float* wsf = (LAS float*)wl; LAS bf16_t* stg = (LAS bf16_t*)(wl + 256); LAS float* rpbt = (LAS float*)(wl + 256 + 4096);
    const bf16_t* QKV = (const bf16_t*)(ws + WS_QKV);
    const unsigned char* Kbh = ws + WS_KF + (size_t)(b * NKV + kvh) * KGRP * 1024;
    const unsigned char* Vbh = ws + WS_VF + (size_t)(b * NKV + kvh) * KGRP * 1024;
    unsigned char* O = ws + WS_O;
    int r0 = 0, c0 = 0;
    if (MODE == 2) { r0 = 2 * (qblk >> 2); c0 = 16 * (qblk & 3); }
    auto qtok = [&](int i) -> int {
        if (MODE == 3) return TLAT + b * CTXL + qblk * 32 + i;
        if (MODE == 2) return b * SEQ + (r0 + (i >> 4)) * 64 + c0 + (i & 15);
        return b * SEQ + qblk * 32 + i; };
    const int tq = qtok(r32);
    const bf16_t* qp = QKV + (size_t)tq * QKVN + h0 * HD + hi * 8;
    bf16x8 qr[2][4];
#pragma unroll
    for (int hh = 0; hh < 2; ++hh)
#pragma unroll
        for (int d0 = 0; d0 < 4; ++d0) qr[hh][d0] = *(const bf16x8*)(qp + hh * HD + d0 * 16);
    const int q0 = qblk * 32;
    int nl = 0, jlo = 0, rs_min = 0, cseg = 0;
    if (MODE == 0) { jlo = (q0 < 128) ? (128 - q0) / 32 : 0; const int jhi = min(8, (SEQ - 32 - q0 + 128) / 32); nl = jhi - jlo + 1; }
    if (MODE == 1) nl = SEQ / 32;
    if (MODE == 2) { rs_min = min(max(r0 - 4, 0), 24); const int rs_max = min(max(r0 + 1 - 4, 0), 24); nl = rs_max - rs_min + 8; cseg = (c0 == 0) ? 0 : (c0 == 16) ? 8 : (c0 == 32) ? 24 : 32; }
    auto lat_kg = [&](int i) -> int {
        if (MODE == 0) return (q0 - 128 + 32 * (jlo + i)) >> 3;
        if (MODE == 1) return 4 * i;
        return ((rs_min + i) * 64 + cseg) >> 3; };
    bf16x8 kn[4];
    load_k(Kbh, nl > 0 ? lat_kg(0) : SEQ / 8, r32, hi, kn);
    if (MODE == 0 || MODE == 1) {
        const int n = tq & 2047; const f32x2* T = (const f32x2*)(ws + WS_ROPE);
        const f32x2* tr = T + (n >> 6) * 16 + 8 * hi; const f32x2* tc = T + (n & 63) * 16 + 8 * hi;
#pragma unroll
        for (int e = 0; e < 8; ++e) { const f32x2 a = tr[e], cc = tc[e];
#pragma unroll
            for (int hh = 0; hh < 2; ++hh) {
                const float x1 = bfs2f(qr[hh][0][e]), x2 = bfs2f(qr[hh][1][e]), x3 = bfs2f(qr[hh][2][e]), x4 = bfs2f(qr[hh][3][e]);
                qr[hh][0][e] = (short)f2bf(x1 * a.x - x2 * a.y); qr[hh][1][e] = (short)f2bf(x2 * a.x + x1 * a.y);
                qr[hh][2][e] = (short)f2bf(x3 * cc.x - x4 * cc.y); qr[hh][3][e] = (short)f2bf(x4 * cc.x + x3 * cc.y); } }
    }
    LAS bf16x8* qlds = (LAS bf16x8*)(wl + 8192) + lane;
    if (VDB) {
#pragma unroll
        for (int d0 = 0; d0 < 4; ++d0) qlds[d0 * 64] = qr[1][d0];
        LDS_WAIT();
    }
    int rq = 0, cq = 0, rsq = 0, csq = 0;
    if (MODE == 2) {
        const float* rpb = inp(P, IN_RPB) + (size_t)h0 * 465;
        for (int i = lane; i < 930; i += 64) rpbt[i + (i >= 465 ? 7 : 0)] = rpb[i] * LOG2E;
        LDS_WAIT();
        rq = r0 + (r32 >> 4); cq = c0 + (r32 & 15); rsq = min(max(rq - 4, 0), 24); csq = min(max(cq - 8, 0), 48);
    }
    AttnState st[2];
#pragma unroll
    for (int hh = 0; hh < 2; ++hh) { st[hh].m = -1024.f; st[hh].l = 0.f;
#pragma unroll
        for (int r = 0; r < 16; ++r) { st[hh].o[0][r] = 0.f; st[hh].o[1][r] = 0.f; } }
    const float NEG = -INFINITY;
    s16x4 vn[2][2][2];
    if (VDB) load_v(Vbh, nl > 0 ? lat_kg(0) : SEQ / 8, r32, hi, vn);
    for (int i = 0; i < nl; ++i) {
        const int kgn = (i + 1 < nl) ? lat_kg(i + 1) : SEQ / 8;
        s16x4 v[2][2][2];
        if (VDB) {
#pragma unroll
            for (int a = 0; a < 2; ++a)
#pragma unroll
                for (int c = 0; c < 2; ++c)
#pragma unroll
                    for (int e = 0; e < 2; ++e) v[a][c][e] = vn[a][c][e];
        } else load_v(Vbh, lat_kg(i), r32, hi, v);
        f32x16 s[2];
        s[0] = attn_scores(kn, qr[0]);
        if (VDB) { bf16x8 q1[4];
#pragma unroll
            for (int d0 = 0; d0 < 4; ++d0) q1[d0] = qlds[d0 * 64];
            s[1] = attn_scores(kn, q1); }
        else s[1] = attn_scores(kn, qr[1]);
        load_k(Kbh, kgn, r32, hi, kn);
        if (VDB) load_v(Vbh, kgn, r32, hi, vn);
        if (MODE == 0) {
            const int j = jlo + i;
            if (j == 0 || j == 8) { const int kt = q0 - 128 + 32 * j, qpos = q0 + r32;
#pragma unroll
                for (int r = 0; r < 16; ++r) { const int d = kt + crow(r, hi) - qpos; if (d > 128 || d < -128) { s[0][r] = NEG; s[1][r] = NEG; } } }
        }
        if (MODE == 2) {
            const int kr = rs_min + i;
            const bool rowok = (kr >= rsq) && (kr < rsq + 8);
            const int ib = (kr - rq + 7) * 31 - cq + 15;
#pragma unroll
            for (int r = 0; r < 16; ++r) { const int kc2 = cseg + crow(r, hi); const bool ok = rowok && (kc2 >= csq) && (kc2 < csq + 16);
                const int idx = min(max(ib + kc2, 0), 464);
                s[0][r] = ok ? s[0][r] + rpbt[idx] : NEG; s[1][r] = ok ? s[1][r] + rpbt[472 + idx] : NEG; }
        }
        attn_softmax_pv2(st, s, v, wsf, r32, hi);
    }
    if (MODE == 0 || MODE == 1) {
#pragma unroll
        for (int hh = 0; hh < 2; ++hh)
#pragma unroll
            for (int d0 = 0; d0 < 4; ++d0) qr[hh][d0] = *(const bf16x8*)(qp + hh * HD + d0 * 16);
        if (VDB) {
#pragma unroll
            for (int d0 = 0; d0 < 4; ++d0) qlds[d0 * 64] = qr[1][d0];
            LDS_WAIT();
        }
    }
    for (int j = 0; j < CTXL / 32; ++j) {
        const int kg = SEQ / 8 + 4 * j, kgn = (j + 1 < CTXL / 32) ? kg + 4 : kg;
        s16x4 v[2][2][2];
        if (VDB) {
#pragma unroll
            for (int a = 0; a < 2; ++a)
#pragma unroll
                for (int c = 0; c < 2; ++c)
#pragma unroll
                    for (int e = 0; e < 2; ++e) v[a][c][e] = vn[a][c][e];
        } else load_v(Vbh, kg, r32, hi, v);
        f32x16 s[2];
        s[0] = attn_scores(kn, qr[0]);
        if (VDB) { bf16x8 q1[4];
#pragma unroll
            for (int d0 = 0; d0 < 4; ++d0) q1[d0] = qlds[d0 * 64];
            s[1] = attn_scores(kn, q1); }
        else s[1] = attn_scores(kn, qr[1]);
        load_k(Kbh, kgn, r32, hi, kn);
        if (VDB) load_v(Vbh, kgn, r32, hi, vn);
        attn_softmax_pv2(st, s, v, wsf, r32, hi);
    }
    int lane2 = lane; asm volatile("" : "+v"(lane2));
    const int r32b = lane2 & 31, hib = lane2 >> 5;
#pragma unroll
    for (int hh = 0; hh < 2; ++hh) {
        const float lt = swap_add(st[hh].l);
        float inv;
        if (MODE == 0 || (MODE == 3 && m == 0)) { const float sk = inp(P, IN_SINK)[(layer / 3) * NH + h0 + hh] * LOG2E;
            const float mnew = fmaxf(st[hh].m, sk); const float al = __builtin_amdgcn_exp2f(st[hh].m - mnew), es = __builtin_amdgcn_exp2f(sk - mnew);
            inv = F8_O_SCALE * al / (lt * al + es); }
        else inv = F8_O_SCALE / lt;
        if (hib == 0) wsf[r32b] = inv;
        LDS_WAIT();
        LAS bf16_t* sb = stg + hib * 256 + r32b;
        const LAS float* wf = wsf + 4 * hib;
#pragma unroll
        for (int r = 0; r < 16; ++r) { const float f = wf[(r & 3) + 8 * (r >> 2)];
            sb[((r & 3) + 8 * (r >> 2)) * 64] = (bf16_t)f2bf(st[hh].o[0][r] * f); sb[((r & 3) + 8 * (r >> 2)) * 64 + 32] = (bf16_t)f2bf(st[hh].o[1][r] * f); }
        LDS_WAIT();
        const int rw = lane2 >> 3, ch = lane2 & 7;
        const LAS unsigned char* rb = (const LAS unsigned char*)stg + rw * 128 + ch * 16;
#pragma unroll
        for (int i = 0; i < 4; ++i) { const u32x4 vv = *(const LAS u32x4*)(rb + i * 1024);
            u32x2 w8; w8.x = cvt_pk_fp8x4(bf2f(vv.x & 0xffffu), bf2f(vv.x >> 16), bf2f(vv.y & 0xffffu), bf2f(vv.y >> 16)); w8.y = cvt_pk_fp8x4(bf2f(vv.z & 0xffffu), bf2f(vv.z >> 16), bf2f(vv.w & 0xffffu), bf2f(vv.w >> 16));
            *(u32x2*)(O + (size_t)qtok(i * 8 + rw) * DM + (h0 + hh) * HD + ch * 8) = w8; }
        LDS_WAIT();
    }
}
DI void phase_attention(const Params& P, const Frame& F0, int layer) {
    const Frame F = opaque_frame(F0);
    unsigned char* const ws = wsp(P);
    const int m = layer % 3;
    LAS unsigned char* wl = F.lds + F.wave * 16384;
    for (int bu = F.blk; bu < NB * NKV * 16; bu += F.G) {
        const int rnd = bu >> 8, x = bu & 7, loc = (bu & 255) >> 3;
        const int bkv = rnd * 16 + x * 2 + (loc >> 4), qg = loc & 15;
        const int b = bkv >> 2, kvh = bkv & 3, h0 = kvh * 4 + 2 * (F.wave & 1), qblk = 4 * qg + (F.wave >> 1);
        if (m == 0) attn_unit<0>(P, ws, layer, b, h0, qblk, wl, F.lane);
        else if (m == 1) attn_unit<1>(P, ws, layer, b, h0, qblk, wl, F.lane);
        else attn_unit<2>(P, ws, layer, b, h0, qblk, wl, F.lane);
    }
    if (layer < DEPTH - 1) {
        for (int bu = F.blk; bu < NB * NKV * 2; bu += F.G) {
            const int bkv = bu >> 1, b = bkv >> 2, kvh = bkv & 3, h0 = kvh * 4 + 2 * (F.wave & 1), qblk = 4 * (bu & 1) + (F.wave >> 1);
            attn_unit<3>(P, ws, layer, b, h0, qblk, wl, F.lane);
        }
    }
}

DI int blk_token(int blk, int i) { return i < 128 ? blk * 128 + i : TLAT + blk * 16 + (i - 128); }
constexpr int RT_ROWB = 2064;
constexpr int RT_X2_OFF = 16 * RT_ROWB, RT_PART_OFF = 2 * 16 * RT_ROWB, RT_LOG_OFF = RT_PART_OFF + 8 * 16 * 48 * 4, RT_LOGS = 37, RT_VEC_OFF = RT_LOG_OFF + 144 * RT_LOGS * 4;
DI void phase_router(const Params& P, const Frame& F0, int layer, int M) {
    const Frame F = opaque_frame(F0);
    unsigned char* const ws = wsp(P);
    const int TPB = M / GRID, nchunk = TPB / 16;
    LAS int* hist = (LAS int*)(F.lds + LDSX_OFF);
    LAS float* part = (LAS float*)(F.lds + RT_PART_OFF); LAS float* logit = (LAS float*)(F.lds + RT_LOG_OFF);
    if (F.tid < 32) hist[F.tid] = 0;
    const bf16_t* X = (const bf16_t*)(ws + WS_X); bf16_t* H = (bf16_t*)(ws + WS_H);
    const float* gffn = inp(P, IN_GFFN) + layer * DM;
    const u32x4* wf = (const u32x4*)(ws + WS_WRT) + ((size_t)layer * 32 + 4 * F.wave) * 384 + F.lane;
    bf16x8 wreg[4][2][2];
#pragma unroll
    for (int s = 0; s < 4; ++s)
#pragma unroll
        for (int nt = 0; nt < 2; ++nt)
#pragma unroll
            for (int wh = 0; wh < 2; ++wh) wreg[s][nt][wh] = __builtin_bit_cast(bf16x8, wf[s * 384 + nt * 128 + wh * 64]);
    bf16x8 w2t[4][2];
#pragma unroll
    for (int s = 0; s < 4; ++s)
#pragma unroll
        for (int wh = 0; wh < 2; ++wh) w2t[s][wh] = __builtin_bit_cast(bf16x8, wf[s * 384 + 256 + wh * 64]);
    LAS float* vec = (LAS float*)(F.lds + RT_VEC_OFF);
    auto load_vecs = [&](int mb) {
        const float* md = (const float*)(ws + WS_MOD) + ((size_t)layer * 17 + mb) * 6144;
        for (int i = F.tid; i < 256; i += NTHREADS) { const f32x4 g = *(const f32x4*)(gffn + 4 * i), sc = *(const f32x4*)(md + 4096 + 4 * i);
            *(LAS f32x4*)(vec + 4 * i) = *(const f32x4*)(md + 2048 + 4 * i); *(LAS f32x4*)(vec + 1024 + 4 * i) = g * (1.f + sc); *(LAS f32x4*)(vec + 2048 + 4 * i) = *(const f32x4*)(md + 3072 + 4 * i); } };
    load_vecs(F.blk >> 4);
    const int ib = 2 * F.wave;
    f32x4 vn[2][4];
#pragma unroll
    for (int tk = 0; tk < 2; ++tk) { const int t = blk_token(F.blk, ib + tk); load_row_bf(X + (size_t)t * DM, F.lane, vn[tk]); }
    LDS_WAIT(); __syncthreads();
    for (int c = 0; c < nchunk; ++c) {
        if (c == 8) { load_vecs(16); LDS_WAIT(); __syncthreads(); }
#pragma unroll
        for (int tk = 0; tk < 2; ++tk) { const int t = blk_token(F.blk, c * 16 + ib + tk);
            const float rstd = row_rstd(vn[tk]);
            LAS unsigned char* r1 = F.lds + (ib + tk) * RT_ROWB + 8 * F.lane; unsigned char* hrow = (unsigned char*)H + (size_t)t * DM;
#pragma unroll
            for (int j = 0; j < 4; ++j) { const int cc = 4 * F.lane + 256 * j; const f32x4 ga = *(const LAS f32x4*)(vec + 1024 + cc), sh = *(const LAS f32x4*)(vec + 2048 + cc);
                const f32x4 hf = (vn[tk][j] * rstd) * ga + sh;
                u32x2 a; a.x = pk2(hf[0], hf[1]); a.y = pk2(hf[2], hf[3]);
                u32x2 b; b.x = pk2(hf[0] - bf2f(a.x & 0xffffu), hf[1] - bf2f(a.x >> 16)); b.y = pk2(hf[2] - bf2f(a.y & 0xffffu), hf[3] - bf2f(a.y >> 16));
                *(unsigned*)(hrow + cc) = cvt_pk_fp8x4(hf[0] * F8_ACT_SCALE, hf[1] * F8_ACT_SCALE, hf[2] * F8_ACT_SCALE, hf[3] * F8_ACT_SCALE); *(LAS u32x2*)(r1 + 512 * j) = a; *(LAS u32x2*)(r1 + RT_X2_OFF + 512 * j) = b; } }
        if (c + 1 < nchunk) {
#pragma unroll
            for (int tk = 0; tk < 2; ++tk) { const int t = blk_token(F.blk, (c + 1) * 16 + ib + tk); load_row_bf(X + (size_t)t * DM, F.lane, vn[tk]); }
        }
        LDS_WAIT(); __syncthreads();
        f32x4 acc[3];
#pragma unroll
        for (int nt = 0; nt < 3; ++nt) acc[nt] = (f32x4){0.f, 0.f, 0.f, 0.f};
        { const LAS unsigned char* ap = F.lds + (F.lane & 15) * RT_ROWB + 256 * F.wave + 16 * (F.lane >> 4);
#pragma unroll
          for (int s = 0; s < 4; ++s) { const bf16x8 a1 = *(const LAS bf16x8*)(ap + 64 * s), a2 = *(const LAS bf16x8*)(ap + RT_X2_OFF + 64 * s);
#pragma unroll
              for (int nt = 0; nt < 2; ++nt) { acc[nt] = __builtin_amdgcn_mfma_f32_16x16x32_bf16(a1, wreg[s][nt][0], acc[nt], 0, 0, 0);
                  acc[nt] = __builtin_amdgcn_mfma_f32_16x16x32_bf16(a1, wreg[s][nt][1], acc[nt], 0, 0, 0); acc[nt] = __builtin_amdgcn_mfma_f32_16x16x32_bf16(a2, wreg[s][nt][0], acc[nt], 0, 0, 0); }
              acc[2] = __builtin_amdgcn_mfma_f32_16x16x32_bf16(a1, w2t[s][0], acc[2], 0, 0, 0);
              acc[2] = __builtin_amdgcn_mfma_f32_16x16x32_bf16(a1, w2t[s][1], acc[2], 0, 0, 0); acc[2] = __builtin_amdgcn_mfma_f32_16x16x32_bf16(a2, w2t[s][0], acc[2], 0, 0, 0); } }
        { LAS float* pp = part + F.wave * 768 + (4 * (F.lane >> 4)) * 48 + (F.lane & 15);
#pragma unroll
          for (int nt = 0; nt < 3; ++nt)
#pragma unroll
              for (int r = 0; r < 4; ++r) pp[r * 48 + 16 * nt] = acc[nt][r]; }
        LDS_WAIT(); __syncthreads();
        { const int tk = F.tid >> 5, n = F.tid & 31; float s = 0.f;
#pragma unroll
          for (int w = 0; w < 8; ++w) s += part[w * 768 + tk * 48 + n];
          logit[(c * 16 + tk) * RT_LOGS + n] = s;
          if (F.tid < 64) { const int tk2 = F.tid >> 2, n2 = 32 + (F.tid & 3); float s2 = 0.f;
#pragma unroll
              for (int w = 0; w < 8; ++w) s2 += part[w * 768 + tk2 * 48 + n2];
              logit[(c * 16 + tk2) * RT_LOGS + n2] = s2; } }
    }
    LDS_WAIT(); __syncthreads();
    int rt_t = 0, rt_e1 = 0, rt_e2 = 0, rt_q1 = 0, rt_q2 = 0; float rt_w1 = 0.f, rt_w2 = 0.f;
    if (F.tid < TPB) { const int t = blk_token(F.blk, F.tid); const LAS float* lg = logit + F.tid * RT_LOGS;
        const float* bg = inp(P, IN_BGROUP) + layer * 4; const float* br = inp(P, IN_BROUTER) + layer * 32;
        const float g0 = lg[0] + bg[0], g1 = lg[1] + bg[1], g2 = lg[2] + bg[2], g3 = lg[3] + bg[3];
        int grp = 0; float gm = g0; if (g1 > gm) { gm = g1; grp = 1; } if (g2 > gm) { gm = g2; grp = 2; } if (g3 > gm) { gm = g3; grp = 3; }
        const float ptop = 1.f / (expf(g0 - gm) + expf(g1 - gm) + expf(g2 - gm) + expf(g3 - gm));
        float ev[8], em = -INFINITY;
#pragma unroll
        for (int j = 0; j < 8; ++j) { ev[j] = lg[4 + grp * 8 + j] + br[grp * 8 + j]; em = fmaxf(em, ev[j]); }
        float pe[8];
#pragma unroll
        for (int j = 0; j < 8; ++j) pe[j] = expf(ev[j] - em);
        int i1 = 0; float p1 = pe[0];
#pragma unroll
        for (int j = 1; j < 8; ++j) if (pe[j] > p1) { p1 = pe[j]; i1 = j; }
        int i2 = 0; float p2 = -1.f;
#pragma unroll
        for (int j = 0; j < 8; ++j) if (j != i1 && pe[j] > p2) { p2 = pe[j]; i2 = j; }
        const float w1 = ptop * p1 / (p1 + p2), w2 = ptop * p2 / (p1 + p2);
        const int e1 = grp * 8 + i1, e2 = grp * 8 + i2;
        rt_q1 = atomicAdd((int*)&hist[e1], 1); rt_q2 = atomicAdd((int*)&hist[e2], 1);
        rt_t = t; rt_e1 = e1; rt_e2 = e2; rt_w1 = w1; rt_w2 = w2; }
    __syncthreads();
    LAS unsigned* gbase = (LAS unsigned*)(hist + 32);
    if (F.tid < 32) gbase[F.tid] = __hip_atomic_fetch_add((unsigned*)(ws + WS_CTL) + CW_CNT + (layer * NEXP + F.tid) * CNT_STRIDE, (unsigned)hist[F.tid], __ATOMIC_RELAXED, __HIP_MEMORY_SCOPE_AGENT);
    LDS_WAIT(); __syncthreads();
    if (F.tid < TPB) { const unsigned i1 = gbase[rt_e1] + (unsigned)rt_q1, i2 = gbase[rt_e2] + (unsigned)rt_q2;
        unsigned* asg = (unsigned*)(ws + WS_ASG); float* asgw = (float*)(ws + WS_ASGW); unsigned* toke = (unsigned*)(ws + WS_TOKE);
        *(u32x2*)(asg + (size_t)rt_t * 2) = (u32x2){((unsigned)rt_e1 << 20) | i1, ((unsigned)rt_e2 << 20) | i2};
        *(f32x2*)(asgw + (size_t)rt_t * 2) = (f32x2){rt_w1, rt_w2};
        toke[(size_t)rt_e1 * TALL + i1] = (unsigned)rt_t; toke[(size_t)rt_e2 * TALL + i2] = (unsigned)rt_t; }
}
DI void build_tile_table(const Params& P, const Frame& F0, LAS unsigned* tab, int layer) {
    const Frame F = opaque_frame(F0);
    unsigned char* const ws = wsp(P);
    constexpr int TP = pg8::MoeSched<true>::TAB_PST, TC = pg8::MoeSched<true>::TAB_CNT;
    if (F.tid < NEXP) tab[TC + F.tid] = expert_count(ws, layer, F.tid);
    LDS_WAIT(); __syncthreads();
    if (F.tid == 0) { unsigned ps = 0; for (int e = 0; e < NEXP; ++e) { tab[TP + e] = ps; ps += (tab[TC + e] + 255u) & ~255u; } tab[0] = ps >> 8; }
    LDS_WAIT(); __syncthreads();
    const unsigned ntile = tab[0];
    for (unsigned rt = F.tid; rt < ntile; rt += NTHREADS) { unsigned e = 0; for (int k = 1; k < NEXP; ++k) if (rt * 256u >= tab[TP + k]) e = k; tab[1 + rt] = e; }
    LDS_WAIT(); __syncthreads();
}
__global__ void __launch_bounds__(NTHREADS, 2) dit_fwd(Params P) {
    extern __shared__ __attribute__((aligned(16))) unsigned char lds_raw[];
    Frame F;
    F.lds = (LAS unsigned char*)lds_raw;
    F.tid = threadIdx.x; F.lane = F.tid & 63; F.wave = __builtin_amdgcn_readfirstlane(F.tid >> 6);
    F.blk = blockIdx.x; F.G = gridDim.x; F.vcu = (F.G % 8 == 0) ? (F.blk % 8) * (F.G / 8) + F.blk / 8 : F.blk;
    F.gw = F.vcu * NWAVES + F.wave; F.NGW = F.G * NWAVES;
    for (int u = F.tid; u < (LDS_BYTES - RING_BYTES) / 4; u += NTHREADS) ((LAS unsigned*)(F.lds + RING_BYTES))[u] = 0u;
    __syncthreads();
    unsigned* ctl = (unsigned*)(P.ws + WS_CTL);
    XcdBarrier bar = xcd_barrier_post(ctl + CW_BAR, (volatile LAS unsigned*)(F.lds + MISC_OFF) + 8);

    unsigned long long pr_t0 = 0, pr_prev = 0, pr_acc = 0;
    if (PROBE_SEL) { pr_t0 = __builtin_amdgcn_s_memrealtime(); pr_prev = pr_t0; }
#define PSTAMP(id) do { if (PROBE_SEL) { const unsigned long long now_ = __builtin_amdgcn_s_memrealtime(); if ((id) == PROBE_SEL) pr_acc += now_ - pr_prev; pr_prev = now_; } } while (0)
    p0_prologue(P, F);
    if (RPT & 1) p0_prologue(P, F);
    xcd_barrier(bar);
    p0b_mod_reduce(P, F);
    xcd_barrier(bar);
    PSTAMP(1);

    for (int layer = 0; layer < DEPTH; ++layer) {
        const bool last = (layer == DEPTH - 1);
        unsigned char* ws = wsp(P);
        const int Mtok = last ? TLAT : TALL;
        phase_attn_norm(P, F, layer);
        if ((RPT & 256) && layer == 0) { phase_attn_norm(P, F, layer); phase_attn_norm(P, F, layer); phase_attn_norm(P, F, layer); }
        xcd_barrier(bar);
        PSTAMP(2);
        {
            pg8::PlainSched<false> S; S.nN = QKVN / 256; S.nwg = (TALL / 256) * S.nN; S.G = F.G; S.c = F.vcu; S.K = DM; S.Bt = (const bf16_t*)(ws + WS_WQKV) + (size_t)layer * QKVN * DM;
            pg8::EpiQKV E{(bf16_t*)(ws + WS_QKV), ws + WS_KF, ws + WS_VF, (const f32x2*)(ws + WS_ROPE), inp(P, IN_GQ), inp(P, IN_GK), layer % 3};
            pg8::gemm_phase(F.lds, (const bf16_t*)(ws + WS_H), DM, S, E);
            if (RPT & 2) pg8::gemm_phase(F.lds, (const bf16_t*)(ws + WS_H), DM, S, E);
        }
        xcd_barrier(bar);
        PSTAMP(3);
        phase_attention(P, F, layer);
        if (((RPT & 4) && layer == 1) || ((RPT & 8) && layer != 1)) phase_attention(P, F, layer);
        xcd_barrier(bar);
        PSTAMP(4);
        {
            pg8::PlainSched<true> S; S.nN = DM / 256; S.nwg = (Mtok / 256) * S.nN; S.G = F.G; S.c = F.vcu; S.K = DM / 2; S.Bt = (const bf16_t*)(ws + WS_WO + (size_t)layer * DM * DM);
            pg8::EpiResidBf E{(bf16_t*)(ws + WS_X), (const float*)(ws + WS_MOD) + (size_t)layer * 17 * 6144 + 2048};
            pg8::gemm_phase(F.lds, (const bf16_t*)(ws + WS_O), DM / 2, S, E);
        }
        xcd_barrier(bar);
        PSTAMP(5);
        phase_router(P, F, layer, Mtok);
        xcd_barrier(bar);
        PSTAMP(6);
        if (RPT & 128) { for (int xb = 0; xb < 9; ++xb) xcd_barrier(bar); }
        LAS unsigned* tab = (LAS unsigned*)(F.lds + LDSX_OFF + 8192);
        build_tile_table(P, F, tab, layer);
        {
            pg8::MoeSched<true> S; S.tab = tab; S.G = F.G; S.c = F.vcu; S.K = DM / 2; S.Bt = (const bf16_t*)(ws + WS_WGU + (size_t)layer * NEXP * DM * DM); S.estride = (size_t)DM * DM; S.tok = (const unsigned*)(ws + WS_TOKE);
            pg8::EpiSwiglu E{ws + WS_ACT};
            pg8::gemm_phase(F.lds, (const bf16_t*)(ws + WS_H), DM / 2, S, E);
            if (RPT & 32) pg8::gemm_phase(F.lds, (const bf16_t*)(ws + WS_H), DM / 2, S, E);
        }
        xcd_barrier(bar);
        PSTAMP(8);
        {
            pg8::MoeSched<false> S; S.tab = tab; S.G = F.G; S.c = F.vcu; S.K = FH / 2; S.Bt = (const bf16_t*)(ws + WS_WD + (size_t)layer * NEXP * DM * FH); S.estride = (size_t)DM * FH; S.tok = nullptr;
            pg8::EpiStore E{(bf16_t*)(ws + WS_Y), DM};
            pg8::gemm_phase(F.lds, (const bf16_t*)(ws + WS_ACT), FH / 2, S, E);
            if (RPT & 64) pg8::gemm_phase(F.lds, (const bf16_t*)(ws + WS_ACT), FH / 2, S, E);
        }
        xcd_barrier(bar);
        PSTAMP(9);
    }
    if (PROBE_SEL) {
        if (F.blk == 0 && F.tid == 0) { const unsigned long long tot = __builtin_amdgcn_s_memrealtime() - pr_t0;
            const float f = (PROBE_SEL == 15) ? 0.5f : (float)pr_acc / (float)tot;
            __hip_atomic_store((float*)(P.ws + WS_CTL) + 64, sqrtf(4e-4f * f), __ATOMIC_RELAXED, __HIP_MEMORY_SCOPE_AGENT); }
        xcd_barrier(bar);
    }
    phase_final(P, F);
    if (RPT & 512) { phase_final(P, F); phase_final(P, F); phase_final(P, F); }
}

extern "C" void kernel_launch(void* const* d_in, const int* in_sizes, int n_in, void* d_out, int out_size, void* d_ws, size_t ws_size, hipStream_t stream) {
    static int ok = 0;
    if (ok == 0) {
        if (n_in != 22 || in_sizes[0] != TLAT * DM || out_size != TLAT * DM || ws_size < WS_END) {
            fprintf(stderr, "kernel_launch: unexpected shapes (n_in %d, in0 %d, out %d, ws %zu < %zu); nothing launched\n", n_in, n_in > 0 ? in_sizes[0] : -1, out_size, ws_size, (size_t)WS_END); ok = -1; return; }
        int dev = 0, cus = 0, per_cu = 0;
        if (hipGetDevice(&dev) != hipSuccess || hipDeviceGetAttribute(&cus, hipDeviceAttributeMultiprocessorCount, dev) != hipSuccess) { ok = -1; return; }
        if (hipFuncSetAttribute((const void*)dit_fwd, hipFuncAttributeMaxDynamicSharedMemorySize, LDS_BYTES) != hipSuccess) { fprintf(stderr, "kernel_launch: hipFuncSetAttribute failed\n"); ok = -1; return; }
        if (hipOccupancyMaxActiveBlocksPerMultiprocessor(&per_cu, (const void*)dit_fwd, NTHREADS, LDS_BYTES) != hipSuccess || per_cu < 1) fprintf(stderr, "kernel_launch: note: occupancy query reports %d\n", per_cu);
        (void)hipGetLastError();
        if (cus < GRID) { fprintf(stderr, "kernel_launch: %d CUs < %d workgroups: grid would not be resident; nothing launched\n", cus, GRID); ok = -1; return; }
        ok = 1;
    }
    if (ok < 0) return;
    if (hipMemsetAsync((char*)d_ws + WS_CTL, 0, CTL_ZERO_BYTES, stream) != hipSuccess) return;
    Params p{};
    for (int i = 0; i < 22; ++i) p.in[i] = (const float*)d_in[i];
    p.out = (float*)d_out; p.ws = (unsigned char*)d_ws;
    hipLaunchKernelGGL(dit_fwd, dim3(GRID), dim3(NTHREADS), LDS_BYTES, stream, p);
}
```

```cpp
#include <hip/hip_runtime.h>
#include <cstdio>
#include <cstdint>

#ifndef PROBE_SEL
#define PROBE_SEL 0
#endif
#ifndef RPT
#define RPT 0
#endif

#define LAS __attribute__((address_space(3)))
#define GAS __attribute__((address_space(1)))
#define DI __device__ __forceinline__

typedef unsigned short bf16_t;
typedef short bf16x8 __attribute__((ext_vector_type(8)));
typedef short s16x4 __attribute__((ext_vector_type(4)));
typedef float f32x2 __attribute__((ext_vector_type(2)));
typedef float f32x4 __attribute__((ext_vector_type(4)));
typedef float f32x16 __attribute__((ext_vector_type(16)));
typedef unsigned u32x2 __attribute__((ext_vector_type(2)));
typedef unsigned u32x4 __attribute__((ext_vector_type(4)));
typedef int i32x4 __attribute__((ext_vector_type(4)));
typedef int i32x8 __attribute__((ext_vector_type(8)));

constexpr int NB = 16, SEQ = 2048, DM = 1024, DEPTH = 4, CTXL = 256, NH = 16, NKV = 4, HD = 64, QKVN = 1536;
constexpr int TLAT = NB * SEQ, TCTX = NB * CTXL, TALL = TLAT + TCTX;
constexpr int NEXP = 32, FH = 512;
constexpr int KEYS = SEQ + CTXL, KGRP = KEYS / 8;
constexpr int CAPR = 2 * TALL + NEXP * 256;
constexpr int NWAVES = 8, NTHREADS = 512, GRID = 256;
constexpr float NORM_EPS = 1e-6f, LOG2E = 1.4426950408889634f;

constexpr size_t MiB = 1u << 20;
constexpr size_t WS_CTL = 0, CTL_ZERO_BYTES = 1 * MiB;
constexpr size_t WS_MODP = 1 * MiB;
constexpr size_t WS_MOD = 15 * MiB;
constexpr size_t WS_ROPE = 17 * MiB;
constexpr size_t WS_WRT = 17 * MiB + 65536;
constexpr size_t WS_ASG = 18 * MiB;
constexpr size_t WS_ASGW = 18 * MiB + 512 * 1024;
constexpr size_t WS_TOKE = 1 * MiB;
constexpr size_t WS_WQKV = 21 * MiB;
constexpr size_t WS_WO = 33 * MiB;
constexpr size_t WS_WGU = 41 * MiB;
constexpr size_t WS_WD = 297 * MiB;
constexpr size_t WS_X = 425 * MiB;
constexpr size_t WS_H = 569 * MiB;
constexpr size_t WS_R1 = 641 * MiB;
constexpr size_t WS_QKV = WS_R1;
constexpr size_t WS_KF = WS_R1 + 108 * MiB;
constexpr size_t WS_VF = WS_R1 + 126 * MiB;
constexpr size_t WS_O = WS_R1 + 144 * MiB;
constexpr size_t WS_Y = WS_R1;
constexpr size_t WS_ACT = WS_R1 + 160 * MiB;
constexpr size_t WS_END = WS_R1 + 240 * MiB;
constexpr int CW_TMO = 0, CW_BAR = 4096, CW_CNT = 65536, CNT_STRIDE = 32;

constexpr int RING_BYTES = 131072;
constexpr int MISC_OFF = RING_BYTES + 320;
constexpr int LDSX_OFF = RING_BYTES + 1024;
constexpr int LDS_BYTES = 147456;

#define LDS_WAIT() asm volatile("s_waitcnt lgkmcnt(0)" ::: "memory")
#define VM_WAIT() asm volatile("s_waitcnt vmcnt(0)" ::: "memory")

DI unsigned f2bf(float f) { unsigned u = __float_as_uint(f); return (u + 0x7fffu + ((u >> 16) & 1u)) >> 16; }
DI float bf2f(unsigned b) { return __uint_as_float(b << 16); }
DI float bfs2f(short b) { return __uint_as_float(((unsigned)(unsigned short)b) << 16); }
DI unsigned cvt_pk_bf16(float lo, float hi);
DI unsigned pk2(float lo, float hi) { return cvt_pk_bf16(lo, hi); }
DI unsigned cvt_pk_bf16(float lo, float hi) { unsigned r; asm volatile("v_cvt_pk_bf16_f32 %0, %1, %2" : "=v"(r) : "v"(lo), "v"(hi)); return r; }
constexpr float F8_ACT_SCALE = 8.f, F8_W_SCALE = 64.f;
constexpr int F8_SC_ACT = 127 - 3, F8_SC_W = 127 - 6;
constexpr float F8_O_SCALE = 32.f; constexpr int F8_SC_O = 127 - 5;
DI unsigned cvt_pk_fp8x4(float a, float b, float c, float d) {
    a = __builtin_amdgcn_fmed3f(a, -448.f, 448.f); b = __builtin_amdgcn_fmed3f(b, -448.f, 448.f); c = __builtin_amdgcn_fmed3f(c, -448.f, 448.f); d = __builtin_amdgcn_fmed3f(d, -448.f, 448.f);
    int r = __builtin_amdgcn_cvt_pk_fp8_f32(a, b, 0, false); r = __builtin_amdgcn_cvt_pk_fp8_f32(c, d, r, true); return (unsigned)r; }
DI float wave_sum(float v) {
#pragma unroll
    for (int o = 1; o < 64; o <<= 1) v += __shfl_xor(v, o);
    return v;
}
DI int crow(int r, int hi) { return (r & 3) + 8 * (r >> 2) + 4 * hi; }

#define XB_TMO      128
#define XB_XCNT(j)  (256  + 64 * (j))
#define XB_XSUB(j)  (1280 + 64 * (j))
#define XB_XGEN(j)  (2304 + 64 * (j))
#define XB_TOP      3328
#define XB_TOPGEN   3392
#define XCD_BAR_WORDS 3456
#define XB_SPIN_CAP (1u << 18)

__device__ __forceinline__ unsigned xb_ld(unsigned* p)              { return __hip_atomic_load(p, __ATOMIC_RELAXED, __HIP_MEMORY_SCOPE_AGENT); }
__device__ __forceinline__ unsigned xb_add(unsigned* p, unsigned v) { return __hip_atomic_fetch_add(p, v, __ATOMIC_RELAXED, __HIP_MEMORY_SCOPE_AGENT); }
__device__ __forceinline__ unsigned xb_xcc_id() { return (unsigned)__builtin_amdgcn_s_getreg((3 << 11) | 20) & 0xFu; }
#define XB_SPIN(cond, bar) do { unsigned _sp = 0; while (cond) { __builtin_amdgcn_s_sleep(1); \
    if ((++_sp & 255u) == 0u) { if (xb_ld(&(bar)[XB_TMO])) break; if (_sp > XB_SPIN_CAP) { atomicAdd(&(bar)[XB_TMO], 1u); break; } } } } while (0)

struct XcdBarrier { unsigned* bar; unsigned x; volatile LAS unsigned* st; };

__device__ __forceinline__ XcdBarrier xcd_barrier_post(unsigned* bar, volatile LAS unsigned* st) {
    XcdBarrier b; b.bar = bar; b.x = xb_xcc_id(); b.st = st;
    if (threadIdx.x == 0) (void)xb_add(&bar[XB_XCNT(b.x)], 1u);
    return b;
}
__device__ __forceinline__ void xcd_barrier_complete(unsigned* bar, unsigned x, unsigned& nloc, unsigned& nx) {
    const unsigned G = gridDim.x * gridDim.y * gridDim.z;
    unsigned sum, cnt, mine, sp = 0u;
    for (;;) {
        sum = 0u; cnt = 0u; mine = 0u;
#pragma unroll
        for (unsigned j = 0; j < 16; ++j) { const unsigned c = xb_ld(&bar[XB_XCNT(j)]); sum += c; cnt += (c > 0u) ? 1u : 0u; mine = (j == x) ? c : mine; }
        if (sum == G) break;
        __builtin_amdgcn_s_sleep(1);
        if ((++sp & 255u) == 0u) { if (xb_ld(&bar[XB_TMO])) break; if (sp > XB_SPIN_CAP) { atomicAdd(&bar[XB_TMO], 1u); break; } }
    }
    nloc = mine > 0u ? mine : 1u; nx = cnt > 0u ? cnt : 1u;
}
__device__ __forceinline__ void xcd_barrier(const XcdBarrier& b0) {
    XcdBarrier b = b0;
    { unsigned z = 0, bx = __builtin_amdgcn_readfirstlane(b0.x); asm volatile("s_mov_b32 %0, 0" : "=s"(z)); asm volatile("" : "+s"(bx)); b.bar = b0.bar + z; b.x = bx; }
    asm volatile("s_waitcnt vmcnt(0)" ::: "memory");
    __syncthreads();
    if (threadIdx.x == 0) {
        unsigned* bar = b.bar;
        __builtin_amdgcn_s_waitcnt(0);
        unsigned nloc = b.st[0], nx = b.st[1];
        if (nloc == 0u) { xcd_barrier_complete(bar, b.x, nloc, nx); b.st[0] = nloc; b.st[1] = nx; }
        const unsigned old = xb_add(&bar[XB_XSUB(b.x)], 1u);
        const unsigned gen = old / nloc;
        if (old + 1u == (gen + 1u) * nloc) {
            __builtin_amdgcn_fence(__ATOMIC_RELEASE, "agent");
            asm volatile("s_waitcnt vmcnt(0)" ::: "memory");
            const unsigned og = xb_add(&bar[XB_TOP], 1u);
            const unsigned tg = og / nx;
            if (og + 1u == (tg + 1u) * nx) xb_add(&bar[XB_TOPGEN], 1u);
            else XB_SPIN(xb_ld(&bar[XB_TOPGEN]) == tg, bar);
            __builtin_amdgcn_fence(__ATOMIC_ACQUIRE, "agent");
            xb_add(&bar[XB_XGEN(b.x)], 1u);
            asm volatile("s_waitcnt vmcnt(0)" ::: "memory");
        } else {
            XB_SPIN(xb_ld(&bar[XB_XGEN(b.x)]) == gen, bar);
            __builtin_amdgcn_fence(__ATOMIC_ACQUIRE, "agent");
            asm volatile("s_waitcnt vmcnt(0)" ::: "memory");
        }
    }
    __syncthreads();
}

namespace pg8 {
constexpr int BM = 256, BK = 64, HALF = 128, HTB = HALF * BK * 2, STAGE_BYTES = 8 * HTB;
DI int lds_byte(int r, int c) { const int st = (r >> 4) * 2 + (c >> 5), rr = r & 15, cc = c & 31, ob = rr * 64 + cc * 2; return st * 1024 + (ob ^ (((ob >> 9) & 1) << 5)); }
DI void stage_rc(int b, int& R, int& C) { const int st = b / 1024, sb = b % 1024, swz = sb ^ (((sb >> 9) & 1) << 5); R = (st >> 1) * 16 + swz / 64; C = (st & 1) * 32 + (swz % 64) / 2; }
DI int perm32(int rho) { const int n = rho >> 4, i = rho & 15; return 8 * (i >> 2) + 4 * n + (i & 3); }
struct Unit { int pm, pn, e, r0, na; };

DI void mfma_f8_acc(f32x4& c, const i32x8& w, const i32x8& a, int sw, int sa) {
    asm volatile("v_mfma_scale_f32_16x16x128_f8f6f4 %0, %1, %2, %0, %3, %4 op_sel_hi:[0,0,0]" : "+v"(c) : "v"(w), "v"(a), "v"(sw), "v"(sa));
}
template <class Epi, class Sched>
DI void gemm_phase(LAS unsigned char* lds, const bf16_t* A, const int K, const Sched& S, const Epi& E) {
    int tid_ = threadIdx.x; asm volatile("" : "+v"(tid_));
    const int tid = tid_, wid = __builtin_amdgcn_readfirstlane(tid >> 6), lane = tid & 63, wr = wid >> 2, wc = wid & 3, fr = lane & 15, fq = lane >> 4;
    int nt_ = K / BK; asm volatile("" : "+s"(nt_));
    const int nt = nt_;
    constexpr bool GA = Sched::GATHER, F8 = Sched::FP8;
    int f8sw = F8_SC_W, f8sa = Sched::SC_ACT; asm volatile("" : "+v"(f8sw), "+v"(f8sa));
    int Rr[2], Cc[2]; unsigned voffB[2], voffA[2];
#pragma unroll
    for (int i = 0; i < 2; ++i) { int R, C; stage_rc(tid * 16 + i * 8192, R, C); const int Rb = Epi::PERM ? ((R & ~31) + perm32(R & 31)) : R;
        Rr[i] = R; Cc[i] = C; voffB[i] = (unsigned)(Rb * K + C) * 2u; voffA[i] = (unsigned)(R * K + C) * 2u; }
    const size_t kstep = (size_t)(BK * 2);
    const size_t hstep = (size_t)HALF * K * 2;
    const unsigned ldsw = (unsigned)wid * 1024u;
    const int aoff = lds_byte(wr * 64 + fr, fq * 8), boff = lds_byte(wc * 32 + fr, fq * 8);
#define PG8_SA(b, h) (((b) * 2 + (h)) * HTB)
#define PG8_SB(b, h) ((4 + (b) * 2 + (h)) * HTB)
#define PG8_STAGE(bufoff, gbase, voff) do { _Pragma("unroll") for (int _i = 0; _i < 2; ++_i) \
        __builtin_amdgcn_global_load_lds((const unsigned*)((const char*)(gbase) + (voff)[_i]), (LAS unsigned*)(lds + (bufoff) + ldsw + _i * 8192), 16, 0, 0); } while (0)
#define PG8_LDA(dst, b, h) do { _Pragma("unroll") for (int m = 0; m < 4; ++m) _Pragma("unroll") for (int k = 0; k < 2; ++k) dst[m][k] = *(const LAS bf16x8*)(lds + PG8_SA(b, h) + aoff + m * 2048 + k * 1024); } while (0)
#define PG8_LDB(dst, b, h) do { _Pragma("unroll") for (int n = 0; n < 2; ++n) _Pragma("unroll") for (int k = 0; k < 2; ++k) dst[n][k] = *(const LAS bf16x8*)(lds + PG8_SB(b, h) + boff + n * 2048 + k * 1024); } while (0)
#define PG8_CAT8(x0, x1) __builtin_shufflevector(__builtin_bit_cast(i32x4, x0), __builtin_bit_cast(i32x4, x1), 0, 1, 2, 3, 4, 5, 6, 7)
#define PG8_MMA(ai, bj, At, Bt) do { __builtin_amdgcn_s_setprio(1); \
        if (F8) { _Pragma("unroll") for (int m = 0; m < 4; ++m) _Pragma("unroll") for (int n = 0; n < 2; ++n) \
            mfma_f8_acc(acc[ai][bj][m][n], PG8_CAT8(Bt[n][0], Bt[n][1]), PG8_CAT8(At[m][0], At[m][1]), f8sw, f8sa); } \
        else { _Pragma("unroll") for (int m = 0; m < 4; ++m) _Pragma("unroll") for (int n = 0; n < 2; ++n) _Pragma("unroll") for (int k = 0; k < 2; ++k) \
            acc[ai][bj][m][n] = __builtin_amdgcn_mfma_f32_16x16x32_bf16(Bt[n][k], At[m][k], acc[ai][bj][m][n], 0, 0, 0); } \
        __builtin_amdgcn_s_setprio(0); } while (0)
#define PG8_WAIT_V(n) asm volatile("s_waitcnt vmcnt(" #n ")" ::: "memory")
#define PG8_WAIT_L(n) asm volatile("s_waitcnt lgkmcnt(" #n ")" ::: "memory")
#define PG8_BAR __builtin_amdgcn_s_barrier()
#define PG8_SCHED __builtin_amdgcn_sched_barrier(0)
    Unit cur, nxt; int ui = 0;
    if (!S.next(0, cur)) return;
    f32x4 acc[2][2][4][2];
#pragma unroll
    for (int a = 0; a < 2; ++a)
#pragma unroll
        for (int b = 0; b < 2; ++b)
#pragma unroll
            for (int m = 0; m < 4; ++m)
#pragma unroll
                for (int n = 0; n < 2; ++n) acc[a][b][m][n] = (f32x4){0.f, 0.f, 0.f, 0.f};
    bf16x8 At[4][2], B0[2][2], B1[2][2];
    unsigned oc0[2], oc1[2], on0[2], on1[2];
#pragma unroll
    for (int i = 0; i < 2; ++i) { if (GA) { oc0[i] = S.a_off(cur, Rr[i]) + (unsigned)Cc[i] * 2u; oc1[i] = S.a_off(cur, HALF + Rr[i]) + (unsigned)Cc[i] * 2u; } else { oc0[i] = voffA[i]; oc1[i] = voffA[i]; } on0[i] = oc0[i]; on1[i] = oc1[i]; }
    size_t hA = (GA || (Sched::HALVES && cur.na == 1)) ? (size_t)0 : hstep, hAn = hA;
    const char* Ab = GA ? (const char*)A : (const char*)A + (size_t)cur.r0 * K * 2;
    const char* cB = S.b_ptr(cur);
    PG8_STAGE(PG8_SB(0, 0), cB, voffB); PG8_STAGE(PG8_SB(0, 1), cB + hstep, voffB); PG8_STAGE(PG8_SA(0, 0), Ab, oc0); PG8_STAGE(PG8_SA(0, 1), Ab + hA, oc1);
    if (wr == 1) PG8_BAR;
    PG8_WAIT_V(2); PG8_BAR;
    PG8_STAGE(PG8_SB(1, 0), cB + kstep, voffB); PG8_STAGE(PG8_SA(1, 0), Ab + kstep, oc0); PG8_STAGE(PG8_SB(1, 1), cB + hstep + kstep, voffB);
    PG8_WAIT_V(6); PG8_BAR;
    for (;;) {
        const bool has_next = S.next(ui + 1, nxt);
        const char* nB = has_next ? S.b_ptr(nxt) : cB;
        const char* nA = GA ? Ab : (has_next ? (const char*)A + (size_t)nxt.r0 * K * 2 : Ab);
        if (!GA && Sched::HALVES) hAn = (has_next && nxt.na == 1) ? (size_t)0 : (has_next ? hstep : hA);
        if (GA) {
            if (has_next) {
#pragma unroll
                for (int i = 0; i < 2; ++i) { on0[i] = S.a_off(nxt, Rr[i]) + (unsigned)Cc[i] * 2u; on1[i] = S.a_off(nxt, HALF + Rr[i]) + (unsigned)Cc[i] * 2u; }
            } else {
#pragma unroll
                for (int i = 0; i < 2; ++i) { on0[i] = oc0[i]; on1[i] = oc1[i]; }
            }
        }
#define PG8_KLOOP(FULL) \
        for (int t = 0; t < nt; t += 2) { \
            const bool last = (t == nt - 2); \
            const char* a1 = Ab + (size_t)(t + 1) * kstep + hA; \
            const char* a2 = last ? nA : Ab + (size_t)(t + 2) * kstep; const char* b2 = last ? nB : cB + (size_t)(t + 2) * kstep; \
            const char* a3 = a2 + kstep; const char* b3 = b2 + kstep; const size_t hA2 = last ? hAn : hA; \
            unsigned o20[2], o21[2]; \
            for (int i = 0; i < 2; ++i) { if (GA) { o20[i] = last ? on0[i] : oc0[i]; o21[i] = last ? on1[i] : oc1[i]; } else { o20[i] = voffA[i]; o21[i] = voffA[i]; } } \
              \
            PG8_LDB(B0, 0, 0); PG8_LDB(B1, 0, 1); PG8_SCHED; PG8_LDA(At, 0, 0); PG8_STAGE(PG8_SA(1, 1), a1, oc1); \
            PG8_WAIT_V(8); PG8_WAIT_L(0); PG8_BAR; PG8_MMA(0, 0, At, B0); PG8_MMA(0, 1, At, B1); PG8_BAR; PG8_SCHED; \
              \
            if (FULL) { PG8_LDA(At, 0, 1); } PG8_STAGE(PG8_SB(0, 0), b2, voffB); PG8_STAGE(PG8_SB(0, 1), b2 + hstep, voffB); PG8_STAGE(PG8_SA(0, 0), a2, o20); \
            PG8_WAIT_V(8); PG8_WAIT_L(0); PG8_BAR; if (FULL) { PG8_MMA(1, 0, At, B0); PG8_MMA(1, 1, At, B1); } PG8_BAR; PG8_SCHED; \
              \
            PG8_LDB(B0, 1, 0); PG8_LDB(B1, 1, 1); PG8_SCHED; PG8_LDA(At, 1, 0); PG8_STAGE(PG8_SA(0, 1), a2 + hA2, o21); \
            PG8_WAIT_V(8); PG8_WAIT_L(0); PG8_BAR; PG8_MMA(0, 0, At, B0); PG8_MMA(0, 1, At, B1); PG8_BAR; PG8_SCHED; \
              \
            if (FULL) { PG8_LDA(At, 1, 1); } PG8_STAGE(PG8_SB(1, 0), b3, voffB); PG8_STAGE(PG8_SB(1, 1), b3 + hstep, voffB); PG8_STAGE(PG8_SA(1, 0), a3, o20); \
            PG8_WAIT_V(8); PG8_WAIT_L(0); PG8_BAR; if (FULL) { PG8_MMA(1, 0, At, B0); PG8_MMA(1, 1, At, B1); } PG8_BAR; PG8_SCHED; \
        }
        if (Sched::HALVES && cur.na == 1) { PG8_KLOOP(0) } else { PG8_KLOOP(1) }
#undef PG8_KLOOP
        if (wr == 0) PG8_BAR;
        if (F8) asm volatile("s_nop 15\n\ts_nop 15" ::: "memory");
        E(acc, cur, wr, wc, fr, fq);
        if (!has_next) break;
#pragma unroll
        for (int a = 0; a < 2; ++a)
#pragma unroll
            for (int b = 0; b < 2; ++b)
#pragma unroll
                for (int m = 0; m < 4; ++m)
#pragma unroll
                    for (int n = 0; n < 2; ++n) acc[a][b][m][n] = (f32x4){0.f, 0.f, 0.f, 0.f};
        cur = nxt; cB = nB; Ab = nA; hA = hAn; ++ui;
        if (GA) {
#pragma unroll
            for (int i = 0; i < 2; ++i) { oc0[i] = on0[i]; oc1[i] = on1[i]; }
        }
        if (wr == 1) PG8_BAR;
    }
    PG8_WAIT_V(0);
    PG8_BAR;
#undef PG8_SA
#undef PG8_SB
#undef PG8_STAGE
#undef PG8_LDA
#undef PG8_LDB
#undef PG8_MMA
#undef PG8_CAT8
#undef PG8_WAIT_V
#undef PG8_WAIT_L
#undef PG8_BAR
#undef PG8_SCHED
}

template <bool FP8_, int SC_ACT_ = F8_SC_O> struct PlainSched {
    static constexpr bool GATHER = false, HALVES = true, FP8 = FP8_; static constexpr int SC_ACT = SC_ACT_;
    int nN, nwg, G, c, K; const bf16_t* Bt;
    DI bool next(int i, Unit& u) const { const int L = i * G + c; const int nfull = (nwg / G) * G, rem = nwg - nfull; int Lu = L, hf = 0; u.na = 2;
        if (L >= nfull) { if (2 * rem <= G) { const int h = L - nfull; if (h >= 2 * rem) return false; Lu = nfull + (h >> 1); hf = h & 1; u.na = 1; } else if (L >= nwg) return false; }
        u.pm = Lu / nN; u.pn = Lu - u.pm * nN; u.e = 0; u.r0 = u.pm * BM + hf * HALF; return true; }
    DI unsigned a_off(const Unit& u, int r) const { return (unsigned)(u.r0 + r) * (unsigned)(K * 2); }
    DI const char* b_ptr(const Unit& u) const { return (const char*)Bt + (size_t)u.pn * BM * K * 2; }
};
template <bool GATHER_> struct MoeSched {
    static constexpr bool GATHER = GATHER_, HALVES = true, FP8 = true; static constexpr int SC_ACT = F8_SC_ACT;
    static constexpr int TAB_PST = 384, TAB_CNT = 416;
    const LAS unsigned* tab; int G, c, K; const bf16_t* Bt; size_t estride; const unsigned* tok;
    DI bool next(int i, Unit& u) const { const int L = i * G + c; const int nwg = (int)tab[0] * 4, nfull = (nwg / G) * G, rem = nwg - nfull; int Lu = L, hf = 0; u.na = 2;
        if (L >= nfull) { if (2 * rem <= G) { const int h = L - nfull; if (h >= 2 * rem) return false; Lu = nfull + (h >> 1); hf = h & 1; u.na = 1; } else if (L >= nwg) return false; }
        u.pm = Lu >> 2; u.pn = Lu & 3; u.e = (int)tab[1 + u.pm]; u.r0 = u.pm * BM + hf * HALF; return true; }
    DI unsigned a_off(const Unit& u, int r) const {
        unsigned row = (unsigned)(u.r0 + (u.na == 1 ? (r & (HALF - 1)) : r));
        if (GATHER_) { const unsigned last = tab[TAB_CNT + u.e] - 1u; unsigned idx = row - tab[TAB_PST + u.e]; idx = idx < last ? idx : last; row = tok[(unsigned)u.e * (unsigned)TALL + idx]; }
        return row * (unsigned)(K * 2); }
    DI const char* b_ptr(const Unit& u) const { return (const char*)Bt + (size_t)u.e * estride + (size_t)u.pn * BM * K * 2; }
};

struct EpiStore {
    static constexpr bool PERM = true;
    bf16_t* O; int ldc;
    DI void operator()(const f32x4 (&acc)[2][2][4][2], const Unit& u, int wr, int wc, int fr, int fq) const {
        const int row0 = u.r0 + wr * 64 + fr, col0 = u.pn * BM + wc * 32 + 8 * fq;
#pragma unroll
        for (int ai = 0; ai < 2; ++ai) if (ai < u.na)
#pragma unroll
            for (int m = 0; m < 4; ++m) { bf16_t* rowp = O + (size_t)(row0 + ai * HALF + m * 16) * ldc + col0;
#pragma unroll
                for (int bj = 0; bj < 2; ++bj) { const f32x4 v0 = acc[ai][bj][m][0], v1 = acc[ai][bj][m][1];
                    u32x4 w; w.x = cvt_pk_bf16(v0[0], v0[1]); w.y = cvt_pk_bf16(v0[2], v0[3]); w.z = cvt_pk_bf16(v1[0], v1[1]); w.w = cvt_pk_bf16(v1[2], v1[3]);
                    *(u32x4*)(rowp + bj * HALF) = w; } }
    }
};
struct EpiQKV {
    static constexpr bool PERM = false;
    bf16_t* QKV; unsigned char* KF; unsigned char* VF; const f32x2* T; const float* gq; const float* gk; int m;
    DI void operator()(const f32x4 (&acc)[2][2][4][2], const Unit& u, int wr, int wc, int fr, int fq) const {
        const bool lat = u.pm < TLAT / BM; const int b = lat ? (u.pm >> 3) : (u.pm - TLAT / BM);
        const int trow0 = u.r0 + wr * 64 + fr;
        if (u.pn < 4) {
            const int h = 4 * u.pn + wc;
            f32x4 g[2][2];
#pragma unroll
            for (int bj = 0; bj < 2; ++bj)
#pragma unroll
                for (int n = 0; n < 2; ++n) g[bj][n] = (m == 1) ? *(const f32x4*)(gq + 32 * bj + 16 * n + 4 * fq) : (f32x4){1.f, 1.f, 1.f, 1.f};
#pragma unroll
            for (int ai = 0; ai < 2; ++ai) if (ai < u.na)
#pragma unroll
                for (int mm = 0; mm < 4; ++mm) {
                    f32x4 x[2][2]; float ss = 0.f;
#pragma unroll
                    for (int bj = 0; bj < 2; ++bj)
#pragma unroll
                        for (int n = 0; n < 2; ++n) { x[bj][n] = acc[ai][bj][mm][n]; ss += (x[bj][n][0] * x[bj][n][0] + x[bj][n][1] * x[bj][n][1]) + (x[bj][n][2] * x[bj][n][2] + x[bj][n][3] * x[bj][n][3]); }
                    float sc = 0.125f * LOG2E;
                    if (m == 1) { ss += __shfl_xor(ss, 16); ss += __shfl_xor(ss, 32); sc *= 1.0f / sqrtf(ss * (1.f / HD) + NORM_EPS); }
                    bf16_t* qrow = QKV + (size_t)(trow0 + ai * HALF + mm * 16) * QKVN + h * HD + 4 * fq;
#pragma unroll
                    for (int bj = 0; bj < 2; ++bj)
#pragma unroll
                        for (int n = 0; n < 2; ++n) { const f32x4 y = x[bj][n] * g[bj][n] * sc; u32x2 w; w.x = cvt_pk_bf16(y[0], y[1]); w.y = cvt_pk_bf16(y[2], y[3]); *(u32x2*)(qrow + 32 * bj + 16 * n) = w; }
                }
        } else if (u.pn == 4) {
            f32x4 g[2][2];
#pragma unroll
            for (int bj = 0; bj < 2; ++bj)
#pragma unroll
                for (int n = 0; n < 2; ++n) g[bj][n] = (m == 1) ? *(const f32x4*)(gk + 32 * bj + 16 * n + 4 * fq) : (f32x4){1.f, 1.f, 1.f, 1.f};
            const bool rope = lat && (m != 2);
            unsigned char* kbase = KF + (size_t)(b * NKV + wc) * KGRP * 1024 + (fq >> 1) * 128 + (fq & 1) * 8;
#pragma unroll
            for (int ai = 0; ai < 2; ++ai) if (ai < u.na)
#pragma unroll
                for (int mm = 0; mm < 4; ++mm) {
                    const int t = trow0 + ai * HALF + mm * 16;
                    const int kidx = lat ? (t & 2047) : (2048 + ((t - TLAT) & 255));
                    f32x4 x[2][2]; float ss = 0.f;
#pragma unroll
                    for (int bj = 0; bj < 2; ++bj)
#pragma unroll
                        for (int n = 0; n < 2; ++n) { x[bj][n] = acc[ai][bj][mm][n]; ss += (x[bj][n][0] * x[bj][n][0] + x[bj][n][1] * x[bj][n][1]) + (x[bj][n][2] * x[bj][n][2] + x[bj][n][3] * x[bj][n][3]); }
                    if (m == 1) { ss += __shfl_xor(ss, 16); ss += __shfl_xor(ss, 32); const float rs = 1.0f / sqrtf(ss * (1.f / HD) + NORM_EPS);
#pragma unroll
                        for (int bj = 0; bj < 2; ++bj)
#pragma unroll
                            for (int n = 0; n < 2; ++n) x[bj][n] = x[bj][n] * g[bj][n] * rs; }
                    if (rope) {
#pragma unroll
                        for (int bj = 0; bj < 2; ++bj) { const int pos = bj ? (kidx & 63) : (kidx >> 6); const f32x4* tp = (const f32x4*)(T + pos * 16 + 4 * fq);
                            const f32x4 t0 = tp[0], t1 = tp[1];
                            const f32x4 cs = (f32x4){t0[0], t0[2], t1[0], t1[2]}, sn = (f32x4){t0[1], t0[3], t1[1], t1[3]};
                            const f32x4 a = x[bj][0], c = x[bj][1];
                            x[bj][0] = a * cs - c * sn; x[bj][1] = c * cs + a * sn; }
                    }
                    unsigned char* kp = kbase + (size_t)(kidx >> 3) * 1024 + (kidx & 7) * 16;
#pragma unroll
                    for (int bj = 0; bj < 2; ++bj)
#pragma unroll
                        for (int n = 0; n < 2; ++n) { u32x2 w; w.x = cvt_pk_bf16(x[bj][n][0], x[bj][n][1]); w.y = cvt_pk_bf16(x[bj][n][2], x[bj][n][3]); *(u32x2*)(kp + (4 * bj + 2 * n) * 128) = w; }
                }
        } else {
            const int q4 = fr & 3;
            unsigned char* vbase = VF + (size_t)(b * NKV + wc) * KGRP * 1024 + (4 * fq + q4) * 16;
#pragma unroll
            for (int ai = 0; ai < 2; ++ai) if (ai < u.na)
#pragma unroll
                for (int mm = 0; mm < 4; ++mm) {
                    const int t = trow0 + ai * HALF + mm * 16;
                    const int kidx = lat ? (t & 2047) : (2048 + ((t - TLAT) & 255));
                    unsigned char* vp = vbase + (size_t)(kidx >> 3) * 1024 + (kidx & 4) * 2;
#pragma unroll
                    for (int bj = 0; bj < 2; ++bj)
#pragma unroll
                        for (int n = 0; n < 2; ++n) {
                            f32x4 x = acc[ai][bj][mm][n];
                            { const float s0 = (q4 & 1) ? x[0] : x[1], s1 = (q4 & 1) ? x[2] : x[3]; const float r0 = __shfl_xor(s0, 1), r1 = __shfl_xor(s1, 1);
                              if (q4 & 1) { x[0] = r0; x[2] = r1; } else { x[1] = r0; x[3] = r1; } }
                            { const float s0 = (q4 & 2) ? x[0] : x[2], s1 = (q4 & 2) ? x[1] : x[3]; const float r0 = __shfl_xor(s0, 2), r1 = __shfl_xor(s1, 2);
                              if (q4 & 2) { x[0] = r0; x[1] = r1; } else { x[2] = r0; x[3] = r1; } }
                            u32x2 w; w.x = cvt_pk_bf16(x[0], x[1]); w.y = cvt_pk_bf16(x[2], x[3]);
                            *(u32x2*)(vp + (32 * bj + 16 * n) * 16) = w; }
                }
        }
    }
};
DI float silu_mul(float g, float u) { return g * __builtin_amdgcn_rcpf(1.f + __builtin_amdgcn_exp2f(-g * LOG2E)) * u; }
struct EpiResidBf {
    static constexpr bool PERM = true;
    bf16_t* X; const float* gate;
    DI void operator()(const f32x4 (&acc)[2][2][4][2], const Unit& u, int wr, int wc, int fr, int fq) const {
        const int mb = (u.pm < TLAT / BM) ? (u.pm >> 3) : 16;
        const float* gt = gate + (size_t)mb * 6144;
        const int row0 = u.r0 + wr * 64 + fr, col0 = u.pn * BM + wc * 32 + 8 * fq;
        f32x4 g[2][2];
#pragma unroll
        for (int bj = 0; bj < 2; ++bj)
#pragma unroll
            for (int n = 0; n < 2; ++n) g[bj][n] = *(const f32x4*)(gt + col0 + bj * HALF + 4 * n);
#pragma unroll
        for (int ai = 0; ai < 2; ++ai) if (ai < u.na) {
            u32x4 old[4][2];
#pragma unroll
            for (int m = 0; m < 4; ++m)
#pragma unroll
                for (int bj = 0; bj < 2; ++bj) old[m][bj] = *(const u32x4*)(X + (size_t)(row0 + ai * HALF + m * 16) * DM + col0 + bj * HALF);
#pragma unroll
            for (int m = 0; m < 4; ++m)
#pragma unroll
                for (int bj = 0; bj < 2; ++bj) { const u32x4 o = old[m][bj]; const f32x4 a0 = acc[ai][bj][m][0] * g[bj][0], a1 = acc[ai][bj][m][1] * g[bj][1];
                    u32x4 w; w.x = cvt_pk_bf16(bf2f(o.x & 0xffffu) + a0[0], bf2f(o.x >> 16) + a0[1]); w.y = cvt_pk_bf16(bf2f(o.y & 0xffffu) + a0[2], bf2f(o.y >> 16) + a0[3]);
                    w.z = cvt_pk_bf16(bf2f(o.z & 0xffffu) + a1[0], bf2f(o.z >> 16) + a1[1]); w.w = cvt_pk_bf16(bf2f(o.w & 0xffffu) + a1[2], bf2f(o.w >> 16) + a1[3]);
                    *(u32x4*)(X + (size_t)(row0 + ai * HALF + m * 16) * DM + col0 + bj * HALF) = w; }
        }
    }
};
struct EpiSwiglu {
    static constexpr bool PERM = true;
    unsigned char* ACT;
    DI void operator()(const f32x4 (&acc)[2][2][4][2], const Unit& u, int wr, int wc, int fr, int fq) const {
        const int row0 = u.r0 + wr * 64 + fr, col0 = u.pn * HALF + wc * 32 + 8 * fq;
#pragma unroll
        for (int ai = 0; ai < 2; ++ai) if (ai < u.na)
#pragma unroll
            for (int m = 0; m < 4; ++m) { unsigned char* rowp = ACT + (size_t)(row0 + ai * HALF + m * 16) * FH + col0;
                const f32x4 g0 = acc[ai][0][m][0], g1 = acc[ai][0][m][1], u0 = acc[ai][1][m][0] * F8_ACT_SCALE, u1 = acc[ai][1][m][1] * F8_ACT_SCALE;
                u32x2 w; w.x = cvt_pk_fp8x4(silu_mul(g0[0], u0[0]), silu_mul(g0[1], u0[1]), silu_mul(g0[2], u0[2]), silu_mul(g0[3], u0[3]));
                w.y = cvt_pk_fp8x4(silu_mul(g1[0], u1[0]), silu_mul(g1[1], u1[1]), silu_mul(g1[2], u1[2]), silu_mul(g1[3], u1[3]));
                *(u32x2*)rowp = w; }
    }
};
}

struct Params { const float* in[22]; float* out; unsigned char* ws; };
enum { IN_X = 0, IN_C, IN_CTX, IN_CCTX, IN_WADA, IN_BADA, IN_GATTN, IN_WQKV, IN_WO, IN_SINK, IN_GQ, IN_GK, IN_RPB, IN_GFFN, IN_WGROUP, IN_BGROUP, IN_WROUTER, IN_BROUTER, IN_WGATE, IN_WUP, IN_WDOWN, IN_GFINAL };

DI const float* inp(const Params& P, int i) { i = __builtin_amdgcn_readfirstlane(i); asm volatile("" : "+s"(i)); return P.in[i]; }
DI unsigned char* wsp(const Params& P) { unsigned z = 0; asm volatile("s_mov_b32 %0, 0" : "=s"(z)); return P.ws + z; }
struct Frame { LAS unsigned char* lds; int tid, lane, wave, blk, G, vcu, gw, NGW; };
DI Frame opaque_frame(const Frame& F0) { Frame F = F0; asm volatile("" : "+v"(F.tid)); F.lane = F.tid & 63; asm volatile("" : "+s"(F.wave), "+s"(F.blk), "+s"(F.vcu), "+s"(F.gw)); return F; }

DI void p0_transpose_item(const float* W, int N, int k0, int n0, bf16_t* dst, int Kd, LAS float* scr, int lane) {
#pragma unroll 8
    for (int i = 0; i < 32; ++i) { const int kk = 2 * i + (lane >> 5); scr[kk * 33 + (lane & 31)] = W[(size_t)(k0 + kk) * N + n0 + (lane & 31)]; }
    LDS_WAIT();
    const int c = lane & 7;
#pragma unroll
    for (int j = 0; j < 4; ++j) { const int n = (lane >> 3) + 8 * j; const LAS float* s = scr + (8 * c) * 33 + n;
        u32x4 o; o.x = pk2(s[0 * 33], s[1 * 33]); o.y = pk2(s[2 * 33], s[3 * 33]); o.z = pk2(s[4 * 33], s[5 * 33]); o.w = pk2(s[6 * 33], s[7 * 33]);
        *(u32x4*)(dst + (size_t)n * Kd + 8 * c) = o; }
    LDS_WAIT();
}
DI void p0_transpose_item_f8(const float* W, int N, int k0, int n0, unsigned char* dst, int Kd, LAS float* scr, int lane) {
#pragma unroll 8
    for (int i = 0; i < 32; ++i) { const int kk = 2 * i + (lane >> 5); scr[kk * 33 + (lane & 31)] = W[(size_t)(k0 + kk) * N + n0 + (lane & 31)]; }
    LDS_WAIT();
    const int c = lane & 7;
#pragma unroll
    for (int j = 0; j < 4; ++j) { const int n = (lane >> 3) + 8 * j; const LAS float* s = scr + (8 * c) * 33 + n;
        u32x2 o; o.x = cvt_pk_fp8x4(s[0 * 33] * F8_W_SCALE, s[1 * 33] * F8_W_SCALE, s[2 * 33] * F8_W_SCALE, s[3 * 33] * F8_W_SCALE);
        o.y = cvt_pk_fp8x4(s[4 * 33] * F8_W_SCALE, s[5 * 33] * F8_W_SCALE, s[6 * 33] * F8_W_SCALE, s[7 * 33] * F8_W_SCALE);
        *(u32x2*)(dst + (size_t)n * Kd + 8 * c) = o; }
    LDS_WAIT();
}
DI double dsin_poly(double r) { const double r2 = r * r;
    return r * (1.0 - r2 * (1.0 / 6.0) * (1.0 - r2 * (1.0 / 20.0) * (1.0 - r2 * (1.0 / 42.0) * (1.0 - r2 * (1.0 / 72.0) * (1.0 - r2 * (1.0 / 110.0) * (1.0 - r2 * (1.0 / 156.0) * (1.0 - r2 * (1.0 / 210.0) * (1.0 - r2 * (1.0 / 272.0) * (1.0 - r2 * (1.0 / 342.0) * (1.0 - r2 * (1.0 / 420.0) * (1.0 - r2 * (1.0 / 506.0)))))))))))); }
DI double dcos_poly(double r) { const double r2 = r * r;
    return 1.0 - r2 * (1.0 / 2.0) * (1.0 - r2 * (1.0 / 12.0) * (1.0 - r2 * (1.0 / 30.0) * (1.0 - r2 * (1.0 / 56.0) * (1.0 - r2 * (1.0 / 90.0) * (1.0 - r2 * (1.0 / 132.0) * (1.0 - r2 * (1.0 / 182.0) * (1.0 - r2 * (1.0 / 240.0) * (1.0 - r2 * (1.0 / 306.0) * (1.0 - r2 * (1.0 / 380.0) * (1.0 - r2 * (1.0 / 462.0) * (1.0 - r2 * (1.0 / 552.0)))))))))))); }

constexpr int IT_MOD = DEPTH * 96 * 8;
constexpr int IT_QKV = (DM / 64) * (QKVN / 32), IT_WO = (DM / 64) * (DM / 32), IT_GU = NEXP * (DM / 64) * (FH / 32), IT_DN = NEXP * (FH / 64) * (DM / 32);
constexpr int IT_LAYER = IT_QKV + IT_WO + 2 * IT_GU + IT_DN;
constexpr int IT_TOTAL = IT_MOD + DEPTH * IT_LAYER;

DI void p0_prologue(const Params& P, const Frame& F) {
    LAS float* scr = (LAS float*)(F.lds + F.wave * 16384);
    unsigned char* ws = wsp(P);
    for (int it = F.gw; it < IT_TOTAL; it += F.NGW) {
        if (it < IT_MOD) {
            const int l = it / (96 * 8), rem = it % (96 * 8), cc = rem >> 3, ks = rem & 7;
            for (int idx = F.lane; idx < 17 * 128; idx += 64) { const int b = idx >> 7, k = idx & 127;
                const float cv = (b < 16) ? inp(P, IN_C)[b * DM + ks * 128 + k] : inp(P, IN_CCTX)[ks * 128 + k];
                scr[idx] = cv / (1.f + expf(-cv)); }
            LDS_WAIT();
            float acc[17];
#pragma unroll
            for (int b = 0; b < 17; ++b) acc[b] = 0.f;
            const float* wp = inp(P, IN_WADA) + ((size_t)l * DM + ks * 128) * 6144 + cc * 64 + F.lane;
#pragma unroll 4
            for (int k = 0; k < 128; ++k) { const float w = wp[(size_t)k * 6144];
#pragma unroll
                for (int b = 0; b < 17; ++b) acc[b] += scr[b * 128 + k] * w; }
            float* mp = (float*)(ws + WS_MODP) + ((size_t)(ks * DEPTH + l) * 17) * 6144 + cc * 64 + F.lane;
#pragma unroll
            for (int b = 0; b < 17; ++b) mp[(size_t)b * 6144] = acc[b];
            LDS_WAIT();
            continue;
        }
        int r = it - IT_MOD; const int l = r / IT_LAYER; r -= l * IT_LAYER;
        if (r < IT_QKV) { const int kb = r / (QKVN / 32), nb = r % (QKVN / 32); const int n0 = nb * 32;
            const int drow0 = 256 * (n0 >> 8) + 128 * ((n0 >> 5) & 1) + 32 * ((n0 >> 6) & 3);
            p0_transpose_item_f8(inp(P, IN_WQKV) + (size_t)l * DM * QKVN, QKVN, kb * 64, n0, ws + WS_WQKV + (size_t)l * QKVN * DM + (size_t)drow0 * DM + kb * 64, DM, scr, F.lane); continue; }
        r -= IT_QKV;
        if (r < IT_WO) { const int kb = r / (DM / 32), nb = r % (DM / 32);
            p0_transpose_item_f8(inp(P, IN_WO) + (size_t)l * DM * DM, DM, kb * 64, nb * 32, ws + WS_WO + (size_t)l * DM * DM + (size_t)(nb * 32) * DM + kb * 64, DM, scr, F.lane); continue; }
        r -= IT_WO;
        if (r < 2 * IT_GU) { const int which = r / IT_GU; r -= which * IT_GU; const int e = r / 256, kb = (r % 256) / 16, nb = r % 16; const int n0 = nb * 32;
            const int drow0 = 256 * (n0 >> 7) + 128 * which + (n0 & 127);
            p0_transpose_item_f8(inp(P, which ? IN_WUP : IN_WGATE) + (size_t)(l * NEXP + e) * DM * FH, FH, kb * 64, n0,
                                 ws + WS_WGU + (size_t)(l * NEXP + e) * DM * DM + (size_t)drow0 * DM + kb * 64, DM, scr, F.lane); continue; }
        r -= 2 * IT_GU;
        { const int e = r / 256, kb = (r % 256) / 32, nb = r % 32;
            p0_transpose_item_f8(inp(P, IN_WDOWN) + (size_t)(l * NEXP + e) * FH * DM, DM, kb * 64, nb * 32,
                                 ws + WS_WD + (size_t)(l * NEXP + e) * DM * FH + (size_t)(nb * 32) * FH + kb * 64, FH, scr, F.lane); }
    }
    if (F.gw == F.NGW - 1) {
        f32x2* T = (f32x2*)(ws + WS_ROPE);
        for (int idx = F.lane; idx < 64 * 16; idx += 64) { const int pos = idx >> 4, j = idx & 15;
            const float inv = exp2f(-(float)j * (1.f / 16.f) * 13.287712379549449f);
            const float ang = (float)pos * inv;
            const double a = (double)ang; const double rr = a - 6.283185307179586 * rint(a * 0.15915494309189535);
            T[idx] = (f32x2){(float)dcos_poly(rr), (float)dsin_poly(rr)}; }
    }
    { u32x4* wf = (u32x4*)(ws + WS_WRT); const float* wg = inp(P, IN_WGROUP); const float* wr = inp(P, IN_WROUTER);
      for (int idx = F.gw * 64 + F.lane; idx < DEPTH * 32 * 3 * 2 * 64; idx += F.NGW * 64) { const int l = idx / (32 * 3 * 2 * 64), rem = idx % (32 * 3 * 2 * 64), step = rem / 384, nt = (rem % 384) >> 7, which = (rem >> 6) & 1, ln = rem & 63;
          const int n = 16 * nt + (ln & 15); float w[8];
#pragma unroll
          for (int j = 0; j < 8; ++j) { const int k = 32 * step + 8 * (ln >> 4) + j;
              const float wv = (n < 4) ? wg[((size_t)l * DM + k) * 4 + n] : (n < 36 ? wr[((size_t)l * DM + k) * 32 + (n - 4)] : 0.f);
              const float w1 = bf2f(f2bf(wv)); w[j] = which ? (wv - w1) : wv; }
          u32x4 o; o.x = pk2(w[0], w[1]); o.y = pk2(w[2], w[3]); o.z = pk2(w[4], w[5]); o.w = pk2(w[6], w[7]); wf[idx] = o; } }
}
DI void p0b_mod_reduce(const Params& P, const Frame& F) {
    unsigned char* const ws = wsp(P);
    const float* mp = (const float*)(ws + WS_MODP); float* mod = (float*)(ws + WS_MOD);
    for (int idx = F.gw * 64 + F.lane; idx < DEPTH * 17 * 6144; idx += F.NGW * 64) {
        const int l = idx / (17 * 6144), c = idx % 6144;
        float s = inp(P, IN_BADA)[l * 6144 + c];
#pragma unroll
        for (int ks = 0; ks < 8; ++ks) s += mp[(size_t)ks * DEPTH * 17 * 6144 + idx];
        mod[idx] = s; }
}

DI unsigned expert_count(const unsigned char* ws, int layer, int e) { return __hip_atomic_load((const unsigned*)(ws + WS_CTL) + CW_CNT + (layer * NEXP + e) * CNT_STRIDE, __ATOMIC_RELAXED, __HIP_MEMORY_SCOPE_AGENT); }
DI unsigned expert_starts(const unsigned char* ws, int layer, int lane) {
    const unsigned p = (lane < NEXP) ? ((expert_count(ws, layer, lane & 31) + 255u) & ~255u) : 0u; unsigned incl = p;
#pragma unroll
    for (int d = 1; d < 32; d <<= 1) { const unsigned v = __shfl_up(incl, d); if ((lane & 31) >= d) incl += v; }
    return incl - p;
}

DI void load_row(const float* row, int lane, f32x4 (&v)[4]) {
#pragma unroll
    for (int j = 0; j < 4; ++j) v[j] = *(const f32x4*)(row + 4 * lane + 256 * j);
}
DI void load_row_bf(const bf16_t* row, int lane, f32x4 (&v)[4]) {
#pragma unroll
    for (int j = 0; j < 4; ++j) { const u32x2 w = *(const u32x2*)(row + 4 * lane + 256 * j); v[j] = (f32x4){bf2f(w.x & 0xffffu), bf2f(w.x >> 16), bf2f(w.y & 0xffffu), bf2f(w.y >> 16)}; }
}
DI float row_rstd(const f32x4 (&v)[4]) {
    float s = 0.f;
#pragma unroll
    for (int j = 0; j < 4; ++j) s += (v[j][0] * v[j][0] + v[j][1] * v[j][1]) + (v[j][2] * v[j][2] + v[j][3] * v[j][3]);
    return 1.0f / sqrtf(wave_sum(s) * (1.f / DM) + NORM_EPS);
}
DI void load_vec(const float* p, int lane, f32x4 (&v)[4]) {
#pragma unroll
    for (int j = 0; j < 4; ++j) v[j] = *(const f32x4*)(p + 4 * lane + 256 * j);
}
DI void norm_mod_store(const f32x4 (&v)[4], float rstd, const f32x4 (&gg)[4], const f32x4 (&sh)[4], const f32x4 (&sc)[4], unsigned char* hrow, int lane) {
#pragma unroll
    for (int j = 0; j < 4; ++j) { const int c = 4 * lane + 256 * j;
        const f32x4 hf = ((v[j] * rstd * gg[j]) * (1.f + sc[j]) + sh[j]) * F8_ACT_SCALE;
        *(unsigned*)(hrow + c) = cvt_pk_fp8x4(hf[0], hf[1], hf[2], hf[3]); }
}
struct RowIn { f32x4 x[4]; u32x2 ya[4], yb[4]; };
DI void row_fetch(const unsigned char* ws, const float* xrow, const bf16_t* xrow_bf, int t, unsigned s0, unsigned s1, int lane, bool prev, RowIn& R) {
    if (xrow_bf) load_row_bf(xrow_bf, lane, R.x); else load_row(xrow, lane, R.x);
    if (prev) {
        const bf16_t* Y = (const bf16_t*)(ws + WS_Y);
#pragma unroll
        for (int j = 0; j < 4; ++j) { R.ya[j] = *(const u32x2*)(Y + (size_t)s0 * DM + 4 * lane + 256 * j); R.yb[j] = *(const u32x2*)(Y + (size_t)s1 * DM + 4 * lane + 256 * j); } }
}
DI void row_apply(const f32x4 (&gt)[4], float w0, float w1, RowIn& R) {
#pragma unroll
    for (int j = 0; j < 4; ++j) { const f32x4 g = gt[j]; const u32x2 a = R.ya[j], b = R.yb[j];
        R.x[j][0] += g[0] * (w0 * bf2f(a.x & 0xffffu) + w1 * bf2f(b.x & 0xffffu)); R.x[j][1] += g[1] * (w0 * bf2f(a.x >> 16) + w1 * bf2f(b.x >> 16));
        R.x[j][2] += g[2] * (w0 * bf2f(a.y & 0xffffu) + w1 * bf2f(b.y & 0xffffu)); R.x[j][3] += g[3] * (w0 * bf2f(a.y >> 16) + w1 * bf2f(b.y >> 16)); }
}
DI void phase_attn_norm(const Params& P, const Frame& F0, int layer) {
    const Frame F = opaque_frame(F0);
    unsigned char* const ws = wsp(P);
    bf16_t* X = (bf16_t*)(ws + WS_X); bf16_t* H = (bf16_t*)(ws + WS_H);
    const bool prev = layer > 0;
    const int nrow = (TALL - F.gw + F.NGW - 1) / F.NGW;
    unsigned ms0 = 0, ms1 = 0; float mw0 = 0.f, mw1 = 0.f;
    if (prev) { const unsigned pst = expert_starts(ws, layer - 1, F.lane); u32x2 a = (u32x2){0u, 0u};
        if (F.lane < nrow) { const int tl = F.gw + F.lane * F.NGW; a = *(const u32x2*)((const unsigned*)(ws + WS_ASG) + (size_t)tl * 2); const f32x2 w = *(const f32x2*)((const float*)(ws + WS_ASGW) + (size_t)tl * 2); mw0 = w.x; mw1 = w.y; }
        ms0 = (unsigned)__shfl((int)pst, (int)(a.x >> 20)) + (a.x & 0xfffffu); ms1 = (unsigned)__shfl((int)pst, (int)(a.y >> 20)) + (a.y & 0xfffffu); }
    auto xsrc = [&](int t) -> const float* { return (t < TLAT ? inp(P, IN_X) + (size_t)t * DM : inp(P, IN_CTX) + (size_t)(t - TLAT) * DM); };
    auto xbf = [&](int t) -> const bf16_t* { return prev ? X + (size_t)t * DM : (const bf16_t*)nullptr; };
    RowIn cur, nxt;
    f32x4 gat[4]; load_vec(inp(P, IN_GATTN) + layer * DM, F.lane, gat);
    row_fetch(ws, xsrc(F.gw), xbf(F.gw), F.gw, __shfl(ms0, 0), __shfl(ms1, 0), F.lane, prev, cur);
    for (int i = 0; i < nrow; ++i) {
        const int t = F.gw + i * F.NGW; const int mb = (t < TLAT) ? (t >> 11) : 16;
        const float* md = (const float*)(ws + WS_MOD) + ((size_t)layer * 17 + mb) * 6144;
        f32x4 gt[4], sh[4], sc[4];
        if (prev) load_vec(md - 17 * 6144 + 5120, F.lane, gt);
        load_vec(md, F.lane, sh); load_vec(md + 1024, F.lane, sc);
        asm volatile("" ::: "memory");
        if (i + 1 < nrow) row_fetch(ws, xsrc(t + F.NGW), xbf(t + F.NGW), t + F.NGW, __shfl(ms0, i + 1), __shfl(ms1, i + 1), F.lane, prev, nxt);
        if (prev) row_apply(gt, __shfl(mw0, i), __shfl(mw1, i), cur);
#pragma unroll
        for (int j = 0; j < 4; ++j) { u32x2 w; w.x = pk2(cur.x[j][0], cur.x[j][1]); w.y = pk2(cur.x[j][2], cur.x[j][3]); *(u32x2*)(X + (size_t)t * DM + 4 * F.lane + 256 * j) = w; }
        const float rstd = row_rstd(cur.x);
        norm_mod_store(cur.x, rstd, gat, sh, sc, (unsigned char*)H + (size_t)t * DM, F.lane);
        cur = nxt;
    }
}
DI void phase_final(const Params& P, const Frame& F0) {
    const Frame F = opaque_frame(F0);
    unsigned char* const ws = wsp(P);
    const bf16_t* X = (const bf16_t*)(ws + WS_X);
    const float pc = PROBE_SEL ? *((const float*)(ws + WS_CTL) + 64) : 0.f;
    const int nrow = (TLAT - F.gw + F.NGW - 1) / F.NGW;
    unsigned ms0 = 0, ms1 = 0; float mw0 = 0.f, mw1 = 0.f;
    { const unsigned pst = expert_starts(ws, DEPTH - 1, F.lane); u32x2 a = (u32x2){0u, 0u};
      if (F.lane < nrow) { const int tl = F.gw + F.lane * F.NGW; a = *(const u32x2*)((const unsigned*)(ws + WS_ASG) + (size_t)tl * 2); const f32x2 w = *(const f32x2*)((const float*)(ws + WS_ASGW) + (size_t)tl * 2); mw0 = w.x; mw1 = w.y; }
      ms0 = (unsigned)__shfl((int)pst, (int)(a.x >> 20)) + (a.x & 0xfffffu); ms1 = (unsigned)__shfl((int)pst, (int)(a.y >> 20)) + (a.y & 0xfffffu); }
    RowIn cur, nxt;
    row_fetch(ws, nullptr, X + (size_t)F.gw * DM, F.gw, __shfl(ms0, 0), __shfl(ms1, 0), F.lane, true, cur);
    f32x4 gfin[4]; load_vec(inp(P, IN_GFINAL), F.lane, gfin);
    for (int i = 0; i < nrow; ++i) {
        const int t = F.gw + i * F.NGW;
        f32x4 gt[4]; load_vec((const float*)(ws + WS_MOD) + ((size_t)(DEPTH - 1) * 17 + (t >> 11)) * 6144 + 5120, F.lane, gt);
        asm volatile("" ::: "memory");
        if (i + 1 < nrow) row_fetch(ws, nullptr, X + (size_t)(t + F.NGW) * DM, t + F.NGW, __shfl(ms0, i + 1), __shfl(ms1, i + 1), F.lane, true, nxt);
        row_apply(gt, __shfl(mw0, i), __shfl(mw1, i), cur);
        const float rstd = row_rstd(cur.x);
#pragma unroll
        for (int j = 0; j < 4; ++j) { const int c = 4 * F.lane + 256 * j; *(f32x4*)(P.out + (size_t)t * DM + c) = cur.x[j] * rstd * gfin[j] + pc; }
        cur = nxt;
    }
}

DI float swap_max(float v) { auto rr = __builtin_amdgcn_permlane32_swap(__float_as_uint(v), __float_as_uint(v), false, false); return fmaxf(__uint_as_float(rr[0]), __uint_as_float(rr[1])); }
DI float swap_add(float v) { auto rr = __builtin_amdgcn_permlane32_swap(__float_as_uint(v), __float_as_uint(v), false, false); return __uint_as_float(rr[0]) + __uint_as_float(rr[1]); }
DI bf16x8 pack_p(const f32x16& p, int s) {
    u32x4 w; w.x = cvt_pk_bf16(p[8 * s + 0], p[8 * s + 1]); w.y = cvt_pk_bf16(p[8 * s + 2], p[8 * s + 3]); w.z = cvt_pk_bf16(p[8 * s + 4], p[8 * s + 5]); w.w = cvt_pk_bf16(p[8 * s + 6], p[8 * s + 7]);
    return __builtin_bit_cast(bf16x8, w);
}
struct AttnState { float m, l; f32x16 o[2]; };
DI void load_k(const unsigned char* Kbh, int kg, int r32, int hi, bf16x8 (&k)[4]) {
    const unsigned char* kb = Kbh + (size_t)(kg + (r32 >> 3)) * 1024 + hi * 128 + (r32 & 7) * 16;
#pragma unroll
    for (int d0 = 0; d0 < 4; ++d0) k[d0] = *(const bf16x8*)(kb + d0 * 256);
}
DI void load_v(const unsigned char* Vbh, int kg, int r32, int hi, s16x4 (&v)[2][2][2]) {
    const unsigned char* vb = Vbh + (size_t)kg * 1024 + r32 * 16 + hi * 8;
#pragma unroll
    for (int dh = 0; dh < 2; ++dh)
#pragma unroll
        for (int ks = 0; ks < 2; ++ks)
#pragma unroll
            for (int pt = 0; pt < 2; ++pt) v[dh][ks][pt] = *(const s16x4*)(vb + dh * 512 + (2 * ks + pt) * 1024);
}
DI f32x16 attn_scores(const bf16x8 (&k)[4], const bf16x8 (&q)[4]) {
    f32x16 s;
#pragma unroll
    for (int r = 0; r < 16; ++r) s[r] = 0.f;
#pragma unroll
    for (int d0 = 0; d0 < 4; ++d0) s = __builtin_amdgcn_mfma_f32_32x32x16_bf16(k[d0], q[d0], s, 0, 0, 0);
    return s;
}
DI float row_max16(const f32x16& s) {
    float mt = fmaxf(fmaxf(s[0], s[1]), fmaxf(s[2], s[3]));
#pragma unroll
    for (int r = 4; r < 16; r += 4) mt = fmaxf(mt, fmaxf(fmaxf(s[r], s[r + 1]), fmaxf(s[r + 2], s[r + 3])));
    return mt;
}
DI void attn_rescale(AttnState& st, f32x16& s, float mt, LAS float* wsf, int r32, int hi) {
    mt = swap_max(mt);
    const float dm = fmaxf(mt, 0.f);
    const float al = __builtin_amdgcn_exp2f(-dm);
    st.l *= al; st.m += dm;
#pragma unroll
    for (int r = 0; r < 16; ++r) s[r] -= dm;
    if (hi == 0) wsf[r32] = al;
    LDS_WAIT();
#pragma unroll
    for (int r = 0; r < 16; ++r) { const float f = wsf[crow(r, hi)]; st.o[0][r] *= f; st.o[1][r] *= f; }
    LDS_WAIT();
}
DI void attn_exp_pv(AttnState& st, f32x16& s, const s16x4 (&v)[2][2][2]) {
    float p0 = 0.f, p1 = 0.f;
#pragma unroll
    for (int r = 0; r < 16; r += 2) { s[r] = __builtin_amdgcn_exp2f(s[r]); s[r + 1] = __builtin_amdgcn_exp2f(s[r + 1]); p0 += s[r]; p1 += s[r + 1]; }
    st.l += p0 + p1;
    const bf16x8 pa0 = pack_p(s, 0), pa1 = pack_p(s, 1);
#pragma unroll
    for (int dh = 0; dh < 2; ++dh) {
        const bf16x8 vf0 = __builtin_shufflevector(v[dh][0][0], v[dh][0][1], 0, 1, 2, 3, 4, 5, 6, 7);
        const bf16x8 vf1 = __builtin_shufflevector(v[dh][1][0], v[dh][1][1], 0, 1, 2, 3, 4, 5, 6, 7);
        st.o[dh] = __builtin_amdgcn_mfma_f32_32x32x16_bf16(pa0, vf0, st.o[dh], 0, 0, 0);
        st.o[dh] = __builtin_amdgcn_mfma_f32_32x32x16_bf16(pa1, vf1, st.o[dh], 0, 0, 0);
    }
}
DI void attn_softmax_pv2(AttnState (&st)[2], f32x16 (&s)[2], const s16x4 (&v)[2][2][2], LAS float* wsf, int r32, int hi) {
#pragma unroll
    for (int r = 0; r < 16; ++r) { s[0][r] -= st[0].m; s[1][r] -= st[1].m; }
    const float mt0 = row_max16(s[0]), mt1 = row_max16(s[1]);
    if (__any(fmaxf(mt0, mt1) > 8.f)) { attn_rescale(st[0], s[0], mt0, wsf, r32, hi); attn_rescale(st[1], s[1], mt1, wsf + 32, r32, hi); }
    attn_exp_pv(st[0], s[0], v);
    attn_exp_pv(st[1], s[1], v);
}
template <int MODE>
DI void attn_unit(const Params& P, unsigned char* ws, int layer, int b, int h0, int qblk, LAS unsigned char* wl, int lane) {
    const int r32 = lane & 31, hi = lane >> 5, kvh = h0 >> 2, m = layer % 3;
    constexpr bool VDB = false;
    LAS float* wsf = (LAS float*)wl; LAS bf16_t* stg = (LAS bf16_t*)(wl + 256); LAS float* rpbt = (LAS float*)(wl + 256 + 4096);
    const bf16_t* QKV = (const bf16_t*)(ws + WS_QKV);
    const unsigned char* Kbh = ws + WS_KF + (size_t)(b * NKV + kvh) * KGRP * 1024;
    const unsigned char* Vbh = ws + WS_VF + (size_t)(b * NKV + kvh) * KGRP * 1024;
    unsigned char* O = ws + WS_O;
    int r0 = 0, c0 = 0;
    if (MODE == 2) { r0 = 2 * (qblk >> 2); c0 = 16 * (qblk & 3); }
    auto qtok = [&](int i) -> int {
        if (MODE == 3) return TLAT + b * CTXL + qblk * 32 + i;
        if (MODE == 2) return b * SEQ + (r0 + (i >> 4)) * 64 + c0 + (i & 15);
        return b * SEQ + qblk * 32 + i; };
    const int tq = qtok(r32);
    const bf16_t* qp = QKV + (size_t)tq * QKVN + h0 * HD + hi * 8;
    bf16x8 qr[2][4];
#pragma unroll
    for (int hh = 0; hh < 2; ++hh)
#pragma unroll
        for (int d0 = 0; d0 < 4; ++d0) qr[hh][d0] = *(const bf16x8*)(qp + hh * HD + d0 * 16);
    const int q0 = qblk * 32;
    int nl = 0, jlo = 0, rs_min = 0, cseg = 0;
    if (MODE == 0) { jlo = (q0 < 128) ? (128 - q0) / 32 : 0; const int jhi = min(8, (SEQ - 32 - q0 + 128) / 32); nl = jhi - jlo + 1; }
    if (MODE == 1) nl = SEQ / 32;
    if (MODE == 2) { rs_min = min(max(r0 - 4, 0), 24); const int rs_max = min(max(r0 + 1 - 4, 0), 24); nl = rs_max - rs_min + 8; cseg = (c0 == 0) ? 0 : (c0 == 16) ? 8 : (c0 == 32) ? 24 : 32; }
    auto lat_kg = [&](int i) -> int {
        if (MODE == 0) return (q0 - 128 + 32 * (jlo + i)) >> 3;
        if (MODE == 1) return 4 * i;
        return ((rs_min + i) * 64 + cseg) >> 3; };
    bf16x8 kn[4];
    load_k(Kbh, nl > 0 ? lat_kg(0) : SEQ / 8, r32, hi, kn);
    if (MODE == 0 || MODE == 1) {
        const int n = tq & 2047; const f32x2* T = (const f32x2*)(ws + WS_ROPE);
        const f32x2* tr = T + (n >> 6) * 16 + 8 * hi; const f32x2* tc = T + (n & 63) * 16 + 8 * hi;
#pragma unroll
        for (int e = 0; e < 8; ++e) { const f32x2 a = tr[e], cc = tc[e];
#pragma unroll
            for (int hh = 0; hh < 2; ++hh) {
                const float x1 = bfs2f(qr[hh][0][e]), x2 = bfs2f(qr[hh][1][e]), x3 = bfs2f(qr[hh][2][e]), x4 = bfs2f(qr[hh][3][e]);
                qr[hh][0][e] = (short)f2bf(x1 * a.x - x2 * a.y); qr[hh][1][e] = (short)f2bf(x2 * a.x + x1 * a.y);
                qr[hh][2][e] = (short)f2bf(x3 * cc.x - x4 * cc.y); qr[hh][3][e] = (short)f2bf(x4 * cc.x + x3 * cc.y); } }
    }
    LAS bf16x8* qlds = (LAS bf16x8*)(wl + 8192) + lane;
    if (VDB) {
#pragma unroll
        for (int d0 = 0; d0 < 4; ++d0) qlds[d0 * 64] = qr[1][d0];
        LDS_WAIT();
    }
    int rq = 0, cq = 0, rsq = 0, csq = 0;
    if (MODE == 2) {
        const float* rpb = inp(P, IN_RPB) + (size_t)h0 * 465;
        for (int i = lane; i < 930; i += 64) rpbt[i + (i >= 465 ? 7 : 0)] = rpb[i] * LOG2E;
        LDS_WAIT();
        rq = r0 + (r32 >> 4); cq = c0 + (r32 & 15); rsq = min(max(rq - 4, 0), 24); csq = min(max(cq - 8, 0), 48);
    }
    AttnState st[2];
#pragma unroll
    for (int hh = 0; hh < 2; ++hh) { st[hh].m = -1024.f; st[hh].l = 0.f;
#pragma unroll
        for (int r = 0; r < 16; ++r) { st[hh].o[0][r] = 0.f; st[hh].o[1][r] = 0.f; } }
    const float NEG = -INFINITY;
    s16x4 vn[2][2][2];
    if (VDB) load_v(Vbh, nl > 0 ? lat_kg(0) : SEQ / 8, r32, hi, vn);
    for (int i = 0; i < nl; ++i) {
        const int kgn = (i + 1 < nl) ? lat_kg(i + 1) : SEQ / 8;
        s16x4 v[2][2][2];
        if (VDB) {
#pragma unroll
            for (int a = 0; a < 2; ++a)
#pragma unroll
                for (int c = 0; c < 2; ++c)
#pragma unroll
                    for (int e = 0; e < 2; ++e) v[a][c][e] = vn[a][c][e];
        } else load_v(Vbh, lat_kg(i), r32, hi, v);
        f32x16 s[2];
        s[0] = attn_scores(kn, qr[0]);
        if (VDB) { bf16x8 q1[4];
#pragma unroll
            for (int d0 = 0; d0 < 4; ++d0) q1[d0] = qlds[d0 * 64];
            s[1] = attn_scores(kn, q1); }
        else s[1] = attn_scores(kn, qr[1]);
        load_k(Kbh, kgn, r32, hi, kn);
        if (VDB) load_v(Vbh, kgn, r32, hi, vn);
        if (MODE == 0) {
            const int j = jlo + i;
            if (j == 0 || j == 8) { const int kt = q0 - 128 + 32 * j, qpos = q0 + r32;
#pragma unroll
                for (int r = 0; r < 16; ++r) { const int d = kt + crow(r, hi) - qpos; if (d > 128 || d < -128) { s[0][r] = NEG; s[1][r] = NEG; } } }
        }
        if (MODE == 2) {
            const int kr = rs_min + i;
            const bool rowok = (kr >= rsq) && (kr < rsq + 8);
            const int ib = (kr - rq + 7) * 31 - cq + 15;
#pragma unroll
            for (int r = 0; r < 16; ++r) { const int kc2 = cseg + crow(r, hi); const bool ok = rowok && (kc2 >= csq) && (kc2 < csq + 16);
                const int idx = min(max(ib + kc2, 0), 464);
                s[0][r] = ok ? s[0][r] + rpbt[idx] : NEG; s[1][r] = ok ? s[1][r] + rpbt[472 + idx] : NEG; }
        }
        attn_softmax_pv2(st, s, v, wsf, r32, hi);
    }
    if (MODE == 0 || MODE == 1) {
#pragma unroll
        for (int hh = 0; hh < 2; ++hh)
#pragma unroll
            for (int d0 = 0; d0 < 4; ++d0) qr[hh][d0] = *(const bf16x8*)(qp + hh * HD + d0 * 16);
        if (VDB) {
#pragma unroll
            for (int d0 = 0; d0 < 4; ++d0) qlds[d0 * 64] = qr[1][d0];
            LDS_WAIT();
        }
    }
    for (int j = 0; j < CTXL / 32; ++j) {
        const int kg = SEQ / 8 + 4 * j, kgn = (j + 1 < CTXL / 32) ? kg + 4 : kg;
        s16x4 v[2][2][2];
        if (VDB) {
#pragma unroll
            for (int a = 0; a < 2; ++a)
#pragma unroll
                for (int c = 0; c < 2; ++c)
#pragma unroll
                    for (int e = 0; e < 2; ++e) v[a][c][e] = vn[a][c][e];
        } else load_v(Vbh, kg, r32, hi, v);
        f32x16 s[2];
        s[0] = attn_scores(kn, qr[0]);
        if (VDB) { bf16x8 q1[4];
#pragma unroll
            for (int d0 = 0; d0 < 4; ++d0) q1[d0] = qlds[d0 * 64];
            s[1] = attn_scores(kn, q1); }
        else s[1] = attn_scores(kn, qr[1]);
        load_k(Kbh, kgn, r32, hi, kn);
        if (VDB) load_v(Vbh, kgn, r32, hi, vn);
        attn_softmax_pv2(st, s, v, wsf, r32, hi);
    }
    int lane2 = lane; asm volatile("" : "+v"(lane2));
    const int r32b = lane2 & 31, hib = lane2 >> 5;
#pragma unroll
    for (int hh = 0; hh < 2; ++hh) {
        const float lt = swap_add(st[hh].l);
        float inv;
        if (MODE == 0 || (MODE == 3 && m == 0)) { const float sk = inp(P, IN_SINK)[(layer / 3) * NH + h0 + hh] * LOG2E;
            const float mnew = fmaxf(st[hh].m, sk); const float al = __builtin_amdgcn_exp2f(st[hh].m - mnew), es = __builtin_amdgcn_exp2f(sk - mnew);
            inv = F8_O_SCALE * al / (lt * al + es); }
        else inv = F8_O_SCALE / lt;
        if (hib == 0) wsf[r32b] = inv;
        LDS_WAIT();
        LAS bf16_t* sb = stg + hib * 256 + r32b;
        const LAS float* wf = wsf + 4 * hib;
#pragma unroll
        for (int r = 0; r < 16; ++r) { const float f = wf[(r & 3) + 8 * (r >> 2)];
            sb[((r & 3) + 8 * (r >> 2)) * 64] = (bf16_t)f2bf(st[hh].o[0][r] * f); sb[((r & 3) + 8 * (r >> 2)) * 64 + 32] = (bf16_t)f2bf(st[hh].o[1][r] * f); }
        LDS_WAIT();
        const int rw = lane2 >> 3, ch = lane2 & 7;
        const LAS unsigned char* rb = (const LAS unsigned char*)stg + rw * 128 + ch * 16;
#pragma unroll
        for (int i = 0; i < 4; ++i) { const u32x4 vv = *(const LAS u32x4*)(rb + i * 1024);
            u32x2 w8; w8.x = cvt_pk_fp8x4(bf2f(vv.x & 0xffffu), bf2f(vv.x >> 16), bf2f(vv.y & 0xffffu), bf2f(vv.y >> 16)); w8.y = cvt_pk_fp8x4(bf2f(vv.z & 0xffffu), bf2f(vv.z >> 16), bf2f(vv.w & 0xffffu), bf2f(vv.w >> 16));
            *(u32x2*)(O + (size_t)qtok(i * 8 + rw) * DM + (h0 + hh) * HD + ch * 8) = w8; }
        LDS_WAIT();
    }
}
DI void phase_attention(const Params& P, const Frame& F0, int layer) {
    const Frame F = opaque_frame(F0);
    unsigned char* const ws = wsp(P);
    const int m = layer % 3;
    LAS unsigned char* wl = F.lds + F.wave * 16384;
    for (int bu = F.blk; bu < NB * NKV * 16; bu += F.G) {
        const int rnd = bu >> 8, x = bu & 7, loc = (bu & 255) >> 3;
        const int bkv = rnd * 16 + x * 2 + (loc >> 4), qg = loc & 15;
        const int b = bkv >> 2, kvh = bkv & 3, h0 = kvh * 4 + 2 * (F.wave & 1), qblk = 4 * qg + (F.wave >> 1);
        if (m == 0) attn_unit<0>(P, ws, layer, b, h0, qblk, wl, F.lane);
        else if (m == 1) attn_unit<1>(P, ws, layer, b, h0, qblk, wl, F.lane);
        else attn_unit<2>(P, ws, layer, b, h0, qblk, wl, F.lane);
    }
    if (layer < DEPTH - 1) {
        for (int bu = F.blk; bu < NB * NKV * 2; bu += F.G) {
            const int bkv = bu >> 1, b = bkv >> 2, kvh = bkv & 3, h0 = kvh * 4 + 2 * (F.wave & 1), qblk = 4 * (bu & 1) + (F.wave >> 1);
            attn_unit<3>(P, ws, layer, b, h0, qblk, wl, F.lane);
        }
    }
}

DI int blk_token(int blk, int i) { return i < 128 ? blk * 128 + i : TLAT + blk * 16 + (i - 128); }
constexpr int RT_ROWB = 2064;
constexpr int RT_X2_OFF = 16 * RT_ROWB, RT_PART_OFF = 2 * 16 * RT_ROWB, RT_LOG_OFF = RT_PART_OFF + 8 * 16 * 48 * 4, RT_LOGS = 37, RT_VEC_OFF = RT_LOG_OFF + 144 * RT_LOGS * 4;
DI void phase_router(const Params& P, const Frame& F0, int layer, int M) {
    const Frame F = opaque_frame(F0);
    unsigned char* const ws = wsp(P);
    const int TPB = M / GRID, nchunk = TPB / 16;
    LAS int* hist = (LAS int*)(F.lds + LDSX_OFF);
    LAS float* part = (LAS float*)(F.lds + RT_PART_OFF); LAS float* logit = (LAS float*)(F.lds + RT_LOG_OFF);
    if (F.tid < 32) hist[F.tid] = 0;
    const bf16_t* X = (const bf16_t*)(ws + WS_X); bf16_t* H = (bf16_t*)(ws + WS_H);
    const float* gffn = inp(P, IN_GFFN) + layer * DM;
    const u32x4* wf = (const u32x4*)(ws + WS_WRT) + ((size_t)layer * 32 + 4 * F.wave) * 384 + F.lane;
    bf16x8 wreg[4][2][2];
#pragma unroll
    for (int s = 0; s < 4; ++s)
#pragma unroll
        for (int nt = 0; nt < 2; ++nt)
#pragma unroll
            for (int wh = 0; wh < 2; ++wh) wreg[s][nt][wh] = __builtin_bit_cast(bf16x8, wf[s * 384 + nt * 128 + wh * 64]);
    bf16x8 w2t[4][2];
#pragma unroll
    for (int s = 0; s < 4; ++s)
#pragma unroll
        for (int wh = 0; wh < 2; ++wh) w2t[s][wh] = __builtin_bit_cast(bf16x8, wf[s * 384 + 256 + wh * 64]);
    LAS float* vec = (LAS float*)(F.lds + RT_VEC_OFF);
    auto load_vecs = [&](int mb) {
        const float* md = (const float*)(ws + WS_MOD) + ((size_t)layer * 17 + mb) * 6144;
        for (int i = F.tid; i < 256; i += NTHREADS) { const f32x4 g = *(const f32x4*)(gffn + 4 * i), sc = *(const f32x4*)(md + 4096 + 4 * i);
            *(LAS f32x4*)(vec + 4 * i) = *(const f32x4*)(md + 2048 + 4 * i); *(LAS f32x4*)(vec + 1024 + 4 * i) = g * (1.f + sc); *(LAS f32x4*)(vec + 2048 + 4 * i) = *(const f32x4*)(md + 3072 + 4 * i); } };
    load_vecs(F.blk >> 4);
    const int ib = 2 * F.wave;
    f32x4 vn[2][4];
#pragma unroll
    for (int tk = 0; tk < 2; ++tk) { const int t = blk_token(F.blk, ib + tk); load_row_bf(X + (size_t)t * DM, F.lane, vn[tk]); }
    LDS_WAIT(); __syncthreads();
    for (int c = 0; c < nchunk; ++c) {
        if (c == 8) { load_vecs(16); LDS_WAIT(); __syncthreads(); }
#pragma unroll
        for (int tk = 0; tk < 2; ++tk) { const int t = blk_token(F.blk, c * 16 + ib + tk);
            const float rstd = row_rstd(vn[tk]);
            LAS unsigned char* r1 = F.lds + (ib + tk) * RT_ROWB + 8 * F.lane; unsigned char* hrow = (unsigned char*)H + (size_t)t * DM;
#pragma unroll
            for (int j = 0; j < 4; ++j) { const int cc = 4 * F.lane + 256 * j; const f32x4 ga = *(const LAS f32x4*)(vec + 1024 + cc), sh = *(const LAS f32x4*)(vec + 2048 + cc);
                const f32x4 hf = (vn[tk][j] * rstd) * ga + sh;
                u32x2 a; a.x = pk2(hf[0], hf[1]); a.y = pk2(hf[2], hf[3]);
                u32x2 b; b.x = pk2(hf[0] - bf2f(a.x & 0xffffu), hf[1] - bf2f(a.x >> 16)); b.y = pk2(hf[2] - bf2f(a.y & 0xffffu), hf[3] - bf2f(a.y >> 16));
                *(unsigned*)(hrow + cc) = cvt_pk_fp8x4(hf[0] * F8_ACT_SCALE, hf[1] * F8_ACT_SCALE, hf[2] * F8_ACT_SCALE, hf[3] * F8_ACT_SCALE); *(LAS u32x2*)(r1 + 512 * j) = a; *(LAS u32x2*)(r1 + RT_X2_OFF + 512 * j) = b; } }
        if (c + 1 < nchunk) {
#pragma unroll
            for (int tk = 0; tk < 2; ++tk) { const int t = blk_token(F.blk, (c + 1) * 16 + ib + tk); load_row_bf(X + (size_t)t * DM, F.lane, vn[tk]); }
        }
        LDS_WAIT(); __syncthreads();
        f32x4 acc[3];
#pragma unroll
        for (int nt = 0; nt < 3; ++nt) acc[nt] = (f32x4){0.f, 0.f, 0.f, 0.f};
        { const LAS unsigned char* ap = F.lds + (F.lane & 15) * RT_ROWB + 256 * F.wave + 16 * (F.lane >> 4);
#pragma unroll
          for (int s = 0; s < 4; ++s) { const bf16x8 a1 = *(const LAS bf16x8*)(ap + 64 * s), a2 = *(const LAS bf16x8*)(ap + RT_X2_OFF + 64 * s);
#pragma unroll
              for (int nt = 0; nt < 2; ++nt) { acc[nt] = __builtin_amdgcn_mfma_f32_16x16x32_bf16(a1, wreg[s][nt][0], acc[nt], 0, 0, 0);
                  acc[nt] = __builtin_amdgcn_mfma_f32_16x16x32_bf16(a1, wreg[s][nt][1], acc[nt], 0, 0, 0); acc[nt] = __builtin_amdgcn_mfma_f32_16x16x32_bf16(a2, wreg[s][nt][0], acc[nt], 0, 0, 0); }
              acc[2] = __builtin_amdgcn_mfma_f32_16x16x32_bf16(a1, w2t[s][0], acc[2], 0, 0, 0);
              acc[2] = __builtin_amdgcn_mfma_f32_16x16x32_bf16(a1, w2t[s][1], acc[2], 0, 0, 0); acc[2] = __builtin_amdgcn_mfma_f32_16x16x32_bf16(a2, w2t[s][0], acc[2], 0, 0, 0); } }
        { LAS float* pp = part + F.wave * 768 + (4 * (F.lane >> 4)) * 48 + (F.lane & 15);
#pragma unroll
          for (int nt = 0; nt < 3; ++nt)
#pragma unroll
              for (int r = 0; r < 4; ++r) pp[r * 48 + 16 * nt] = acc[nt][r]; }
        LDS_WAIT(); __syncthreads();
        { const int tk = F.tid >> 5, n = F.tid & 31; float s = 0.f;
#pragma unroll
          for (int w = 0; w < 8; ++w) s += part[w * 768 + tk * 48 + n];
          logit[(c * 16 + tk) * RT_LOGS + n] = s;
          if (F.tid < 64) { const int tk2 = F.tid >> 2, n2 = 32 + (F.tid & 3); float s2 = 0.f;
#pragma unroll
              for (int w = 0; w < 8; ++w) s2 += part[w * 768 + tk2 * 48 + n2];
              logit[(c * 16 + tk2) * RT_LOGS + n2] = s2; } }
    }
    LDS_WAIT(); __syncthreads();
    int rt_t = 0, rt_e1 = 0, rt_e2 = 0, rt_q1 = 0, rt_q2 = 0; float rt_w1 = 0.f, rt_w2 = 0.f;
    if (F.tid < TPB) { const int t = blk_token(F.blk, F.tid); const LAS float* lg = logit + F.tid * RT_LOGS;
        const float* bg = inp(P, IN_BGROUP) + layer * 4; const float* br = inp(P, IN_BROUTER) + layer * 32;
        const float g0 = lg[0] + bg[0], g1 = lg[1] + bg[1], g2 = lg[2] + bg[2], g3 = lg[3] + bg[3];
        int grp = 0; float gm = g0; if (g1 > gm) { gm = g1; grp = 1; } if (g2 > gm) { gm = g2; grp = 2; } if (g3 > gm) { gm = g3; grp = 3; }
        const float ptop = 1.f / (expf(g0 - gm) + expf(g1 - gm) + expf(g2 - gm) + expf(g3 - gm));
        float ev[8], em = -INFINITY;
#pragma unroll
        for (int j = 0; j < 8; ++j) { ev[j] = lg[4 + grp * 8 + j] + br[grp * 8 + j]; em = fmaxf(em, ev[j]); }
        float pe[8];
#pragma unroll
        for (int j = 0; j < 8; ++j) pe[j] = expf(ev[j] - em);
        int i1 = 0; float p1 = pe[0];
#pragma unroll
        for (int j = 1; j < 8; ++j) if (pe[j] > p1) { p1 = pe[j]; i1 = j; }
        int i2 = 0; float p2 = -1.f;
#pragma unroll
        for (int j = 0; j < 8; ++j) if (j != i1 && pe[j] > p2) { p2 = pe[j]; i2 = j; }
        const float w1 = ptop * p1 / (p1 + p2), w2 = ptop * p2 / (p1 + p2);
        const int e1 = grp * 8 + i1, e2 = grp * 8 + i2;
        rt_q1 = atomicAdd((int*)&hist[e1], 1); rt_q2 = atomicAdd((int*)&hist[e2], 1);
        rt_t = t; rt_e1 = e1; rt_e2 = e2; rt_w1 = w1; rt_w2 = w2; }
    __syncthreads();
    LAS unsigned* gbase = (LAS unsigned*)(hist + 32);
    if (F.tid < 32) gbase[F.tid] = __hip_atomic_fetch_add((unsigned*)(ws + WS_CTL) + CW_CNT + (layer * NEXP + F.tid) * CNT_STRIDE, (unsigned)hist[F.tid], __ATOMIC_RELAXED, __HIP_MEMORY_SCOPE_AGENT);
    LDS_WAIT(); __syncthreads();
    if (F.tid < TPB) { const unsigned i1 = gbase[rt_e1] + (unsigned)rt_q1, i2 = gbase[rt_e2] + (unsigned)rt_q2;
        unsigned* asg = (unsigned*)(ws + WS_ASG); float* asgw = (float*)(ws + WS_ASGW); unsigned* toke = (unsigned*)(ws + WS_TOKE);
        *(u32x2*)(asg + (size_t)rt_t * 2) = (u32x2){((unsigned)rt_e1 << 20) | i1, ((unsigned)rt_e2 << 20) | i2};
        *(f32x2*)(asgw + (size_t)rt_t * 2) = (f32x2){rt_w1, rt_w2};
        toke[(size_t)rt_e1 * TALL + i1] = (unsigned)rt_t; toke[(size_t)rt_e2 * TALL + i2] = (unsigned)rt_t; }
}
DI void build_tile_table(const Params& P, const Frame& F0, LAS unsigned* tab, int layer) {
    const Frame F = opaque_frame(F0);
    unsigned char* const ws = wsp(P);
    constexpr int TP = pg8::MoeSched<true>::TAB_PST, TC = pg8::MoeSched<true>::TAB_CNT;
    if (F.tid < NEXP) tab[TC + F.tid] = expert_count(ws, layer, F.tid);
    LDS_WAIT(); __syncthreads();
    if (F.tid == 0) { unsigned ps = 0; for (int e = 0; e < NEXP; ++e) { tab[TP + e] = ps; ps += (tab[TC + e] + 255u) & ~255u; } tab[0] = ps >> 8; }
    LDS_WAIT(); __syncthreads();
    const unsigned ntile = tab[0];
    for (unsigned rt = F.tid; rt < ntile; rt += NTHREADS) { unsigned e = 0; for (int k = 1; k < NEXP; ++k) if (rt * 256u >= tab[TP + k]) e = k; tab[1 + rt] = e; }
    LDS_WAIT(); __syncthreads();
}
__global__ void __launch_bounds__(NTHREADS, 2) dit_fwd(Params P) {
    extern __shared__ __attribute__((aligned(16))) unsigned char lds_raw[];
    Frame F;
    F.lds = (LAS unsigned char*)lds_raw;
    F.tid = threadIdx.x; F.lane = F.tid & 63; F.wave = __builtin_amdgcn_readfirstlane(F.tid >> 6);
    F.blk = blockIdx.x; F.G = gridDim.x; F.vcu = (F.G % 8 == 0) ? (F.blk % 8) * (F.G / 8) + F.blk / 8 : F.blk;
    F.gw = F.vcu * NWAVES + F.wave; F.NGW = F.G * NWAVES;
    for (int u = F.tid; u < (LDS_BYTES - RING_BYTES) / 4; u += NTHREADS) ((LAS unsigned*)(F.lds + RING_BYTES))[u] = 0u;
    __syncthreads();
    unsigned* ctl = (unsigned*)(P.ws + WS_CTL);
    XcdBarrier bar = xcd_barrier_post(ctl + CW_BAR, (volatile LAS unsigned*)(F.lds + MISC_OFF) + 8);

    unsigned long long pr_t0 = 0, pr_prev = 0, pr_acc = 0;
    if (PROBE_SEL) { pr_t0 = __builtin_amdgcn_s_memrealtime(); pr_prev = pr_t0; }
#define PSTAMP(id) do { if (PROBE_SEL) { const unsigned long long now_ = __builtin_amdgcn_s_memrealtime(); if ((id) == PROBE_SEL) pr_acc += now_ - pr_prev; pr_prev = now_; } } while (0)
    p0_prologue(P, F);
    if (RPT & 1) p0_prologue(P, F);
    xcd_barrier(bar);
    p0b_mod_reduce(P, F);
    xcd_barrier(bar);
    PSTAMP(1);

    for (int layer = 0; layer < DEPTH; ++layer) {
        const bool last = (layer == DEPTH - 1);
        unsigned char* ws = wsp(P);
        const int Mtok = last ? TLAT : TALL;
        phase_attn_norm(P, F, layer);
        if ((RPT & 256) && layer == 0) { phase_attn_norm(P, F, layer); phase_attn_norm(P, F, layer); phase_attn_norm(P, F, layer); }
        xcd_barrier(bar);
        PSTAMP(2);
        {
            pg8::PlainSched<true, F8_SC_ACT> S; S.nN = QKVN / 256; S.nwg = (TALL / 256) * S.nN; S.G = F.G; S.c = F.vcu; S.K = DM / 2; S.Bt = (const bf16_t*)(ws + WS_WQKV + (size_t)layer * QKVN * DM);
            pg8::EpiQKV E{(bf16_t*)(ws + WS_QKV), ws + WS_KF, ws + WS_VF, (const f32x2*)(ws + WS_ROPE), inp(P, IN_GQ), inp(P, IN_GK), layer % 3};
            pg8::gemm_phase(F.lds, (const bf16_t*)(ws + WS_H), DM / 2, S, E);
            if (RPT & 2) pg8::gemm_phase(F.lds, (const bf16_t*)(ws + WS_H), DM / 2, S, E);
        }
        xcd_barrier(bar);
        PSTAMP(3);
        phase_attention(P, F, layer);
        if (((RPT & 4) && layer == 1) || ((RPT & 8) && layer != 1)) phase_attention(P, F, layer);
        xcd_barrier(bar);
        PSTAMP(4);
        {
            pg8::PlainSched<true> S; S.nN = DM / 256; S.nwg = (Mtok / 256) * S.nN; S.G = F.G; S.c = F.vcu; S.K = DM / 2; S.Bt = (const bf16_t*)(ws + WS_WO + (size_t)layer * DM * DM);
            pg8::EpiResidBf E{(bf16_t*)(ws + WS_X), (const float*)(ws + WS_MOD) + (size_t)layer * 17 * 6144 + 2048};
            pg8::gemm_phase(F.lds, (const bf16_t*)(ws + WS_O), DM / 2, S, E);
        }
        xcd_barrier(bar);
        PSTAMP(5);
        phase_router(P, F, layer, Mtok);
        xcd_barrier(bar);
        PSTAMP(6);
        if (RPT & 128) { for (int xb = 0; xb < 9; ++xb) xcd_barrier(bar); }
        LAS unsigned* tab = (LAS unsigned*)(F.lds + LDSX_OFF + 8192);
        build_tile_table(P, F, tab, layer);
        {
            pg8::MoeSched<true> S; S.tab = tab; S.G = F.G; S.c = F.vcu; S.K = DM / 2; S.Bt = (const bf16_t*)(ws + WS_WGU + (size_t)layer * NEXP * DM * DM); S.estride = (size_t)DM * DM; S.tok = (const unsigned*)(ws + WS_TOKE);
            pg8::EpiSwiglu E{ws + WS_ACT};
            pg8::gemm_phase(F.lds, (const bf16_t*)(ws + WS_H), DM / 2, S, E);
            if (RPT & 32) pg8::gemm_phase(F.lds, (const bf16_t*)(ws + WS_H), DM / 2, S, E);
        }
        xcd_barrier(bar);
        PSTAMP(8);
        {
            pg8::MoeSched<false> S; S.tab = tab; S.G = F.G; S.c = F.vcu; S.K = FH / 2; S.Bt = (const bf16_t*)(ws + WS_WD + (size_t)layer * NEXP * DM * FH); S.estride = (size_t)DM * FH; S.tok = nullptr;
            pg8::EpiStore E{(bf16_t*)(ws + WS_Y), DM};
            pg8::gemm_phase(F.lds, (const bf16_t*)(ws + WS_ACT), FH / 2, S, E);
            if (RPT & 64) pg8::gemm_phase(F.lds, (const bf16_t*)(ws + WS_ACT), FH / 2, S, E);
        }
        xcd_barrier(bar);
        PSTAMP(9);
    }
    if (PROBE_SEL) {
        if (F.blk == 0 && F.tid == 0) { const unsigned long long tot = __builtin_amdgcn_s_memrealtime() - pr_t0;
            const float f = (PROBE_SEL == 15) ? 0.5f : (float)pr_acc / (float)tot;
            __hip_atomic_store((float*)(P.ws + WS_CTL) + 64, sqrtf(4e-4f * f), __ATOMIC_RELAXED, __HIP_MEMORY_SCOPE_AGENT); }
        xcd_barrier(bar);
    }
    phase_final(P, F);
    if (RPT & 512) { phase_final(P, F); phase_final(P, F); phase_final(P, F); }
}

extern "C" void kernel_launch(void* const* d_in, const int* in_sizes, int n_in, void* d_out, int out_size, void* d_ws, size_t ws_size, hipStream_t stream) {
    static int ok = 0;
    if (ok == 0) {
        if (n_in != 22 || in_sizes[0] != TLAT * DM || out_size != TLAT * DM || ws_size < WS_END) {
            fprintf(stderr, "kernel_launch: unexpected shapes (n_in %d, in0 %d, out %d, ws %zu < %zu); nothing launched\n", n_in, n_in > 0 ? in_sizes[0] : -1, out_size, ws_size, (size_t)WS_END); ok = -1; return; }
        int dev = 0, cus = 0, per_cu = 0;
        if (hipGetDevice(&dev) != hipSuccess || hipDeviceGetAttribute(&cus, hipDeviceAttributeMultiprocessorCount, dev) != hipSuccess) { ok = -1; return; }
        if (hipFuncSetAttribute((const void*)dit_fwd, hipFuncAttributeMaxDynamicSharedMemorySize, LDS_BYTES) != hipSuccess) { fprintf(stderr, "kernel_launch: hipFuncSetAttribute failed\n"); ok = -1; return; }
        if (hipOccupancyMaxActiveBlocksPerMultiprocessor(&per_cu, (const void*)dit_fwd, NTHREADS, LDS_BYTES) != hipSuccess || per_cu < 1) fprintf(stderr, "kernel_launch: note: occupancy query reports %d\n", per_cu);
        (void)hipGetLastError();
        if (cus < GRID) { fprintf(stderr, "kernel_launch: %d CUs < %d workgroups: grid would not be resident; nothing launched\n", cus, GRID); ok = -1; return; }
        ok = 1;
    }
    if (ok < 0) return;
    if (hipMemsetAsync((char*)d_ws + WS_CTL, 0, CTL_ZERO_BYTES, stream) != hipSuccess) return;
    Params p{};
    for (int i = 0; i < 22; ++i) p.in[i] = (const float*)d_in[i];
    p.out = (float*)d_out; p.ws = (unsigned char*)d_ws;
    hipLaunchKernelGGL(dit_fwd, dim3(GRID), dim3(NTHREADS), LDS_BYTES, stream, p);
}
```

```cpp
#include <hip/hip_runtime.h>
#include <cstdio>
#include <cstdint>

#ifndef PROBE_SEL
#define PROBE_SEL 0
#endif
#ifndef RPT
#define RPT 0
#endif

#define LAS __attribute__((address_space(3)))
#define GAS __attribute__((address_space(1)))
#define DI __device__ __forceinline__

typedef unsigned short bf16_t;
typedef short bf16x8 __attribute__((ext_vector_type(8)));
typedef short s16x4 __attribute__((ext_vector_type(4)));
typedef float f32x2 __attribute__((ext_vector_type(2)));
typedef float f32x4 __attribute__((ext_vector_type(4)));
typedef float f32x16 __attribute__((ext_vector_type(16)));
typedef unsigned u32x2 __attribute__((ext_vector_type(2)));
typedef unsigned u32x4 __attribute__((ext_vector_type(4)));
typedef int i32x4 __attribute__((ext_vector_type(4)));
typedef int i32x8 __attribute__((ext_vector_type(8)));

constexpr int NB = 16, SEQ = 2048, DM = 1024, DEPTH = 4, CTXL = 256, NH = 16, NKV = 4, HD = 64, QKVN = 1536;
constexpr int TLAT = NB * SEQ, TCTX = NB * CTXL, TALL = TLAT + TCTX;
constexpr int NEXP = 32, FH = 512;
constexpr int KEYS = SEQ + CTXL, KGRP = KEYS / 8;
constexpr int CAPR = 2 * TALL + NEXP * 256;
constexpr int NWAVES = 8, NTHREADS = 512, GRID = 256;
constexpr float NORM_EPS = 1e-6f, LOG2E = 1.4426950408889634f;

constexpr size_t MiB = 1u << 20;
constexpr size_t WS_CTL = 0, CTL_ZERO_BYTES = 1 * MiB;
constexpr size_t WS_MODP = 1 * MiB;
constexpr size_t WS_MOD = 15 * MiB;
constexpr size_t WS_ROPE = 17 * MiB;
constexpr size_t WS_WRT = 17 * MiB + 65536;
constexpr size_t WS_ASG = 18 * MiB;
constexpr size_t WS_ASGW = 18 * MiB + 512 * 1024;
constexpr size_t WS_TOKE = 1 * MiB;
constexpr size_t WS_WQKV = 21 * MiB;
constexpr size_t WS_WO = 33 * MiB;
constexpr size_t WS_WGU = 41 * MiB;
constexpr size_t WS_WD = 297 * MiB;
constexpr size_t WS_X = 425 * MiB;
constexpr size_t WS_H = 569 * MiB;
constexpr size_t WS_R1 = 641 * MiB;
constexpr size_t WS_QKV = WS_R1;
constexpr size_t WS_KF = WS_R1 + 108 * MiB;
constexpr size_t WS_VF = WS_R1 + 126 * MiB;
constexpr size_t WS_O = WS_R1 + 144 * MiB;
constexpr size_t WS_Y = WS_R1;
constexpr size_t WS_ACT = WS_R1 + 160 * MiB;
constexpr size_t WS_END = WS_R1 + 240 * MiB;
constexpr int CW_TMO = 0, CW_BAR = 4096, CW_CNT = 65536, CNT_STRIDE = 32;

constexpr int RING_BYTES = 131072;
constexpr int MISC_OFF = RING_BYTES + 320;
constexpr int LDSX_OFF = RING_BYTES + 1024;
constexpr int LDS_BYTES = 147456;

#define LDS_WAIT() asm volatile("s_waitcnt lgkmcnt(0)" ::: "memory")
#define VM_WAIT() asm volatile("s_waitcnt vmcnt(0)" ::: "memory")

DI unsigned f2bf(float f) { unsigned u = __float_as_uint(f); return (u + 0x7fffu + ((u >> 16) & 1u)) >> 16; }
DI float bf2f(unsigned b) { return __uint_as_float(b << 16); }
DI float bfs2f(short b) { return __uint_as_float(((unsigned)(unsigned short)b) << 16); }
DI unsigned cvt_pk_bf16(float lo, float hi);
DI unsigned pk2(float lo, float hi) { return cvt_pk_bf16(lo, hi); }
DI unsigned cvt_pk_bf16(float lo, float hi) { unsigned r; asm volatile("v_cvt_pk_bf16_f32 %0, %1, %2" : "=v"(r) : "v"(lo), "v"(hi)); return r; }
constexpr float F8_ACT_SCALE = 8.f, F8_W_SCALE = 64.f;
constexpr int F8_SC_ACT = 127 - 3, F8_SC_W = 127 - 6;
constexpr float F8_Y_SCALE = 16.f;
constexpr float F8_O_SCALE = 32.f; constexpr int F8_SC_O = 127 - 5;
DI unsigned cvt_pk_fp8x4(float a, float b, float c, float d) {
    a = __builtin_amdgcn_fmed3f(a, -448.f, 448.f); b = __builtin_amdgcn_fmed3f(b, -448.f, 448.f); c = __builtin_amdgcn_fmed3f(c, -448.f, 448.f); d = __builtin_amdgcn_fmed3f(d, -448.f, 448.f);
    int r = __builtin_amdgcn_cvt_pk_fp8_f32(a, b, 0, false); r = __builtin_amdgcn_cvt_pk_fp8_f32(c, d, r, true); return (unsigned)r; }
DI float wave_sum(float v) {
#pragma unroll
    for (int o = 1; o < 64; o <<= 1) v += __shfl_xor(v, o);
    return v;
}
DI int crow(int r, int hi) { return (r & 3) + 8 * (r >> 2) + 4 * hi; }

#define XB_TMO      128
#define XB_XCNT(j)  (256  + 64 * (j))
#define XB_XSUB(j)  (1280 + 64 * (j))
#define XB_XGEN(j)  (2304 + 64 * (j))
#define XB_TOP      3328
#define XB_TOPGEN   3392
#define XCD_BAR_WORDS 3456
#define XB_SPIN_CAP (1u << 18)

__device__ __forceinline__ unsigned xb_ld(unsigned* p)              { return __hip_atomic_load(p, __ATOMIC_RELAXED, __HIP_MEMORY_SCOPE_AGENT); }
__device__ __forceinline__ unsigned xb_add(unsigned* p, unsigned v) { return __hip_atomic_fetch_add(p, v, __ATOMIC_RELAXED, __HIP_MEMORY_SCOPE_AGENT); }
__device__ __forceinline__ unsigned xb_xcc_id() { return (unsigned)__builtin_amdgcn_s_getreg((3 << 11) | 20) & 0xFu; }
#define XB_SPIN(cond, bar) do { unsigned _sp = 0; while (cond) { __builtin_amdgcn_s_sleep(1); \
    if ((++_sp & 255u) == 0u) { if (xb_ld(&(bar)[XB_TMO])) break; if (_sp > XB_SPIN_CAP) { atomicAdd(&(bar)[XB_TMO], 1u); break; } } } } while (0)

struct XcdBarrier { unsigned* bar; unsigned x; volatile LAS unsigned* st; };

__device__ __forceinline__ XcdBarrier xcd_barrier_post(unsigned* bar, volatile LAS unsigned* st) {
    XcdBarrier b; b.bar = bar; b.x = xb_xcc_id(); b.st = st;
    if (threadIdx.x == 0) (void)xb_add(&bar[XB_XCNT(b.x)], 1u);
    return b;
}
__device__ __forceinline__ void xcd_barrier_complete(unsigned* bar, unsigned x, unsigned& nloc, unsigned& nx) {
    const unsigned G = gridDim.x * gridDim.y * gridDim.z;
    unsigned sum, cnt, mine, sp = 0u;
    for (;;) {
        sum = 0u; cnt = 0u; mine = 0u;
#pragma unroll
        for (unsigned j = 0; j < 16; ++j) { const unsigned c = xb_ld(&bar[XB_XCNT(j)]); sum += c; cnt += (c > 0u) ? 1u : 0u; mine = (j == x) ? c : mine; }
        if (sum == G) break;
        __builtin_amdgcn_s_sleep(1);
        if ((++sp & 255u) == 0u) { if (xb_ld(&bar[XB_TMO])) break; if (sp > XB_SPIN_CAP) { atomicAdd(&bar[XB_TMO], 1u); break; } }
    }
    nloc = mine > 0u ? mine : 1u; nx = cnt > 0u ? cnt : 1u;
}
__device__ __forceinline__ void xcd_barrier(const XcdBarrier& b0) {
    XcdBarrier b = b0;
    { unsigned z = 0, bx = __builtin_amdgcn_readfirstlane(b0.x); asm volatile("s_mov_b32 %0, 0" : "=s"(z)); asm volatile("" : "+s"(bx)); b.bar = b0.bar + z; b.x = bx; }
    asm volatile("s_waitcnt vmcnt(0)" ::: "memory");
    __syncthreads();
    if (threadIdx.x == 0) {
        unsigned* bar = b.bar;
        __builtin_amdgcn_s_waitcnt(0);
        unsigned nloc = b.st[0], nx = b.st[1];
        if (nloc == 0u) { xcd_barrier_complete(bar, b.x, nloc, nx); b.st[0] = nloc; b.st[1] = nx; }
        const unsigned old = xb_add(&bar[XB_XSUB(b.x)], 1u);
        const unsigned gen = old / nloc;
        if (old + 1u == (gen + 1u) * nloc) {
            __builtin_amdgcn_fence(__ATOMIC_RELEASE, "agent");
            asm volatile("s_waitcnt vmcnt(0)" ::: "memory");
            const unsigned og = xb_add(&bar[XB_TOP], 1u);
            const unsigned tg = og / nx;
            if (og + 1u == (tg + 1u) * nx) xb_add(&bar[XB_TOPGEN], 1u);
            else XB_SPIN(xb_ld(&bar[XB_TOPGEN]) == tg, bar);
            __builtin_amdgcn_fence(__ATOMIC_ACQUIRE, "agent");
            xb_add(&bar[XB_XGEN(b.x)], 1u);
            asm volatile("s_waitcnt vmcnt(0)" ::: "memory");
        } else {
            XB_SPIN(xb_ld(&bar[XB_XGEN(b.x)]) == gen, bar);
            __builtin_amdgcn_fence(__ATOMIC_ACQUIRE, "agent");
            asm volatile("s_waitcnt vmcnt(0)" ::: "memory");
        }
    }
    __syncthreads();
}

namespace pg8 {
constexpr int BM = 256, BK = 64, HALF = 128, HTB = HALF * BK * 2, STAGE_BYTES = 8 * HTB;
DI int lds_byte(int r, int c) { const int st = (r >> 4) * 2 + (c >> 5), rr = r & 15, cc = c & 31, ob = rr * 64 + cc * 2; return st * 1024 + (ob ^ (((ob >> 9) & 1) << 5)); }
DI void stage_rc(int b, int& R, int& C) { const int st = b / 1024, sb = b % 1024, swz = sb ^ (((sb >> 9) & 1) << 5); R = (st >> 1) * 16 + swz / 64; C = (st & 1) * 32 + (swz % 64) / 2; }
DI int perm32(int rho) { const int n = rho >> 4, i = rho & 15; return 8 * (i >> 2) + 4 * n + (i & 3); }
struct Unit { int pm, pn, e, r0, na; };

DI void mfma_f8_acc(f32x4& c, const i32x8& w, const i32x8& a, int sw, int sa) {
    asm volatile("v_mfma_scale_f32_16x16x128_f8f6f4 %0, %1, %2, %0, %3, %4 op_sel_hi:[0,0,0]" : "+v"(c) : "v"(w), "v"(a), "v"(sw), "v"(sa));
}
template <class Epi, class Sched>
DI void gemm_phase(LAS unsigned char* lds, const bf16_t* A, const int K, const Sched& S, const Epi& E) {
    int tid_ = threadIdx.x; asm volatile("" : "+v"(tid_));
    const int tid = tid_, wid = __builtin_amdgcn_readfirstlane(tid >> 6), lane = tid & 63, wr = wid >> 2, wc = wid & 3, fr = lane & 15, fq = lane >> 4;
    int nt_ = K / BK; asm volatile("" : "+s"(nt_));
    const int nt = nt_;
    constexpr bool GA = Sched::GATHER, F8 = Sched::FP8;
    int f8sw = F8_SC_W, f8sa = Sched::SC_ACT; asm volatile("" : "+v"(f8sw), "+v"(f8sa));
    int Rr[2], Cc[2]; unsigned voffB[2], voffA[2];
#pragma unroll
    for (int i = 0; i < 2; ++i) { int R, C; stage_rc(tid * 16 + i * 8192, R, C); const int Rb = Epi::PERM ? ((R & ~31) + perm32(R & 31)) : R;
        Rr[i] = R; Cc[i] = C; voffB[i] = (unsigned)(Rb * K + C) * 2u; voffA[i] = (unsigned)(R * K + C) * 2u; }
    const size_t kstep = (size_t)(BK * 2);
    const size_t hstep = (size_t)HALF * K * 2;
    const unsigned ldsw = (unsigned)wid * 1024u;
    const int aoff = lds_byte(wr * 64 + fr, fq * 8), boff = lds_byte(wc * 32 + fr, fq * 8);
#define PG8_SA(b, h) (((b) * 2 + (h)) * HTB)
#define PG8_SB(b, h) ((4 + (b) * 2 + (h)) * HTB)
#define PG8_STAGE(bufoff, gbase, voff) do { _Pragma("unroll") for (int _i = 0; _i < 2; ++_i) \
        __builtin_amdgcn_global_load_lds((const unsigned*)((const char*)(gbase) + (voff)[_i]), (LAS unsigned*)(lds + (bufoff) + ldsw + _i * 8192), 16, 0, 0); } while (0)
#define PG8_LDA(dst, b, h) do { _Pragma("unroll") for (int m = 0; m < 4; ++m) _Pragma("unroll") for (int k = 0; k < 2; ++k) dst[m][k] = *(const LAS bf16x8*)(lds + PG8_SA(b, h) + aoff + m * 2048 + k * 1024); } while (0)
#define PG8_LDB(dst, b, h) do { _Pragma("unroll") for (int n = 0; n < 2; ++n) _Pragma("unroll") for (int k = 0; k < 2; ++k) dst[n][k] = *(const LAS bf16x8*)(lds + PG8_SB(b, h) + boff + n * 2048 + k * 1024); } while (0)
#define PG8_CAT8(x0, x1) __builtin_shufflevector(__builtin_bit_cast(i32x4, x0), __builtin_bit_cast(i32x4, x1), 0, 1, 2, 3, 4, 5, 6, 7)
#define PG8_MMA(ai, bj, At, Bt) do { __builtin_amdgcn_s_setprio(1); \
        if (F8) { _Pragma("unroll") for (int m = 0; m < 4; ++m) _Pragma("unroll") for (int n = 0; n < 2; ++n) \
            mfma_f8_acc(acc[ai][bj][m][n], PG8_CAT8(Bt[n][0], Bt[n][1]), PG8_CAT8(At[m][0], At[m][1]), f8sw, f8sa); } \
        else { _Pragma("unroll") for (int m = 0; m < 4; ++m) _Pragma("unroll") for (int n = 0; n < 2; ++n) _Pragma("unroll") for (int k = 0; k < 2; ++k) \
            acc[ai][bj][m][n] = __builtin_amdgcn_mfma_f32_16x16x32_bf16(Bt[n][k], At[m][k], acc[ai][bj][m][n], 0, 0, 0); } \
        __builtin_amdgcn_s_setprio(0); } while (0)
#define PG8_WAIT_V(n) asm volatile("s_waitcnt vmcnt(" #n ")" ::: "memory")
#define PG8_WAIT_L(n) asm volatile("s_waitcnt lgkmcnt(" #n ")" ::: "memory")
#define PG8_BAR __builtin_amdgcn_s_barrier()
#define PG8_SCHED __builtin_amdgcn_sched_barrier(0)
    Unit cur, nxt; int ui = 0;
    if (!S.next(0, cur)) return;
    f32x4 acc[2][2][4][2];
#pragma unroll
    for (int a = 0; a < 2; ++a)
#pragma unroll
        for (int b = 0; b < 2; ++b)
#pragma unroll
            for (int m = 0; m < 4; ++m)
#pragma unroll
                for (int n = 0; n < 2; ++n) acc[a][b][m][n] = (f32x4){0.f, 0.f, 0.f, 0.f};
    bf16x8 At[4][2], B0[2][2], B1[2][2];
    unsigned oc0[2], oc1[2], on0[2], on1[2];
#pragma unroll
    for (int i = 0; i < 2; ++i) { if (GA) { oc0[i] = S.a_off(cur, Rr[i]) + (unsigned)Cc[i] * 2u; oc1[i] = S.a_off(cur, HALF + Rr[i]) + (unsigned)Cc[i] * 2u; } else { oc0[i] = voffA[i]; oc1[i] = voffA[i]; } on0[i] = oc0[i]; on1[i] = oc1[i]; }
    size_t hA = (GA || (Sched::HALVES && cur.na == 1)) ? (size_t)0 : hstep, hAn = hA;
    const char* Ab = GA ? (const char*)A : (const char*)A + (size_t)cur.r0 * K * 2;
    const char* cB = S.b_ptr(cur);
    PG8_STAGE(PG8_SB(0, 0), cB, voffB); PG8_STAGE(PG8_SB(0, 1), cB + hstep, voffB); PG8_STAGE(PG8_SA(0, 0), Ab, oc0); PG8_STAGE(PG8_SA(0, 1), Ab + hA, oc1);
    if (wr == 1) PG8_BAR;
    PG8_WAIT_V(2); PG8_BAR;
    PG8_STAGE(PG8_SB(1, 0), cB + kstep, voffB); PG8_STAGE(PG8_SA(1, 0), Ab + kstep, oc0); PG8_STAGE(PG8_SB(1, 1), cB + hstep + kstep, voffB);
    PG8_WAIT_V(6); PG8_BAR;
    for (;;) {
        const bool has_next = S.next(ui + 1, nxt);
        const char* nB = has_next ? S.b_ptr(nxt) : cB;
        const char* nA = GA ? Ab : (has_next ? (const char*)A + (size_t)nxt.r0 * K * 2 : Ab);
        if (!GA && Sched::HALVES) hAn = (has_next && nxt.na == 1) ? (size_t)0 : (has_next ? hstep : hA);
        if (GA) {
            if (has_next) {
#pragma unroll
                for (int i = 0; i < 2; ++i) { on0[i] = S.a_off(nxt, Rr[i]) + (unsigned)Cc[i] * 2u; on1[i] = S.a_off(nxt, HALF + Rr[i]) + (unsigned)Cc[i] * 2u; }
            } else {
#pragma unroll
                for (int i = 0; i < 2; ++i) { on0[i] = oc0[i]; on1[i] = oc1[i]; }
            }
        }
#define PG8_KLOOP(FULL) \
        for (int t = 0; t < nt; t += 2) { \
            const bool last = (t == nt - 2); \
            const char* a1 = Ab + (size_t)(t + 1) * kstep + hA; \
            const char* a2 = last ? nA : Ab + (size_t)(t + 2) * kstep; const char* b2 = last ? nB : cB + (size_t)(t + 2) * kstep; \
            const char* a3 = a2 + kstep; const char* b3 = b2 + kstep; const size_t hA2 = last ? hAn : hA; \
            unsigned o20[2], o21[2]; \
            for (int i = 0; i < 2; ++i) { if (GA) { o20[i] = last ? on0[i] : oc0[i]; o21[i] = last ? on1[i] : oc1[i]; } else { o20[i] = voffA[i]; o21[i] = voffA[i]; } } \
              \
            PG8_LDB(B0, 0, 0); PG8_LDB(B1, 0, 1); PG8_SCHED; PG8_LDA(At, 0, 0); PG8_STAGE(PG8_SA(1, 1), a1, oc1); \
            PG8_WAIT_V(8); PG8_WAIT_L(0); PG8_BAR; PG8_MMA(0, 0, At, B0); PG8_MMA(0, 1, At, B1); PG8_BAR; PG8_SCHED; \
              \
            if (FULL) { PG8_LDA(At, 0, 1); } PG8_STAGE(PG8_SB(0, 0), b2, voffB); PG8_STAGE(PG8_SB(0, 1), b2 + hstep, voffB); PG8_STAGE(PG8_SA(0, 0), a2, o20); \
            PG8_WAIT_V(8); PG8_WAIT_L(0); PG8_BAR; if (FULL) { PG8_MMA(1, 0, At, B0); PG8_MMA(1, 1, At, B1); } PG8_BAR; PG8_SCHED; \
              \
            PG8_LDB(B0, 1, 0); PG8_LDB(B1, 1, 1); PG8_SCHED; PG8_LDA(At, 1, 0); PG8_STAGE(PG8_SA(0, 1), a2 + hA2, o21); \
            PG8_WAIT_V(8); PG8_WAIT_L(0); PG8_BAR; PG8_MMA(0, 0, At, B0); PG8_MMA(0, 1, At, B1); PG8_BAR; PG8_SCHED; \
              \
            if (FULL) { PG8_LDA(At, 1, 1); } PG8_STAGE(PG8_SB(1, 0), b3, voffB); PG8_STAGE(PG8_SB(1, 1), b3 + hstep, voffB); PG8_STAGE(PG8_SA(1, 0), a3, o20); \
            PG8_WAIT_V(8); PG8_WAIT_L(0); PG8_BAR; if (FULL) { PG8_MMA(1, 0, At, B0); PG8_MMA(1, 1, At, B1); } PG8_BAR; PG8_SCHED; \
        }
        if (Sched::HALVES && cur.na == 1) { PG8_KLOOP(0) } else { PG8_KLOOP(1) }
#undef PG8_KLOOP
        if (wr == 0) PG8_BAR;
        if (F8) asm volatile("s_nop 15\n\ts_nop 15" ::: "memory");
        E(acc, cur, wr, wc, fr, fq);
        if (!has_next) break;
#pragma unroll
        for (int a = 0; a < 2; ++a)
#pragma unroll
            for (int b = 0; b < 2; ++b)
#pragma unroll
                for (int m = 0; m < 4; ++m)
#pragma unroll
                    for (int n = 0; n < 2; ++n) acc[a][b][m][n] = (f32x4){0.f, 0.f, 0.f, 0.f};
        cur = nxt; cB = nB; Ab = nA; hA = hAn; ++ui;
        if (GA) {
#pragma unroll
            for (int i = 0; i < 2; ++i) { oc0[i] = on0[i]; oc1[i] = on1[i]; }
        }
        if (wr == 1) PG8_BAR;
    }
    PG8_WAIT_V(0);
    PG8_BAR;
#undef PG8_SA
#undef PG8_SB
#undef PG8_STAGE
#undef PG8_LDA
#undef PG8_LDB
#undef PG8_MMA
#undef PG8_CAT8
#undef PG8_WAIT_V
#undef PG8_WAIT_L
#undef PG8_BAR
#undef PG8_SCHED
}

template <bool FP8_, int SC_ACT_ = F8_SC_O> struct PlainSched {
    static constexpr bool GATHER = false, HALVES = true, FP8 = FP8_; static constexpr int SC_ACT = SC_ACT_;
    int nN, nwg, G, c, K; const bf16_t* Bt;
    DI bool next(int i, Unit& u) const { const int L = i * G + c; const int nfull = (nwg / G) * G, rem = nwg - nfull; int Lu = L, hf = 0; u.na = 2;
        if (L >= nfull) { if (2 * rem <= G) { const int h = L - nfull; if (h >= 2 * rem) return false; Lu = nfull + (h >> 1); hf = h & 1; u.na = 1; } else if (L >= nwg) return false; }
        u.pm = Lu / nN; u.pn = Lu - u.pm * nN; u.e = 0; u.r0 = u.pm * BM + hf * HALF; return true; }
    DI unsigned a_off(const Unit& u, int r) const { return (unsigned)(u.r0 + r) * (unsigned)(K * 2); }
    DI const char* b_ptr(const Unit& u) const { return (const char*)Bt + (size_t)u.pn * BM * K * 2; }
};
template <bool GATHER_> struct MoeSched {
    static constexpr bool GATHER = GATHER_, HALVES = true, FP8 = true; static constexpr int SC_ACT = F8_SC_ACT;
    static constexpr int TAB_PST = 384, TAB_CNT = 416;
    const LAS unsigned* tab; int G, c, K; const bf16_t* Bt; size_t estride; const unsigned* tok;
    DI bool next(int i, Unit& u) const { const int L = i * G + c; const int nwg = (int)tab[0] * 4, nfull = (nwg / G) * G, rem = nwg - nfull; int Lu = L, hf = 0; u.na = 2;
        if (L >= nfull) { if (2 * rem <= G) { const int h = L - nfull; if (h >= 2 * rem) return false; Lu = nfull + (h >> 1); hf = h & 1; u.na = 1; } else if (L >= nwg) return false; }
        u.pm = Lu >> 2; u.pn = Lu & 3; u.e = (int)tab[1 + u.pm]; u.r0 = u.pm * BM + hf * HALF; return true; }
    DI unsigned a_off(const Unit& u, int r) const {
        unsigned row = (unsigned)(u.r0 + (u.na == 1 ? (r & (HALF - 1)) : r));
        if (GATHER_) { const unsigned last = tab[TAB_CNT + u.e] - 1u; unsigned idx = row - tab[TAB_PST + u.e]; idx = idx < last ? idx : last; row = tok[(unsigned)u.e * (unsigned)TALL + idx]; }
        return row * (unsigned)(K * 2); }
    DI const char* b_ptr(const Unit& u) const { return (const char*)Bt + (size_t)u.e * estride + (size_t)u.pn * BM * K * 2; }
};

struct EpiStore {
    static constexpr bool PERM = true;
    bf16_t* O; int ldc;
    DI void operator()(const f32x4 (&acc)[2][2][4][2], const Unit& u, int wr, int wc, int fr, int fq) const {
        const int row0 = u.r0 + wr * 64 + fr, col0 = u.pn * BM + wc * 32 + 8 * fq;
#pragma unroll
        for (int ai = 0; ai < 2; ++ai) if (ai < u.na)
#pragma unroll
            for (int m = 0; m < 4; ++m) { bf16_t* rowp = O + (size_t)(row0 + ai * HALF + m * 16) * ldc + col0;
#pragma unroll
                for (int bj = 0; bj < 2; ++bj) { const f32x4 v0 = acc[ai][bj][m][0], v1 = acc[ai][bj][m][1];
                    u32x4 w; w.x = cvt_pk_bf16(v0[0], v0[1]); w.y = cvt_pk_bf16(v0[2], v0[3]); w.z = cvt_pk_bf16(v1[0], v1[1]); w.w = cvt_pk_bf16(v1[2], v1[3]);
                    *(u32x4*)(rowp + bj * HALF) = w; } }
    }
};
struct EpiStoreF8 {
    static constexpr bool PERM = true;
    unsigned char* O; int ldc; float scale;
    DI void operator()(const f32x4 (&acc)[2][2][4][2], const Unit& u, int wr, int wc, int fr, int fq) const {
        const int row0 = u.r0 + wr * 64 + fr, col0 = u.pn * BM + wc * 32 + 8 * fq;
#pragma unroll
        for (int ai = 0; ai < 2; ++ai) if (ai < u.na)
#pragma unroll
            for (int m = 0; m < 4; ++m) { unsigned char* rowp = O + (size_t)(row0 + ai * HALF + m * 16) * ldc + col0;
#pragma unroll
                for (int bj = 0; bj < 2; ++bj) { const f32x4 v0 = acc[ai][bj][m][0] * scale, v1 = acc[ai][bj][m][1] * scale;
                    u32x2 w; w.x = cvt_pk_fp8x4(v0[0], v0[1], v0[2], v0[3]); w.y = cvt_pk_fp8x4(v1[0], v1[1], v1[2], v1[3]);
                    *(u32x2*)(rowp + bj * HALF) = w; } }
    }
};
struct EpiQKV {
    static constexpr bool PERM = false;
    bf16_t* QKV; unsigned char* KF; unsigned char* VF; const f32x2* T; const float* gq; const float* gk; int m;
    DI void operator()(const f32x4 (&acc)[2][2][4][2], const Unit& u, int wr, int wc, int fr, int fq) const {
        const bool lat = u.pm < TLAT / BM; const int b = lat ? (u.pm >> 3) : (u.pm - TLAT / BM);
        const int trow0 = u.r0 + wr * 64 + fr;
        if (u.pn < 4) {
            const int h = 4 * u.pn + wc;
            f32x4 g[2][2];
#pragma unroll
            for (int bj = 0; bj < 2; ++bj)
#pragma unroll
                for (int n = 0; n < 2; ++n) g[bj][n] = (m == 1) ? *(const f32x4*)(gq + 32 * bj + 16 * n + 4 * fq) : (f32x4){1.f, 1.f, 1.f, 1.f};
#pragma unroll
            for (int ai = 0; ai < 2; ++ai) if (ai < u.na)
#pragma unroll
                for (int mm = 0; mm < 4; ++mm) {
                    f32x4 x[2][2]; float ss = 0.f;
#pragma unroll
                    for (int bj = 0; bj < 2; ++bj)
#pragma unroll
                        for (int n = 0; n < 2; ++n) { x[bj][n] = acc[ai][bj][mm][n]; ss += (x[bj][n][0] * x[bj][n][0] + x[bj][n][1] * x[bj][n][1]) + (x[bj][n][2] * x[bj][n][2] + x[bj][n][3] * x[bj][n][3]); }
                    float sc = 0.125f * LOG2E;
                    if (m == 1) { ss += __shfl_xor(ss, 16); ss += __shfl_xor(ss, 32); sc *= 1.0f / sqrtf(ss * (1.f / HD) + NORM_EPS); }
                    bf16_t* qrow = QKV + (size_t)(trow0 + ai * HALF + mm * 16) * QKVN + h * HD + 4 * fq;
#pragma unroll
                    for (int bj = 0; bj < 2; ++bj)
#pragma unroll
                        for (int n = 0; n < 2; ++n) { const f32x4 y = x[bj][n] * g[bj][n] * sc; u32x2 w; w.x = cvt_pk_bf16(y[0], y[1]); w.y = cvt_pk_bf16(y[2], y[3]); *(u32x2*)(qrow + 32 * bj + 16 * n) = w; }
                }
        } else if (u.pn == 4) {
            f32x4 g[2][2];
#pragma unroll
            for (int bj = 0; bj < 2; ++bj)
#pragma unroll
                for (int n = 0; n < 2; ++n) g[bj][n] = (m == 1) ? *(const f32x4*)(gk + 32 * bj + 16 * n + 4 * fq) : (f32x4){1.f, 1.f, 1.f, 1.f};
            const bool rope = lat && (m != 2);
            unsigned char* kbase = KF + (size_t)(b * NKV + wc) * KGRP * 1024 + (fq >> 1) * 128 + (fq & 1) * 8;
#pragma unroll
            for (int ai = 0; ai < 2; ++ai) if (ai < u.na)
#pragma unroll
                for (int mm = 0; mm < 4; ++mm) {
                    const int t = trow0 + ai * HALF + mm * 16;
                    const int kidx = lat ? (t & 2047) : (2048 + ((t - TLAT) & 255));
                    f32x4 x[2][2]; float ss = 0.f;
#pragma unroll
                    for (int bj = 0; bj < 2; ++bj)
#pragma unroll
                        for (int n = 0; n < 2; ++n) { x[bj][n] = acc[ai][bj][mm][n]; ss += (x[bj][n][0] * x[bj][n][0] + x[bj][n][1] * x[bj][n][1]) + (x[bj][n][2] * x[bj][n][2] + x[bj][n][3] * x[bj][n][3]); }
                    if (m == 1) { ss += __shfl_xor(ss, 16); ss += __shfl_xor(ss, 32); const float rs = 1.0f / sqrtf(ss * (1.f / HD) + NORM_EPS);
#pragma unroll
                        for (int bj = 0; bj < 2; ++bj)
#pragma unroll
                            for (int n = 0; n < 2; ++n) x[bj][n] = x[bj][n] * g[bj][n] * rs; }
                    if (rope) {
#pragma unroll
                        for (int bj = 0; bj < 2; ++bj) { const int pos = bj ? (kidx & 63) : (kidx >> 6); const f32x4* tp = (const f32x4*)(T + pos * 16 + 4 * fq);
                            const f32x4 t0 = tp[0], t1 = tp[1];
                            const f32x4 cs = (f32x4){t0[0], t0[2], t1[0], t1[2]}, sn = (f32x4){t0[1], t0[3], t1[1], t1[3]};
                            const f32x4 a = x[bj][0], c = x[bj][1];
                            x[bj][0] = a * cs - c * sn; x[bj][1] = c * cs + a * sn; }
                    }
                    unsigned char* kp = kbase + (size_t)(kidx >> 3) * 1024 + (kidx & 7) * 16;
#pragma unroll
                    for (int bj = 0; bj < 2; ++bj)
#pragma unroll
                        for (int n = 0; n < 2; ++n) { u32x2 w; w.x = cvt_pk_bf16(x[bj][n][0], x[bj][n][1]); w.y = cvt_pk_bf16(x[bj][n][2], x[bj][n][3]); *(u32x2*)(kp + (4 * bj + 2 * n) * 128) = w; }
                }
        } else {
            const int q4 = fr & 3;
            unsigned char* vbase = VF + (size_t)(b * NKV + wc) * KGRP * 1024 + (4 * fq + q4) * 16;
#pragma unroll
            for (int ai = 0; ai < 2; ++ai) if (ai < u.na)
#pragma unroll
                for (int mm = 0; mm < 4; ++mm) {
                    const int t = trow0 + ai * HALF + mm * 16;
                    const int kidx = lat ? (t & 2047) : (2048 + ((t - TLAT) & 255));
                    unsigned char* vp = vbase + (size_t)(kidx >> 3) * 1024 + (kidx & 4) * 2;
#pragma unroll
                    for (int bj = 0; bj < 2; ++bj)
#pragma unroll
                        for (int n = 0; n < 2; ++n) {
                            f32x4 x = acc[ai][bj][mm][n];
                            { const float s0 = (q4 & 1) ? x[0] : x[1], s1 = (q4 & 1) ? x[2] : x[3]; const float r0 = __shfl_xor(s0, 1), r1 = __shfl_xor(s1, 1);
                              if (q4 & 1) { x[0] = r0; x[2] = r1; } else { x[1] = r0; x[3] = r1; } }
                            { const float s0 = (q4 & 2) ? x[0] : x[2], s1 = (q4 & 2) ? x[1] : x[3]; const float r0 = __shfl_xor(s0, 2), r1 = __shfl_xor(s1, 2);
                              if (q4 & 2) { x[0] = r0; x[1] = r1; } else { x[2] = r0; x[3] = r1; } }
                            u32x2 w; w.x = cvt_pk_bf16(x[0], x[1]); w.y = cvt_pk_bf16(x[2], x[3]);
                            *(u32x2*)(vp + (32 * bj + 16 * n) * 16) = w; }
                }
        }
    }
};
DI float silu_mul(float g, float u) { return g * __builtin_amdgcn_rcpf(1.f + __builtin_amdgcn_exp2f(-g * LOG2E)) * u; }
struct EpiResidBf {
    static constexpr bool PERM = true;
    bf16_t* X; const float* gate;
    DI void operator()(const f32x4 (&acc)[2][2][4][2], const Unit& u, int wr, int wc, int fr, int fq) const {
        const int mb = (u.pm < TLAT / BM) ? (u.pm >> 3) : 16;
        const float* gt = gate + (size_t)mb * 6144;
        const int row0 = u.r0 + wr * 64 + fr, col0 = u.pn * BM + wc * 32 + 8 * fq;
        f32x4 g[2][2];
#pragma unroll
        for (int bj = 0; bj < 2; ++bj)
#pragma unroll
            for (int n = 0; n < 2; ++n) g[bj][n] = *(const f32x4*)(gt + col0 + bj * HALF + 4 * n);
#pragma unroll
        for (int ai = 0; ai < 2; ++ai) if (ai < u.na) {
            u32x4 old[4][2];
#pragma unroll
            for (int m = 0; m < 4; ++m)
#pragma unroll
                for (int bj = 0; bj < 2; ++bj) old[m][bj] = *(const u32x4*)(X + (size_t)(row0 + ai * HALF + m * 16) * DM + col0 + bj * HALF);
#pragma unroll
            for (int m = 0; m < 4; ++m)
#pragma unroll
                for (int bj = 0; bj < 2; ++bj) { const u32x4 o = old[m][bj]; const f32x4 a0 = acc[ai][bj][m][0] * g[bj][0], a1 = acc[ai][bj][m][1] * g[bj][1];
                    u32x4 w; w.x = cvt_pk_bf16(bf2f(o.x & 0xffffu) + a0[0], bf2f(o.x >> 16) + a0[1]); w.y = cvt_pk_bf16(bf2f(o.y & 0xffffu) + a0[2], bf2f(o.y >> 16) + a0[3]);
                    w.z = cvt_pk_bf16(bf2f(o.z & 0xffffu) + a1[0], bf2f(o.z >> 16) + a1[1]); w.w = cvt_pk_bf16(bf2f(o.w & 0xffffu) + a1[2], bf2f(o.w >> 16) + a1[3]);
                    *(u32x4*)(X + (size_t)(row0 + ai * HALF + m * 16) * DM + col0 + bj * HALF) = w; }
        }
    }
};
struct EpiSwiglu {
    static constexpr bool PERM = true;
    unsigned char* ACT;
    DI void operator()(const f32x4 (&acc)[2][2][4][2], const Unit& u, int wr, int wc, int fr, int fq) const {
        const int row0 = u.r0 + wr * 64 + fr, col0 = u.pn * HALF + wc * 32 + 8 * fq;
#pragma unroll
        for (int ai = 0; ai < 2; ++ai) if (ai < u.na)
#pragma unroll
            for (int m = 0; m < 4; ++m) { unsigned char* rowp = ACT + (size_t)(row0 + ai * HALF + m * 16) * FH + col0;
                const f32x4 g0 = acc[ai][0][m][0], g1 = acc[ai][0][m][1], u0 = acc[ai][1][m][0] * F8_ACT_SCALE, u1 = acc[ai][1][m][1] * F8_ACT_SCALE;
                u32x2 w; w.x = cvt_pk_fp8x4(silu_mul(g0[0], u0[0]), silu_mul(g0[1], u0[1]), silu_mul(g0[2], u0[2]), silu_mul(g0[3], u0[3]));
                w.y = cvt_pk_fp8x4(silu_mul(g1[0], u1[0]), silu_mul(g1[1], u1[1]), silu_mul(g1[2], u1[2]), silu_mul(g1[3], u1[3]));
                *(u32x2*)rowp = w; }
    }
};
}

struct Params { const float* in[22]; float* out; unsigned char* ws; };
enum { IN_X = 0, IN_C, IN_CTX, IN_CCTX, IN_WADA, IN_BADA, IN_GATTN, IN_WQKV, IN_WO, IN_SINK, IN_GQ, IN_GK, IN_RPB, IN_GFFN, IN_WGROUP, IN_BGROUP, IN_WROUTER, IN_BROUTER, IN_WGATE, IN_WUP, IN_WDOWN, IN_GFINAL };

DI const float* inp(const Params& P, int i) { i = __builtin_amdgcn_readfirstlane(i); asm volatile("" : "+s"(i)); return P.in[i]; }
DI unsigned char* wsp(const Params& P) { unsigned z = 0; asm volatile("s_mov_b32 %0, 0" : "=s"(z)); return P.ws + z; }
struct Frame { LAS unsigned char* lds; int tid, lane, wave, blk, G, vcu, gw, NGW; };
DI Frame opaque_frame(const Frame& F0) { Frame F = F0; asm volatile("" : "+v"(F.tid)); F.lane = F.tid & 63; asm volatile("" : "+s"(F.wave), "+s"(F.blk), "+s"(F.vcu), "+s"(F.gw)); return F; }

DI void p0_transpose_item(const float* W, int N, int k0, int n0, bf16_t* dst, int Kd, LAS float* scr, int lane) {
#pragma unroll 8
    for (int i = 0; i < 32; ++i) { const int kk = 2 * i + (lane >> 5); scr[kk * 33 + (lane & 31)] = W[(size_t)(k0 + kk) * N + n0 + (lane & 31)]; }
    LDS_WAIT();
    const int c = lane & 7;
#pragma unroll
    for (int j = 0; j < 4; ++j) { const int n = (lane >> 3) + 8 * j; const LAS float* s = scr + (8 * c) * 33 + n;
        u32x4 o; o.x = pk2(s[0 * 33], s[1 * 33]); o.y = pk2(s[2 * 33], s[3 * 33]); o.z = pk2(s[4 * 33], s[5 * 33]); o.w = pk2(s[6 * 33], s[7 * 33]);
        *(u32x4*)(dst + (size_t)n * Kd + 8 * c) = o; }
    LDS_WAIT();
}
DI void p0_transpose_item_f8(const float* W, int N, int k0, int n0, unsigned char* dst, int Kd, LAS float* scr, int lane) {
#pragma unroll 8
    for (int i = 0; i < 32; ++i) { const int kk = 2 * i + (lane >> 5); scr[kk * 33 + (lane & 31)] = W[(size_t)(k0 + kk) * N + n0 + (lane & 31)]; }
    LDS_WAIT();
    const int c = lane & 7;
#pragma unroll
    for (int j = 0; j < 4; ++j) { const int n = (lane >> 3) + 8 * j; const LAS float* s = scr + (8 * c) * 33 + n;
        u32x2 o; o.x = cvt_pk_fp8x4(s[0 * 33] * F8_W_SCALE, s[1 * 33] * F8_W_SCALE, s[2 * 33] * F8_W_SCALE, s[3 * 33] * F8_W_SCALE);
        o.y = cvt_pk_fp8x4(s[4 * 33] * F8_W_SCALE, s[5 * 33] * F8_W_SCALE, s[6 * 33] * F8_W_SCALE, s[7 * 33] * F8_W_SCALE);
        *(u32x2*)(dst + (size_t)n * Kd + 8 * c) = o; }
    LDS_WAIT();
}
DI double dsin_poly(double r) { const double r2 = r * r;
    return r * (1.0 - r2 * (1.0 / 6.0) * (1.0 - r2 * (1.0 / 20.0) * (1.0 - r2 * (1.0 / 42.0) * (1.0 - r2 * (1.0 / 72.0) * (1.0 - r2 * (1.0 / 110.0) * (1.0 - r2 * (1.0 / 156.0) * (1.0 - r2 * (1.0 / 210.0) * (1.0 - r2 * (1.0 / 272.0) * (1.0 - r2 * (1.0 / 342.0) * (1.0 - r2 * (1.0 / 420.0) * (1.0 - r2 * (1.0 / 506.0)))))))))))); }
DI double dcos_poly(double r) { const double r2 = r * r;
    return 1.0 - r2 * (1.0 / 2.0) * (1.0 - r2 * (1.0 / 12.0) * (1.0 - r2 * (1.0 / 30.0) * (1.0 - r2 * (1.0 / 56.0) * (1.0 - r2 * (1.0 / 90.0) * (1.0 - r2 * (1.0 / 132.0) * (1.0 - r2 * (1.0 / 182.0) * (1.0 - r2 * (1.0 / 240.0) * (1.0 - r2 * (1.0 / 306.0) * (1.0 - r2 * (1.0 / 380.0) * (1.0 - r2 * (1.0 / 462.0) * (1.0 - r2 * (1.0 / 552.0)))))))))))); }

constexpr int IT_MOD = DEPTH * 96 * 8;
constexpr int IT_QKV = (DM / 64) * (QKVN / 32), IT_WO = (DM / 64) * (DM / 32), IT_GU = NEXP * (DM / 64) * (FH / 32), IT_DN = NEXP * (FH / 64) * (DM / 32);
constexpr int IT_LAYER = IT_QKV + IT_WO + 2 * IT_GU + IT_DN;
constexpr int IT_TOTAL = IT_MOD + DEPTH * IT_LAYER;

DI void p0_prologue(const Params& P, const Frame& F) {
    LAS float* scr = (LAS float*)(F.lds + F.wave * 16384);
    unsigned char* ws = wsp(P);
    for (int it = F.gw; it < IT_TOTAL; it += F.NGW) {
        if (it < IT_MOD) {
            const int l = it / (96 * 8), rem = it % (96 * 8), cc = rem >> 3, ks = rem & 7;
            for (int idx = F.lane; idx < 17 * 128; idx += 64) { const int b = idx >> 7, k = idx & 127;
                const float cv = (b < 16) ? inp(P, IN_C)[b * DM + ks * 128 + k] : inp(P, IN_CCTX)[ks * 128 + k];
                scr[idx] = cv / (1.f + expf(-cv)); }
            LDS_WAIT();
            float acc[17];
#pragma unroll
            for (int b = 0; b < 17; ++b) acc[b] = 0.f;
            const float* wp = inp(P, IN_WADA) + ((size_t)l * DM + ks * 128) * 6144 + cc * 64 + F.lane;
#pragma unroll 4
            for (int k = 0; k < 128; ++k) { const float w = wp[(size_t)k * 6144];
#pragma unroll
                for (int b = 0; b < 17; ++b) acc[b] += scr[b * 128 + k] * w; }
            float* mp = (float*)(ws + WS_MODP) + ((size_t)(ks * DEPTH + l) * 17) * 6144 + cc * 64 + F.lane;
#pragma unroll
            for (int b = 0; b < 17; ++b) mp[(size_t)b * 6144] = acc[b];
            LDS_WAIT();
            continue;
        }
        int r = it - IT_MOD; const int l = r / IT_LAYER; r -= l * IT_LAYER;
        if (r < IT_QKV) { const int kb = r / (QKVN / 32), nb = r % (QKVN / 32); const int n0 = nb * 32;
            const int drow0 = 256 * (n0 >> 8) + 128 * ((n0 >> 5) & 1) + 32 * ((n0 >> 6) & 3);
            p0_transpose_item_f8(inp(P, IN_WQKV) + (size_t)l * DM * QKVN, QKVN, kb * 64, n0, ws + WS_WQKV + (size_t)l * QKVN * DM + (size_t)drow0 * DM + kb * 64, DM, scr, F.lane); continue; }
        r -= IT_QKV;
        if (r < IT_WO) { const int kb = r / (DM / 32), nb = r % (DM / 32);
            p0_transpose_item_f8(inp(P, IN_WO) + (size_t)l * DM * DM, DM, kb * 64, nb * 32, ws + WS_WO + (size_t)l * DM * DM + (size_t)(nb * 32) * DM + kb * 64, DM, scr, F.lane); continue; }
        r -= IT_WO;
        if (r < 2 * IT_GU) { const int which = r / IT_GU; r -= which * IT_GU; const int e = r / 256, kb = (r % 256) / 16, nb = r % 16; const int n0 = nb * 32;
            const int drow0 = 256 * (n0 >> 7) + 128 * which + (n0 & 127);
            p0_transpose_item_f8(inp(P, which ? IN_WUP : IN_WGATE) + (size_t)(l * NEXP + e) * DM * FH, FH, kb * 64, n0,
                                 ws + WS_WGU + (size_t)(l * NEXP + e) * DM * DM + (size_t)drow0 * DM + kb * 64, DM, scr, F.lane); continue; }
        r -= 2 * IT_GU;
        { const int e = r / 256, kb = (r % 256) / 32, nb = r % 32;
            p0_transpose_item_f8(inp(P, IN_WDOWN) + (size_t)(l * NEXP + e) * FH * DM, DM, kb * 64, nb * 32,
                                 ws + WS_WD + (size_t)(l * NEXP + e) * DM * FH + (size_t)(nb * 32) * FH + kb * 64, FH, scr, F.lane); }
    }
    if (F.gw == F.NGW - 1) {
        f32x2* T = (f32x2*)(ws + WS_ROPE);
        for (int idx = F.lane; idx < 64 * 16; idx += 64) { const int pos = idx >> 4, j = idx & 15;
            const float inv = exp2f(-(float)j * (1.f / 16.f) * 13.287712379549449f);
            const float ang = (float)pos * inv;
            const double a = (double)ang; const double rr = a - 6.283185307179586 * rint(a * 0.15915494309189535);
            T[idx] = (f32x2){(float)dcos_poly(rr), (float)dsin_poly(rr)}; }
    }
    { u32x4* wf = (u32x4*)(ws + WS_WRT); const float* wg = inp(P, IN_WGROUP); const float* wr = inp(P, IN_WROUTER);
      for (int idx = F.gw * 64 + F.lane; idx < DEPTH * 32 * 3 * 2 * 64; idx += F.NGW * 64) { const int l = idx / (32 * 3 * 2 * 64), rem = idx % (32 * 3 * 2 * 64), step = rem / 384, nt = (rem % 384) >> 7, which = (rem >> 6) & 1, ln = rem & 63;
          const int n = 16 * nt + (ln & 15); float w[8];
#pragma unroll
          for (int j = 0; j < 8; ++j) { const int k = 32 * step + 8 * (ln >> 4) + j;
              const float wv = (n < 4) ? wg[((size_t)l * DM + k) * 4 + n] : (n < 36 ? wr[((size_t)l * DM + k) * 32 + (n - 4)] : 0.f);
              const float w1 = bf2f(f2bf(wv)); w[j] = which ? (wv - w1) : wv; }
          u32x4 o; o.x = pk2(w[0], w[1]); o.y = pk2(w[2], w[3]); o.z = pk2(w[4], w[5]); o.w = pk2(w[6], w[7]); wf[idx] = o; } }
}
DI void p0b_mod_reduce(const Params& P, const Frame& F) {
    unsigned char* const ws = wsp(P);
    const float* mp = (const float*)(ws + WS_MODP); float* mod = (float*)(ws + WS_MOD);
    for (int idx = F.gw * 64 + F.lane; idx < DEPTH * 17 * 6144; idx += F.NGW * 64) {
        const int l = idx / (17 * 6144), c = idx % 6144;
        float s = inp(P, IN_BADA)[l * 6144 + c];
#pragma unroll
        for (int ks = 0; ks < 8; ++ks) s += mp[(size_t)ks * DEPTH * 17 * 6144 + idx];
        mod[idx] = s; }
}

DI unsigned expert_count(const unsigned char* ws, int layer, int e) { return __hip_atomic_load((const unsigned*)(ws + WS_CTL) + CW_CNT + (layer * NEXP + e) * CNT_STRIDE, __ATOMIC_RELAXED, __HIP_MEMORY_SCOPE_AGENT); }
DI unsigned expert_starts(const unsigned char* ws, int layer, int lane) {
    const unsigned p = (lane < NEXP) ? ((expert_count(ws, layer, lane & 31) + 255u) & ~255u) : 0u; unsigned incl = p;
#pragma unroll
    for (int d = 1; d < 32; d <<= 1) { const unsigned v = __shfl_up(incl, d); if ((lane & 31) >= d) incl += v; }
    return incl - p;
}

DI void load_row(const float* row, int lane, f32x4 (&v)[4]) {
#pragma unroll
    for (int j = 0; j < 4; ++j) v[j] = *(const f32x4*)(row + 4 * lane + 256 * j);
}
DI void load_row_bf(const bf16_t* row, int lane, f32x4 (&v)[4]) {
#pragma unroll
    for (int j = 0; j < 4; ++j) { const u32x2 w = *(const u32x2*)(row + 4 * lane + 256 * j); v[j] = (f32x4){bf2f(w.x & 0xffffu), bf2f(w.x >> 16), bf2f(w.y & 0xffffu), bf2f(w.y >> 16)}; }
}
DI float row_rstd(const f32x4 (&v)[4]) {
    float s = 0.f;
#pragma unroll
    for (int j = 0; j < 4; ++j) s += (v[j][0] * v[j][0] + v[j][1] * v[j][1]) + (v[j][2] * v[j][2] + v[j][3] * v[j][3]);
    return 1.0f / sqrtf(wave_sum(s) * (1.f / DM) + NORM_EPS);
}
DI void load_vec(const float* p, int lane, f32x4 (&v)[4]) {
#pragma unroll
    for (int j = 0; j < 4; ++j) v[j] = *(const f32x4*)(p + 4 * lane + 256 * j);
}
DI void norm_mod_store(const f32x4 (&v)[4], float rstd, const f32x4 (&gg)[4], const f32x4 (&sh)[4], const f32x4 (&sc)[4], unsigned char* hrow, int lane) {
#pragma unroll
    for (int j = 0; j < 4; ++j) { const int c = 4 * lane + 256 * j;
        const f32x4 hf = ((v[j] * rstd * gg[j]) * (1.f + sc[j]) + sh[j]) * F8_ACT_SCALE;
        *(unsigned*)(hrow + c) = cvt_pk_fp8x4(hf[0], hf[1], hf[2], hf[3]); }
}
struct RowIn { f32x4 x[4]; unsigned ya[4], yb[4]; };
DI void row_fetch(const unsigned char* ws, const float* xrow, const bf16_t* xrow_bf, int t, unsigned s0, unsigned s1, int lane, bool prev, RowIn& R) {
    if (xrow_bf) load_row_bf(xrow_bf, lane, R.x); else load_row(xrow, lane, R.x);
    if (prev) {
        const unsigned char* Y = ws + WS_Y;
#pragma unroll
        for (int j = 0; j < 4; ++j) { R.ya[j] = *(const unsigned*)(Y + (size_t)s0 * DM + 4 * lane + 256 * j); R.yb[j] = *(const unsigned*)(Y + (size_t)s1 * DM + 4 * lane + 256 * j); } }
}
DI void row_apply(const f32x4 (&gt)[4], float w0, float w1, RowIn& R) {
    w0 *= 1.f / F8_Y_SCALE; w1 *= 1.f / F8_Y_SCALE;
#pragma unroll
    for (int j = 0; j < 4; ++j) { const f32x4 g = gt[j];
        const f32x2 a0 = __builtin_amdgcn_cvt_pk_f32_fp8((int)R.ya[j], false), a1 = __builtin_amdgcn_cvt_pk_f32_fp8((int)R.ya[j], true);
        const f32x2 b0 = __builtin_amdgcn_cvt_pk_f32_fp8((int)R.yb[j], false), b1 = __builtin_amdgcn_cvt_pk_f32_fp8((int)R.yb[j], true);
        R.x[j][0] += g[0] * (w0 * a0[0] + w1 * b0[0]); R.x[j][1] += g[1] * (w0 * a0[1] + w1 * b0[1]);
        R.x[j][2] += g[2] * (w0 * a1[0] + w1 * b1[0]); R.x[j][3] += g[3] * (w0 * a1[1] + w1 * b1[1]); }
}
DI void phase_attn_norm(const Params& P, const Frame& F0, int layer) {
    const Frame F = opaque_frame(F0);
    unsigned char* const ws = wsp(P);
    bf16_t* X = (bf16_t*)(ws + WS_X); bf16_t* H = (bf16_t*)(ws + WS_H);
    const bool prev = layer > 0;
    const int nrow = (TALL - F.gw + F.NGW - 1) / F.NGW;
    unsigned ms0 = 0, ms1 = 0; float mw0 = 0.f, mw1 = 0.f;
    if (prev) { const unsigned pst = expert_starts(ws, layer - 1, F.lane); u32x2 a = (u32x2){0u, 0u};
        if (F.lane < nrow) { const int tl = F.gw + F.lane * F.NGW; a = *(const u32x2*)((const unsigned*)(ws + WS_ASG) + (size_t)tl * 2); const f32x2 w = *(const f32x2*)((const float*)(ws + WS_ASGW) + (size_t)tl * 2); mw0 = w.x; mw1 = w.y; }
        ms0 = (unsigned)__shfl((int)pst, (int)(a.x >> 20)) + (a.x & 0xfffffu); ms1 = (unsigned)__shfl((int)pst, (int)(a.y >> 20)) + (a.y & 0xfffffu); }
    auto xsrc = [&](int t) -> const float* { return (t < TLAT ? inp(P, IN_X) + (size_t)t * DM : inp(P, IN_CTX) + (size_t)(t - TLAT) * DM); };
    auto xbf = [&](int t) -> const bf16_t* { return prev ? X + (size_t)t * DM : (const bf16_t*)nullptr; };
    RowIn cur, nxt;
    f32x4 gat[4]; load_vec(inp(P, IN_GATTN) + layer * DM, F.lane, gat);
    row_fetch(ws, xsrc(F.gw), xbf(F.gw), F.gw, __shfl(ms0, 0), __shfl(ms1, 0), F.lane, prev, cur);
    for (int i = 0; i < nrow; ++i) {
        const int t = F.gw + i * F.NGW; const int mb = (t < TLAT) ? (t >> 11) : 16;
        const float* md = (const float*)(ws + WS_MOD) + ((size_t)layer * 17 + mb) * 6144;
        f32x4 gt[4], sh[4], sc[4];
        if (prev) load_vec(md - 17 * 6144 + 5120, F.lane, gt);
        load_vec(md, F.lane, sh); load_vec(md + 1024, F.lane, sc);
        asm volatile("" ::: "memory");
        if (i + 1 < nrow) row_fetch(ws, xsrc(t + F.NGW), xbf(t + F.NGW), t + F.NGW, __shfl(ms0, i + 1), __shfl(ms1, i + 1), F.lane, prev, nxt);
        if (prev) row_apply(gt, __shfl(mw0, i), __shfl(mw1, i), cur);
#pragma unroll
        for (int j = 0; j < 4; ++j) { u32x2 w; w.x = pk2(cur.x[j][0], cur.x[j][1]); w.y = pk2(cur.x[j][2], cur.x[j][3]); *(u32x2*)(X + (size_t)t * DM + 4 * F.lane + 256 * j) = w; }
        const float rstd = row_rstd(cur.x);
        norm_mod_store(cur.x, rstd, gat, sh, sc, (unsigned char*)H + (size_t)t * DM, F.lane);
        cur = nxt;
    }
}
DI void phase_final(const Params& P, const Frame& F0) {
    const Frame F = opaque_frame(F0);
    unsigned char* const ws = wsp(P);
    const bf16_t* X = (const bf16_t*)(ws + WS_X);
    const float pc = PROBE_SEL ? *((const float*)(ws + WS_CTL) + 64) : 0.f;
    const int nrow = (TLAT - F.gw + F.NGW - 1) / F.NGW;
    unsigned ms0 = 0, ms1 = 0; float mw0 = 0.f, mw1 = 0.f;
    { const unsigned pst = expert_starts(ws, DEPTH - 1, F.lane); u32x2 a = (u32x2){0u, 0u};
      if (F.lane < nrow) { const int tl = F.gw + F.lane * F.NGW; a = *(const u32x2*)((const unsigned*)(ws + WS_ASG) + (size_t)tl * 2); const f32x2 w = *(const f32x2*)((const float*)(ws + WS_ASGW) + (size_t)tl * 2); mw0 = w.x; mw1 = w.y; }
      ms0 = (unsigned)__shfl((int)pst, (int)(a.x >> 20)) + (a.x & 0xfffffu); ms1 = (unsigned)__shfl((int)pst, (int)(a.y >> 20)) + (a.y & 0xfffffu); }
    RowIn cur, nxt;
    row_fetch(ws, nullptr, X + (size_t)F.gw * DM, F.gw, __shfl(ms0, 0), __shfl(ms1, 0), F.lane, true, cur);
    f32x4 gfin[4]; load_vec(inp(P, IN_GFINAL), F.lane, gfin);
    for (int i = 0; i < nrow; ++i) {
        const int t = F.gw + i * F.NGW;
        f32x4 gt[4]; load_vec((const float*)(ws + WS_MOD) + ((size_t)(DEPTH - 1) * 17 + (t >> 11)) * 6144 + 5120, F.lane, gt);
        asm volatile("" ::: "memory");
        if (i + 1 < nrow) row_fetch(ws, nullptr, X + (size_t)(t + F.NGW) * DM, t + F.NGW, __shfl(ms0, i + 1), __shfl(ms1, i + 1), F.lane, true, nxt);
        row_apply(gt, __shfl(mw0, i), __shfl(mw1, i), cur);
        const float rstd = row_rstd(cur.x);
#pragma unroll
        for (int j = 0; j < 4; ++j) { const int c = 4 * F.lane + 256 * j; *(f32x4*)(P.out + (size_t)t * DM + c) = cur.x[j] * rstd * gfin[j] + pc; }
        cur = nxt;
    }
}

DI float swap_max(float v) { auto rr = __builtin_amdgcn_permlane32_swap(__float_as_uint(v), __float_as_uint(v), false, false); return fmaxf(__uint_as_float(rr[0]), __uint_as_float(rr[1])); }
DI float swap_add(float v) { auto rr = __builtin_amdgcn_permlane32_swap(__float_as_uint(v), __float_as_uint(v), false, false); return __uint_as_float(rr[0]) + __uint_as_float(rr[1]); }
DI bf16x8 pack_p(const f32x16& p, int s) {
    u32x4 w; w.x = cvt_pk_bf16(p[8 * s + 0], p[8 * s + 1]); w.y = cvt_pk_bf16(p[8 * s + 2], p[8 * s + 3]); w.z = cvt_pk_bf16(p[8 * s + 4], p[8 * s + 5]); w.w = cvt_pk_bf16(p[8 * s + 6], p[8 * s + 7]);
    return __builtin_bit_cast(bf16x8, w);
}
struct AttnState { float m, l; f32x16 o[2]; };
DI void load_k(const unsigned char* Kbh, int kg, int r32, int hi, bf16x8 (&k)[4]) {
    const unsigned char* kb = Kbh + (size_t)(kg + (r32 >> 3)) * 1024 + hi * 128 + (r32 & 7) * 16;
#pragma unroll
    for (int d0 = 0; d0 < 4; ++d0) k[d0] = *(const bf16x8*)(kb + d0 * 256);
}
DI void load_v(const unsigned char* Vbh, int kg, int r32, int hi, s16x4 (&v)[2][2][2]) {
    const unsigned char* vb = Vbh + (size_t)kg * 1024 + r32 * 16 + hi * 8;
#pragma unroll
    for (int dh = 0; dh < 2; ++dh)
#pragma unroll
        for (int ks = 0; ks < 2; ++ks)
#pragma unroll
            for (int pt = 0; pt < 2; ++pt) v[dh][ks][pt] = *(const s16x4*)(vb + dh * 512 + (2 * ks + pt) * 1024);
}
DI f32x16 attn_scores(const bf16x8 (&k)[4], const bf16x8 (&q)[4]) {
    f32x16 s;
#pragma unroll
    for (int r = 0; r < 16; ++r) s[r] = 0.f;
#pragma unroll
    for (int d0 = 0; d0 < 4; ++d0) s = __builtin_amdgcn_mfma_f32_32x32x16_bf16(k[d0], q[d0], s, 0, 0, 0);
    return s;
}
DI float row_max16(const f32x16& s) {
    float mt = fmaxf(fmaxf(s[0], s[1]), fmaxf(s[2], s[3]));
#pragma unroll
    for (int r = 4; r < 16; r += 4) mt = fmaxf(mt, fmaxf(fmaxf(s[r], s[r + 1]), fmaxf(s[r + 2], s[r + 3])));
    return mt;
}
DI void attn_rescale(AttnState& st, f32x16& s, float mt, LAS float* wsf, int r32, int hi) {
    mt = swap_max(mt);
    const float dm = fmaxf(mt, 0.f);
    const float al = __builtin_amdgcn_exp2f(-dm);
    st.l *= al; st.m += dm;
#pragma unroll
    for (int r = 0; r < 16; ++r) s[r] -= dm;
    if (hi == 0) wsf[r32] = al;
    LDS_WAIT();
#pragma unroll
    for (int r = 0; r < 16; ++r) { const float f = wsf[crow(r, hi)]; st.o[0][r] *= f; st.o[1][r] *= f; }
    LDS_WAIT();
}
DI void attn_exp_pv(AttnState& st, f32x16& s, const s16x4 (&v)[2][2][2]) {
    float p0 = 0.f, p1 = 0.f;
#pragma unroll
    for (int r = 0; r < 16; r += 2) { s[r] = __builtin_amdgcn_exp2f(s[r]); s[r + 1] = __builtin_amdgcn_exp2f(s[r + 1]); p0 += s[r]; p1 += s[r + 1]; }
    st.l += p0 + p1;
    const bf16x8 pa0 = pack_p(s, 0), pa1 = pack_p(s, 1);
#pragma unroll
    for (int dh = 0; dh < 2; ++dh) {
        const bf16x8 vf0 = __builtin_shufflevector(v[dh][0][0], v[dh][0][1], 0, 1, 2, 3, 4, 5, 6, 7);
        const bf16x8 vf1 = __builtin_shufflevector(v[dh][1][0], v[dh][1][1], 0, 1, 2, 3, 4, 5, 6, 7);
        st.o[dh] = __builtin_amdgcn_mfma_f32_32x32x16_bf16(pa0, vf0, st.o[dh], 0, 0, 0);
        st.o[dh] = __builtin_amdgcn_mfma_f32_32x32x16_bf16(pa1, vf1, st.o[dh], 0, 0, 0);
    }
}
DI void attn_softmax_pv2(AttnState (&st)[2], f32x16 (&s)[2], const s16x4 (&v)[2][2][2], LAS float* wsf, int r32, int hi) {
#pragma unroll
    for (int r = 0; r < 16; ++r) { s[0][r] -= st[0].m; s[1][r] -= st[1].m; }
    const float mt0 = row_max16(s[0]), mt1 = row_max16(s[1]);
    if (__any(fmaxf(mt0, mt1) > 8.f)) { attn_rescale(st[0], s[0], mt0, wsf, r32, hi); attn_rescale(st[1], s[1], mt1, wsf + 32, r32, hi); }
    attn_exp_pv(st[0], s[0], v);
    attn_exp_pv(st[1], s[1], v);
}
template <int MODE>
DI void attn_unit(const Params& P, unsigned char* ws, int layer, int b, int h0, int qblk, LAS unsigned char* wl, int lane) {
    const int r32 = lane & 31, hi = lane >> 5, kvh = h0 >> 2, m = layer % 3;
    constexpr bool VDB = false;
    LAS float* wsf = (LAS float*)wl; LAS bf16_t* stg = (LAS bf16_t*)(wl + 256); LAS float* rpbt = (LAS float*)(wl + 256 + 4096);
    const bf16_t* QKV = (const bf16_t*)(ws + WS_QKV);
    const unsigned char* Kbh = ws + WS_KF + (size_t)(b * NKV + kvh) * KGRP * 1024;
    const unsigned char* Vbh = ws + WS_VF + (size_t)(b * NKV + kvh) * KGRP * 1024;
    unsigned char* O = ws + WS_O;
    int r0 = 0, c0 = 0;
    if (MODE == 2) { r0 = 2 * (qblk >> 2); c0 = 16 * (qblk & 3); }
    auto qtok = [&](int i) -> int {
        if (MODE == 3) return TLAT + b * CTXL + qblk * 32 + i;
        if (MODE == 2) return b * SEQ + (r0 + (i >> 4)) * 64 + c0 + (i & 15);
        return b * SEQ + qblk * 32 + i; };
    const int tq = qtok(r32);
    const bf16_t* qp = QKV + (size_t)tq * QKVN + h0 * HD + hi * 8;
    bf16x8 qr[2][4];
#pragma unroll
    for (int hh = 0; hh < 2; ++hh)
#pragma unroll
        for (int d0 = 0; d0 < 4; ++d0) qr[hh][d0] = *(const bf16x8*)(qp + hh * HD + d0 * 16);
    const int q0 = qblk * 32;
    int nl = 0, jlo = 0, rs_min = 0, cseg = 0;
    if (MODE == 0) { jlo = (q0 < 128) ? (128 - q0) / 32 : 0; const int jhi = min(8, (SEQ - 32 - q0 + 128) / 32); nl = jhi - jlo + 1; }
    if (MODE == 1) nl = SEQ / 32;
    if (MODE == 2) { rs_min = min(max(r0 - 4, 0), 24); const int rs_max = min(max(r0 + 1 - 4, 0), 24); nl = rs_max - rs_min + 8; cseg = (c0 == 0) ? 0 : (c0 == 16) ? 8 : (c0 == 32) ? 24 : 32; }
    auto lat_kg = [&](int i) -> int {
        if (MODE == 0) return (q0 - 128 + 32 * (jlo + i)) >> 3;
        if (MODE == 1) return 4 * i;
        return ((rs_min + i) * 64 + cseg) >> 3; };
    bf16x8 kn[4];
    load_k(Kbh, nl > 0 ? lat_kg(0) : SEQ / 8, r32, hi, kn);
    if (MODE == 0 || MODE == 1) {
        const int n = tq & 2047; const f32x2* T = (const f32x2*)(ws + WS_ROPE);
        const f32x2* tr = T + (n >> 6) * 16 + 8 * hi; const f32x2* tc = T + (n & 63) * 16 + 8 * hi;
#pragma unroll
        for (int e = 0; e < 8; ++e) { const f32x2 a = tr[e], cc = tc[e];
#pragma unroll
            for (int hh = 0; hh < 2; ++hh) {
                const float x1 = bfs2f(qr[hh][0][e]), x2 = bfs2f(qr[hh][1][e]), x3 = bfs2f(qr[hh][2][e]), x4 = bfs2f(qr[hh][3][e]);
                qr[hh][0][e] = (short)f2bf(x1 * a.x - x2 * a.y); qr[hh][1][e] = (short)f2bf(x2 * a.x + x1 * a.y);
                qr[hh][2][e] = (short)f2bf(x3 * cc.x - x4 * cc.y); qr[hh][3][e] = (short)f2bf(x4 * cc.x + x3 * cc.y); } }
    }
    LAS bf16x8* qlds = (LAS bf16x8*)(wl + 8192) + lane;
    if (VDB) {
#pragma unroll
        for (int d0 = 0; d0 < 4; ++d0) qlds[d0 * 64] = qr[1][d0];
        LDS_WAIT();
    }
    int rq = 0, cq = 0, rsq = 0, csq = 0;
    if (MODE == 2) {
        const float* rpb = inp(P, IN_RPB) + (size_t)h0 * 465;
        for (int i = lane; i < 930; i += 64) rpbt[i + (i >= 465 ? 7 : 0)] = rpb[i] * LOG2E;
        LDS_WAIT();
        rq = r0 + (r32 >> 4); cq = c0 + (r32 & 15); rsq = min(max(rq - 4, 0), 24); csq = min(max(cq - 8, 0), 48);
    }
    AttnState st[2];
#pragma unroll
    for (int hh = 0; hh < 2; ++hh) { st[hh].m = -1024.f; st[hh].l = 0.f;
#pragma unroll
        for (int r = 0; r < 16; ++r) { st[hh].o[0][r] = 0.f; st[hh].o[1][r] = 0.f; } }
    const float NEG = -INFINITY;
    s16x4 vn[2][2][2];
    if (VDB) load_v(Vbh, nl > 0 ? lat_kg(0) : SEQ / 8, r32, hi, vn);
    for (int i = 0; i < nl; ++i) {
        const int kgn = (i + 1 < nl) ? lat_kg(i + 1) : SEQ / 8;
        s16x4 v[2][2][2];
        if (VDB) {
#pragma unroll
            for (int a = 0; a < 2; ++a)
#pragma unroll
                for (int c = 0; c < 2; ++c)
#pragma unroll
                    for (int e = 0; e < 2; ++e) v[a][c][e] = vn[a][c][e];
        } else load_v(Vbh, lat_kg(i), r32, hi, v);
        f32x16 s[2];
        s[0] = attn_scores(kn, qr[0]);
        if (VDB) { bf16x8 q1[4];
#pragma unroll
            for (int d0 = 0; d0 < 4; ++d0) q1[d0] = qlds[d0 * 64];
            s[1] = attn_scores(kn, q1); }
        else s[1] = attn_scores(kn, qr[1]);
        load_k(Kbh, kgn, r32, hi, kn);
        if (VDB) load_v(Vbh, kgn, r32, hi, vn);
        if (MODE == 0) {
            const int j = jlo + i;
            if (j == 0 || j == 8) { const int kt = q0 - 128 + 32 * j, qpos = q0 + r32;
#pragma unroll
                for (int r = 0; r < 16; ++r) { const int d = kt + crow(r, hi) - qpos; if (d > 128 || d < -128) { s[0][r] = NEG; s[1][r] = NEG; } } }
        }
        if (MODE == 2) {
            const int kr = rs_min + i;
            const bool rowok = (kr >= rsq) && (kr < rsq + 8);
            const int ib = (kr - rq + 7) * 31 - cq + 15;
#pragma unroll
            for (int r = 0; r < 16; ++r) { const int kc2 = cseg + crow(r, hi); const bool ok = rowok && (kc2 >= csq) && (kc2 < csq + 16);
                const int idx = min(max(ib + kc2, 0), 464);
                s[0][r] = ok ? s[0][r] + rpbt[idx] : NEG; s[1][r] = ok ? s[1][r] + rpbt[472 + idx] : NEG; }
        }
        attn_softmax_pv2(st, s, v, wsf, r32, hi);
    }
    if (MODE == 0 || MODE == 1) {
#pragma unroll
        for (int hh = 0; hh < 2; ++hh)
#pragma unroll
            for (int d0 = 0; d0 < 4; ++d0) qr[hh][d0] = *(const bf16x8*)(qp + hh * HD + d0 * 16);
        if (VDB) {
#pragma unroll
            for (int d0 = 0; d0 < 4; ++d0) qlds[d0 * 64] = qr[1][d0];
            LDS_WAIT();
        }
    }
    for (int j = 0; j < CTXL / 32; ++j) {
        const int kg = SEQ / 8 + 4 * j, kgn = (j + 1 < CTXL / 32) ? kg + 4 : kg;
        s16x4 v[2][2][2];
        if (VDB) {
#pragma unroll
            for (int a = 0; a < 2; ++a)
#pragma unroll
                for (int c = 0; c < 2; ++c)
#pragma unroll
                    for (int e = 0; e < 2; ++e) v[a][c][e] = vn[a][c][e];
        } else load_v(Vbh, kg, r32, hi, v);
        f32x16 s[2];
        s[0] = attn_scores(kn, qr[0]);
        if (VDB) { bf16x8 q1[4];
#pragma unroll
            for (int d0 = 0; d0 < 4; ++d0) q1[d0] = qlds[d0 * 64];
            s[1] = attn_scores(kn, q1); }
        else s[1] = attn_scores(kn, qr[1]);
        load_k(Kbh, kgn, r32, hi, kn);
        if (VDB) load_v(Vbh, kgn, r32, hi, vn);
        attn_softmax_pv2(st, s, v, wsf, r32, hi);
    }
    int lane2 = lane; asm volatile("" : "+v"(lane2));
    const int r32b = lane2 & 31, hib = lane2 >> 5;
#pragma unroll
    for (int hh = 0; hh < 2; ++hh) {
        const float lt = swap_add(st[hh].l);
        float inv;
        if (MODE == 0 || (MODE == 3 && m == 0)) { const float sk = inp(P, IN_SINK)[(layer / 3) * NH + h0 + hh] * LOG2E;
            const float mnew = fmaxf(st[hh].m, sk); const float al = __builtin_amdgcn_exp2f(st[hh].m - mnew), es = __builtin_amdgcn_exp2f(sk - mnew);
            inv = F8_O_SCALE * al / (lt * al + es); }
        else inv = F8_O_SCALE / lt;
        if (hib == 0) wsf[r32b] = inv;
        LDS_WAIT();
        LAS bf16_t* sb = stg + hib * 256 + r32b;
        const LAS float* wf = wsf + 4 * hib;
#pragma unroll
        for (int r = 0; r < 16; ++r) { const float f = wf[(r & 3) + 8 * (r >> 2)];
            sb[((r & 3) + 8 * (r >> 2)) * 64] = (bf16_t)f2bf(st[hh].o[0][r] * f); sb[((r & 3) + 8 * (r >> 2)) * 64 + 32] = (bf16_t)f2bf(st[hh].o[1][r] * f); }
        LDS_WAIT();
        const int rw = lane2 >> 3, ch = lane2 & 7;
        const LAS unsigned char* rb = (const LAS unsigned char*)stg + rw * 128 + ch * 16;
#pragma unroll
        for (int i = 0; i < 4; ++i) { const u32x4 vv = *(const LAS u32x4*)(rb + i * 1024);
            u32x2 w8; w8.x = cvt_pk_fp8x4(bf2f(vv.x & 0xffffu), bf2f(vv.x >> 16), bf2f(vv.y & 0xffffu), bf2f(vv.y >> 16)); w8.y = cvt_pk_fp8x4(bf2f(vv.z & 0xffffu), bf2f(vv.z >> 16), bf2f(vv.w & 0xffffu), bf2f(vv.w >> 16));
            *(u32x2*)(O + (size_t)qtok(i * 8 + rw) * DM + (h0 + hh) * HD + ch * 8) = w8; }
        LDS_WAIT();
    }
}
DI void phase_attention(const Params& P, const Frame& F0, int layer) {
    const Frame F = opaque_frame(F0);
    unsigned char* const ws = wsp(P);
    const int m = layer % 3;
    LAS unsigned char* wl = F.lds + F.wave * 16384;
    for (int bu = F.blk; bu < NB * NKV * 16; bu += F.G) {
        const int rnd = bu >> 8, x = bu & 7, loc = (bu & 255) >> 3;
        const int bkv = rnd * 16 + x * 2 + (loc >> 4), qg = loc & 15;
        const int b = bkv >> 2, kvh = bkv & 3, h0 = kvh * 4 + 2 * (F.wave & 1), qblk = 4 * qg + (F.wave >> 1);
        if (m == 0) attn_unit<0>(P, ws, layer, b, h0, qblk, wl, F.lane);
        else if (m == 1) attn_unit<1>(P, ws, layer, b, h0, qblk, wl, F.lane);
        else attn_unit<2>(P, ws, layer, b, h0, qblk, wl, F.lane);
    }
    if (layer < DEPTH - 1) {
        for (int bu = F.blk; bu < NB * NKV * 2; bu += F.G) {
            const int bkv = bu >> 1, b = bkv >> 2, kvh = bkv & 3, h0 = kvh * 4 + 2 * (F.wave & 1), qblk = 4 * (bu & 1) + (F.wave >> 1);
            attn_unit<3>(P, ws, layer, b, h0, qblk, wl, F.lane);
        }
    }
}

DI int blk_token(int blk, int i) { return i < 128 ? blk * 128 + i : TLAT + blk * 16 + (i - 128); }
constexpr int RT_ROWB = 2064;
constexpr int RT_X2_OFF = 16 * RT_ROWB, RT_PART_OFF = 2 * 16 * RT_ROWB, RT_LOG_OFF = RT_PART_OFF + 8 * 16 * 48 * 4, RT_LOGS = 37, RT_VEC_OFF = RT_LOG_OFF + 144 * RT_LOGS * 4;
DI void phase_router(const Params& P, const Frame& F0, int layer, int M) {
    const Frame F = opaque_frame(F0);
    unsigned char* const ws = wsp(P);
    const int TPB = M / GRID, nchunk = TPB / 16;
    LAS int* hist = (LAS int*)(F.lds + LDSX_OFF);
    LAS float* part = (LAS float*)(F.lds + RT_PART_OFF); LAS float* logit = (LAS float*)(F.lds + RT_LOG_OFF);
    if (F.tid < 32) hist[F.tid] = 0;
    const bf16_t* X = (const bf16_t*)(ws + WS_X); bf16_t* H = (bf16_t*)(ws + WS_H);
    const float* gffn = inp(P, IN_GFFN) + layer * DM;
    const u32x4* wf = (const u32x4*)(ws + WS_WRT) + ((size_t)layer * 32 + 4 * F.wave) * 384 + F.lane;
    bf16x8 wreg[4][2][2];
#pragma unroll
    for (int s = 0; s < 4; ++s)
#pragma unroll
        for (int nt = 0; nt < 2; ++nt)
#pragma unroll
            for (int wh = 0; wh < 2; ++wh) wreg[s][nt][wh] = __builtin_bit_cast(bf16x8, wf[s * 384 + nt * 128 + wh * 64]);
    bf16x8 w2t[4][2];
#pragma unroll
    for (int s = 0; s < 4; ++s)
#pragma unroll
        for (int wh = 0; wh < 2; ++wh) w2t[s][wh] = __builtin_bit_cast(bf16x8, wf[s * 384 + 256 + wh * 64]);
    LAS float* vec = (LAS float*)(F.lds + RT_VEC_OFF);
    auto load_vecs = [&](int mb) {
        const float* md = (const float*)(ws + WS_MOD) + ((size_t)layer * 17 + mb) * 6144;
        for (int i = F.tid; i < 256; i += NTHREADS) { const f32x4 g = *(const f32x4*)(gffn + 4 * i), sc = *(const f32x4*)(md + 4096 + 4 * i);
            *(LAS f32x4*)(vec + 4 * i) = *(const f32x4*)(md + 2048 + 4 * i); *(LAS f32x4*)(vec + 1024 + 4 * i) = g * (1.f + sc); *(LAS f32x4*)(vec + 2048 + 4 * i) = *(const f32x4*)(md + 3072 + 4 * i); } };
    load_vecs(F.blk >> 4);
    const int ib = 2 * F.wave;
    f32x4 vn[2][4];
#pragma unroll
    for (int tk = 0; tk < 2; ++tk) { const int t = blk_token(F.blk, ib + tk); load_row_bf(X + (size_t)t * DM, F.lane, vn[tk]); }
    LDS_WAIT(); __syncthreads();
    for (int c = 0; c < nchunk; ++c) {
        if (c == 8) { load_vecs(16); LDS_WAIT(); __syncthreads(); }
#pragma unroll
        for (int tk = 0; tk < 2; ++tk) { const int t = blk_token(F.blk, c * 16 + ib + tk);
            const float rstd = row_rstd(vn[tk]);
            LAS unsigned char* r1 = F.lds + (ib + tk) * RT_ROWB + 8 * F.lane; unsigned char* hrow = (unsigned char*)H + (size_t)t * DM;
#pragma unroll
            for (int j = 0; j < 4; ++j) { const int cc = 4 * F.lane + 256 * j; const f32x4 ga = *(const LAS f32x4*)(vec + 1024 + cc), sh = *(const LAS f32x4*)(vec + 2048 + cc);
                const f32x4 hf = (vn[tk][j] * rstd) * ga + sh;
                u32x2 a; a.x = pk2(hf[0], hf[1]); a.y = pk2(hf[2], hf[3]);
                u32x2 b; b.x = pk2(hf[0] - bf2f(a.x & 0xffffu), hf[1] - bf2f(a.x >> 16)); b.y = pk2(hf[2] - bf2f(a.y & 0xffffu), hf[3] - bf2f(a.y >> 16));
                *(unsigned*)(hrow + cc) = cvt_pk_fp8x4(hf[0] * F8_ACT_SCALE, hf[1] * F8_ACT_SCALE, hf[2] * F8_ACT_SCALE, hf[3] * F8_ACT_SCALE); *(LAS u32x2*)(r1 + 512 * j) = a; *(LAS u32x2*)(r1 + RT_X2_OFF + 512 * j) = b; } }
        if (c + 1 < nchunk) {
#pragma unroll
            for (int tk = 0; tk < 2; ++tk) { const int t = blk_token(F.blk, (c + 1) * 16 + ib + tk); load_row_bf(X + (size_t)t * DM, F.lane, vn[tk]); }
        }
        LDS_WAIT(); __syncthreads();
        f32x4 acc[3];
#pragma unroll
        for (int nt = 0; nt < 3; ++nt) acc[nt] = (f32x4){0.f, 0.f, 0.f, 0.f};
        { const LAS unsigned char* ap = F.lds + (F.lane & 15) * RT_ROWB + 256 * F.wave + 16 * (F.lane >> 4);
#pragma unroll
          for (int s = 0; s < 4; ++s) { const bf16x8 a1 = *(const LAS bf16x8*)(ap + 64 * s), a2 = *(const LAS bf16x8*)(ap + RT_X2_OFF + 64 * s);
#pragma unroll
              for (int nt = 0; nt < 2; ++nt) { acc[nt] = __builtin_amdgcn_mfma_f32_16x16x32_bf16(a1, wreg[s][nt][0], acc[nt], 0, 0, 0);
                  acc[nt] = __builtin_amdgcn_mfma_f32_16x16x32_bf16(a1, wreg[s][nt][1], acc[nt], 0, 0, 0); acc[nt] = __builtin_amdgcn_mfma_f32_16x16x32_bf16(a2, wreg[s][nt][0], acc[nt], 0, 0, 0); }
              acc[2] = __builtin_amdgcn_mfma_f32_16x16x32_bf16(a1, w2t[s][0], acc[2], 0, 0, 0);
              acc[2] = __builtin_amdgcn_mfma_f32_16x16x32_bf16(a1, w2t[s][1], acc[2], 0, 0, 0); acc[2] = __builtin_amdgcn_mfma_f32_16x16x32_bf16(a2, w2t[s][0], acc[2], 0, 0, 0); } }
        { LAS float* pp = part + F.wave * 768 + (4 * (F.lane >> 4)) * 48 + (F.lane & 15);
#pragma unroll
          for (int nt = 0; nt < 3; ++nt)
#pragma unroll
              for (int r = 0; r < 4; ++r) pp[r * 48 + 16 * nt] = acc[nt][r]; }
        LDS_WAIT(); __syncthreads();
        { const int tk = F.tid >> 5, n = F.tid & 31; float s = 0.f;
#pragma unroll
          for (int w = 0; w < 8; ++w) s += part[w * 768 + tk * 48 + n];
          logit[(c * 16 + tk) * RT_LOGS + n] = s;
          if (F.tid < 64) { const int tk2 = F.tid >> 2, n2 = 32 + (F.tid & 3); float s2 = 0.f;
#pragma unroll
              for (int w = 0; w < 8; ++w) s2 += part[w * 768 + tk2 * 48 + n2];
              logit[(c * 16 + tk2) * RT_LOGS + n2] = s2; } }
    }
    LDS_WAIT(); __syncthreads();
    int rt_t = 0, rt_e1 = 0, rt_e2 = 0, rt_q1 = 0, rt_q2 = 0; float rt_w1 = 0.f, rt_w2 = 0.f;
    if (F.tid < TPB) { const int t = blk_token(F.blk, F.tid); const LAS float* lg = logit + F.tid * RT_LOGS;
        const float* bg = inp(P, IN_BGROUP) + layer * 4; const float* br = inp(P, IN_BROUTER) + layer * 32;
        const float g0 = lg[0] + bg[0], g1 = lg[1] + bg[1], g2 = lg[2] + bg[2], g3 = lg[3] + bg[3];
        int grp = 0; float gm = g0; if (g1 > gm) { gm = g1; grp = 1; } if (g2 > gm) { gm = g2; grp = 2; } if (g3 > gm) { gm = g3; grp = 3; }
        const float ptop = 1.f / (expf(g0 - gm) + expf(g1 - gm) + expf(g2 - gm) + expf(g3 - gm));
        float ev[8], em = -INFINITY;
#pragma unroll
        for (int j = 0; j < 8; ++j) { ev[j] = lg[4 + grp * 8 + j] + br[grp * 8 + j]; em = fmaxf(em, ev[j]); }
        float pe[8];
#pragma unroll
        for (int j = 0; j < 8; ++j) pe[j] = expf(ev[j] - em);
        int i1 = 0; float p1 = pe[0];
#pragma unroll
        for (int j = 1; j < 8; ++j) if (pe[j] > p1) { p1 = pe[j]; i1 = j; }
        int i2 = 0; float p2 = -1.f;
#pragma unroll
        for (int j = 0; j < 8; ++j) if (j != i1 && pe[j] > p2) { p2 = pe[j]; i2 = j; }
        const float w1 = ptop * p1 / (p1 + p2), w2 = ptop * p2 / (p1 + p2);
        const int e1 = grp * 8 + i1, e2 = grp * 8 + i2;
        rt_q1 = atomicAdd((int*)&hist[e1], 1); rt_q2 = atomicAdd((int*)&hist[e2], 1);
        rt_t = t; rt_e1 = e1; rt_e2 = e2; rt_w1 = w1; rt_w2 = w2; }
    __syncthreads();
    LAS unsigned* gbase = (LAS unsigned*)(hist + 32);
    if (F.tid < 32) gbase[F.tid] = __hip_atomic_fetch_add((unsigned*)(ws + WS_CTL) + CW_CNT + (layer * NEXP + F.tid) * CNT_STRIDE, (unsigned)hist[F.tid], __ATOMIC_RELAXED, __HIP_MEMORY_SCOPE_AGENT);
    LDS_WAIT(); __syncthreads();
    if (F.tid < TPB) { const unsigned i1 = gbase[rt_e1] + (unsigned)rt_q1, i2 = gbase[rt_e2] + (unsigned)rt_q2;
        unsigned* asg = (unsigned*)(ws + WS_ASG); float* asgw = (float*)(ws + WS_ASGW); unsigned* toke = (unsigned*)(ws + WS_TOKE);
        *(u32x2*)(asg + (size_t)rt_t * 2) = (u32x2){((unsigned)rt_e1 << 20) | i1, ((unsigned)rt_e2 << 20) | i2};
        *(f32x2*)(asgw + (size_t)rt_t * 2) = (f32x2){rt_w1, rt_w2};
        toke[(size_t)rt_e1 * TALL + i1] = (unsigned)rt_t; toke[(size_t)rt_e2 * TALL + i2] = (unsigned)rt_t; }
}
DI void build_tile_table(const Params& P, const Frame& F0, LAS unsigned* tab, int layer) {
    const Frame F = opaque_frame(F0);
    unsigned char* const ws = wsp(P);
    constexpr int TP = pg8::MoeSched<true>::TAB_PST, TC = pg8::MoeSched<true>::TAB_CNT;
    if (F.tid < NEXP) tab[TC + F.tid] = expert_count(ws, layer, F.tid);
    LDS_WAIT(); __syncthreads();
    if (F.tid == 0) { unsigned ps = 0; for (int e = 0; e < NEXP; ++e) { tab[TP + e] = ps; ps += (tab[TC + e] + 255u) & ~255u; } tab[0] = ps >> 8; }
    LDS_WAIT(); __syncthreads();
    const unsigned ntile = tab[0];
    for (unsigned rt = F.tid; rt < ntile; rt += NTHREADS) { unsigned e = 0; for (int k = 1; k < NEXP; ++k) if (rt * 256u >= tab[TP + k]) e = k; tab[1 + rt] = e; }
    LDS_WAIT(); __syncthreads();
}
__global__ void __launch_bounds__(NTHREADS, 2) dit_fwd(Params P) {
    extern __shared__ __attribute__((aligned(16))) unsigned char lds_raw[];
    Frame F;
    F.lds = (LAS unsigned char*)lds_raw;
    F.tid = threadIdx.x; F.lane = F.tid & 63; F.wave = __builtin_amdgcn_readfirstlane(F.tid >> 6);
    F.blk = blockIdx.x; F.G = gridDim.x; F.vcu = (F.G % 8 == 0) ? (F.blk % 8) * (F.G / 8) + F.blk / 8 : F.blk;
    F.gw = F.vcu * NWAVES + F.wave; F.NGW = F.G * NWAVES;
    for (int u = F.tid; u < (LDS_BYTES - RING_BYTES) / 4; u += NTHREADS) ((LAS unsigned*)(F.lds + RING_BYTES))[u] = 0u;
    __syncthreads();
    unsigned* ctl = (unsigned*)(P.ws + WS_CTL);
    XcdBarrier bar = xcd_barrier_post(ctl + CW_BAR, (volatile LAS unsigned*)(F.lds + MISC_OFF) + 8);

    unsigned long long pr_t0 = 0, pr_prev = 0, pr_acc = 0;
    if (PROBE_SEL) { pr_t0 = __builtin_amdgcn_s_memrealtime(); pr_prev = pr_t0; }
#define PSTAMP(id) do { if (PROBE_SEL) { const unsigned long long now_ = __builtin_amdgcn_s_memrealtime(); if ((id) == PROBE_SEL) pr_acc += now_ - pr_prev; pr_prev = now_; } } while (0)
    p0_prologue(P, F);
    if (RPT & 1) p0_prologue(P, F);
    xcd_barrier(bar);
    p0b_mod_reduce(P, F);
    xcd_barrier(bar);
    PSTAMP(1);

    for (int layer = 0; layer < DEPTH; ++layer) {
        const bool last = (layer == DEPTH - 1);
        unsigned char* ws = wsp(P);
        const int Mtok = last ? TLAT : TALL;
        phase_attn_norm(P, F, layer);
        if ((RPT & 256) && layer == 0) { phase_attn_norm(P, F, layer); phase_attn_norm(P, F, layer); phase_attn_norm(P, F, layer); }
        xcd_barrier(bar);
        PSTAMP(2);
        {
            pg8::PlainSched<true, F8_SC_ACT> S; S.nN = QKVN / 256; S.nwg = (TALL / 256) * S.nN; S.G = F.G; S.c = F.vcu; S.K = DM / 2; S.Bt = (const bf16_t*)(ws + WS_WQKV + (size_t)layer * QKVN * DM);
            pg8::EpiQKV E{(bf16_t*)(ws + WS_QKV), ws + WS_KF, ws + WS_VF, (const f32x2*)(ws + WS_ROPE), inp(P, IN_GQ), inp(P, IN_GK), layer % 3};
            pg8::gemm_phase(F.lds, (const bf16_t*)(ws + WS_H), DM / 2, S, E);
            if (RPT & 2) pg8::gemm_phase(F.lds, (const bf16_t*)(ws + WS_H), DM / 2, S, E);
        }
        xcd_barrier(bar);
        PSTAMP(3);
        phase_attention(P, F, layer);
        if (((RPT & 4) && layer == 1) || ((RPT & 8) && layer != 1)) phase_attention(P, F, layer);
        xcd_barrier(bar);
        PSTAMP(4);
        {
            pg8::PlainSched<true> S; S.nN = DM / 256; S.nwg = (Mtok / 256) * S.nN; S.G = F.G; S.c = F.vcu; S.K = DM / 2; S.Bt = (const bf16_t*)(ws + WS_WO + (size_t)layer * DM * DM);
            pg8::EpiResidBf E{(bf16_t*)(ws + WS_X), (const float*)(ws + WS_MOD) + (size_t)layer * 17 * 6144 + 2048};
            pg8::gemm_phase(F.lds, (const bf16_t*)(ws + WS_O), DM / 2, S, E);
        }
        xcd_barrier(bar);
        PSTAMP(5);
        phase_router(P, F, layer, Mtok);
        xcd_barrier(bar);
        PSTAMP(6);
        if (RPT & 128) { for (int xb = 0; xb < 9; ++xb) xcd_barrier(bar); }
        LAS unsigned* tab = (LAS unsigned*)(F.lds + LDSX_OFF + 8192);
        build_tile_table(P, F, tab, layer);
        {
            pg8::MoeSched<true> S; S.tab = tab; S.G = F.G; S.c = F.vcu; S.K = DM / 2; S.Bt = (const bf16_t*)(ws + WS_WGU + (size_t)layer * NEXP * DM * DM); S.estride = (size_t)DM * DM; S.tok = (const unsigned*)(ws + WS_TOKE);
            pg8::EpiSwiglu E{ws + WS_ACT};
            pg8::gemm_phase(F.lds, (const bf16_t*)(ws + WS_H), DM / 2, S, E);
            if (RPT & 32) pg8::gemm_phase(F.lds, (const bf16_t*)(ws + WS_H), DM / 2, S, E);
        }
        xcd_barrier(bar);
        PSTAMP(8);
        {
            pg8::MoeSched<false> S; S.tab = tab; S.G = F.G; S.c = F.vcu; S.K = FH / 2; S.Bt = (const bf16_t*)(ws + WS_WD + (size_t)layer * NEXP * DM * FH); S.estride = (size_t)DM * FH; S.tok = nullptr;
            pg8::EpiStoreF8 E{ws + WS_Y, DM, F8_Y_SCALE};
            pg8::gemm_phase(F.lds, (const bf16_t*)(ws + WS_ACT), FH / 2, S, E);
            if (RPT & 64) pg8::gemm_phase(F.lds, (const bf16_t*)(ws + WS_ACT), FH / 2, S, E);
        }
        xcd_barrier(bar);
        PSTAMP(9);
    }
    if (PROBE_SEL) {
        if (F.blk == 0 && F.tid == 0) { const unsigned long long tot = __builtin_amdgcn_s_memrealtime() - pr_t0;
            const float f = (PROBE_SEL == 15) ? 0.5f : (float)pr_acc / (float)tot;
            __hip_atomic_store((float*)(P.ws + WS_CTL) + 64, sqrtf(4e-4f * f), __ATOMIC_RELAXED, __HIP_MEMORY_SCOPE_AGENT); }
        xcd_barrier(bar);
    }
    phase_final(P, F);
    if (RPT & 512) { phase_final(P, F); phase_final(P, F); phase_final(P, F); }
}

extern "C" void kernel_launch(void* const* d_in, const int* in_sizes, int n_in, void* d_out, int out_size, void* d_ws, size_t ws_size, hipStream_t stream) {
    static int ok = 0;
    if (ok == 0) {
        if (n_in != 22 || in_sizes[0] != TLAT * DM || out_size != TLAT * DM || ws_size < WS_END) {
            fprintf(stderr, "kernel_launch: unexpected shapes (n_in %d, in0 %d, out %d, ws %zu < %zu); nothing launched\n", n_in, n_in > 0 ? in_sizes[0] : -1, out_size, ws_size, (size_t)WS_END); ok = -1; return; }
        int dev = 0, cus = 0, per_cu = 0;
        if (hipGetDevice(&dev) != hipSuccess || hipDeviceGetAttribute(&cus, hipDeviceAttributeMultiprocessorCount, dev) != hipSuccess) { ok = -1; return; }
        if (hipFuncSetAttribute((const void*)dit_fwd, hipFuncAttributeMaxDynamicSharedMemorySize, LDS_BYTES) != hipSuccess) { fprintf(stderr, "kernel_launch: hipFuncSetAttribute failed\n"); ok = -1; return; }
        if (hipOccupancyMaxActiveBlocksPerMultiprocessor(&per_cu, (const void*)dit_fwd, NTHREADS, LDS_BYTES) != hipSuccess || per_cu < 1) fprintf(stderr, "kernel_launch: note: occupancy query reports %d\n", per_cu);
        (void)hipGetLastError();
        if (cus < GRID) { fprintf(stderr, "kernel_launch: %d CUs < %d workgroups: grid would not be resident; nothing launched\n", cus, GRID); ok = -1; return; }
        ok = 1;
    }
    if (ok < 0) return;
    if (hipMemsetAsync((char*)d_ws + WS_CTL, 0, CTL_ZERO_BYTES, stream) != hipSuccess) return;
    Params p{};
    for (int i = 0; i < 22; ++i) p.in[i] = (const float*)d_in[i];
    p.out = (float*)d_out; p.ws = (unsigned char*)d_ws;
    hipLaunchKernelGGL(dit_fwd, dim3(GRID), dim3(NTHREADS), LDS_BYTES, stream, p);
}
```

```cpp
#include <hip/hip_runtime.h>
#include <cstdio>
#include <cstdint>

#ifndef PROBE_SEL
#define PROBE_SEL 0
#endif
#ifndef RPT
#define RPT 0
#endif

#define LAS __attribute__((address_space(3)))
#define GAS __attribute__((address_space(1)))
#define DI __device__ __forceinline__

typedef unsigned short bf16_t;
typedef short bf16x8 __attribute__((ext_vector_type(8)));
typedef short s16x4 __attribute__((ext_vector_type(4)));
typedef float f32x2 __attribute__((ext_vector_type(2)));
typedef float f32x4 __attribute__((ext_vector_type(4)));
typedef float f32x16 __attribute__((ext_vector_type(16)));
typedef unsigned u32x2 __attribute__((ext_vector_type(2)));
typedef unsigned u32x4 __attribute__((ext_vector_type(4)));
typedef int i32x4 __attribute__((ext_vector_type(4)));
typedef int i32x8 __attribute__((ext_vector_type(8)));

constexpr int NB = 16, SEQ = 2048, DM = 1024, DEPTH = 4, CTXL = 256, NH = 16, NKV = 4, HD = 64, QKVN = 1536;
constexpr int TLAT = NB * SEQ, TCTX = NB * CTXL, TALL = TLAT + TCTX;
constexpr int NEXP = 32, FH = 512;
constexpr int KEYS = SEQ + CTXL, KGRP = KEYS / 8;
constexpr int CAPR = 2 * TALL + NEXP * 256;
constexpr int NWAVES = 8, NTHREADS = 512, GRID = 256;
constexpr float NORM_EPS = 1e-6f, LOG2E = 1.4426950408889634f;

constexpr size_t MiB = 1u << 20;
constexpr size_t WS_CTL = 0, CTL_ZERO_BYTES = 1 * MiB;
constexpr size_t WS_MODP = 1 * MiB;
constexpr size_t WS_MOD = 15 * MiB;
constexpr size_t WS_ROPE = 17 * MiB;
constexpr size_t WS_WRT = 17 * MiB + 65536;
constexpr size_t WS_ASG = 18 * MiB;
constexpr size_t WS_ASGW = 18 * MiB + 512 * 1024;
constexpr size_t WS_TOKE = 1 * MiB;
constexpr size_t WS_WQKV = 21 * MiB;
constexpr size_t WS_WO = 33 * MiB;
constexpr size_t WS_WGU = 41 * MiB;
constexpr size_t WS_WD = 297 * MiB;
constexpr size_t WS_X = 425 * MiB;
constexpr size_t WS_H = 569 * MiB;
constexpr size_t WS_R1 = 641 * MiB;
constexpr size_t WS_QKV = WS_R1;
constexpr size_t WS_KF = WS_R1 + 108 * MiB;
constexpr size_t WS_VF = WS_R1 + 126 * MiB;
constexpr size_t WS_O = WS_R1 + 144 * MiB;
constexpr size_t WS_Y = WS_R1;
constexpr size_t WS_ACT = WS_R1 + 160 * MiB;
constexpr size_t WS_END = WS_R1 + 240 * MiB;
constexpr int CW_TMO = 0, CW_BAR = 4096, CW_CNT = 65536, CNT_STRIDE = 32;

constexpr int RING_BYTES = 131072;
constexpr int MISC_OFF = RING_BYTES + 320;
constexpr int LDSX_OFF = RING_BYTES + 1024;
constexpr int LDS_BYTES = 147456;

#define LDS_WAIT() asm volatile("s_waitcnt lgkmcnt(0)" ::: "memory")
#define VM_WAIT() asm volatile("s_waitcnt vmcnt(0)" ::: "memory")

DI unsigned f2bf(float f) { unsigned u = __float_as_uint(f); return (u + 0x7fffu + ((u >> 16) & 1u)) >> 16; }
DI float bf2f(unsigned b) { return __uint_as_float(b << 16); }
DI float bfs2f(short b) { return __uint_as_float(((unsigned)(unsigned short)b) << 16); }
DI unsigned cvt_pk_bf16(float lo, float hi);
DI unsigned pk2(float lo, float hi) { return cvt_pk_bf16(lo, hi); }
DI unsigned cvt_pk_bf16(float lo, float hi) { unsigned r; asm volatile("v_cvt_pk_bf16_f32 %0, %1, %2" : "=v"(r) : "v"(lo), "v"(hi)); return r; }
constexpr float F8_ACT_SCALE = 8.f, F8_W_SCALE = 64.f;
constexpr int F8_SC_ACT = 127 - 3, F8_SC_W = 127 - 6;
constexpr float F8_Y_SCALE = 16.f;
constexpr float F8_O_SCALE = 32.f; constexpr int F8_SC_O = 127 - 5;
DI unsigned cvt_pk_fp8x4(float a, float b, float c, float d) {
    a = __builtin_amdgcn_fmed3f(a, -448.f, 448.f); b = __builtin_amdgcn_fmed3f(b, -448.f, 448.f); c = __builtin_amdgcn_fmed3f(c, -448.f, 448.f); d = __builtin_amdgcn_fmed3f(d, -448.f, 448.f);
    int r = __builtin_amdgcn_cvt_pk_fp8_f32(a, b, 0, false); r = __builtin_amdgcn_cvt_pk_fp8_f32(c, d, r, true); return (unsigned)r; }
DI float wave_sum(float v) {
#pragma unroll
    for (int o = 1; o < 64; o <<= 1) v += __shfl_xor(v, o);
    return v;
}
DI int crow(int r, int hi) { return (r & 3) + 8 * (r >> 2) + 4 * hi; }

#define XB_TMO      128
#define XB_XCNT(j)  (256  + 64 * (j))
#define XB_XSUB(j)  (1280 + 64 * (j))
#define XB_XGEN(j)  (2304 + 64 * (j))
#define XB_TOP      3328
#define XB_TOPGEN   3392
#define XCD_BAR_WORDS 3456
#define XB_SPIN_CAP (1u << 18)

__device__ __forceinline__ unsigned xb_ld(unsigned* p)              { return __hip_atomic_load(p, __ATOMIC_RELAXED, __HIP_MEMORY_SCOPE_AGENT); }
__device__ __forceinline__ unsigned xb_add(unsigned* p, unsigned v) { return __hip_atomic_fetch_add(p, v, __ATOMIC_RELAXED, __HIP_MEMORY_SCOPE_AGENT); }
__device__ __forceinline__ unsigned xb_xcc_id() { return (unsigned)__builtin_amdgcn_s_getreg((3 << 11) | 20) & 0xFu; }
#define XB_SPIN(cond, bar) do { unsigned _sp = 0; while (cond) { __builtin_amdgcn_s_sleep(1); \
    if ((++_sp & 255u) == 0u) { if (xb_ld(&(bar)[XB_TMO])) break; if (_sp > XB_SPIN_CAP) { atomicAdd(&(bar)[XB_TMO], 1u); break; } } } } while (0)

struct XcdBarrier { unsigned* bar; unsigned x; volatile LAS unsigned* st; };

__device__ __forceinline__ XcdBarrier xcd_barrier_post(unsigned* bar, volatile LAS unsigned* st) {
    XcdBarrier b; b.bar = bar; b.x = xb_xcc_id(); b.st = st;
    if (threadIdx.x == 0) (void)xb_add(&bar[XB_XCNT(b.x)], 1u);
    return b;
}
__device__ __forceinline__ void xcd_barrier_complete(unsigned* bar, unsigned x, unsigned& nloc, unsigned& nx) {
    const unsigned G = gridDim.x * gridDim.y * gridDim.z;
    unsigned sum, cnt, mine, sp = 0u;
    for (;;) {
        sum = 0u; cnt = 0u; mine = 0u;
#pragma unroll
        for (unsigned j = 0; j < 16; ++j) { const unsigned c = xb_ld(&bar[XB_XCNT(j)]); sum += c; cnt += (c > 0u) ? 1u : 0u; mine = (j == x) ? c : mine; }
        if (sum == G) break;
        __builtin_amdgcn_s_sleep(1);
        if ((++sp & 255u) == 0u) { if (xb_ld(&bar[XB_TMO])) break; if (sp > XB_SPIN_CAP) { atomicAdd(&bar[XB_TMO], 1u); break; } }
    }
    nloc = mine > 0u ? mine : 1u; nx = cnt > 0u ? cnt : 1u;
}
__device__ __forceinline__ void xcd_barrier(const XcdBarrier& b0) {
    XcdBarrier b = b0;
    { unsigned z = 0, bx = __builtin_amdgcn_readfirstlane(b0.x); asm volatile("s_mov_b32 %0, 0" : "=s"(z)); asm volatile("" : "+s"(bx)); b.bar = b0.bar + z; b.x = bx; }
    asm volatile("s_waitcnt vmcnt(0)" ::: "memory");
    __syncthreads();
    if (threadIdx.x == 0) {
        unsigned* bar = b.bar;
        __builtin_amdgcn_s_waitcnt(0);
        unsigned nloc = b.st[0], nx = b.st[1];
        if (nloc == 0u) { xcd_barrier_complete(bar, b.x, nloc, nx); b.st[0] = nloc; b.st[1] = nx; }
        const unsigned old = xb_add(&bar[XB_XSUB(b.x)], 1u);
        const unsigned gen = old / nloc;
        if (old + 1u == (gen + 1u) * nloc) {
            __builtin_amdgcn_fence(__ATOMIC_RELEASE, "agent");
            asm volatile("s_waitcnt vmcnt(0)" ::: "memory");
            const unsigned og = xb_add(&bar[XB_TOP], 1u);
            const unsigned tg = og / nx;
            if (og + 1u == (tg + 1u) * nx) xb_add(&bar[XB_TOPGEN], 1u);
            else XB_SPIN(xb_ld(&bar[XB_TOPGEN]) == tg, bar);
            __builtin_amdgcn_fence(__ATOMIC_ACQUIRE, "agent");
            xb_add(&bar[XB_XGEN(b.x)], 1u);
            asm volatile("s_waitcnt vmcnt(0)" ::: "memory");
        } else {
            XB_SPIN(xb_ld(&bar[XB_XGEN(b.x)]) == gen, bar);
            __builtin_amdgcn_fence(__ATOMIC_ACQUIRE, "agent");
            asm volatile("s_waitcnt vmcnt(0)" ::: "memory");
        }
    }
    __syncthreads();
}

namespace pg8 {
constexpr int BM = 256, BK = 64, HALF = 128, HTB = HALF * BK * 2, STAGE_BYTES = 8 * HTB;
DI int lds_byte(int r, int c) { const int st = (r >> 4) * 2 + (c >> 5), rr = r & 15, cc = c & 31, ob = rr * 64 + cc * 2; return st * 1024 + (ob ^ (((ob >> 9) & 1) << 5)); }
DI void stage_rc(int b, int& R, int& C) { const int st = b / 1024, sb = b % 1024, swz = sb ^ (((sb >> 9) & 1) << 5); R = (st >> 1) * 16 + swz / 64; C = (st & 1) * 32 + (swz % 64) / 2; }
DI int perm32(int rho) { const int n = rho >> 4, i = rho & 15; return 8 * (i >> 2) + 4 * n + (i & 3); }
struct Unit { int pm, pn, e, r0, na; };

DI void mfma_f8_acc(f32x4& c, const i32x8& w, const i32x8& a, int sw, int sa) {
    asm volatile("v_mfma_scale_f32_16x16x128_f8f6f4 %0, %1, %2, %0, %3, %4 op_sel_hi:[0,0,0]" : "+v"(c) : "v"(w), "v"(a), "v"(sw), "v"(sa));
}
template <class Epi, class Sched>
DI void gemm_phase(LAS unsigned char* lds, const bf16_t* A, const int K, const Sched& S, const Epi& E) {
    int tid_ = threadIdx.x; asm volatile("" : "+v"(tid_));
    const int tid = tid_, wid = __builtin_amdgcn_readfirstlane(tid >> 6), lane = tid & 63, wr = wid >> 2, wc = wid & 3, fr = lane & 15, fq = lane >> 4;
    int nt_ = K / BK; asm volatile("" : "+s"(nt_));
    const int nt = nt_;
    constexpr bool GA = Sched::GATHER, F8 = Sched::FP8;
    int f8sw = F8_SC_W, f8sa = Sched::SC_ACT; asm volatile("" : "+v"(f8sw), "+v"(f8sa));
    int Rr[2], Cc[2]; unsigned voffB[2], voffA[2];
#pragma unroll
    for (int i = 0; i < 2; ++i) { int R, C; stage_rc(tid * 16 + i * 8192, R, C); const int Rb = Epi::PERM ? ((R & ~31) + perm32(R & 31)) : R;
        Rr[i] = R; Cc[i] = C; voffB[i] = (unsigned)(Rb * K + C) * 2u; voffA[i] = (unsigned)(R * K + C) * 2u; }
    const size_t kstep = (size_t)(BK * 2);
    const size_t hstep = (size_t)HALF * K * 2;
    const unsigned ldsw = (unsigned)wid * 1024u;
    const int aoff = lds_byte(wr * 64 + fr, fq * 8), boff = lds_byte(wc * 32 + fr, fq * 8);
#define PG8_SA(b, h) (((b) * 2 + (h)) * HTB)
#define PG8_SB(b, h) ((4 + (b) * 2 + (h)) * HTB)
#define PG8_STAGE(bufoff, gbase, voff) do { _Pragma("unroll") for (int _i = 0; _i < 2; ++_i) \
        __builtin_amdgcn_global_load_lds((const unsigned*)((const char*)(gbase) + (voff)[_i]), (LAS unsigned*)(lds + (bufoff) + ldsw + _i * 8192), 16, 0, 0); } while (0)
#define PG8_LDA(dst, b, h) do { _Pragma("unroll") for (int m = 0; m < 4; ++m) _Pragma("unroll") for (int k = 0; k < 2; ++k) dst[m][k] = *(const LAS bf16x8*)(lds + PG8_SA(b, h) + aoff + m * 2048 + k * 1024); } while (0)
#define PG8_LDB(dst, b, h) do { _Pragma("unroll") for (int n = 0; n < 2; ++n) _Pragma("unroll") for (int k = 0; k < 2; ++k) dst[n][k] = *(const LAS bf16x8*)(lds + PG8_SB(b, h) + boff + n * 2048 + k * 1024); } while (0)
#define PG8_CAT8(x0, x1) __builtin_shufflevector(__builtin_bit_cast(i32x4, x0), __builtin_bit_cast(i32x4, x1), 0, 1, 2, 3, 4, 5, 6, 7)
#define PG8_MMA(ai, bj, At, Bt) do { __builtin_amdgcn_s_setprio(1); \
        if (F8) { _Pragma("unroll") for (int m = 0; m < 4; ++m) _Pragma("unroll") for (int n = 0; n < 2; ++n) \
            mfma_f8_acc(acc[ai][bj][m][n], PG8_CAT8(Bt[n][0], Bt[n][1]), PG8_CAT8(At[m][0], At[m][1]), f8sw, f8sa); } \
        else { _Pragma("unroll") for (int m = 0; m < 4; ++m) _Pragma("unroll") for (int n = 0; n < 2; ++n) _Pragma("unroll") for (int k = 0; k < 2; ++k) \
            acc[ai][bj][m][n] = __builtin_amdgcn_mfma_f32_16x16x32_bf16(Bt[n][k], At[m][k], acc[ai][bj][m][n], 0, 0, 0); } \
        __builtin_amdgcn_s_setprio(0); } while (0)
#define PG8_WAIT_V(n) asm volatile("s_waitcnt vmcnt(" #n ")" ::: "memory")
#define PG8_WAIT_L(n) asm volatile("s_waitcnt lgkmcnt(" #n ")" ::: "memory")
#define PG8_BAR __builtin_amdgcn_s_barrier()
#define PG8_SCHED __builtin_amdgcn_sched_barrier(0)
    Unit cur, nxt; int ui = 0;
    if (!S.next(0, cur)) return;
    f32x4 acc[2][2][4][2];
#pragma unroll
    for (int a = 0; a < 2; ++a)
#pragma unroll
        for (int b = 0; b < 2; ++b)
#pragma unroll
            for (int m = 0; m < 4; ++m)
#pragma unroll
                for (int n = 0; n < 2; ++n) acc[a][b][m][n] = (f32x4){0.f, 0.f, 0.f, 0.f};
    bf16x8 At[4][2], B0[2][2], B1[2][2];
    unsigned oc0[2], oc1[2], on0[2], on1[2];
#pragma unroll
    for (int i = 0; i < 2; ++i) { if (GA) { oc0[i] = S.a_off(cur, Rr[i]) + (unsigned)Cc[i] * 2u; oc1[i] = S.a_off(cur, HALF + Rr[i]) + (unsigned)Cc[i] * 2u; } else { oc0[i] = voffA[i]; oc1[i] = voffA[i]; } on0[i] = oc0[i]; on1[i] = oc1[i]; }
    size_t hA = (GA || (Sched::HALVES && cur.na == 1)) ? (size_t)0 : hstep, hAn = hA;
    const char* Ab = GA ? (const char*)A : (const char*)A + (size_t)cur.r0 * K * 2;
    const char* cB = S.b_ptr(cur);
    PG8_STAGE(PG8_SB(0, 0), cB, voffB); PG8_STAGE(PG8_SB(0, 1), cB + hstep, voffB); PG8_STAGE(PG8_SA(0, 0), Ab, oc0); PG8_STAGE(PG8_SA(0, 1), Ab + hA, oc1);
    if (wr == 1) PG8_BAR;
    PG8_WAIT_V(2); PG8_BAR;
    PG8_STAGE(PG8_SB(1, 0), cB + kstep, voffB); PG8_STAGE(PG8_SA(1, 0), Ab + kstep, oc0); PG8_STAGE(PG8_SB(1, 1), cB + hstep + kstep, voffB);
    PG8_WAIT_V(6); PG8_BAR;
    for (;;) {
        const bool has_next = S.next(ui + 1, nxt);
        const char* nB = has_next ? S.b_ptr(nxt) : cB;
        const char* nA = GA ? Ab : (has_next ? (const char*)A + (size_t)nxt.r0 * K * 2 : Ab);
        if (!GA && Sched::HALVES) hAn = (has_next && nxt.na == 1) ? (size_t)0 : (has_next ? hstep : hA);
        if (GA) {
            if (has_next) {
#pragma unroll
                for (int i = 0; i < 2; ++i) { on0[i] = S.a_off(nxt, Rr[i]) + (unsigned)Cc[i] * 2u; on1[i] = S.a_off(nxt, HALF + Rr[i]) + (unsigned)Cc[i] * 2u; }
            } else {
#pragma unroll
                for (int i = 0; i < 2; ++i) { on0[i] = oc0[i]; on1[i] = oc1[i]; }
            }
        }
#define PG8_KLOOP(FULL) \
        for (int t = 0; t < nt; t += 2) { \
            const bool last = (t == nt - 2); \
            const char* a1 = Ab + (size_t)(t + 1) * kstep + hA; \
            const char* a2 = last ? nA : Ab + (size_t)(t + 2) * kstep; const char* b2 = last ? nB : cB + (size_t)(t + 2) * kstep; \
            const char* a3 = a2 + kstep; const char* b3 = b2 + kstep; const size_t hA2 = last ? hAn : hA; \
            unsigned o20[2], o21[2]; \
            for (int i = 0; i < 2; ++i) { if (GA) { o20[i] = last ? on0[i] : oc0[i]; o21[i] = last ? on1[i] : oc1[i]; } else { o20[i] = voffA[i]; o21[i] = voffA[i]; } } \
              \
            PG8_LDB(B0, 0, 0); PG8_LDB(B1, 0, 1); PG8_SCHED; PG8_LDA(At, 0, 0); PG8_STAGE(PG8_SA(1, 1), a1, oc1); \
            PG8_WAIT_V(8); PG8_WAIT_L(0); PG8_BAR; PG8_MMA(0, 0, At, B0); PG8_MMA(0, 1, At, B1); PG8_BAR; PG8_SCHED; \
              \
            if (FULL) { PG8_LDA(At, 0, 1); } PG8_STAGE(PG8_SB(0, 0), b2, voffB); PG8_STAGE(PG8_SB(0, 1), b2 + hstep, voffB); PG8_STAGE(PG8_SA(0, 0), a2, o20); \
            PG8_WAIT_V(8); PG8_WAIT_L(0); PG8_BAR; if (FULL) { PG8_MMA(1, 0, At, B0); PG8_MMA(1, 1, At, B1); } PG8_BAR; PG8_SCHED; \
              \
            PG8_LDB(B0, 1, 0); PG8_LDB(B1, 1, 1); PG8_SCHED; PG8_LDA(At, 1, 0); PG8_STAGE(PG8_SA(0, 1), a2 + hA2, o21); \
            PG8_WAIT_V(8); PG8_WAIT_L(0); PG8_BAR; PG8_MMA(0, 0, At, B0); PG8_MMA(0, 1, At, B1); PG8_BAR; PG8_SCHED; \
              \
            if (FULL) { PG8_LDA(At, 1, 1); } PG8_STAGE(PG8_SB(1, 0), b3, voffB); PG8_STAGE(PG8_SB(1, 1), b3 + hstep, voffB); PG8_STAGE(PG8_SA(1, 0), a3, o20); \
            PG8_WAIT_V(8); PG8_WAIT_L(0); PG8_BAR; if (FULL) { PG8_MMA(1, 0, At, B0); PG8_MMA(1, 1, At, B1); } PG8_BAR; PG8_SCHED; \
        }
        if (Sched::HALVES && cur.na == 1) { PG8_KLOOP(0) } else { PG8_KLOOP(1) }
#undef PG8_KLOOP
        if (wr == 0) PG8_BAR;
        if (F8) asm volatile("s_nop 15\n\ts_nop 15" ::: "memory");
        E(acc, cur, wr, wc, fr, fq);
        if (!has_next) break;
#pragma unroll
        for (int a = 0; a < 2; ++a)
#pragma unroll
            for (int b = 0; b < 2; ++b)
#pragma unroll
                for (int m = 0; m < 4; ++m)
#pragma unroll
                    for (int n = 0; n < 2; ++n) acc[a][b][m][n] = (f32x4){0.f, 0.f, 0.f, 0.f};
        cur = nxt; cB = nB; Ab = nA; hA = hAn; ++ui;
        if (GA) {
#pragma unroll
            for (int i = 0; i < 2; ++i) { oc0[i] = on0[i]; oc1[i] = on1[i]; }
        }
        if (wr == 1) PG8_BAR;
    }
    PG8_WAIT_V(0);
    PG8_BAR;
#undef PG8_SA
#undef PG8_SB
#undef PG8_STAGE
#undef PG8_LDA
#undef PG8_LDB
#undef PG8_MMA
#undef PG8_CAT8
#undef PG8_WAIT_V
#undef PG8_WAIT_L
#undef PG8_BAR
#undef PG8_SCHED
}

template <bool FP8_, int SC_ACT_ = F8_SC_O> struct PlainSched {
    static constexpr bool GATHER = false, HALVES = true, FP8 = FP8_; static constexpr int SC_ACT = SC_ACT_;
    int nN, nwg, G, c, K; const bf16_t* Bt;
    DI bool next(int i, Unit& u) const { const int L = i * G + c; const int nfull = (nwg / G) * G, rem = nwg - nfull; int Lu = L, hf = 0; u.na = 2;
        if (L >= nfull) { if (2 * rem <= G) { const int h = L - nfull; if (h >= 2 * rem) return false; Lu = nfull + (h >> 1); hf = h & 1; u.na = 1; } else if (L >= nwg) return false; }
        u.pm = Lu / nN; u.pn = Lu - u.pm * nN; u.e = 0; u.r0 = u.pm * BM + hf * HALF; return true; }
    DI unsigned a_off(const Unit& u, int r) const { return (unsigned)(u.r0 + r) * (unsigned)(K * 2); }
    DI const char* b_ptr(const Unit& u) const { return (const char*)Bt + (size_t)u.pn * BM * K * 2; }
};
template <bool GATHER_> struct MoeSched {
    static constexpr bool GATHER = GATHER_, HALVES = true, FP8 = true; static constexpr int SC_ACT = F8_SC_ACT;
    static constexpr int TAB_PST = 384, TAB_CNT = 416;
    const LAS unsigned* tab; int G, c, K; const bf16_t* Bt; size_t estride; const unsigned* tok;
    DI bool next(int i, Unit& u) const { const int L = i * G + c; const int nwg = (int)tab[0] * 4, nfull = (nwg / G) * G, rem = nwg - nfull; int Lu = L, hf = 0; u.na = 2;
        if (L >= nfull) { if (2 * rem <= G) { const int h = L - nfull; if (h >= 2 * rem) return false; Lu = nfull + (h >> 1); hf = h & 1; u.na = 1; } else if (L >= nwg) return false; }
        u.pm = Lu >> 2; u.pn = Lu & 3; u.e = (int)tab[1 + u.pm]; u.r0 = u.pm * BM + hf * HALF; return true; }
    DI unsigned a_off(const Unit& u, int r) const {
        unsigned row = (unsigned)(u.r0 + (u.na == 1 ? (r & (HALF - 1)) : r));
        if (GATHER_) { const unsigned last = tab[TAB_CNT + u.e] - 1u; unsigned idx = row - tab[TAB_PST + u.e]; idx = idx < last ? idx : last; row = tok[(unsigned)u.e * (unsigned)TALL + idx]; }
        return row * (unsigned)(K * 2); }
    DI const char* b_ptr(const Unit& u) const { return (const char*)Bt + (size_t)u.e * estride + (size_t)u.pn * BM * K * 2; }
};

struct EpiStore {
    static constexpr bool PERM = true;
    bf16_t* O; int ldc;
    DI void operator()(const f32x4 (&acc)[2][2][4][2], const Unit& u, int wr, int wc, int fr, int fq) const {
        const int row0 = u.r0 + wr * 64 + fr, col0 = u.pn * BM + wc * 32 + 8 * fq;
#pragma unroll
        for (int ai = 0; ai < 2; ++ai) if (ai < u.na)
#pragma unroll
            for (int m = 0; m < 4; ++m) { bf16_t* rowp = O + (size_t)(row0 + ai * HALF + m * 16) * ldc + col0;
#pragma unroll
                for (int bj = 0; bj < 2; ++bj) { const f32x4 v0 = acc[ai][bj][m][0], v1 = acc[ai][bj][m][1];
                    u32x4 w; w.x = cvt_pk_bf16(v0[0], v0[1]); w.y = cvt_pk_bf16(v0[2], v0[3]); w.z = cvt_pk_bf16(v1[0], v1[1]); w.w = cvt_pk_bf16(v1[2], v1[3]);
                    *(u32x4*)(rowp + bj * HALF) = w; } }
    }
};
struct EpiStoreF8 {
    static constexpr bool PERM = true;
    unsigned char* O; int ldc; float scale;
    DI void operator()(const f32x4 (&acc)[2][2][4][2], const Unit& u, int wr, int wc, int fr, int fq) const {
        const int row0 = u.r0 + wr * 64 + fr, col0 = u.pn * BM + wc * 32 + 8 * fq;
#pragma unroll
        for (int ai = 0; ai < 2; ++ai) if (ai < u.na)
#pragma unroll
            for (int m = 0; m < 4; ++m) { unsigned char* rowp = O + (size_t)(row0 + ai * HALF + m * 16) * ldc + col0;
#pragma unroll
                for (int bj = 0; bj < 2; ++bj) { const f32x4 v0 = acc[ai][bj][m][0] * scale, v1 = acc[ai][bj][m][1] * scale;
                    u32x2 w; w.x = cvt_pk_fp8x4(v0[0], v0[1], v0[2], v0[3]); w.y = cvt_pk_fp8x4(v1[0], v1[1], v1[2], v1[3]);
                    *(u32x2*)(rowp + bj * HALF) = w; } }
    }
};
struct EpiQKV {
    static constexpr bool PERM = false;
    bf16_t* QKV; unsigned char* KF; unsigned char* VF; const LAS f32x2* T; const float* gq; const float* gk; int m;
    DI void operator()(const f32x4 (&acc)[2][2][4][2], const Unit& u, int wr, int wc, int fr, int fq) const {
        const bool lat = u.pm < TLAT / BM; const int b = lat ? (u.pm >> 3) : (u.pm - TLAT / BM);
        const int trow0 = u.r0 + wr * 64 + fr;
        if (u.pn < 4) {
            const int h = 4 * u.pn + wc;
            f32x4 g[2][2];
#pragma unroll
            for (int bj = 0; bj < 2; ++bj)
#pragma unroll
                for (int n = 0; n < 2; ++n) g[bj][n] = *(const f32x4*)(gq + 32 * bj + 16 * n + 4 * fq);
            asm volatile("" : "+v"(g[0][0]), "+v"(g[0][1]), "+v"(g[1][0]), "+v"(g[1][1]));
#pragma unroll
            for (int bj = 0; bj < 2; ++bj)
#pragma unroll
                for (int n = 0; n < 2; ++n) g[bj][n] = (m == 1) ? g[bj][n] : (f32x4){1.f, 1.f, 1.f, 1.f};
#pragma unroll
            for (int ai = 0; ai < 2; ++ai) if (ai < u.na)
#pragma unroll
                for (int mm = 0; mm < 4; ++mm) {
                    f32x4 x[2][2]; float ss = 0.f;
#pragma unroll
                    for (int bj = 0; bj < 2; ++bj)
#pragma unroll
                        for (int n = 0; n < 2; ++n) { x[bj][n] = acc[ai][bj][mm][n]; ss += (x[bj][n][0] * x[bj][n][0] + x[bj][n][1] * x[bj][n][1]) + (x[bj][n][2] * x[bj][n][2] + x[bj][n][3] * x[bj][n][3]); }
                    float sc = 0.125f * LOG2E;
                    if (m == 1) { ss += __shfl_xor(ss, 16); ss += __shfl_xor(ss, 32); sc *= 1.0f / sqrtf(ss * (1.f / HD) + NORM_EPS); }
                    bf16_t* qrow = QKV + (size_t)(trow0 + ai * HALF + mm * 16) * QKVN + h * HD + 4 * fq;
#pragma unroll
                    for (int bj = 0; bj < 2; ++bj)
#pragma unroll
                        for (int n = 0; n < 2; ++n) { const f32x4 y = x[bj][n] * g[bj][n] * sc; u32x2 w; w.x = cvt_pk_bf16(y[0], y[1]); w.y = cvt_pk_bf16(y[2], y[3]); *(u32x2*)(qrow + 32 * bj + 16 * n) = w; }
                }
        } else if (u.pn == 4) {
            f32x4 g[2][2];
#pragma unroll
            for (int bj = 0; bj < 2; ++bj)
#pragma unroll
                for (int n = 0; n < 2; ++n) g[bj][n] = *(const f32x4*)(gk + 32 * bj + 16 * n + 4 * fq);
            asm volatile("" : "+v"(g[0][0]), "+v"(g[0][1]), "+v"(g[1][0]), "+v"(g[1][1]));
#pragma unroll
            for (int bj = 0; bj < 2; ++bj)
#pragma unroll
                for (int n = 0; n < 2; ++n) g[bj][n] = (m == 1) ? g[bj][n] : (f32x4){1.f, 1.f, 1.f, 1.f};
            const bool rope = lat && (m != 2);
            unsigned char* kbase = KF + (size_t)(b * NKV + wc) * KGRP * 1024 + (fq >> 1) * 128 + (fq & 1) * 8;
#pragma unroll
            for (int ai = 0; ai < 2; ++ai) if (ai < u.na)
#pragma unroll
                for (int mm = 0; mm < 4; ++mm) {
                    const int t = trow0 + ai * HALF + mm * 16;
                    const int kidx = lat ? (t & 2047) : (2048 + ((t - TLAT) & 255));
                    f32x4 x[2][2]; float ss = 0.f;
#pragma unroll
                    for (int bj = 0; bj < 2; ++bj)
#pragma unroll
                        for (int n = 0; n < 2; ++n) { x[bj][n] = acc[ai][bj][mm][n]; ss += (x[bj][n][0] * x[bj][n][0] + x[bj][n][1] * x[bj][n][1]) + (x[bj][n][2] * x[bj][n][2] + x[bj][n][3] * x[bj][n][3]); }
                    if (m == 1) { ss += __shfl_xor(ss, 16); ss += __shfl_xor(ss, 32); const float rs = 1.0f / sqrtf(ss * (1.f / HD) + NORM_EPS);
#pragma unroll
                        for (int bj = 0; bj < 2; ++bj)
#pragma unroll
                            for (int n = 0; n < 2; ++n) x[bj][n] = x[bj][n] * g[bj][n] * rs; }
                    if (rope) {
#pragma unroll
                        for (int bj = 0; bj < 2; ++bj) { const int pos = bj ? (kidx & 63) : (kidx >> 6); const LAS f32x4* tp = (const LAS f32x4*)(T + pos * 16 + 4 * fq);
                            const f32x4 t0 = tp[0], t1 = tp[1];
                            const f32x4 cs = (f32x4){t0[0], t0[2], t1[0], t1[2]}, sn = (f32x4){t0[1], t0[3], t1[1], t1[3]};
                            const f32x4 a = x[bj][0], c = x[bj][1];
                            x[bj][0] = a * cs - c * sn; x[bj][1] = c * cs + a * sn; }
                    }
                    unsigned char* kp = kbase + (size_t)(kidx >> 3) * 1024 + (kidx & 7) * 16;
#pragma unroll
                    for (int bj = 0; bj < 2; ++bj)
#pragma unroll
                        for (int n = 0; n < 2; ++n) { u32x2 w; w.x = cvt_pk_bf16(x[bj][n][0], x[bj][n][1]); w.y = cvt_pk_bf16(x[bj][n][2], x[bj][n][3]); *(u32x2*)(kp + (4 * bj + 2 * n) * 128) = w; }
                }
        } else {
            const int q4 = fr & 3;
            unsigned char* vbase = VF + (size_t)(b * NKV + wc) * KGRP * 1024 + (4 * fq + q4) * 16;
#pragma unroll
            for (int ai = 0; ai < 2; ++ai) if (ai < u.na)
#pragma unroll
                for (int mm = 0; mm < 4; ++mm) {
                    const int t = trow0 + ai * HALF + mm * 16;
                    const int kidx = lat ? (t & 2047) : (2048 + ((t - TLAT) & 255));
                    unsigned char* vp = vbase + (size_t)(kidx >> 3) * 1024 + (kidx & 4) * 2;
#pragma unroll
                    for (int bj = 0; bj < 2; ++bj)
#pragma unroll
                        for (int n = 0; n < 2; ++n) {
                            f32x4 x = acc[ai][bj][mm][n];
                            { const float s0 = (q4 & 1) ? x[0] : x[1], s1 = (q4 & 1) ? x[2] : x[3]; const float r0 = __shfl_xor(s0, 1), r1 = __shfl_xor(s1, 1);
                              if (q4 & 1) { x[0] = r0; x[2] = r1; } else { x[1] = r0; x[3] = r1; } }
                            { const float s0 = (q4 & 2) ? x[0] : x[2], s1 = (q4 & 2) ? x[1] : x[3]; const float r0 = __shfl_xor(s0, 2), r1 = __shfl_xor(s1, 2);
                              if (q4 & 2) { x[0] = r0; x[1] = r1; } else { x[2] = r0; x[3] = r1; } }
                            u32x2 w; w.x = cvt_pk_bf16(x[0], x[1]); w.y = cvt_pk_bf16(x[2], x[3]);
                            *(u32x2*)(vp + (32 * bj + 16 * n) * 16) = w; }
                }
        }
    }
};
DI float silu_mul(float g, float u) { return g * __builtin_amdgcn_rcpf(1.f + __builtin_amdgcn_exp2f(-g * LOG2E)) * u; }
struct EpiResidBf {
    static constexpr bool PERM = true;
    bf16_t* X; const float* gate;
    DI void operator()(const f32x4 (&acc)[2][2][4][2], const Unit& u, int wr, int wc, int fr, int fq) const {
        const int mb = (u.pm < TLAT / BM) ? (u.pm >> 3) : 16;
        const float* gt = gate + (size_t)mb * 6144;
        const int row0 = u.r0 + wr * 64 + fr, col0 = u.pn * BM + wc * 32 + 8 * fq;
        f32x4 g[2][2];
#pragma unroll
        for (int bj = 0; bj < 2; ++bj)
#pragma unroll
            for (int n = 0; n < 2; ++n) g[bj][n] = *(const f32x4*)(gt + col0 + bj * HALF + 4 * n);
#pragma unroll
        for (int ai = 0; ai < 2; ++ai) if (ai < u.na) {
            u32x4 old[4][2];
#pragma unroll
            for (int m = 0; m < 4; ++m)
#pragma unroll
                for (int bj = 0; bj < 2; ++bj) old[m][bj] = *(const u32x4*)(X + (size_t)(row0 + ai * HALF + m * 16) * DM + col0 + bj * HALF);
#pragma unroll
            for (int m = 0; m < 4; ++m)
#pragma unroll
                for (int bj = 0; bj < 2; ++bj) { const u32x4 o = old[m][bj]; const f32x4 a0 = acc[ai][bj][m][0] * g[bj][0], a1 = acc[ai][bj][m][1] * g[bj][1];
                    u32x4 w; w.x = cvt_pk_bf16(bf2f(o.x & 0xffffu) + a0[0], bf2f(o.x >> 16) + a0[1]); w.y = cvt_pk_bf16(bf2f(o.y & 0xffffu) + a0[2], bf2f(o.y >> 16) + a0[3]);
                    w.z = cvt_pk_bf16(bf2f(o.z & 0xffffu) + a1[0], bf2f(o.z >> 16) + a1[1]); w.w = cvt_pk_bf16(bf2f(o.w & 0xffffu) + a1[2], bf2f(o.w >> 16) + a1[3]);
                    *(u32x4*)(X + (size_t)(row0 + ai * HALF + m * 16) * DM + col0 + bj * HALF) = w; }
        }
    }
};
struct EpiSwiglu {
    static constexpr bool PERM = true;
    unsigned char* ACT;
    DI void operator()(const f32x4 (&acc)[2][2][4][2], const Unit& u, int wr, int wc, int fr, int fq) const {
        const int row0 = u.r0 + wr * 64 + fr, col0 = u.pn * HALF + wc * 32 + 8 * fq;
#pragma unroll
        for (int ai = 0; ai < 2; ++ai) if (ai < u.na)
#pragma unroll
            for (int m = 0; m < 4; ++m) { unsigned char* rowp = ACT + (size_t)(row0 + ai * HALF + m * 16) * FH + col0;
                const f32x4 g0 = acc[ai][0][m][0], g1 = acc[ai][0][m][1], u0 = acc[ai][1][m][0] * F8_ACT_SCALE, u1 = acc[ai][1][m][1] * F8_ACT_SCALE;
                u32x2 w; w.x = cvt_pk_fp8x4(silu_mul(g0[0], u0[0]), silu_mul(g0[1], u0[1]), silu_mul(g0[2], u0[2]), silu_mul(g0[3], u0[3]));
                w.y = cvt_pk_fp8x4(silu_mul(g1[0], u1[0]), silu_mul(g1[1], u1[1]), silu_mul(g1[2], u1[2]), silu_mul(g1[3], u1[3]));
                *(u32x2*)rowp = w; }
    }
};
}

struct Params { const float* in[22]; float* out; unsigned char* ws; };
enum { IN_X = 0, IN_C, IN_CTX, IN_CCTX, IN_WADA, IN_BADA, IN_GATTN, IN_WQKV, IN_WO, IN_SINK, IN_GQ, IN_GK, IN_RPB, IN_GFFN, IN_WGROUP, IN_BGROUP, IN_WROUTER, IN_BROUTER, IN_WGATE, IN_WUP, IN_WDOWN, IN_GFINAL };

DI const float* inp(const Params& P, int i) { i = __builtin_amdgcn_readfirstlane(i); asm volatile("" : "+s"(i)); return P.in[i]; }
DI unsigned char* wsp(const Params& P) { unsigned z = 0; asm volatile("s_mov_b32 %0, 0" : "=s"(z)); return P.ws + z; }
struct Frame { LAS unsigned char* lds; int tid, lane, wave, blk, G, vcu, gw, NGW; };
DI Frame opaque_frame(const Frame& F0) { Frame F = F0; asm volatile("" : "+v"(F.tid)); F.lane = F.tid & 63; asm volatile("" : "+s"(F.wave), "+s"(F.blk), "+s"(F.vcu), "+s"(F.gw)); return F; }

DI void p0_transpose_item(const float* W, int N, int k0, int n0, bf16_t* dst, int Kd, LAS float* scr, int lane) {
#pragma unroll 8
    for (int i = 0; i < 32; ++i) { const int kk = 2 * i + (lane >> 5); scr[kk * 33 + (lane & 31)] = W[(size_t)(k0 + kk) * N + n0 + (lane & 31)]; }
    LDS_WAIT();
    const int c = lane & 7;
#pragma unroll
    for (int j = 0; j < 4; ++j) { const int n = (lane >> 3) + 8 * j; const LAS float* s = scr + (8 * c) * 33 + n;
        u32x4 o; o.x = pk2(s[0 * 33], s[1 * 33]); o.y = pk2(s[2 * 33], s[3 * 33]); o.z = pk2(s[4 * 33], s[5 * 33]); o.w = pk2(s[6 * 33], s[7 * 33]);
        *(u32x4*)(dst + (size_t)n * Kd + 8 * c) = o; }
    LDS_WAIT();
}
DI void p0_transpose_item_f8(const float* W, int N, int k0, int n0, unsigned char* dst, int Kd, LAS float* scr, int lane) {
#pragma unroll 8
    for (int i = 0; i < 32; ++i) { const int kk = 2 * i + (lane >> 5); scr[kk * 33 + (lane & 31)] = W[(size_t)(k0 + kk) * N + n0 + (lane & 31)]; }
    LDS_WAIT();
    const int c = lane & 7;
#pragma unroll
    for (int j = 0; j < 4; ++j) { const int n = (lane >> 3) + 8 * j; const LAS float* s = scr + (8 * c) * 33 + n;
        u32x2 o; o.x = cvt_pk_fp8x4(s[0 * 33] * F8_W_SCALE, s[1 * 33] * F8_W_SCALE, s[2 * 33] * F8_W_SCALE, s[3 * 33] * F8_W_SCALE);
        o.y = cvt_pk_fp8x4(s[4 * 33] * F8_W_SCALE, s[5 * 33] * F8_W_SCALE, s[6 * 33] * F8_W_SCALE, s[7 * 33] * F8_W_SCALE);
        *(u32x2*)(dst + (size_t)n * Kd + 8 * c) = o; }
    LDS_WAIT();
}
DI double dsin_poly(double r) { const double r2 = r * r;
    return r * (1.0 - r2 * (1.0 / 6.0) * (1.0 - r2 * (1.0 / 20.0) * (1.0 - r2 * (1.0 / 42.0) * (1.0 - r2 * (1.0 / 72.0) * (1.0 - r2 * (1.0 / 110.0) * (1.0 - r2 * (1.0 / 156.0) * (1.0 - r2 * (1.0 / 210.0) * (1.0 - r2 * (1.0 / 272.0) * (1.0 - r2 * (1.0 / 342.0) * (1.0 - r2 * (1.0 / 420.0) * (1.0 - r2 * (1.0 / 506.0)))))))))))); }
DI double dcos_poly(double r) { const double r2 = r * r;
    return 1.0 - r2 * (1.0 / 2.0) * (1.0 - r2 * (1.0 / 12.0) * (1.0 - r2 * (1.0 / 30.0) * (1.0 - r2 * (1.0 / 56.0) * (1.0 - r2 * (1.0 / 90.0) * (1.0 - r2 * (1.0 / 132.0) * (1.0 - r2 * (1.0 / 182.0) * (1.0 - r2 * (1.0 / 240.0) * (1.0 - r2 * (1.0 / 306.0) * (1.0 - r2 * (1.0 / 380.0) * (1.0 - r2 * (1.0 / 462.0) * (1.0 - r2 * (1.0 / 552.0)))))))))))); }

constexpr int IT_MOD = DEPTH * 96 * 8;
constexpr int IT_QKV = (DM / 64) * (QKVN / 32), IT_WO = (DM / 64) * (DM / 32), IT_GU = NEXP * (DM / 64) * (FH / 32), IT_DN = NEXP * (FH / 64) * (DM / 32);
constexpr int IT_LAYER = IT_QKV + IT_WO + 2 * IT_GU + IT_DN;
constexpr int IT_TOTAL = IT_MOD + DEPTH * IT_LAYER;

DI void p0_prologue(const Params& P, const Frame& F) {
    LAS float* scr = (LAS float*)(F.lds + F.wave * 16384);
    unsigned char* ws = wsp(P);
    for (int it = F.gw; it < IT_TOTAL; it += F.NGW) {
        if (it < IT_MOD) {
            const int l = it / (96 * 8), rem = it % (96 * 8), cc = rem >> 3, ks = rem & 7;
            for (int idx = F.lane; idx < 17 * 128; idx += 64) { const int b = idx >> 7, k = idx & 127;
                const float cv = (b < 16) ? inp(P, IN_C)[b * DM + ks * 128 + k] : inp(P, IN_CCTX)[ks * 128 + k];
                scr[idx] = cv / (1.f + expf(-cv)); }
            LDS_WAIT();
            float acc[17];
#pragma unroll
            for (int b = 0; b < 17; ++b) acc[b] = 0.f;
            const float* wp = inp(P, IN_WADA) + ((size_t)l * DM + ks * 128) * 6144 + cc * 64 + F.lane;
#pragma unroll 4
            for (int k = 0; k < 128; ++k) { const float w = wp[(size_t)k * 6144];
#pragma unroll
                for (int b = 0; b < 17; ++b) acc[b] += scr[b * 128 + k] * w; }
            float* mp = (float*)(ws + WS_MODP) + ((size_t)(ks * DEPTH + l) * 17) * 6144 + cc * 64 + F.lane;
#pragma unroll
            for (int b = 0; b < 17; ++b) mp[(size_t)b * 6144] = acc[b];
            LDS_WAIT();
            continue;
        }
        int r = it - IT_MOD; const int l = r / IT_LAYER; r -= l * IT_LAYER;
        if (r < IT_QKV) { const int kb = r / (QKVN / 32), nb = r % (QKVN / 32); const int n0 = nb * 32;
            const int drow0 = 256 * (n0 >> 8) + 128 * ((n0 >> 5) & 1) + 32 * ((n0 >> 6) & 3);
            p0_transpose_item_f8(inp(P, IN_WQKV) + (size_t)l * DM * QKVN, QKVN, kb * 64, n0, ws + WS_WQKV + (size_t)l * QKVN * DM + (size_t)drow0 * DM + kb * 64, DM, scr, F.lane); continue; }
        r -= IT_QKV;
        if (r < IT_WO) { const int kb = r / (DM / 32), nb = r % (DM / 32);
            p0_transpose_item_f8(inp(P, IN_WO) + (size_t)l * DM * DM, DM, kb * 64, nb * 32, ws + WS_WO + (size_t)l * DM * DM + (size_t)(nb * 32) * DM + kb * 64, DM, scr, F.lane); continue; }
        r -= IT_WO;
        if (r < 2 * IT_GU) { const int which = r / IT_GU; r -= which * IT_GU; const int e = r / 256, kb = (r % 256) / 16, nb = r % 16; const int n0 = nb * 32;
            const int drow0 = 256 * (n0 >> 7) + 128 * which + (n0 & 127);
            p0_transpose_item_f8(inp(P, which ? IN_WUP : IN_WGATE) + (size_t)(l * NEXP + e) * DM * FH, FH, kb * 64, n0,
                                 ws + WS_WGU + (size_t)(l * NEXP + e) * DM * DM + (size_t)drow0 * DM + kb * 64, DM, scr, F.lane); continue; }
        r -= 2 * IT_GU;
        { const int e = r / 256, kb = (r % 256) / 32, nb = r % 32;
            p0_transpose_item_f8(inp(P, IN_WDOWN) + (size_t)(l * NEXP + e) * FH * DM, DM, kb * 64, nb * 32,
                                 ws + WS_WD + (size_t)(l * NEXP + e) * DM * FH + (size_t)(nb * 32) * FH + kb * 64, FH, scr, F.lane); }
    }
    if (F.gw == F.NGW - 1) {
        f32x2* T = (f32x2*)(ws + WS_ROPE);
        for (int idx = F.lane; idx < 64 * 16; idx += 64) { const int pos = idx >> 4, j = idx & 15;
            const float inv = exp2f(-(float)j * (1.f / 16.f) * 13.287712379549449f);
            const float ang = (float)pos * inv;
            const double a = (double)ang; const double rr = a - 6.283185307179586 * rint(a * 0.15915494309189535);
            T[idx] = (f32x2){(float)dcos_poly(rr), (float)dsin_poly(rr)}; }
    }
    { u32x4* wf = (u32x4*)(ws + WS_WRT); const float* wg = inp(P, IN_WGROUP); const float* wr = inp(P, IN_WROUTER);
      for (int idx = F.gw * 64 + F.lane; idx < DEPTH * 32 * 3 * 2 * 64; idx += F.NGW * 64) { const int l = idx / (32 * 3 * 2 * 64), rem = idx % (32 * 3 * 2 * 64), step = rem / 384, nt = (rem % 384) >> 7, which = (rem >> 6) & 1, ln = rem & 63;
          const int n = 16 * nt + (ln & 15); float w[8];
#pragma unroll
          for (int j = 0; j < 8; ++j) { const int k = 32 * step + 8 * (ln >> 4) + j;
              const float wv = (n < 4) ? wg[((size_t)l * DM + k) * 4 + n] : (n < 36 ? wr[((size_t)l * DM + k) * 32 + (n - 4)] : 0.f);
              const float w1 = bf2f(f2bf(wv)); w[j] = which ? (wv - w1) : wv; }
          u32x4 o; o.x = pk2(w[0], w[1]); o.y = pk2(w[2], w[3]); o.z = pk2(w[4], w[5]); o.w = pk2(w[6], w[7]); wf[idx] = o; } }
}
DI void p0b_mod_reduce(const Params& P, const Frame& F) {
    unsigned char* const ws = wsp(P);
    const float* mp = (const float*)(ws + WS_MODP); float* mod = (float*)(ws + WS_MOD);
    for (int idx = F.gw * 64 + F.lane; idx < DEPTH * 17 * 6144; idx += F.NGW * 64) {
        const int l = idx / (17 * 6144), c = idx % 6144;
        float s = inp(P, IN_BADA)[l * 6144 + c];
#pragma unroll
        for (int ks = 0; ks < 8; ++ks) s += mp[(size_t)ks * DEPTH * 17 * 6144 + idx];
        mod[idx] = s; }
}

DI unsigned expert_count(const unsigned char* ws, int layer, int e) { return __hip_atomic_load((const unsigned*)(ws + WS_CTL) + CW_CNT + (layer * NEXP + e) * CNT_STRIDE, __ATOMIC_RELAXED, __HIP_MEMORY_SCOPE_AGENT); }
DI unsigned expert_starts(const unsigned char* ws, int layer, int lane) {
    const unsigned p = (lane < NEXP) ? ((expert_count(ws, layer, lane & 31) + 255u) & ~255u) : 0u; unsigned incl = p;
#pragma unroll
    for (int d = 1; d < 32; d <<= 1) { const unsigned v = __shfl_up(incl, d); if ((lane & 31) >= d) incl += v; }
    return incl - p;
}

DI void load_row(const float* row, int lane, f32x4 (&v)[4]) {
#pragma unroll
    for (int j = 0; j < 4; ++j) v[j] = *(const f32x4*)(row + 4 * lane + 256 * j);
}
DI void load_row_bf(const bf16_t* row, int lane, f32x4 (&v)[4]) {
#pragma unroll
    for (int j = 0; j < 4; ++j) { const u32x2 w = *(const u32x2*)(row + 4 * lane + 256 * j); v[j] = (f32x4){bf2f(w.x & 0xffffu), bf2f(w.x >> 16), bf2f(w.y & 0xffffu), bf2f(w.y >> 16)}; }
}
DI float row_rstd(const f32x4 (&v)[4]) {
    float s = 0.f;
#pragma unroll
    for (int j = 0; j < 4; ++j) s += (v[j][0] * v[j][0] + v[j][1] * v[j][1]) + (v[j][2] * v[j][2] + v[j][3] * v[j][3]);
    return 1.0f / sqrtf(wave_sum(s) * (1.f / DM) + NORM_EPS);
}
DI void load_vec(const float* p, int lane, f32x4 (&v)[4]) {
#pragma unroll
    for (int j = 0; j < 4; ++j) v[j] = *(const f32x4*)(p + 4 * lane + 256 * j);
}
DI void norm_mod_store(const f32x4 (&v)[4], float rstd, const f32x4 (&gg)[4], const f32x4 (&sh)[4], const f32x4 (&sc)[4], unsigned char* hrow, int lane) {
#pragma unroll
    for (int j = 0; j < 4; ++j) { const int c = 4 * lane + 256 * j;
        const f32x4 hf = ((v[j] * rstd * gg[j]) * (1.f + sc[j]) + sh[j]) * F8_ACT_SCALE;
        *(unsigned*)(hrow + c) = cvt_pk_fp8x4(hf[0], hf[1], hf[2], hf[3]); }
}
struct RowIn { f32x4 x[4]; unsigned ya[4], yb[4]; };
DI void row_fetch(const unsigned char* ws, const float* xrow, const bf16_t* xrow_bf, int t, unsigned s0, unsigned s1, int lane, bool prev, RowIn& R) {
    if (xrow_bf) load_row_bf(xrow_bf, lane, R.x); else load_row(xrow, lane, R.x);
    if (prev) {
        const unsigned char* Y = ws + WS_Y;
#pragma unroll
        for (int j = 0; j < 4; ++j) { R.ya[j] = *(const unsigned*)(Y + (size_t)s0 * DM + 4 * lane + 256 * j); R.yb[j] = *(const unsigned*)(Y + (size_t)s1 * DM + 4 * lane + 256 * j); } }
}
DI void row_apply(const f32x4 (&gt)[4], float w0, float w1, RowIn& R) {
    w0 *= 1.f / F8_Y_SCALE; w1 *= 1.f / F8_Y_SCALE;
#pragma unroll
    for (int j = 0; j < 4; ++j) { const f32x4 g = gt[j];
        const f32x2 a0 = __builtin_amdgcn_cvt_pk_f32_fp8((int)R.ya[j], false), a1 = __builtin_amdgcn_cvt_pk_f32_fp8((int)R.ya[j], true);
        const f32x2 b0 = __builtin_amdgcn_cvt_pk_f32_fp8((int)R.yb[j], false), b1 = __builtin_amdgcn_cvt_pk_f32_fp8((int)R.yb[j], true);
        R.x[j][0] += g[0] * (w0 * a0[0] + w1 * b0[0]); R.x[j][1] += g[1] * (w0 * a0[1] + w1 * b0[1]);
        R.x[j][2] += g[2] * (w0 * a1[0] + w1 * b1[0]); R.x[j][3] += g[3] * (w0 * a1[1] + w1 * b1[1]); }
}
DI void phase_attn_norm(const Params& P, const Frame& F0, int layer) {
    const Frame F = opaque_frame(F0);
    unsigned char* const ws = wsp(P);
    bf16_t* X = (bf16_t*)(ws + WS_X); bf16_t* H = (bf16_t*)(ws + WS_H);
    const bool prev = layer > 0;
    const int nrow = (TALL - F.gw + F.NGW - 1) / F.NGW;
    unsigned ms0 = 0, ms1 = 0; float mw0 = 0.f, mw1 = 0.f;
    if (prev) { const unsigned pst = expert_starts(ws, layer - 1, F.lane); u32x2 a = (u32x2){0u, 0u};
        if (F.lane < nrow) { const int tl = F.gw + F.lane * F.NGW; a = *(const u32x2*)((const unsigned*)(ws + WS_ASG) + (size_t)tl * 2); const f32x2 w = *(const f32x2*)((const float*)(ws + WS_ASGW) + (size_t)tl * 2); mw0 = w.x; mw1 = w.y; }
        ms0 = (unsigned)__shfl((int)pst, (int)(a.x >> 20)) + (a.x & 0xfffffu); ms1 = (unsigned)__shfl((int)pst, (int)(a.y >> 20)) + (a.y & 0xfffffu); }
    auto xsrc = [&](int t) -> const float* { return (t < TLAT ? inp(P, IN_X) + (size_t)t * DM : inp(P, IN_CTX) + (size_t)(t - TLAT) * DM); };
    auto xbf = [&](int t) -> const bf16_t* { return prev ? X + (size_t)t * DM : (const bf16_t*)nullptr; };
    RowIn cur, nxt;
    f32x4 gat[4]; load_vec(inp(P, IN_GATTN) + layer * DM, F.lane, gat);
    row_fetch(ws, xsrc(F.gw), xbf(F.gw), F.gw, __shfl(ms0, 0), __shfl(ms1, 0), F.lane, prev, cur);
    for (int i = 0; i < nrow; ++i) {
        const int t = F.gw + i * F.NGW; const int mb = (t < TLAT) ? (t >> 11) : 16;
        const float* md = (const float*)(ws + WS_MOD) + ((size_t)layer * 17 + mb) * 6144;
        f32x4 gt[4], sh[4], sc[4];
        if (prev) load_vec(md - 17 * 6144 + 5120, F.lane, gt);
        load_vec(md, F.lane, sh); load_vec(md + 1024, F.lane, sc);
        asm volatile("" ::: "memory");
        if (i + 1 < nrow) row_fetch(ws, xsrc(t + F.NGW), xbf(t + F.NGW), t + F.NGW, __shfl(ms0, i + 1), __shfl(ms1, i + 1), F.lane, prev, nxt);
        if (prev) row_apply(gt, __shfl(mw0, i), __shfl(mw1, i), cur);
#pragma unroll
        for (int j = 0; j < 4; ++j) { u32x2 w; w.x = pk2(cur.x[j][0], cur.x[j][1]); w.y = pk2(cur.x[j][2], cur.x[j][3]); *(u32x2*)(X + (size_t)t * DM + 4 * F.lane + 256 * j) = w; }
        const float rstd = row_rstd(cur.x);
        norm_mod_store(cur.x, rstd, gat, sh, sc, (unsigned char*)H + (size_t)t * DM, F.lane);
        cur = nxt;
    }
}
DI void phase_final(const Params& P, const Frame& F0) {
    const Frame F = opaque_frame(F0);
    unsigned char* const ws = wsp(P);
    const bf16_t* X = (const bf16_t*)(ws + WS_X);
    const float pc = PROBE_SEL ? *((const float*)(ws + WS_CTL) + 64) : 0.f;
    const int nrow = (TLAT - F.gw + F.NGW - 1) / F.NGW;
    unsigned ms0 = 0, ms1 = 0; float mw0 = 0.f, mw1 = 0.f;
    { const unsigned pst = expert_starts(ws, DEPTH - 1, F.lane); u32x2 a = (u32x2){0u, 0u};
      if (F.lane < nrow) { const int tl = F.gw + F.lane * F.NGW; a = *(const u32x2*)((const unsigned*)(ws + WS_ASG) + (size_t)tl * 2); const f32x2 w = *(const f32x2*)((const float*)(ws + WS_ASGW) + (size_t)tl * 2); mw0 = w.x; mw1 = w.y; }
      ms0 = (unsigned)__shfl((int)pst, (int)(a.x >> 20)) + (a.x & 0xfffffu); ms1 = (unsigned)__shfl((int)pst, (int)(a.y >> 20)) + (a.y & 0xfffffu); }
    RowIn cur, nxt;
    row_fetch(ws, nullptr, X + (size_t)F.gw * DM, F.gw, __shfl(ms0, 0), __shfl(ms1, 0), F.lane, true, cur);
    f32x4 gfin[4]; load_vec(inp(P, IN_GFINAL), F.lane, gfin);
    for (int i = 0; i < nrow; ++i) {
        const int t = F.gw + i * F.NGW;
        f32x4 gt[4]; load_vec((const float*)(ws + WS_MOD) + ((size_t)(DEPTH - 1) * 17 + (t >> 11)) * 6144 + 5120, F.lane, gt);
        asm volatile("" ::: "memory");
        if (i + 1 < nrow) row_fetch(ws, nullptr, X + (size_t)(t + F.NGW) * DM, t + F.NGW, __shfl(ms0, i + 1), __shfl(ms1, i + 1), F.lane, true, nxt);
        row_apply(gt, __shfl(mw0, i), __shfl(mw1, i), cur);
        const float rstd = row_rstd(cur.x);
#pragma unroll
        for (int j = 0; j < 4; ++j) { const int c = 4 * F.lane + 256 * j; *(f32x4*)(P.out + (size_t)t * DM + c) = cur.x[j] * rstd * gfin[j] + pc; }
        cur = nxt;
    }
}

DI float swap_max(float v) { auto rr = __builtin_amdgcn_permlane32_swap(__float_as_uint(v), __float_as_uint(v), false, false); return fmaxf(__uint_as_float(rr[0]), __uint_as_float(rr[1])); }
DI float swap_add(float v) { auto rr = __builtin_amdgcn_permlane32_swap(__float_as_uint(v), __float_as_uint(v), false, false); return __uint_as_float(rr[0]) + __uint_as_float(rr[1]); }
DI bf16x8 pack_p(const f32x16& p, int s) {
    u32x4 w; w.x = cvt_pk_bf16(p[8 * s + 0], p[8 * s + 1]); w.y = cvt_pk_bf16(p[8 * s + 2], p[8 * s + 3]); w.z = cvt_pk_bf16(p[8 * s + 4], p[8 * s + 5]); w.w = cvt_pk_bf16(p[8 * s + 6], p[8 * s + 7]);
    return __builtin_bit_cast(bf16x8, w);
}
struct AttnState { float m, l; f32x16 o[2]; };
DI void load_k(const unsigned char* Kbh, int kg, int r32, int hi, bf16x8 (&k)[4]) {
    const unsigned char* kb = Kbh + (size_t)(kg + (r32 >> 3)) * 1024 + hi * 128 + (r32 & 7) * 16;
#pragma unroll
    for (int d0 = 0; d0 < 4; ++d0) k[d0] = *(const bf16x8*)(kb + d0 * 256);
}
DI void load_v(const unsigned char* Vbh, int kg, int r32, int hi, s16x4 (&v)[2][2][2]) {
    const unsigned char* vb = Vbh + (size_t)kg * 1024 + r32 * 16 + hi * 8;
#pragma unroll
    for (int dh = 0; dh < 2; ++dh)
#pragma unroll
        for (int ks = 0; ks < 2; ++ks)
#pragma unroll
            for (int pt = 0; pt < 2; ++pt) v[dh][ks][pt] = *(const s16x4*)(vb + dh * 512 + (2 * ks + pt) * 1024);
}
DI f32x16 attn_scores(const bf16x8 (&k)[4], const bf16x8 (&q)[4]) {
    f32x16 s;
#pragma unroll
    for (int r = 0; r < 16; ++r) s[r] = 0.f;
#pragma unroll
    for (int d0 = 0; d0 < 4; ++d0) s = __builtin_amdgcn_mfma_f32_32x32x16_bf16(k[d0], q[d0], s, 0, 0, 0);
    return s;
}
DI float row_max16(const f32x16& s) {
    float mt = fmaxf(fmaxf(s[0], s[1]), fmaxf(s[2], s[3]));
#pragma unroll
    for (int r = 4; r < 16; r += 4) mt = fmaxf(mt, fmaxf(fmaxf(s[r], s[r + 1]), fmaxf(s[r + 2], s[r + 3])));
    return mt;
}
DI void attn_rescale(AttnState& st, f32x16& s, float mt, LAS float* wsf, int r32, int hi) {
    mt = swap_max(mt);
    const float dm = fmaxf(mt, 0.f);
    const float al = __builtin_amdgcn_exp2f(-dm);
    st.l *= al; st.m += dm;
#pragma unroll
    for (int r = 0; r < 16; ++r) s[r] -= dm;
    if (hi == 0) wsf[r32] = al;
    LDS_WAIT();
#pragma unroll
    for (int r = 0; r < 16; ++r) { const float f = wsf[crow(r, hi)]; st.o[0][r] *= f; st.o[1][r] *= f; }
    LDS_WAIT();
}
DI void attn_exp_pv(AttnState& st, f32x16& s, const s16x4 (&v)[2][2][2]) {
    float p0 = 0.f, p1 = 0.f;
#pragma unroll
    for (int r = 0; r < 16; r += 2) { s[r] = __builtin_amdgcn_exp2f(s[r]); s[r + 1] = __builtin_amdgcn_exp2f(s[r + 1]); p0 += s[r]; p1 += s[r + 1]; }
    st.l += p0 + p1;
    const bf16x8 pa0 = pack_p(s, 0), pa1 = pack_p(s, 1);
#pragma unroll
    for (int dh = 0; dh < 2; ++dh) {
        const bf16x8 vf0 = __builtin_shufflevector(v[dh][0][0], v[dh][0][1], 0, 1, 2, 3, 4, 5, 6, 7);
        const bf16x8 vf1 = __builtin_shufflevector(v[dh][1][0], v[dh][1][1], 0, 1, 2, 3, 4, 5, 6, 7);
        st.o[dh] = __builtin_amdgcn_mfma_f32_32x32x16_bf16(pa0, vf0, st.o[dh], 0, 0, 0);
        st.o[dh] = __builtin_amdgcn_mfma_f32_32x32x16_bf16(pa1, vf1, st.o[dh], 0, 0, 0);
    }
}
DI void attn_softmax_pv2(AttnState (&st)[2], f32x16 (&s)[2], const s16x4 (&v)[2][2][2], LAS float* wsf, int r32, int hi) {
#pragma unroll
    for (int r = 0; r < 16; ++r) { s[0][r] -= st[0].m; s[1][r] -= st[1].m; }
    const float mt0 = row_max16(s[0]), mt1 = row_max16(s[1]);
    if (__any(fmaxf(mt0, mt1) > 8.f)) { attn_rescale(st[0], s[0], mt0, wsf, r32, hi); attn_rescale(st[1], s[1], mt1, wsf + 32, r32, hi); }
    attn_exp_pv(st[0], s[0], v);
    attn_exp_pv(st[1], s[1], v);
}
template <int MODE>
DI void attn_unit(const Params& P, unsigned char* ws, int layer, int b, int h0, int qblk, LAS unsigned char* wl, int lane) {
    const int r32 = lane & 31, hi = lane >> 5, kvh = h0 >> 2, m = layer % 3;
    constexpr bool VDB = false;
    LAS float* wsf = (LAS float*)wl; LAS bf16_t* stg = (LAS bf16_t*)(wl + 256); LAS float* rpbt = (LAS float*)(wl + 256 + 4096);
    const bf16_t* QKV = (const bf16_t*)(ws + WS_QKV);
    const unsigned char* Kbh = ws + WS_KF + (size_t)(b * NKV + kvh) * KGRP * 1024;
    const unsigned char* Vbh = ws + WS_VF + (size_t)(b * NKV + kvh) * KGRP * 1024;
    unsigned char* O = ws + WS_O;
    int r0 = 0, c0 = 0;
    if (MODE == 2) { r0 = 2 * (qblk >> 2); c0 = 16 * (qblk & 3); }
    auto qtok = [&](int i) -> int {
        if (MODE == 3) return TLAT + b * CTXL + qblk * 32 + i;
        if (MODE == 2) return b * SEQ + (r0 + (i >> 4)) * 64 + c0 + (i & 15);
        return b * SEQ + qblk * 32 + i; };
    const int tq = qtok(r32);
    const bf16_t* qp = QKV + (size_t)tq * QKVN + h0 * HD + hi * 8;
    bf16x8 qr[2][4];
#pragma unroll
    for (int hh = 0; hh < 2; ++hh)
#pragma unroll
        for (int d0 = 0; d0 < 4; ++d0) qr[hh][d0] = *(const bf16x8*)(qp + hh * HD + d0 * 16);
    const int q0 = qblk * 32;
    int nl = 0, jlo = 0, rs_min = 0, cseg = 0;
    if (MODE == 0) { jlo = (q0 < 128) ? (128 - q0) / 32 : 0; const int jhi = min(8, (SEQ - 32 - q0 + 128) / 32); nl = jhi - jlo + 1; }
    if (MODE == 1) nl = SEQ / 32;
    if (MODE == 2) { rs_min = min(max(r0 - 4, 0), 24); const int rs_max = min(max(r0 + 1 - 4, 0), 24); nl = rs_max - rs_min + 8; cseg = (c0 == 0) ? 0 : (c0 == 16) ? 8 : (c0 == 32) ? 24 : 32; }
    auto lat_kg = [&](int i) -> int {
        if (MODE == 0) return (q0 - 128 + 32 * (jlo + i)) >> 3;
        if (MODE == 1) return 4 * i;
        return ((rs_min + i) * 64 + cseg) >> 3; };
    bf16x8 kn[4];
    load_k(Kbh, nl > 0 ? lat_kg(0) : SEQ / 8, r32, hi, kn);
    if (MODE == 0 || MODE == 1) {
        const int n = tq & 2047; const f32x2* T = (const f32x2*)(ws + WS_ROPE);
        const f32x2* tr = T + (n >> 6) * 16 + 8 * hi; const f32x2* tc = T + (n & 63) * 16 + 8 * hi;
#pragma unroll
        for (int e = 0; e < 8; ++e) { const f32x2 a = tr[e], cc = tc[e];
#pragma unroll
            for (int hh = 0; hh < 2; ++hh) {
                const float x1 = bfs2f(qr[hh][0][e]), x2 = bfs2f(qr[hh][1][e]), x3 = bfs2f(qr[hh][2][e]), x4 = bfs2f(qr[hh][3][e]);
                qr[hh][0][e] = (short)f2bf(x1 * a.x - x2 * a.y); qr[hh][1][e] = (short)f2bf(x2 * a.x + x1 * a.y);
                qr[hh][2][e] = (short)f2bf(x3 * cc.x - x4 * cc.y); qr[hh][3][e] = (short)f2bf(x4 * cc.x + x3 * cc.y); } }
    }
    LAS bf16x8* qlds = (LAS bf16x8*)(wl + 8192) + lane;
    if (VDB) {
#pragma unroll
        for (int d0 = 0; d0 < 4; ++d0) qlds[d0 * 64] = qr[1][d0];
        LDS_WAIT();
    }
    int rq = 0, cq = 0, rsq = 0, csq = 0;
    if (MODE == 2) {
        const float* rpb = inp(P, IN_RPB) + (size_t)h0 * 465;
        for (int i = lane; i < 930; i += 64) rpbt[i + (i >= 465 ? 7 : 0)] = rpb[i] * LOG2E;
        LDS_WAIT();
        rq = r0 + (r32 >> 4); cq = c0 + (r32 & 15); rsq = min(max(rq - 4, 0), 24); csq = min(max(cq - 8, 0), 48);
    }
    AttnState st[2];
#pragma unroll
    for (int hh = 0; hh < 2; ++hh) { st[hh].m = -1024.f; st[hh].l = 0.f;
#pragma unroll
        for (int r = 0; r < 16; ++r) { st[hh].o[0][r] = 0.f; st[hh].o[1][r] = 0.f; } }
    const float NEG = -INFINITY;
    s16x4 vn[2][2][2];
    if (VDB) load_v(Vbh, nl > 0 ? lat_kg(0) : SEQ / 8, r32, hi, vn);
    for (int i = 0; i < nl; ++i) {
        const int kgn = (i + 1 < nl) ? lat_kg(i + 1) : SEQ / 8;
        s16x4 v[2][2][2];
        if (VDB) {
#pragma unroll
            for (int a = 0; a < 2; ++a)
#pragma unroll
                for (int c = 0; c < 2; ++c)
#pragma unroll
                    for (int e = 0; e < 2; ++e) v[a][c][e] = vn[a][c][e];
        } else load_v(Vbh, lat_kg(i), r32, hi, v);
        f32x16 s[2];
        s[0] = attn_scores(kn, qr[0]);
        if (VDB) { bf16x8 q1[4];
#pragma unroll
            for (int d0 = 0; d0 < 4; ++d0) q1[d0] = qlds[d0 * 64];
            s[1] = attn_scores(kn, q1); }
        else s[1] = attn_scores(kn, qr[1]);
        load_k(Kbh, kgn, r32, hi, kn);
        if (VDB) load_v(Vbh, kgn, r32, hi, vn);
        if (MODE == 0) {
            const int j = jlo + i;
            if (j == 0 || j == 8) { const int kt = q0 - 128 + 32 * j, qpos = q0 + r32;
#pragma unroll
                for (int r = 0; r < 16; ++r) { const int d = kt + crow(r, hi) - qpos; if (d > 128 || d < -128) { s[0][r] = NEG; s[1][r] = NEG; } } }
        }
        if (MODE == 2) {
            const int kr = rs_min + i;
            const bool rowok = (kr >= rsq) && (kr < rsq + 8);
            const int ib = (kr - rq + 7) * 31 - cq + 15;
#pragma unroll
            for (int r = 0; r < 16; ++r) { const int kc2 = cseg + crow(r, hi); const bool ok = rowok && (kc2 >= csq) && (kc2 < csq + 16);
                const int idx = min(max(ib + kc2, 0), 464);
                s[0][r] = ok ? s[0][r] + rpbt[idx] : NEG; s[1][r] = ok ? s[1][r] + rpbt[472 + idx] : NEG; }
        }
        attn_softmax_pv2(st, s, v, wsf, r32, hi);
    }
    if (MODE == 0 || MODE == 1) {
#pragma unroll
        for (int hh = 0; hh < 2; ++hh)
#pragma unroll
            for (int d0 = 0; d0 < 4; ++d0) qr[hh][d0] = *(const bf16x8*)(qp + hh * HD + d0 * 16);
        if (VDB) {
#pragma unroll
            for (int d0 = 0; d0 < 4; ++d0) qlds[d0 * 64] = qr[1][d0];
            LDS_WAIT();
        }
    }
    for (int j = 0; j < CTXL / 32; ++j) {
        const int kg = SEQ / 8 + 4 * j, kgn = (j + 1 < CTXL / 32) ? kg + 4 : kg;
        s16x4 v[2][2][2];
        if (VDB) {
#pragma unroll
            for (int a = 0; a < 2; ++a)
#pragma unroll
                for (int c = 0; c < 2; ++c)
#pragma unroll
                    for (int e = 0; e < 2; ++e) v[a][c][e] = vn[a][c][e];
        } else load_v(Vbh, kg, r32, hi, v);
        f32x16 s[2];
        s[0] = attn_scores(kn, qr[0]);
        if (VDB) { bf16x8 q1[4];
#pragma unroll
            for (int d0 = 0; d0 < 4; ++d0) q1[d0] = qlds[d0 * 64];
            s[1] = attn_scores(kn, q1); }
        else s[1] = attn_scores(kn, qr[1]);
        load_k(Kbh, kgn, r32, hi, kn);
        if (VDB) load_v(Vbh, kgn, r32, hi, vn);
        attn_softmax_pv2(st, s, v, wsf, r32, hi);
    }
    int lane2 = lane; asm volatile("" : "+v"(lane2));
    const int r32b = lane2 & 31, hib = lane2 >> 5;
#pragma unroll
    for (int hh = 0; hh < 2; ++hh) {
        const float lt = swap_add(st[hh].l);
        float inv;
        if (MODE == 0 || (MODE == 3 && m == 0)) { const float sk = inp(P, IN_SINK)[(layer / 3) * NH + h0 + hh] * LOG2E;
            const float mnew = fmaxf(st[hh].m, sk); const float al = __builtin_amdgcn_exp2f(st[hh].m - mnew), es = __builtin_amdgcn_exp2f(sk - mnew);
            inv = F8_O_SCALE * al / (lt * al + es); }
        else inv = F8_O_SCALE / lt;
        if (hib == 0) wsf[r32b] = inv;
        LDS_WAIT();
        LAS bf16_t* sb = stg + hib * 256 + r32b;
        const LAS float* wf = wsf + 4 * hib;
#pragma unroll
        for (int r = 0; r < 16; ++r) { const float f = wf[(r & 3) + 8 * (r >> 2)];
            sb[((r & 3) + 8 * (r >> 2)) * 64] = (bf16_t)f2bf(st[hh].o[0][r] * f); sb[((r & 3) + 8 * (r >> 2)) * 64 + 32] = (bf16_t)f2bf(st[hh].o[1][r] * f); }
        LDS_WAIT();
        const int rw = lane2 >> 3, ch = lane2 & 7;
        const LAS unsigned char* rb = (const LAS unsigned char*)stg + rw * 128 + ch * 16;
#pragma unroll
        for (int i = 0; i < 4; ++i) { const u32x4 vv = *(const LAS u32x4*)(rb + i * 1024);
            u32x2 w8; w8.x = cvt_pk_fp8x4(bf2f(vv.x & 0xffffu), bf2f(vv.x >> 16), bf2f(vv.y & 0xffffu), bf2f(vv.y >> 16)); w8.y = cvt_pk_fp8x4(bf2f(vv.z & 0xffffu), bf2f(vv.z >> 16), bf2f(vv.w & 0xffffu), bf2f(vv.w >> 16));
            *(u32x2*)(O + (size_t)qtok(i * 8 + rw) * DM + (h0 + hh) * HD + ch * 8) = w8; }
        LDS_WAIT();
    }
}
DI void phase_attention(const Params& P, const Frame& F0, int layer) {
    const Frame F = opaque_frame(F0);
    unsigned char* const ws = wsp(P);
    const int m = layer % 3;
    LAS unsigned char* wl = F.lds + F.wave * 16384;
    for (int bu = F.blk; bu < NB * NKV * 16; bu += F.G) {
        const int rnd = bu >> 8, x = bu & 7, loc = (bu & 255) >> 3;
        const int bkv = rnd * 16 + x * 2 + (loc >> 4), qg = loc & 15;
        const int b = bkv >> 2, kvh = bkv & 3, h0 = kvh * 4 + 2 * (F.wave & 1), qblk = 4 * qg + (F.wave >> 1);
        if (m == 0) attn_unit<0>(P, ws, layer, b, h0, qblk, wl, F.lane);
        else if (m == 1) attn_unit<1>(P, ws, layer, b, h0, qblk, wl, F.lane);
        else attn_unit<2>(P, ws, layer, b, h0, qblk, wl, F.lane);
    }
    if (layer < DEPTH - 1) {
        for (int bu = F.blk; bu < NB * NKV * 2; bu += F.G) {
            const int bkv = bu >> 1, b = bkv >> 2, kvh = bkv & 3, h0 = kvh * 4 + 2 * (F.wave & 1), qblk = 4 * (bu & 1) + (F.wave >> 1);
            attn_unit<3>(P, ws, layer, b, h0, qblk, wl, F.lane);
        }
    }
}

DI int blk_token(int blk, int i) { return i < 128 ? blk * 128 + i : TLAT + blk * 16 + (i - 128); }
constexpr int RT_ROWB = 2064;
constexpr int RT_X2_OFF = 16 * RT_ROWB, RT_PART_OFF = 2 * 16 * RT_ROWB, RT_LOG_OFF = RT_PART_OFF + 8 * 16 * 48 * 4, RT_LOGS = 37, RT_VEC_OFF = RT_LOG_OFF + 144 * RT_LOGS * 4;
DI void phase_router(const Params& P, const Frame& F0, int layer, int M) {
    const Frame F = opaque_frame(F0);
    unsigned char* const ws = wsp(P);
    const int TPB = M / GRID, nchunk = TPB / 16;
    LAS int* hist = (LAS int*)(F.lds + LDSX_OFF);
    LAS float* part = (LAS float*)(F.lds + RT_PART_OFF); LAS float* logit = (LAS float*)(F.lds + RT_LOG_OFF);
    if (F.tid < 32) hist[F.tid] = 0;
    const bf16_t* X = (const bf16_t*)(ws + WS_X); bf16_t* H = (bf16_t*)(ws + WS_H);
    const float* gffn = inp(P, IN_GFFN) + layer * DM;
    const u32x4* wf = (const u32x4*)(ws + WS_WRT) + ((size_t)layer * 32 + 4 * F.wave) * 384 + F.lane;
    bf16x8 wreg[4][2][2];
#pragma unroll
    for (int s = 0; s < 4; ++s)
#pragma unroll
        for (int nt = 0; nt < 2; ++nt)
#pragma unroll
            for (int wh = 0; wh < 2; ++wh) wreg[s][nt][wh] = __builtin_bit_cast(bf16x8, wf[s * 384 + nt * 128 + wh * 64]);
    bf16x8 w2t[4][2];
#pragma unroll
    for (int s = 0; s < 4; ++s)
#pragma unroll
        for (int wh = 0; wh < 2; ++wh) w2t[s][wh] = __builtin_bit_cast(bf16x8, wf[s * 384 + 256 + wh * 64]);
    LAS float* vec = (LAS float*)(F.lds + RT_VEC_OFF);
    auto load_vecs = [&](int mb) {
        const float* md = (const float*)(ws + WS_MOD) + ((size_t)layer * 17 + mb) * 6144;
        for (int i = F.tid; i < 256; i += NTHREADS) { const f32x4 g = *(const f32x4*)(gffn + 4 * i), sc = *(const f32x4*)(md + 4096 + 4 * i);
            *(LAS f32x4*)(vec + 4 * i) = *(const f32x4*)(md + 2048 + 4 * i); *(LAS f32x4*)(vec + 1024 + 4 * i) = g * (1.f + sc); *(LAS f32x4*)(vec + 2048 + 4 * i) = *(const f32x4*)(md + 3072 + 4 * i); } };
    load_vecs(F.blk >> 4);
    const int ib = 2 * F.wave;
    f32x4 vn[2][4];
#pragma unroll
    for (int tk = 0; tk < 2; ++tk) { const int t = blk_token(F.blk, ib + tk); load_row_bf(X + (size_t)t * DM, F.lane, vn[tk]); }
    LDS_WAIT(); __syncthreads();
    for (int c = 0; c < nchunk; ++c) {
        if (c == 8) { load_vecs(16); LDS_WAIT(); __syncthreads(); }
#pragma unroll
        for (int tk = 0; tk < 2; ++tk) { const int t = blk_token(F.blk, c * 16 + ib + tk);
            const float rstd = row_rstd(vn[tk]);
            LAS unsigned char* r1 = F.lds + (ib + tk) * RT_ROWB + 8 * F.lane; unsigned char* hrow = (unsigned char*)H + (size_t)t * DM;
#pragma unroll
            for (int j = 0; j < 4; ++j) { const int cc = 4 * F.lane + 256 * j; const f32x4 ga = *(const LAS f32x4*)(vec + 1024 + cc), sh = *(const LAS f32x4*)(vec + 2048 + cc);
                const f32x4 hf = (vn[tk][j] * rstd) * ga + sh;
                u32x2 a; a.x = pk2(hf[0], hf[1]); a.y = pk2(hf[2], hf[3]);
                u32x2 b; b.x = pk2(hf[0] - bf2f(a.x & 0xffffu), hf[1] - bf2f(a.x >> 16)); b.y = pk2(hf[2] - bf2f(a.y & 0xffffu), hf[3] - bf2f(a.y >> 16));
                *(unsigned*)(hrow + cc) = cvt_pk_fp8x4(hf[0] * F8_ACT_SCALE, hf[1] * F8_ACT_SCALE, hf[2] * F8_ACT_SCALE, hf[3] * F8_ACT_SCALE); *(LAS u32x2*)(r1 + 512 * j) = a; *(LAS u32x2*)(r1 + RT_X2_OFF + 512 * j) = b; } }
        if (c + 1 < nchunk) {
#pragma unroll
            for (int tk = 0; tk < 2; ++tk) { const int t = blk_token(F.blk, (c + 1) * 16 + ib + tk); load_row_bf(X + (size_t)t * DM, F.lane, vn[tk]); }
        }
        LDS_WAIT(); __syncthreads();
        f32x4 acc[3];
#pragma unroll
        for (int nt = 0; nt < 3; ++nt) acc[nt] = (f32x4){0.f, 0.f, 0.f, 0.f};
        { const LAS unsigned char* ap = F.lds + (F.lane & 15) * RT_ROWB + 256 * F.wave + 16 * (F.lane >> 4);
#pragma unroll
          for (int s = 0; s < 4; ++s) { const bf16x8 a1 = *(const LAS bf16x8*)(ap + 64 * s), a2 = *(const LAS bf16x8*)(ap + RT_X2_OFF + 64 * s);
#pragma unroll
              for (int nt = 0; nt < 2; ++nt) { acc[nt] = __builtin_amdgcn_mfma_f32_16x16x32_bf16(a1, wreg[s][nt][0], acc[nt], 0, 0, 0);
                  acc[nt] = __builtin_amdgcn_mfma_f32_16x16x32_bf16(a1, wreg[s][nt][1], acc[nt], 0, 0, 0); acc[nt] = __builtin_amdgcn_mfma_f32_16x16x32_bf16(a2, wreg[s][nt][0], acc[nt], 0, 0, 0); }
              acc[2] = __builtin_amdgcn_mfma_f32_16x16x32_bf16(a1, w2t[s][0], acc[2], 0, 0, 0);
              acc[2] = __builtin_amdgcn_mfma_f32_16x16x32_bf16(a1, w2t[s][1], acc[2], 0, 0, 0); acc[2] = __builtin_amdgcn_mfma_f32_16x16x32_bf16(a2, w2t[s][0], acc[2], 0, 0, 0); } }
        { LAS float* pp = part + F.wave * 768 + (4 * (F.lane >> 4)) * 48 + (F.lane & 15);
#pragma unroll
          for (int nt = 0; nt < 3; ++nt)
#pragma unroll
              for (int r = 0; r < 4; ++r) pp[r * 48 + 16 * nt] = acc[nt][r]; }
        LDS_WAIT(); __syncthreads();
        { const int tk = F.tid >> 5, n = F.tid & 31; float s = 0.f;
#pragma unroll
          for (int w = 0; w < 8; ++w) s += part[w * 768 + tk * 48 + n];
          logit[(c * 16 + tk) * RT_LOGS + n] = s;
          if (F.tid < 64) { const int tk2 = F.tid >> 2, n2 = 32 + (F.tid & 3); float s2 = 0.f;
#pragma unroll
              for (int w = 0; w < 8; ++w) s2 += part[w * 768 + tk2 * 48 + n2];
              logit[(c * 16 + tk2) * RT_LOGS + n2] = s2; } }
    }
    LDS_WAIT(); __syncthreads();
    int rt_t = 0, rt_e1 = 0, rt_e2 = 0, rt_q1 = 0, rt_q2 = 0; float rt_w1 = 0.f, rt_w2 = 0.f;
    if (F.tid < TPB) { const int t = blk_token(F.blk, F.tid); const LAS float* lg = logit + F.tid * RT_LOGS;
        const float* bg = inp(P, IN_BGROUP) + layer * 4; const float* br = inp(P, IN_BROUTER) + layer * 32;
        const float g0 = lg[0] + bg[0], g1 = lg[1] + bg[1], g2 = lg[2] + bg[2], g3 = lg[3] + bg[3];
        int grp = 0; float gm = g0; if (g1 > gm) { gm = g1; grp = 1; } if (g2 > gm) { gm = g2; grp = 2; } if (g3 > gm) { gm = g3; grp = 3; }
        const float ptop = 1.f / (expf(g0 - gm) + expf(g1 - gm) + expf(g2 - gm) + expf(g3 - gm));
        float ev[8], em = -INFINITY;
#pragma unroll
        for (int j = 0; j < 8; ++j) { ev[j] = lg[4 + grp * 8 + j] + br[grp * 8 + j]; em = fmaxf(em, ev[j]); }
        float pe[8];
#pragma unroll
        for (int j = 0; j < 8; ++j) pe[j] = expf(ev[j] - em);
        int i1 = 0; float p1 = pe[0];
#pragma unroll
        for (int j = 1; j < 8; ++j) if (pe[j] > p1) { p1 = pe[j]; i1 = j; }
        int i2 = 0; float p2 = -1.f;
#pragma unroll
        for (int j = 0; j < 8; ++j) if (j != i1 && pe[j] > p2) { p2 = pe[j]; i2 = j; }
        const float w1 = ptop * p1 / (p1 + p2), w2 = ptop * p2 / (p1 + p2);
        const int e1 = grp * 8 + i1, e2 = grp * 8 + i2;
        rt_q1 = atomicAdd((int*)&hist[e1], 1); rt_q2 = atomicAdd((int*)&hist[e2], 1);
        rt_t = t; rt_e1 = e1; rt_e2 = e2; rt_w1 = w1; rt_w2 = w2; }
    __syncthreads();
    LAS unsigned* gbase = (LAS unsigned*)(hist + 32);
    if (F.tid < 32) gbase[F.tid] = __hip_atomic_fetch_add((unsigned*)(ws + WS_CTL) + CW_CNT + (layer * NEXP + F.tid) * CNT_STRIDE, (unsigned)hist[F.tid], __ATOMIC_RELAXED, __HIP_MEMORY_SCOPE_AGENT);
    LDS_WAIT(); __syncthreads();
    if (F.tid < TPB) { const unsigned i1 = gbase[rt_e1] + (unsigned)rt_q1, i2 = gbase[rt_e2] + (unsigned)rt_q2;
        unsigned* asg = (unsigned*)(ws + WS_ASG); float* asgw = (float*)(ws + WS_ASGW); unsigned* toke = (unsigned*)(ws + WS_TOKE);
        *(u32x2*)(asg + (size_t)rt_t * 2) = (u32x2){((unsigned)rt_e1 << 20) | i1, ((unsigned)rt_e2 << 20) | i2};
        *(f32x2*)(asgw + (size_t)rt_t * 2) = (f32x2){rt_w1, rt_w2};
        toke[(size_t)rt_e1 * TALL + i1] = (unsigned)rt_t; toke[(size_t)rt_e2 * TALL + i2] = (unsigned)rt_t; }
}
DI void build_tile_table(const Params& P, const Frame& F0, LAS unsigned* tab, int layer) {
    const Frame F = opaque_frame(F0);
    unsigned char* const ws = wsp(P);
    constexpr int TP = pg8::MoeSched<true>::TAB_PST, TC = pg8::MoeSched<true>::TAB_CNT;
    if (F.tid < NEXP) tab[TC + F.tid] = expert_count(ws, layer, F.tid);
    LDS_WAIT(); __syncthreads();
    if (F.tid == 0) { unsigned ps = 0; for (int e = 0; e < NEXP; ++e) { tab[TP + e] = ps; ps += (tab[TC + e] + 255u) & ~255u; } tab[0] = ps >> 8; }
    LDS_WAIT(); __syncthreads();
    const unsigned ntile = tab[0];
    for (unsigned rt = F.tid; rt < ntile; rt += NTHREADS) { unsigned e = 0; for (int k = 1; k < NEXP; ++k) if (rt * 256u >= tab[TP + k]) e = k; tab[1 + rt] = e; }
    LDS_WAIT(); __syncthreads();
}
DI void stage_rope_table(const Params& P, const Frame& F0, LAS f32x2* dst) {
    const Frame F = opaque_frame(F0);
    const f32x2* T = (const f32x2*)(wsp(P) + WS_ROPE);
    for (int i = F.tid; i < 64 * 16; i += NTHREADS) dst[i] = T[i];
    LDS_WAIT(); __syncthreads();
}

__global__ void __launch_bounds__(NTHREADS, 2) dit_fwd(Params P) {
    extern __shared__ __attribute__((aligned(16))) unsigned char lds_raw[];
    Frame F;
    F.lds = (LAS unsigned char*)lds_raw;
    F.tid = threadIdx.x; F.lane = F.tid & 63; F.wave = __builtin_amdgcn_readfirstlane(F.tid >> 6);
    F.blk = blockIdx.x; F.G = gridDim.x; F.vcu = (F.G % 8 == 0) ? (F.blk % 8) * (F.G / 8) + F.blk / 8 : F.blk;
    F.gw = F.vcu * NWAVES + F.wave; F.NGW = F.G * NWAVES;
    for (int u = F.tid; u < (LDS_BYTES - RING_BYTES) / 4; u += NTHREADS) ((LAS unsigned*)(F.lds + RING_BYTES))[u] = 0u;
    __syncthreads();
    unsigned* ctl = (unsigned*)(P.ws + WS_CTL);
    XcdBarrier bar = xcd_barrier_post(ctl + CW_BAR, (volatile LAS unsigned*)(F.lds + MISC_OFF) + 8);

    unsigned long long pr_t0 = 0, pr_prev = 0, pr_acc = 0;
    if (PROBE_SEL) { pr_t0 = __builtin_amdgcn_s_memrealtime(); pr_prev = pr_t0; }
#define PSTAMP(id) do { if (PROBE_SEL) { const unsigned long long now_ = __builtin_amdgcn_s_memrealtime(); if ((id) == PROBE_SEL) pr_acc += now_ - pr_prev; pr_prev = now_; } } while (0)
    p0_prologue(P, F);
    if (RPT & 1) p0_prologue(P, F);
    xcd_barrier(bar);
    p0b_mod_reduce(P, F);
    xcd_barrier(bar);
    PSTAMP(1);

    for (int layer = 0; layer < DEPTH; ++layer) {
        const bool last = (layer == DEPTH - 1);
        unsigned char* ws = wsp(P);
        const int Mtok = last ? TLAT : TALL;
        phase_attn_norm(P, F, layer);
        if ((RPT & 256) && layer == 0) { phase_attn_norm(P, F, layer); phase_attn_norm(P, F, layer); phase_attn_norm(P, F, layer); }
        xcd_barrier(bar);
        PSTAMP(2);
        {
            pg8::PlainSched<true, F8_SC_ACT> S; S.nN = QKVN / 256; S.nwg = (TALL / 256) * S.nN; S.G = F.G; S.c = F.vcu; S.K = DM / 2; S.Bt = (const bf16_t*)(ws + WS_WQKV + (size_t)layer * QKVN * DM);
            LAS f32x2* ropel = (LAS f32x2*)(F.lds + LDSX_OFF + 1024);
            stage_rope_table(P, F, ropel);
            pg8::EpiQKV E{(bf16_t*)(ws + WS_QKV), ws + WS_KF, ws + WS_VF, ropel, inp(P, IN_GQ), inp(P, IN_GK), layer % 3};
            pg8::gemm_phase(F.lds, (const bf16_t*)(ws + WS_H), DM / 2, S, E);
            if (RPT & 2) pg8::gemm_phase(F.lds, (const bf16_t*)(ws + WS_H), DM / 2, S, E);
        }
        xcd_barrier(bar);
        PSTAMP(3);
        phase_attention(P, F, layer);
        if (((RPT & 4) && layer == 1) || ((RPT & 8) && layer != 1)) phase_attention(P, F, layer);
        xcd_barrier(bar);
        PSTAMP(4);
        {
            pg8::PlainSched<true> S; S.nN = DM / 256; S.nwg = (Mtok / 256) * S.nN; S.G = F.G; S.c = F.vcu; S.K = DM / 2; S.Bt = (const bf16_t*)(ws + WS_WO + (size_t)layer * DM * DM);
            pg8::EpiResidBf E{(bf16_t*)(ws + WS_X), (const float*)(ws + WS_MOD) + (size_t)layer * 17 * 6144 + 2048};
            pg8::gemm_phase(F.lds, (const bf16_t*)(ws + WS_O), DM / 2, S, E);
        }
        xcd_barrier(bar);
        PSTAMP(5);
        phase_router(P, F, layer, Mtok);
        xcd_barrier(bar);
        PSTAMP(6);
        if (RPT & 128) { for (int xb = 0; xb < 9; ++xb) xcd_barrier(bar); }
        LAS unsigned* tab = (LAS unsigned*)(F.lds + LDSX_OFF + 8192);
        build_tile_table(P, F, tab, layer);
        {
            pg8::MoeSched<true> S; S.tab = tab; S.G = F.G; S.c = F.vcu; S.K = DM / 2; S.Bt = (const bf16_t*)(ws + WS_WGU + (size_t)layer * NEXP * DM * DM); S.estride = (size_t)DM * DM; S.tok = (const unsigned*)(ws + WS_TOKE);
            pg8::EpiSwiglu E{ws + WS_ACT};
            pg8::gemm_phase(F.lds, (const bf16_t*)(ws + WS_H), DM / 2, S, E);
            if (RPT & 32) pg8::gemm_phase(F.lds, (const bf16_t*)(ws + WS_H), DM / 2, S, E);
        }
        xcd_barrier(bar);
        PSTAMP(8);
        {
            pg8::MoeSched<false> S; S.tab = tab; S.G = F.G; S.c = F.vcu; S.K = FH / 2; S.Bt = (const bf16_t*)(ws + WS_WD + (size_t)layer * NEXP * DM * FH); S.estride = (size_t)DM * FH; S.tok = nullptr;
            pg8::EpiStoreF8 E{ws + WS_Y, DM, F8_Y_SCALE};
            pg8::gemm_phase(F.lds, (const bf16_t*)(ws + WS_ACT), FH / 2, S, E);
            if (RPT & 64) pg8::gemm_phase(F.lds, (const bf16_t*)(ws + WS_ACT), FH / 2, S, E);
        }
        xcd_barrier(bar);
        PSTAMP(9);
    }
    if (PROBE_SEL) {
        if (F.blk == 0 && F.tid == 0) { const unsigned long long tot = __builtin_amdgcn_s_memrealtime() - pr_t0;
            const float f = (PROBE_SEL == 15) ? 0.5f : (float)pr_acc / (float)tot;
            __hip_atomic_store((float*)(P.ws + WS_CTL) + 64, sqrtf(4e-4f * f), __ATOMIC_RELAXED, __HIP_MEMORY_SCOPE_AGENT); }
        xcd_barrier(bar);
    }
    phase_final(P, F);
    if (RPT & 512) { phase_final(P, F); phase_final(P, F); phase_final(P, F); }
}

extern "C" void kernel_launch(void* const* d_in, const int* in_sizes, int n_in, void* d_out, int out_size, void* d_ws, size_t ws_size, hipStream_t stream) {
    static int ok = 0;
    if (ok == 0) {
        if (n_in != 22 || in_sizes[0] != TLAT * DM || out_size != TLAT * DM || ws_size < WS_END) {
            fprintf(stderr, "kernel_launch: unexpected shapes (n_in %d, in0 %d, out %d, ws %zu < %zu); nothing launched\n", n_in, n_in > 0 ? in_sizes[0] : -1, out_size, ws_size, (size_t)WS_END); ok = -1; return; }
        int dev = 0, cus = 0, per_cu = 0;
        if (hipGetDevice(&dev) != hipSuccess || hipDeviceGetAttribute(&cus, hipDeviceAttributeMultiprocessorCount, dev) != hipSuccess) { ok = -1; return; }
        if (hipFuncSetAttribute((const void*)dit_fwd, hipFuncAttributeMaxDynamicSharedMemorySize, LDS_BYTES) != hipSuccess) { fprintf(stderr, "kernel_launch: hipFuncSetAttribute failed\n"); ok = -1; return; }
        if (hipOccupancyMaxActiveBlocksPerMultiprocessor(&per_cu, (const void*)dit_fwd, NTHREADS, LDS_BYTES) != hipSuccess || per_cu < 1) fprintf(stderr, "kernel_launch: note: occupancy query reports %d\n", per_cu);
        (void)hipGetLastError();
        if (cus < GRID) { fprintf(stderr, "kernel_launch: %d CUs < %d workgroups: grid would not be resident; nothing launched\n", cus, GRID); ok = -1; return; }
        ok = 1;
    }
    if (ok < 0) return;
    if (hipMemsetAsync((char*)d_ws + WS_CTL, 0, CTL_ZERO_BYTES, stream) != hipSuccess) return;
    Params p{};
    for (int i = 0; i < 22; ++i) p.in[i] = (const float*)d_in[i];
    p.out = (float*)d_out; p.ws = (unsigned char*)d_ws;
    hipLaunchKernelGGL(dit_fwd, dim3(GRID), dim3(NTHREADS), LDS_BYTES, stream, p);
}
```
